# Optimizing an MI355X kernel written in HIP

```python
import math
import jax, jax.numpy as jnp
from jax import lax
import numpy as np

D_MODEL = 2048
BATCH = 4
SEQ = 8192
DEPTH = 4

CHUNK = 64
N_MIXERS = 3
EPS = 1e-6
MASK_VALUE = -1e30

ATT_HEADS = 16
ATT_HEAD_DIM = D_MODEL // ATT_HEADS
LEFT_CHUNKS = 8
BAND_LEFT = LEFT_CHUNKS * CHUNK
BAND = (LEFT_CHUNKS + 1) * CHUNK
MAX_REL = 256
NUM_REL = (CHUNK - 1) + MAX_REL + 1

POOL_WINDOWS = (2, 4, 8, 16)
POOL_GROUPS = len(POOL_WINDOWS)
POOL_DIM = D_MODEL // POOL_GROUPS

GDN_K_HEADS = 16
GDN_V_HEADS = 32
GDN_K_DIM = D_MODEL // GDN_K_HEADS
GDN_V_DIM = D_MODEL // GDN_K_HEADS
GDN_KEY = GDN_K_HEADS * GDN_K_DIM
GDN_VAL = GDN_V_HEADS * GDN_V_DIM
GDN_CONV = 4
GDN_CONV_CH = 2 * GDN_KEY + GDN_VAL
GDN_IN = GDN_CONV_CH + GDN_VAL + 2 * GDN_V_HEADS

D_FF = 128 * ((8 * D_MODEL // 3 + 127) // 128)
FFN_CONV = 3

N_ATT_LAYERS = (DEPTH + 2) // 3
N_POOL_LAYERS = (DEPTH + 1) // 3
N_GDN_LAYERS = DEPTH // 3

kernel_name = "hybrid_chunk_causal_encoder"


def rms_norm(x, gain):
    xf = x.astype(jnp.float32)
    y = xf * lax.rsqrt(jnp.mean(xf * xf, axis=-1, keepdims=True) + EPS)
    return (y * gain.astype(jnp.float32)).astype(x.dtype)


def l2_norm(x):
    xf = x.astype(jnp.float32)
    return xf * lax.rsqrt(jnp.sum(xf * xf, axis=-1, keepdims=True) + EPS)


def causal_depthwise_conv(x, w):
    k = w.shape[0]
    s = x.shape[1]
    xp = jnp.pad(x, ((0, 0), (k - 1, 0), (0, 0)))
    out = xp[:, 0:s] * w[0]
    for j in range(1, k):
        out = out + xp[:, j:j + s] * w[j]
    return out


def chunk_band_attention(h, w_qkv, q_gain, k_gain, rel_bias, w_o):
    b, s, d = h.shape
    nc = s // CHUNK
    qkv = h @ w_qkv
    q = qkv[..., :d].reshape(b, s, ATT_HEADS, ATT_HEAD_DIM)
    k = qkv[..., d:2 * d].reshape(b, s, ATT_HEADS, ATT_HEAD_DIM)
    v = qkv[..., 2 * d:].reshape(b, s, ATT_HEADS, ATT_HEAD_DIM)
    q = rms_norm(q, q_gain)
    k = rms_norm(k, k_gain)
    k_pad = jnp.pad(k, ((0, 0), (BAND_LEFT, 0), (0, 0), (0, 0)))
    v_pad = jnp.pad(v, ((0, 0), (BAND_LEFT, 0), (0, 0), (0, 0)))
    rel = BAND_LEFT + jnp.arange(CHUNK)[:, None] - jnp.arange(BAND)[None, :]
    rel_idx = jnp.clip(rel, -(CHUNK - 1), MAX_REL) + (CHUNK - 1)
    bias = rel_bias.astype(jnp.float32)[:, rel_idx]
    scale = ATT_HEAD_DIM ** -0.5
    q_chunks = q.reshape(b, nc, CHUNK, ATT_HEADS, ATT_HEAD_DIM).transpose(1, 0, 2, 3, 4)

    def per_chunk(args):
        c, qc = args
        kb = lax.dynamic_slice_in_dim(k_pad, c * CHUNK, BAND, axis=1)
        vb = lax.dynamic_slice_in_dim(v_pad, c * CHUNK, BAND, axis=1)
        sc = jnp.einsum('bqhd,bkhd->bhqk', qc, kb,
                        preferred_element_type=jnp.float32) * scale + bias
        valid = (c * CHUNK - BAND_LEFT + jnp.arange(BAND)) >= 0
        sc = jnp.where(valid[None, None, None, :], sc, MASK_VALUE)
        p = jax.nn.softmax(sc, axis=-1).astype(vb.dtype)
        return jnp.einsum('bhqk,bkhd->bqhd', p, vb)

    o = lax.map(per_chunk, (jnp.arange(nc, dtype=jnp.int32), q_chunks))
    o = o.transpose(1, 0, 2, 3, 4).reshape(b, s, d)
    return o @ w_o


def multiscale_pool_mixer(h, pool_w, pool_scale):
    b, s, d = h.shape
    hf = h.astype(jnp.float32)
    cs = jnp.cumsum(jnp.pad(hf, ((0, 0), (1, 0), (0, 0))), axis=1)
    pos = jnp.arange(s)
    groups = []
    for g, w in enumerate(POOL_WINDOWS):
        csg = cs[..., g * POOL_DIM:(g + 1) * POOL_DIM]
        upper = csg[:, 1:]
        lower = jnp.pad(csg[:, :s + 1 - w], ((0, 0), (w - 1, 0), (0, 0)))
        count = jnp.minimum(pos + 1, w).astype(jnp.float32)[None, :, None]
        groups.append((upper - lower) / count - hf[..., g * POOL_DIM:(g + 1) * POOL_DIM])
    pooled = jnp.stack(groups, axis=2)
    y = jnp.einsum('bsgc,gce->bsge', pooled, pool_w.astype(jnp.float32)).reshape(b, s, d)
    return (y * pool_scale.astype(jnp.float32)).astype(h.dtype)


def gated_delta_rule(q, k, v, g, beta):
    b, s, h, dk = q.shape
    dv = v.shape[-1]
    nc = s // CHUNK

    def to_chunks(t):
        return t.reshape(b, nc, CHUNK, h, -1).transpose(0, 3, 1, 2, 4)

    q, k, v = to_chunks(q), to_chunks(k), to_chunks(v)
    g = g.reshape(b, nc, CHUNK, h).transpose(0, 3, 1, 2)
    beta = beta.reshape(b, nc, CHUNK, h).transpose(0, 3, 1, 2)
    gc = jnp.cumsum(g, axis=-1)
    idx = jnp.arange(CHUNK)
    causal = idx[:, None] >= idx[None, :]
    strict = idx[:, None] > idx[None, :]
    diff = gc[..., :, None] - gc[..., None, :]
    decay = jnp.where(causal, jnp.exp(jnp.where(causal, diff, 0.0)), 0.0)
    kb = k * beta[..., None]
    vb = v * beta[..., None]
    a_strict = jnp.where(strict, jnp.einsum('bhncd,bhnjd->bhncj', kb, k) * decay, 0.0)
    eye = jnp.eye(CHUNK, dtype=jnp.float32)
    rhs = jnp.concatenate([vb, kb * jnp.exp(gc)[..., None]], axis=-1)
    sol = lax.linalg.triangular_solve(a_strict + eye, rhs, left_side=True, lower=True,
                                      unit_diagonal=True)
    u = sol[..., :dv]
    w = sol[..., dv:]
    attn = jnp.einsum('bhncd,bhnjd->bhncj', q, k) * decay
    qg = q * jnp.exp(gc)[..., None]
    k_state = k * jnp.exp(gc[..., -1:] - gc)[..., None]
    chunk_decay = jnp.exp(gc[..., -1])
    xs = tuple(jnp.moveaxis(t, 2, 0) for t in (qg, attn, u, w, k_state, chunk_decay))

    def step(state, inp):
        qg_c, attn_c, u_c, w_c, ks_c, dec_c = inp
        v_new = u_c - jnp.einsum('bhcd,bhde->bhce', w_c, state)
        o_c = (jnp.einsum('bhcd,bhde->bhce', qg_c, state)
               + jnp.einsum('bhcj,bhje->bhce', attn_c, v_new))
        state = state * dec_c[..., None, None] + jnp.einsum('bhcd,bhce->bhde', ks_c, v_new)
        return state, o_c

    state0 = jnp.zeros((b, h, dk, dv), jnp.float32)
    _, o = lax.scan(step, state0, xs)
    return o.transpose(1, 0, 3, 2, 4).reshape(b, s, h, dv)


def gated_deltanet_mixer(h, w_in, conv_w, a_log, dt_bias, o_gain, w_o):
    b, s, _ = h.shape
    proj = h @ w_in
    qkv = jax.nn.silu(causal_depthwise_conv(proj[..., :GDN_CONV_CH], conv_w))
    gate = proj[..., GDN_CONV_CH:GDN_CONV_CH + GDN_VAL]
    a = proj[..., GDN_CONV_CH + GDN_VAL:GDN_CONV_CH + GDN_VAL + GDN_V_HEADS]
    bt = proj[..., GDN_CONV_CH + GDN_VAL + GDN_V_HEADS:]
    q = qkv[..., :GDN_KEY].reshape(b, s, GDN_K_HEADS, GDN_K_DIM)
    k = qkv[..., GDN_KEY:2 * GDN_KEY].reshape(b, s, GDN_K_HEADS, GDN_K_DIM)
    v = qkv[..., 2 * GDN_KEY:].reshape(b, s, GDN_V_HEADS, GDN_V_DIM).astype(jnp.float32)
    q = l2_norm(q) * (GDN_K_DIM ** -0.5)
    k = l2_norm(k)
    rep = GDN_V_HEADS // GDN_K_HEADS
    q = jnp.repeat(q, rep, axis=2)
    k = jnp.repeat(k, rep, axis=2)
    beta = jax.nn.sigmoid(bt.astype(jnp.float32))
    g = -jnp.exp(a_log.astype(jnp.float32)) * jax.nn.softplus(
        a.astype(jnp.float32) + dt_bias.astype(jnp.float32))
    o = gated_delta_rule(q, k, v, g, beta)
    o = rms_norm(o, o_gain) * jax.nn.silu(
        gate.astype(jnp.float32).reshape(b, s, GDN_V_HEADS, GDN_V_DIM))
    return o.reshape(b, s, GDN_VAL).astype(h.dtype) @ w_o


def conv_ffn(h, w_up, conv_w, w_down):
    up = h @ w_up
    u = causal_depthwise_conv(up[..., :D_FF], conv_w)
    return (jax.nn.silu(u) * up[..., D_FF:]) @ w_down


def _normal(k, shape, scale):
    return scale * jax.random.normal(k, shape, jnp.float32)


def setup_inputs(seed: int = 0) -> dict:
    key = jax.random.key(seed)
    ks = jax.random.split(key, 24)
    d = D_MODEL
    dt = jnp.exp(jax.random.uniform(ks[14], (N_GDN_LAYERS, GDN_V_HEADS), jnp.float32,
                                    minval=math.log(1e-3), maxval=math.log(1e-1)))
    return {
        "x": _normal(ks[0], (BATCH, SEQ, d), 1.0),
        "mix_norm": 1.0 + _normal(ks[1], (DEPTH, d), 0.02),
        "ffn_norm": 1.0 + _normal(ks[2], (DEPTH, d), 0.02),
        "att_w_qkv": _normal(ks[3], (N_ATT_LAYERS, d, 3 * d), d ** -0.5),
        "att_q_gain": 1.0 + _normal(ks[4], (N_ATT_LAYERS, ATT_HEAD_DIM), 0.02),
        "att_k_gain": 1.0 + _normal(ks[5], (N_ATT_LAYERS, ATT_HEAD_DIM), 0.02),
        "att_rel_bias": _normal(ks[6], (N_ATT_LAYERS, ATT_HEADS, NUM_REL), 0.2),
        "att_w_o": _normal(ks[7], (N_ATT_LAYERS, d, d), d ** -0.5),
        "pool_w": _normal(ks[8], (N_POOL_LAYERS, POOL_GROUPS, POOL_DIM, POOL_DIM),
                           POOL_DIM ** -0.5),
        "pool_scale": 1.0 + _normal(ks[9], (N_POOL_LAYERS, d), 0.1),
        "gdn_w_in": _normal(ks[10], (N_GDN_LAYERS, d, GDN_IN), d ** -0.5),
        "gdn_conv": _normal(ks[11], (N_GDN_LAYERS, GDN_CONV, GDN_CONV_CH), GDN_CONV ** -0.5),
        "gdn_a_log": jnp.log(jax.random.uniform(ks[12], (N_GDN_LAYERS, GDN_V_HEADS),
                                                 jnp.float32, minval=1.0, maxval=16.0)),
        "gdn_dt_bias": dt + jnp.log(-jnp.expm1(-dt)),
        "gdn_o_gain": 1.0 + _normal(ks[13], (N_GDN_LAYERS, GDN_V_DIM), 0.02),
        "gdn_w_o": _normal(ks[15], (N_GDN_LAYERS, GDN_VAL, d), GDN_VAL ** -0.5),
        "ffn_w_up": _normal(ks[16], (DEPTH, d, 2 * D_FF), d ** -0.5),
        "ffn_conv": _normal(ks[17], (DEPTH, FFN_CONV, D_FF), FFN_CONV ** -0.5),
        "ffn_w_down": _normal(ks[18], (DEPTH, D_FF, d), D_FF ** -0.5),
    }


def reference(x, mix_norm, ffn_norm, att_w_qkv, att_q_gain, att_k_gain, att_rel_bias,
              att_w_o, pool_w, pool_scale, gdn_w_in, gdn_conv, gdn_a_log, gdn_dt_bias,
              gdn_o_gain, gdn_w_o, ffn_w_up, ffn_conv, ffn_w_down):
    for i in range(DEPTH):
        kind = i % N_MIXERS
        j = i // N_MIXERS
        h = rms_norm(x, mix_norm[i])
        if kind == 0:
            y = chunk_band_attention(h, att_w_qkv[j], att_q_gain[j], att_k_gain[j],
                                     att_rel_bias[j], att_w_o[j])
        elif kind == 1:
            y = multiscale_pool_mixer(h, pool_w[j], pool_scale[j])
        else:
            y = gated_deltanet_mixer(h, gdn_w_in[j], gdn_conv[j], gdn_a_log[j],
                                     gdn_dt_bias[j], gdn_o_gain[j], gdn_w_o[j])
        x = x + y
        h = rms_norm(x, ffn_norm[i])
        x = x + conv_ffn(h, ffn_w_up[i], ffn_conv[i], ffn_w_down[i])
    return x
```

```cpp
#include <hip/hip_runtime.h>
#include <cstdio>
#include <cstdint>

#ifndef N_LAUNCH_MODE
#define N_LAUNCH_MODE 0
#endif

#define LAS __attribute__((address_space(3)))
#define GAS __attribute__((address_space(1)))
typedef unsigned short bf16_t;
typedef short bf16x8 __attribute__((ext_vector_type(8)));
typedef short s16x4 __attribute__((ext_vector_type(4)));
typedef float f32x4 __attribute__((ext_vector_type(4)));
typedef float f32x2 __attribute__((ext_vector_type(2)));
typedef float f32x16 __attribute__((ext_vector_type(16)));
typedef unsigned u32x4 __attribute__((ext_vector_type(4)));
typedef unsigned u32x2 __attribute__((ext_vector_type(2)));

constexpr int D = 2048, BATCH = 4, SEQ = 8192, T = BATCH * SEQ;
constexpr int CH = 64, NCH = SEQ / CH;
constexpr int AH = 16, AHD = 128, NREL = 320;
constexpr int GKH = 16, GVH = 32, GIN = 12352, GINP = 12544;
constexpr int FF = 5504, FF2 = 11008;
constexpr int MH = T / 2;
constexpr float EPS = 1e-6f;
constexpr int NTHREADS = 512, NWAVES = 8;

constexpr size_t MiB = 1u << 20;
constexpr size_t WS_CTL = 0, CTL_ZERO_BYTES = 1 * MiB;
constexpr size_t WS_WQKV = 1 * MiB;
constexpr size_t WS_WO   = WS_WQKV + 48 * MiB;
constexpr size_t WS_WPOOL= WS_WO + 16 * MiB;
constexpr size_t WS_WGIN = WS_WPOOL + 2 * MiB;
constexpr size_t WS_WGO  = WS_WGIN + 49 * MiB;
constexpr size_t WS_WUP  = WS_WGO + 16 * MiB;
constexpr size_t WS_WDN  = WS_WUP + 172 * MiB;
constexpr size_t WS_H    = WS_WDN + 86 * MiB;
constexpr size_t WS_BIG  = WS_H + 128 * MiB;
constexpr size_t WS_QKV  = WS_BIG;
constexpr size_t WS_AO   = WS_QKV + 384 * MiB;
constexpr size_t WS_UP   = WS_BIG;
constexpr size_t WS_POOLED = WS_BIG;
constexpr size_t WS_PROJ = WS_BIG;
constexpr size_t WS_C    = WS_PROJ + 392 * MiB;
constexpr size_t WS_ATT  = WS_C + 256 * MiB;
constexpr size_t WS_AB   = WS_ATT + 64 * MiB;
constexpr size_t WS_GC   = WS_AB + 4 * MiB;
constexpr size_t WS_END  = WS_GC + 2 * MiB;
constexpr size_t WS_NEED = WS_BIG + 718 * MiB;
static_assert(WS_END <= WS_NEED && WS_UP + (size_t)T * FF2 * 2 <= WS_NEED && WS_AO + (size_t)T * D * 2 <= WS_NEED, "map");

constexpr int CW_BAR = 4096;

__device__ __forceinline__ float bf2f(unsigned b) { return __uint_as_float(b << 16); }
__device__ __forceinline__ float bflo(unsigned w) { return __uint_as_float(w << 16); }
__device__ __forceinline__ float bfhi(unsigned w) { return __uint_as_float(w & 0xffff0000u); }
__device__ __forceinline__ unsigned cvt_pk_bf16(float lo, float hi) { unsigned r; asm volatile("v_cvt_pk_bf16_f32 %0, %1, %2" : "=v"(r) : "v"(lo), "v"(hi)); return r; }
__device__ __forceinline__ unsigned f2bf(float f) { return cvt_pk_bf16(f, 0.f) & 0xffffu; }
__device__ __forceinline__ float wave_sum(float v) {
#pragma unroll
    for (int o = 1; o < 64; o <<= 1) v += __shfl_xor(v, o);
    return v;
}
__device__ __forceinline__ float siluf(float x) { return x * __builtin_amdgcn_rcpf(1.0f + __expf(-x)); }
#define LDS_WAIT() asm volatile("s_waitcnt lgkmcnt(0)" ::: "memory")
#define VM_WAIT() asm volatile("s_waitcnt vmcnt(0)" ::: "memory")

namespace pg8 {
constexpr int BM = 256, BK = 64, HALF = 128, HTB = HALF * BK * 2, STAGE_BYTES = 8 * HTB, NXCD = 8, WGM = 8;
__host__ __device__ __forceinline__ int lds_byte(int r, int c) { const int st = (r >> 4) * 2 + (c >> 5), rr = r & 15, cc = c & 31, ob = rr * 64 + cc * 2; return st * 1024 + (ob ^ (((ob >> 9) & 1) << 5)); }
__host__ __device__ __forceinline__ void stage_rc(int b, int& R, int& C) { const int st = b / 1024, sb = b % 1024, swz = sb ^ (((sb >> 9) & 1) << 5); R = (st >> 1) * 16 + swz / 64; C = (st & 1) * 32 + (swz % 64) / 2; }
__host__ __device__ __forceinline__ int perm32(int rho) { const int n = rho >> 4, i = rho & 15; return 8 * (i >> 2) + 4 * n + (i & 3); }

struct Unit { int pm, pn; };
struct Gemm { const bf16_t* A; const bf16_t* Bt; int M, N, K, lda, ldb, grp; };

struct StaticOrder {
    int nM, nN, nwg, G, c;
    __device__ void init(int M, int N, int G_, int c_) { nM = M / BM; nN = N / BM; nwg = nM * nN; G = G_; c = c_; }
    __device__ bool next(int i, Unit& u) const {
        const long L = (long)i * G + c; if (L >= nwg) return false;
        int wgid = (int)L; { const int q = nwg / NXCD, r = nwg % NXCD, xcd = wgid % NXCD, off = wgid / NXCD; wgid = (xcd < r ? xcd * (q + 1) : r * (q + 1) + (xcd - r) * q) + off; }
        const int nig = WGM * nN, gid = wgid / nig, fm = gid * WGM, gsz = (nM - fm) < WGM ? (nM - fm) : WGM;
        u.pm = fm + ((wgid % nig) % gsz); u.pn = (wgid % nig) / gsz; return true;
    }
};

struct EpiBf16 {
    static constexpr bool PERM = true;
    bf16_t* O; int ldc;
    __device__ __forceinline__ void operator()(const f32x4 (&acc)[2][2][4][2], const Unit& u, int wr, int wc, int fr, int fq) const {
        const int row0 = u.pm * BM + wr * 64 + fr, col0 = u.pn * BM + wc * 32 + 8 * fq;
#pragma unroll
        for (int ai = 0; ai < 2; ++ai)
#pragma unroll
            for (int m = 0; m < 4; ++m) { bf16_t* rowp = O + (size_t)(row0 + ai * HALF + m * 16) * ldc + col0;
#pragma unroll
                for (int bj = 0; bj < 2; ++bj) { const f32x4 v0 = acc[ai][bj][m][0], v1 = acc[ai][bj][m][1];
                    u32x4 w; w.x = cvt_pk_bf16(v0[0], v0[1]); w.y = cvt_pk_bf16(v0[2], v0[3]); w.z = cvt_pk_bf16(v1[0], v1[1]); w.w = cvt_pk_bf16(v1[2], v1[3]);
                    *(u32x4*)(rowp + bj * HALF) = w; } }
    }
};
struct EpiProj {
    static constexpr bool PERM = true;
    bf16_t* O; int ldc; float* AB;
    __device__ __forceinline__ void operator()(const f32x4 (&acc)[2][2][4][2], const Unit& u, int wr, int wc, int fr, int fq) const {
        const int row0 = u.pm * BM + wr * 64 + fr;
        if (u.pn == 48) {
            if (wc < 2) {
#pragma unroll
                for (int ai = 0; ai < 2; ++ai)
#pragma unroll
                    for (int m = 0; m < 4; ++m) { float* rp = AB + (size_t)(row0 + ai * HALF + m * 16) * 64 + wc * 32 + 8 * fq;
                        *(f32x4*)(rp) = acc[ai][0][m][0]; *(f32x4*)(rp + 4) = acc[ai][0][m][1]; }
            }
            return;
        }
        const int col0 = u.pn * BM + wc * 32 + 8 * fq;
#pragma unroll
        for (int ai = 0; ai < 2; ++ai)
#pragma unroll
            for (int m = 0; m < 4; ++m) { bf16_t* rowp = O + (size_t)(row0 + ai * HALF + m * 16) * ldc + col0;
#pragma unroll
                for (int bj = 0; bj < 2; ++bj) { const f32x4 v0 = acc[ai][bj][m][0], v1 = acc[ai][bj][m][1];
                    u32x4 w; w.x = cvt_pk_bf16(v0[0], v0[1]); w.y = cvt_pk_bf16(v0[2], v0[3]); w.z = cvt_pk_bf16(v1[0], v1[1]); w.w = cvt_pk_bf16(v1[2], v1[3]);
                    *(u32x4*)(rowp + bj * HALF) = w; } }
    }
};
struct EpiRes {
    static constexpr bool PERM = false;
    const float* base; float* out; int ldc; const float* scale;
    __device__ __forceinline__ void operator()(const f32x4 (&acc)[2][2][4][2], const Unit& u, int wr, int wc, int fr, int fq) const {
        const int row0 = u.pm * BM + wr * 64 + fr, col0 = u.pn * BM + wc * 32 + 4 * fq;
        f32x4 sv[2][2];
#pragma unroll
        for (int bj = 0; bj < 2; ++bj)
#pragma unroll
            for (int n = 0; n < 2; ++n) sv[bj][n] = scale ? *(const f32x4*)(scale + col0 + bj * HALF + n * 16) : (f32x4){1.f, 1.f, 1.f, 1.f};
#pragma unroll
        for (int ai = 0; ai < 2; ++ai)
#pragma unroll
            for (int m = 0; m < 4; ++m) { const size_t off = (size_t)(row0 + ai * HALF + m * 16) * ldc + col0;
#pragma unroll
                for (int bj = 0; bj < 2; ++bj)
#pragma unroll
                    for (int n = 0; n < 2; ++n) { const f32x4 bs = *(const f32x4*)(base + off + bj * HALF + n * 16);
                        *(f32x4*)(out + off + bj * HALF + n * 16) = bs + acc[ai][bj][m][n] * sv[bj][n]; } }
    }
};

template <class Epi, class Sched>
__device__ __forceinline__ void gemm_phase(LAS unsigned char* lds, const int tid, const Gemm g, const Sched& S, const Epi& E) {
    const int wid = __builtin_amdgcn_readfirstlane(tid >> 6), lane = tid & 63, wr = wid >> 2, wc = wid & 3, fr = lane & 15, fq = lane >> 4;
    const int K = g.K, nt = K / BK;
    unsigned voffA[2], voffB[2];
#pragma unroll
    for (int i = 0; i < 2; ++i) { int R, C; stage_rc(tid * 16 + i * 8192, R, C); const int Rb = Epi::PERM ? ((R & ~31) + perm32(R & 31)) : R;
        voffA[i] = (unsigned)(R * g.lda + C) * 2u; voffB[i] = (unsigned)(Rb * g.ldb + C) * 2u; }
    const size_t kstep = (size_t)(BK * 2);
    const size_t hstepA = (size_t)HALF * g.lda * 2, hstepB = (size_t)HALF * g.ldb * 2;
    const size_t tstepA = 2 * hstepA, tstepB = 2 * hstepB;
    const unsigned ldsw = (unsigned)wid * 1024u;
    const int aoff = lds_byte(wr * 64 + fr, fq * 8), boff = lds_byte(wc * 32 + fr, fq * 8);
#define PG8_SA(b, h) (((b) * 2 + (h)) * HTB)
#define PG8_SB(b, h) ((4 + (b) * 2 + (h)) * HTB)
#define PG8_STAGE(bufoff, gbase, voff) do { _Pragma("unroll") for (int _i = 0; _i < 2; ++_i) \
        __builtin_amdgcn_global_load_lds((const unsigned*)((const char*)(gbase) + (voff)[_i]), (LAS unsigned*)(lds + (bufoff) + ldsw + _i * 8192), 16, 0, 0); } while (0)
#define PG8_LDA(dst, b, h) do { _Pragma("unroll") for (int m = 0; m < 4; ++m) _Pragma("unroll") for (int k = 0; k < 2; ++k) dst[m][k] = *(const LAS bf16x8*)(lds + PG8_SA(b, h) + aoff + m * 2048 + k * 1024); } while (0)
#define PG8_LDB(dst, b, h) do { _Pragma("unroll") for (int n = 0; n < 2; ++n) _Pragma("unroll") for (int k = 0; k < 2; ++k) dst[n][k] = *(const LAS bf16x8*)(lds + PG8_SB(b, h) + boff + n * 2048 + k * 1024); } while (0)
#define PG8_MMA(ai, bj, At, Bt) do { __builtin_amdgcn_s_setprio(1); _Pragma("unroll") for (int m = 0; m < 4; ++m) _Pragma("unroll") for (int n = 0; n < 2; ++n) _Pragma("unroll") for (int k = 0; k < 2; ++k) \
        acc[ai][bj][m][n] = __builtin_amdgcn_mfma_f32_16x16x32_bf16(Bt[n][k], At[m][k], acc[ai][bj][m][n], 0, 0, 0); __builtin_amdgcn_s_setprio(0); } while (0)
#define PG8_WAIT_V(n) asm volatile("s_waitcnt vmcnt(" #n ")" ::: "memory")
#define PG8_WAIT_L(n) asm volatile("s_waitcnt lgkmcnt(" #n ")" ::: "memory")
#define PG8_BAR __builtin_amdgcn_s_barrier()
#define PG8_SCHED __builtin_amdgcn_sched_barrier(0)
#define PG8_AOFF(u) ((size_t)(u).pm * tstepA + (g.grp ? (size_t)((u).pn / g.grp) * (size_t)K * 2 : (size_t)0))
    Unit cur, nxt; int ui = 0;
    if (!S.next(0, cur)) return;
    f32x4 acc[2][2][4][2];
#pragma unroll
    for (int a = 0; a < 2; ++a)
#pragma unroll
        for (int b = 0; b < 2; ++b)
#pragma unroll
            for (int m = 0; m < 4; ++m)
#pragma unroll
                for (int n = 0; n < 2; ++n) acc[a][b][m][n] = (f32x4){0.f, 0.f, 0.f, 0.f};
    bf16x8 At[4][2], B0[2][2], B1[2][2];
    const char* cA = (const char*)g.A + PG8_AOFF(cur); const char* cB = (const char*)g.Bt + (size_t)cur.pn * tstepB;
    PG8_STAGE(PG8_SB(0, 0), cB, voffB); PG8_STAGE(PG8_SB(0, 1), cB + hstepB, voffB); PG8_STAGE(PG8_SA(0, 0), cA, voffA); PG8_STAGE(PG8_SA(0, 1), cA + hstepA, voffA);
    if (wr == 1) PG8_BAR;
    PG8_WAIT_V(2); PG8_BAR;
    PG8_STAGE(PG8_SB(1, 0), cB + kstep, voffB); PG8_STAGE(PG8_SA(1, 0), cA + kstep, voffA); PG8_STAGE(PG8_SB(1, 1), cB + hstepB + kstep, voffB);
    PG8_WAIT_V(6); PG8_BAR;
    for (;;) {
        const bool has_next = S.next(ui + 1, nxt);
        const char* nA = has_next ? (const char*)g.A + PG8_AOFF(nxt) : cA; const char* nB = has_next ? (const char*)g.Bt + (size_t)nxt.pn * tstepB : cB;
        for (int t = 0; t < nt; t += 2) {
            const bool last = (t == nt - 2);
            const char* a1 = cA + (size_t)(t + 1) * kstep;
            const char* a2 = last ? nA : cA + (size_t)(t + 2) * kstep; const char* b2 = last ? nB : cB + (size_t)(t + 2) * kstep;
            const char* a3 = a2 + kstep; const char* b3 = b2 + kstep;
            PG8_LDB(B0, 0, 0); PG8_LDB(B1, 0, 1); PG8_SCHED; PG8_LDA(At, 0, 0); PG8_STAGE(PG8_SA(1, 1), a1 + hstepA, voffA);
            PG8_WAIT_V(8); PG8_WAIT_L(0); PG8_BAR; PG8_MMA(0, 0, At, B0); PG8_MMA(0, 1, At, B1); PG8_BAR; PG8_SCHED;
            PG8_LDA(At, 0, 1); PG8_STAGE(PG8_SB(0, 0), b2, voffB); PG8_STAGE(PG8_SB(0, 1), b2 + hstepB, voffB); PG8_STAGE(PG8_SA(0, 0), a2, voffA);
            PG8_WAIT_V(8); PG8_WAIT_L(0); PG8_BAR; PG8_MMA(1, 0, At, B0); PG8_MMA(1, 1, At, B1); PG8_BAR; PG8_SCHED;
            PG8_LDB(B0, 1, 0); PG8_LDB(B1, 1, 1); PG8_SCHED; PG8_LDA(At, 1, 0); PG8_STAGE(PG8_SA(0, 1), a2 + hstepA, voffA);
            PG8_WAIT_V(8); PG8_WAIT_L(0); PG8_BAR; PG8_MMA(0, 0, At, B0); PG8_MMA(0, 1, At, B1); PG8_BAR; PG8_SCHED;
            PG8_LDA(At, 1, 1); PG8_STAGE(PG8_SB(1, 0), b3, voffB); PG8_STAGE(PG8_SB(1, 1), b3 + hstepB, voffB); PG8_STAGE(PG8_SA(1, 0), a3, voffA);
            PG8_WAIT_V(8); PG8_WAIT_L(0); PG8_BAR; PG8_MMA(1, 0, At, B0); PG8_MMA(1, 1, At, B1); PG8_BAR; PG8_SCHED;
        }
        if (wr == 0) PG8_BAR;
        E(acc, cur, wr, wc, fr, fq);
        if (!has_next) break;
#pragma unroll
        for (int a = 0; a < 2; ++a)
#pragma unroll
            for (int b = 0; b < 2; ++b)
#pragma unroll
                for (int m = 0; m < 4; ++m)
#pragma unroll
                    for (int n = 0; n < 2; ++n) acc[a][b][m][n] = (f32x4){0.f, 0.f, 0.f, 0.f};
        cur = nxt; cA = nA; cB = nB; ++ui;
        if (wr == 1) PG8_BAR;
    }
    PG8_WAIT_V(0);
    PG8_BAR;
#undef PG8_SA
#undef PG8_SB
#undef PG8_STAGE
#undef PG8_LDA
#undef PG8_LDB
#undef PG8_MMA
#undef PG8_WAIT_V
#undef PG8_WAIT_L
#undef PG8_BAR
#undef PG8_SCHED
#undef PG8_AOFF
}
}

#define XB_TMO      128
#define XB_XCNT(j)  (256  + 64 * (j))
#define XB_XSUB(j)  (1280 + 64 * (j))
#define XB_XGEN(j)  (2304 + 64 * (j))
#define XB_TOP      3328
#define XB_TOPGEN   3392
#define XCD_BAR_WORDS 3456
#define XB_SPIN_CAP (1u << 18)
__device__ __forceinline__ unsigned xb_ld(unsigned* p)              { return __hip_atomic_load(p, __ATOMIC_RELAXED, __HIP_MEMORY_SCOPE_AGENT); }
__device__ __forceinline__ unsigned xb_add(unsigned* p, unsigned v) { return __hip_atomic_fetch_add(p, v, __ATOMIC_RELAXED, __HIP_MEMORY_SCOPE_AGENT); }
__device__ __forceinline__ unsigned xb_xcc_id() { return (unsigned)__builtin_amdgcn_s_getreg((3 << 11) | 20) & 0xFu; }
#define XB_SPIN(cond, bar) do { unsigned _sp = 0; while (cond) { __builtin_amdgcn_s_sleep(1); \
    if ((++_sp & 255u) == 0u) { if (xb_ld(&(bar)[XB_TMO])) break; if (_sp > XB_SPIN_CAP) { atomicAdd(&(bar)[XB_TMO], 1u); break; } } } } while (0)
struct XcdBarrier { unsigned* bar; unsigned x; volatile LAS unsigned* st; };
__device__ __forceinline__ XcdBarrier xcd_barrier_post(unsigned* bar, volatile LAS unsigned* st) {
    XcdBarrier b; b.bar = bar; b.x = xb_xcc_id(); b.st = st;
    if (threadIdx.x == 0) (void)xb_add(&bar[XB_XCNT(b.x)], 1u);
    return b;
}
__device__ __forceinline__ void xcd_barrier_complete(unsigned* bar, unsigned x, unsigned& nloc, unsigned& nx) {
    const unsigned G = gridDim.x * gridDim.y * gridDim.z;
    unsigned sum, cnt, mine, sp = 0u;
    for (;;) {
        sum = 0u; cnt = 0u; mine = 0u;
#pragma unroll
        for (unsigned j = 0; j < 16; ++j) { const unsigned c = xb_ld(&bar[XB_XCNT(j)]); sum += c; cnt += (c > 0u) ? 1u : 0u; mine = (j == x) ? c : mine; }
        if (sum == G) break;
        __builtin_amdgcn_s_sleep(1);
        if ((++sp & 255u) == 0u) { if (xb_ld(&bar[XB_TMO])) break; if (sp > XB_SPIN_CAP) { atomicAdd(&bar[XB_TMO], 1u); break; } }
    }
    nloc = mine > 0u ? mine : 1u; nx = cnt > 0u ? cnt : 1u;
}
__device__ __forceinline__ void xcd_barrier(const XcdBarrier& b) {
    asm volatile("s_waitcnt vmcnt(0)" ::: "memory");
    __syncthreads();
    if (threadIdx.x == 0) {
        unsigned* bar = b.bar;
        __builtin_amdgcn_s_waitcnt(0);
        unsigned nloc = b.st[0], nx = b.st[1];
        if (nloc == 0u) { xcd_barrier_complete(bar, b.x, nloc, nx); b.st[0] = nloc; b.st[1] = nx; }
        const unsigned old = xb_add(&bar[XB_XSUB(b.x)], 1u);
        const unsigned gen = old / nloc;
        if (old + 1u == (gen + 1u) * nloc) {
            __builtin_amdgcn_fence(__ATOMIC_RELEASE, "agent");
            asm volatile("s_waitcnt vmcnt(0)" ::: "memory");
            const unsigned og = xb_add(&bar[XB_TOP], 1u);
            const unsigned tg = og / nx;
            if (og + 1u == (tg + 1u) * nx) xb_add(&bar[XB_TOPGEN], 1u);
            else XB_SPIN(xb_ld(&bar[XB_TOPGEN]) == tg, bar);
            __builtin_amdgcn_fence(__ATOMIC_ACQUIRE, "agent");
            xb_add(&bar[XB_XGEN(b.x)], 1u);
            asm volatile("s_waitcnt vmcnt(0)" ::: "memory");
        } else {
            XB_SPIN(xb_ld(&bar[XB_XGEN(b.x)]) == gen, bar);
            __builtin_amdgcn_fence(__ATOMIC_ACQUIRE, "agent");
            asm volatile("s_waitcnt vmcnt(0)" ::: "memory");
        }
    }
    __syncthreads();
}

constexpr int LDS_BYTES = 163840;
constexpr int MISC_OFF = LDS_BYTES - 256;

struct WDesc { const float* W; bf16_t* WT; int K, N, nmat, pad; };
struct Args {
    const float* x; const float* mix_norm; const float* ffn_norm;
    const float* att_q_gain; const float* att_k_gain; const float* att_rel_bias;
    const float* pool_scale; const float* gdn_conv; const float* gdn_a_log; const float* gdn_dt_bias; const float* gdn_o_gain; const float* ffn_conv;
    float* out; unsigned char* ws;
    WDesc wd[7];
    int ph_lo, ph_hi;
};

struct Ctx { LAS unsigned char* lds; int tid, lane, wave, G, bid; };

__device__ __forceinline__ void transpose_item(const float* W, int K, int N, bf16_t* WT, LAS float* scr, int item, int lane) {
    const int nblk = N / 32, kb = item / nblk, nb = item % nblk, k0 = 64 * kb, n0 = 32 * nb;
#pragma unroll 8
    for (int i = 0; i < 32; ++i) { const int kk = 2 * i + (lane >> 5); scr[kk * 33 + (lane & 31)] = W[(size_t)(k0 + kk) * N + n0 + (lane & 31)]; }
    LDS_WAIT();
    const int c = lane & 7;
#pragma unroll
    for (int j = 0; j < 4; ++j) { const int n = (lane >> 3) + 8 * j; const LAS float* s = scr + (8 * c) * 33 + n;
        u32x4 o; o.x = cvt_pk_bf16(s[0 * 33], s[1 * 33]); o.y = cvt_pk_bf16(s[2 * 33], s[3 * 33]); o.z = cvt_pk_bf16(s[4 * 33], s[5 * 33]); o.w = cvt_pk_bf16(s[6 * 33], s[7 * 33]);
        *(u32x4*)(WT + (size_t)(n0 + n) * K + k0 + 8 * c) = o; }
    LDS_WAIT();
}
typedef const __attribute__((address_space(4))) struct Args* KArgsP0;
__device__ __forceinline__ void phase_weights(const Ctx& c, KArgsP0 a) {
    LAS float* scr = (LAS float*)(c.lds + c.wave * 16384);
    const int gw = c.bid * NWAVES + c.wave, NGW = c.G * NWAVES;
#pragma unroll
    for (int d = 0; d < 7; ++d) {
        const float* W = a->wd[d].W; bf16_t* WT = a->wd[d].WT; const int K = a->wd[d].K, N = a->wd[d].N, nmat = a->wd[d].nmat;
        const int per = (K / 64) * (N / 32), tot = per * nmat;
        for (int it = gw; it < tot; it += NGW) { const int mat = it / per, r = it - mat * per;
            transpose_item(W + (size_t)mat * K * N, K, N, WT + (size_t)mat * K * N, scr, r, c.lane); }
    }
    { u32x4* z = (u32x4*)(a->ws + WS_WGIN + (size_t)GIN * D * 2); const int n16 = (GINP - GIN) * D * 2 / 16;
      for (int i = c.bid * NTHREADS + c.tid; i < n16; i += c.G * NTHREADS) z[i] = (u32x4){0u, 0u, 0u, 0u}; }
}

__device__ __forceinline__ void phase_rmsnorm(const Ctx& c, const float* x, const float* gain, bf16_t* out) {
    const int gw = c.bid * NWAVES + c.wave, NGW = c.G * NWAVES;
    f32x4 gv[8];
#pragma unroll
    for (int j = 0; j < 8; ++j) gv[j] = *(const f32x4*)(gain + 4 * c.lane + 256 * j);
    for (int m = gw; m < T; m += NGW) {
        const f32x4* xr = (const f32x4*)(x + (size_t)m * D) + c.lane;
        f32x4 v[8]; float s = 0.f;
#pragma unroll
        for (int j = 0; j < 8; ++j) { v[j] = xr[64 * j]; s += (v[j].x * v[j].x + v[j].y * v[j].y) + (v[j].z * v[j].z + v[j].w * v[j].w); }
        const float rstd = 1.0f / sqrtf(wave_sum(s) * (1.0f / D) + EPS);
        u32x2* o8 = (u32x2*)(out + (size_t)m * D) + c.lane;
#pragma unroll
        for (int j = 0; j < 8; ++j) { u32x2 w; w.x = cvt_pk_bf16(v[j].x * rstd * gv[j].x, v[j].y * rstd * gv[j].y); w.y = cvt_pk_bf16(v[j].z * rstd * gv[j].z, v[j].w * rstd * gv[j].w); o8[64 * j] = w; }
    }
}

__device__ __forceinline__ void phase_ffn_act(const Ctx& c, bf16_t* UP, const float* cw) {
    constexpr int NCG = FF / 8;
    constexpr int RB = 32;
    const int nitems = (T / RB) * NCG;
    for (int it = c.bid * NTHREADS + c.tid; it < nitems; it += c.G * NTHREADS) {
        const int rb = it / NCG, cg = it - rb * NCG, t0 = rb * RB, col = cg * 8;
        float w0[8], w1[8], w2[8];
#pragma unroll
        for (int k = 0; k < 8; k += 4) { const f32x4 a0 = *(const f32x4*)(cw + col + k), a1 = *(const f32x4*)(cw + FF + col + k), a2 = *(const f32x4*)(cw + 2 * FF + col + k);
#pragma unroll
            for (int q = 0; q < 4; ++q) { w0[k + q] = a0[q]; w1[k + q] = a1[q]; w2[k + q] = a2[q]; } }
        float p1[8], p2[8];
        if ((t0 % SEQ) == 0) {
#pragma unroll
            for (int k = 0; k < 8; ++k) { p1[k] = 0.f; p2[k] = 0.f; }
        } else {
            const u32x4 a = *(const u32x4*)(UP + (size_t)(t0 - 1) * FF2 + col), b = *(const u32x4*)(UP + (size_t)(t0 - 2) * FF2 + col);
#pragma unroll
            for (int k = 0; k < 4; ++k) { p1[2 * k] = bflo(a[k]); p1[2 * k + 1] = bfhi(a[k]); p2[2 * k] = bflo(b[k]); p2[2 * k + 1] = bfhi(b[k]); }
        }
#pragma unroll 4
        for (int t = t0; t < t0 + RB; ++t) {
            const u32x4 uu = *(const u32x4*)(UP + (size_t)t * FF2 + col), gg = *(const u32x4*)(UP + (size_t)t * FF2 + FF + col);
            float cu[8], gt[8], r[8];
#pragma unroll
            for (int k = 0; k < 4; ++k) { cu[2 * k] = bflo(uu[k]); cu[2 * k + 1] = bfhi(uu[k]); gt[2 * k] = bflo(gg[k]); gt[2 * k + 1] = bfhi(gg[k]); }
#pragma unroll
            for (int k = 0; k < 8; ++k) { const float s = w0[k] * p2[k] + w1[k] * p1[k] + w2[k] * cu[k]; r[k] = siluf(s) * gt[k]; p2[k] = p1[k]; p1[k] = cu[k]; }
            u32x4 o; o.x = cvt_pk_bf16(r[0], r[1]); o.y = cvt_pk_bf16(r[2], r[3]); o.z = cvt_pk_bf16(r[4], r[5]); o.w = cvt_pk_bf16(r[6], r[7]);
            *(u32x4*)(UP + (size_t)t * FF2 + FF + col) = o;
        }
    }
}

__device__ __forceinline__ void phase_pool_prep(const Ctx& c, const bf16_t* H, bf16_t* P) {
    constexpr int NCG = D / 8, RB = 64;
    const int nitems = (T / RB) * NCG;
    for (int it = c.bid * NTHREADS + c.tid; it < nitems; it += c.G * NTHREADS) {
        const int rb = it / NCG, cg = it - rb * NCG, t0 = rb * RB, col = cg * 8, w = 2 << (col >> 9), tp0 = t0 % SEQ;
        float s[8];
#pragma unroll
        for (int k = 0; k < 8; ++k) s[k] = 0.f;
        for (int i = 1; i <= w; ++i) if (tp0 - i >= 0) {   const u32x4 a = *(const u32x4*)(H + (size_t)(t0 - i) * D + col);
#pragma unroll
            for (int k = 0; k < 4; ++k) { s[2 * k] += bflo(a[k]); s[2 * k + 1] += bfhi(a[k]); } }
        for (int t = t0; t < t0 + RB; ++t) {
            const int tp = tp0 + (t - t0);
            const u32x4 a = *(const u32x4*)(H + (size_t)t * D + col);
            float cu[8];
#pragma unroll
            for (int k = 0; k < 4; ++k) { cu[2 * k] = bflo(a[k]); cu[2 * k + 1] = bfhi(a[k]); }
#pragma unroll
            for (int k = 0; k < 8; ++k) s[k] += cu[k];
            if (tp >= w) { const u32x4 b = *(const u32x4*)(H + (size_t)(t - w) * D + col);
#pragma unroll
                for (int k = 0; k < 4; ++k) { s[2 * k] -= bflo(b[k]); s[2 * k + 1] -= bfhi(b[k]); } }
            const float inv = 1.0f / (float)(tp + 1 < w ? tp + 1 : w);
            u32x4 o; o.x = cvt_pk_bf16(s[0] * inv - cu[0], s[1] * inv - cu[1]); o.y = cvt_pk_bf16(s[2] * inv - cu[2], s[3] * inv - cu[3]);
            o.z = cvt_pk_bf16(s[4] * inv - cu[4], s[5] * inv - cu[5]); o.w = cvt_pk_bf16(s[6] * inv - cu[6], s[7] * inv - cu[7]);
            *(u32x4*)(P + (size_t)t * D + col) = o;
        }
    }
}

constexpr int ATT_ROWB = 272;
constexpr int ATT_WAVE_BYTES = 2 * 32 * ATT_ROWB + NREL * 4;
static_assert(ATT_WAVE_BYTES * NWAVES <= MISC_OFF, "attention LDS");
__device__ __forceinline__ void phase_attention(const Ctx& c, const bf16_t* QKV, bf16_t* O, const float* q_gain, const float* k_gain, const float* rel_bias) {
    LAS unsigned char* Kt = c.lds + c.wave * ATT_WAVE_BYTES;
    LAS unsigned char* Vt = Kt + 32 * ATT_ROWB;
    LAS float* bias = (LAS float*)(Vt + 32 * ATT_ROWB);
    const int lane = c.lane, l31 = lane & 31, hh = lane >> 5;
    const int gw = c.bid * NWAVES + c.wave, NGW = c.G * NWAVES;
    constexpr int NU = BATCH * NCH * AH * 2;
    const float scale = 0.08838834764831845f;
    float kg[8];
    { const int ch = lane & 15; const f32x4 a = *(const f32x4*)(k_gain + ch * 8), b = *(const f32x4*)(k_gain + ch * 8 + 4);
#pragma unroll
      for (int k = 0; k < 4; ++k) { kg[k] = a[k]; kg[4 + k] = b[k]; } }
    for (int u = gw; u < NU; u += NGW) {
        const int qh = u & 1, h = (u >> 1) & 15, ck = (u >> 5) & 127, b = u >> 12;
        const size_t row_q0 = (size_t)b * SEQ + (size_t)ck * CH + qh * 32;
        for (int i = lane; i < NREL; i += 64) bias[i] = rel_bias[h * NREL + i];
        bf16x8 qf[8];
        {
            float qv[8][8]; float ss = 0.f;
            const bf16_t* qp = QKV + (row_q0 + l31) * 6144 + h * AHD + hh * 8;
#pragma unroll
            for (int ks = 0; ks < 8; ++ks) { const u32x4 a = *(const u32x4*)(qp + ks * 16);
#pragma unroll
                for (int k = 0; k < 4; ++k) { qv[ks][2 * k] = bflo(a[k]); qv[ks][2 * k + 1] = bfhi(a[k]); }
#pragma unroll
                for (int k = 0; k < 8; ++k) ss += qv[ks][k] * qv[ks][k]; }
            ss += __shfl_xor(ss, 32);
            const float rq = scale / sqrtf(ss * (1.0f / AHD) + EPS);
#pragma unroll
            for (int ks = 0; ks < 8; ++ks) { const f32x4 g0 = *(const f32x4*)(q_gain + ks * 16 + hh * 8), g1 = *(const f32x4*)(q_gain + ks * 16 + hh * 8 + 4);
                u32x4 w; w.x = cvt_pk_bf16(qv[ks][0] * rq * g0[0], qv[ks][1] * rq * g0[1]); w.y = cvt_pk_bf16(qv[ks][2] * rq * g0[2], qv[ks][3] * rq * g0[3]);
                w.z = cvt_pk_bf16(qv[ks][4] * rq * g1[0], qv[ks][5] * rq * g1[1]); w.w = cvt_pk_bf16(qv[ks][6] * rq * g1[2], qv[ks][7] * rq * g1[3]);
                qf[ks] = __builtin_bit_cast(bf16x8, w); }
        }
        float mrun = -1e30f, lsum = 0.f;
        f32x16 oacc[4];
#pragma unroll
        for (int dt = 0; dt < 4; ++dt)
#pragma unroll
            for (int r = 0; r < 16; ++r) oacc[dt][r] = 0.f;
        const int qi = qh * 32 + l31;
        const int kt_first = (ck >= 8) ? 0 : 2 * (8 - ck);
        for (int kt = kt_first; kt < 18; ++kt) {
            const int kj0 = kt * 32;
            const size_t krow0 = (size_t)b * SEQ + (size_t)((ck - 8) * CH + kj0);
            {
                const int ch = lane & 15, rr = lane >> 4;
#pragma unroll
                for (int i = 0; i < 8; ++i) {
                    const int row = rr + 4 * i;
                    const bf16_t* kp = QKV + (krow0 + row) * 6144 + 2048 + h * AHD + ch * 8;
                    const u32x4 a = *(const u32x4*)kp, vv = *(const u32x4*)(kp + 2048);
                    float kv[8]; float ss = 0.f;
#pragma unroll
                    for (int k = 0; k < 4; ++k) { kv[2 * k] = bflo(a[k]); kv[2 * k + 1] = bfhi(a[k]); }
#pragma unroll
                    for (int k = 0; k < 8; ++k) ss += kv[k] * kv[k];
                    ss += __shfl_xor(ss, 1); ss += __shfl_xor(ss, 2); ss += __shfl_xor(ss, 4); ss += __shfl_xor(ss, 8);
                    const float rk = 1.0f / sqrtf(ss * (1.0f / AHD) + EPS);
                    u32x4 w; w.x = cvt_pk_bf16(kv[0] * rk * kg[0], kv[1] * rk * kg[1]); w.y = cvt_pk_bf16(kv[2] * rk * kg[2], kv[3] * rk * kg[3]);
                    w.z = cvt_pk_bf16(kv[4] * rk * kg[4], kv[5] * rk * kg[5]); w.w = cvt_pk_bf16(kv[6] * rk * kg[6], kv[7] * rk * kg[7]);
                    *(LAS u32x4*)(Kt + row * ATT_ROWB + ch * 16) = w;
                    *(LAS u32x4*)(Vt + row * ATT_ROWB + ch * 16) = vv;
                }
            }
            LDS_WAIT();
            f32x16 st;
#pragma unroll
            for (int r = 0; r < 16; ++r) st[r] = 0.f;
#pragma unroll
            for (int ks = 0; ks < 8; ++ks) { const bf16x8 kf = *(const LAS bf16x8*)(Kt + l31 * ATT_ROWB + ks * 32 + hh * 16);
                st = __builtin_amdgcn_mfma_f32_32x32x16_bf16(kf, qf[ks], st, 0, 0, 0); }
            float mt = -1e30f;
#pragma unroll
            for (int r = 0; r < 16; ++r) { const int kj = kj0 + (r & 3) + 8 * (r >> 2) + 4 * hh; int idx = 575 + qi - kj; idx = idx > 319 ? 319 : idx; st[r] += bias[idx]; mt = fmaxf(mt, st[r]); }
            mt = fmaxf(mt, __shfl_xor(mt, 32));
            const float mnew = fmaxf(mrun, mt), alpha = __expf(mrun - mnew);
            mrun = mnew;
            float ps = 0.f;
#pragma unroll
            for (int r = 0; r < 16; ++r) { st[r] = __expf(st[r] - mnew); ps += st[r]; }
            lsum = lsum * alpha + ps;
#pragma unroll
            for (int dt = 0; dt < 4; ++dt)
#pragma unroll
                for (int r = 0; r < 16; ++r) oacc[dt][r] *= alpha;
            bf16x8 pf[2];
#pragma unroll
            for (int s = 0; s < 2; ++s) { u32x4 w; w.x = cvt_pk_bf16(st[8 * s + 0], st[8 * s + 1]); w.y = cvt_pk_bf16(st[8 * s + 2], st[8 * s + 3]); w.z = cvt_pk_bf16(st[8 * s + 4], st[8 * s + 5]); w.w = cvt_pk_bf16(st[8 * s + 6], st[8 * s + 7]);
                pf[s] = __builtin_bit_cast(bf16x8, w); }
            {
                const int i16 = lane & 15, g1 = (lane >> 4) & 1;
                LAS unsigned char* vb = Vt + (4 * hh + (i16 >> 2)) * ATT_ROWB + (16 * g1 + 4 * (i16 & 3)) * 2;
#pragma unroll
                for (int dt = 0; dt < 4; ++dt)
#pragma unroll
                    for (int s = 0; s < 2; ++s) {
                        const s16x4 lo = __builtin_bit_cast(s16x4, __builtin_amdgcn_ds_read_tr16_b64_v4i16((LAS s16x4*)(vb + (16 * s) * ATT_ROWB + dt * 64)));
                        const s16x4 hi = __builtin_bit_cast(s16x4, __builtin_amdgcn_ds_read_tr16_b64_v4i16((LAS s16x4*)(vb + (16 * s + 8) * ATT_ROWB + dt * 64)));
                        const bf16x8 vf = (bf16x8){lo[0], lo[1], lo[2], lo[3], hi[0], hi[1], hi[2], hi[3]};
                        oacc[dt] = __builtin_amdgcn_mfma_f32_32x32x16_bf16(vf, pf[s], oacc[dt], 0, 0, 0);
                    }
            }
            LDS_WAIT();
        }
        lsum += __shfl_xor(lsum, 32);
        const float inv = 1.0f / lsum;
        bf16_t* op = O + (row_q0 + l31) * D + h * AHD + 4 * hh;
#pragma unroll
        for (int dt = 0; dt < 4; ++dt)
#pragma unroll
            for (int g = 0; g < 4; ++g) { u32x2 w; w.x = cvt_pk_bf16(oacc[dt][4 * g] * inv, oacc[dt][4 * g + 1] * inv); w.y = cvt_pk_bf16(oacc[dt][4 * g + 2] * inv, oacc[dt][4 * g + 3] * inv);
                *(u32x2*)(op + dt * 32 + g * 8) = w; }
        LDS_WAIT();
    }
}

__device__ __forceinline__ void phase_gdn_conv(const Ctx& c, const bf16_t* PROJ, bf16_t* C, const float* cw) {
    constexpr int RB = 64;
    const int gw = c.bid * NWAVES + c.wave, NGW = c.G * NWAVES;
    const int nitems = (MH / RB) * 64;
    for (int it = gw; it < nitems; it += NGW) {
        const int rb = it >> 6, sl = it & 63, t0 = rb * RB, col = sl * 128 + 2 * c.lane;
        float w[4][2];
#pragma unroll
        for (int j = 0; j < 4; ++j) { const f32x2 a = *(const f32x2*)(cw + j * 8192 + col); w[j][0] = a.x; w[j][1] = a.y; }
        float p1[2], p2[2], p3[2];
        if ((t0 % SEQ) == 0) { p1[0] = p1[1] = p2[0] = p2[1] = p3[0] = p3[1] = 0.f; }
        else { const unsigned a = *(const unsigned*)(PROJ + (size_t)(t0 - 1) * GINP + col), b = *(const unsigned*)(PROJ + (size_t)(t0 - 2) * GINP + col), d = *(const unsigned*)(PROJ + (size_t)(t0 - 3) * GINP + col);
            p1[0] = bflo(a); p1[1] = bfhi(a); p2[0] = bflo(b); p2[1] = bfhi(b); p3[0] = bflo(d); p3[1] = bfhi(d); }
        const float qs = (sl < 16) ? 0.08838834764831845f : 1.0f;
#pragma unroll 4
        for (int t = t0; t < t0 + RB; ++t) {
            const unsigned a = *(const unsigned*)(PROJ + (size_t)t * GINP + col);
            const float c0 = bflo(a), c1 = bfhi(a);
            float y0 = siluf(w[0][0] * p3[0] + w[1][0] * p2[0] + w[2][0] * p1[0] + w[3][0] * c0);
            float y1 = siluf(w[0][1] * p3[1] + w[1][1] * p2[1] + w[2][1] * p1[1] + w[3][1] * c1);
            p3[0] = p2[0]; p3[1] = p2[1]; p2[0] = p1[0]; p2[1] = p1[1]; p1[0] = c0; p1[1] = c1;
            if (sl < 32) { const float ss = wave_sum(y0 * y0 + y1 * y1); const float r = qs / sqrtf(ss + EPS); y0 *= r; y1 *= r; }
            *(unsigned*)(C + (size_t)t * 8192 + col) = cvt_pk_bf16(y0, y1);
        }
    }
}

constexpr int G2_QS = 0, G2_KS = 17408, G2_KK = 34816, G2_QK = G2_KK + 64 * 65 * 4, G2_AT = G2_QK + 64 * 65 * 4, G2_GC = G2_AT + 2 * 64 * 64 * 4, G2_BETA = G2_GC + 512, G2_END = G2_BETA + 512;
static_assert(G2_END <= MISC_OFF, "G2 LDS");
__device__ __forceinline__ void phase_gdn_local(const Ctx& c, bf16_t* PROJ, bf16_t* C, bf16_t* ATT, const float* AB, float* GC, const float* a_log, const float* dt_bias) {
    LAS unsigned char* lds = c.lds;
    LAS float* KKs = (LAS float*)(lds + G2_KK); LAS float* QKs = (LAS float*)(lds + G2_QK); LAS float* At = (LAS float*)(lds + G2_AT);
    LAS float* gcs = (LAS float*)(lds + G2_GC); LAS float* betas = (LAS float*)(lds + G2_BETA);
    const int tid = c.tid, lane = c.lane, wave = c.wave, l31 = lane & 31, hh = lane >> 5;
    constexpr int NUNITS = (MH / CH) * GKH;
    for (int u = c.bid; u < NUNITS; u += c.G) {
        const int hk = u & 15, cg = u >> 4, r0 = cg * CH;
#pragma unroll
        for (int i = 0; i < 2; ++i) { const int idx = tid + i * 512, row = idx >> 4, ch = idx & 15;
            *(LAS u32x4*)(lds + G2_QS + row * 272 + ch * 16) = *(const u32x4*)(C + (size_t)(r0 + row) * 8192 + hk * 128 + ch * 8);
            *(LAS u32x4*)(lds + G2_KS + row * 272 + ch * 16) = *(const u32x4*)(C + (size_t)(r0 + row) * 8192 + 2048 + hk * 128 + ch * 8); }
        if (wave < 2) {
            const int hv = 2 * hk + wave;
            const float av = AB[(size_t)(r0 + lane) * 64 + hv], bv = AB[(size_t)(r0 + lane) * 64 + 32 + hv];
            const float z = av + dt_bias[hv];
            const float sp = z > 20.f ? z : log1pf(__expf(z));
            float g = -__expf(a_log[hv]) * sp;
#pragma unroll
            for (int o = 1; o < 64; o <<= 1) { const float t = __shfl_up(g, o); if (lane >= o) g += t; }
            gcs[wave * 64 + lane] = g; betas[wave * 64 + lane] = 1.0f / (1.0f + __expf(-bv));
            GC[(size_t)(r0 + lane) * 32 + hv] = g;
        }
        __syncthreads();
        {
            const int mat = wave >> 2, ti = (wave >> 1) & 1, tj = wave & 1;
            LAS unsigned char* xa = lds + (mat ? G2_QS : G2_KS) + (32 * ti + l31) * 272 + hh * 16;
            LAS unsigned char* xb = lds + G2_KS + (32 * tj + l31) * 272 + hh * 16;
            f32x16 acc;
#pragma unroll
            for (int r = 0; r < 16; ++r) acc[r] = 0.f;
#pragma unroll
            for (int ks = 0; ks < 8; ++ks) acc = __builtin_amdgcn_mfma_f32_32x32x16_bf16(*(const LAS bf16x8*)(xa + ks * 32), *(const LAS bf16x8*)(xb + ks * 32), acc, 0, 0, 0);
            LAS float* dst = mat ? QKs : KKs;
#pragma unroll
            for (int r = 0; r < 16; ++r) dst[(32 * ti + (r & 3) + 8 * (r >> 2) + 4 * hh) * 65 + 32 * tj + l31] = acc[r];
        }
        __syncthreads();
        for (int idx = tid; idx < 2 * 4096; idx += 512) { const int e = idx >> 12, j = (idx >> 6) & 63, i = idx & 63;
            At[idx] = (i > j) ? betas[e * 64 + i] * KKs[i * 65 + j] * __expf(gcs[e * 64 + i] - gcs[e * 64 + j]) : 0.f; }
        for (int idx = tid; idx < 2 * 4096; idx += 512) { const int e = idx >> 12, i = (idx >> 6) & 63, j = idx & 63;
            const float v = (i >= j) ? QKs[i * 65 + j] * __expf(gcs[e * 64 + i] - gcs[e * 64 + j]) : 0.f;
            ATT[((size_t)(cg * 32 + 2 * hk + e) * 64 + i) * 64 + j] = (bf16_t)f2bf(v); }
        __syncthreads();
        {
            const int e = tid >> 8, col = tid & 255, hv = 2 * hk + e;
            float r[64];
            if (col < 128) {
#pragma unroll
                for (int i = 0; i < 64; ++i) r[i] = betas[e * 64 + i] * bf2f(C[(size_t)(r0 + i) * 8192 + 4096 + hv * 128 + col]);
            } else {
#pragma unroll
                for (int i = 0; i < 64; ++i) r[i] = betas[e * 64 + i] * __expf(gcs[e * 64 + i]) * bf2f(*(const LAS bf16_t*)(lds + G2_KS + i * 272 + (col - 128) * 2));
            }
            const LAS float* Ae = At + e * 4096;
#pragma unroll
            for (int j = 0; j < 63; ++j) {
                const float xj = r[j];
#pragma unroll
                for (int i4 = ((j + 1) >> 2); i4 < 16; ++i4) { const f32x4 a = *(const LAS f32x4*)(Ae + j * 64 + 4 * i4);
                    r[4 * i4 + 0] -= a[0] * xj; r[4 * i4 + 1] -= a[1] * xj; r[4 * i4 + 2] -= a[2] * xj; r[4 * i4 + 3] -= a[3] * xj; }
            }
            __syncthreads();
            if (col < 128) {
                bf16_t* up = C + (size_t)(r0 + (col >> 1)) * 8192 + 4096 + hv * 128 + (col & 1) * 64;
#pragma unroll
                for (int q = 0; q < 8; ++q) { u32x4 w; w.x = cvt_pk_bf16(r[8 * q], r[8 * q + 1]); w.y = cvt_pk_bf16(r[8 * q + 2], r[8 * q + 3]); w.z = cvt_pk_bf16(r[8 * q + 4], r[8 * q + 5]); w.w = cvt_pk_bf16(r[8 * q + 6], r[8 * q + 7]);
                    *(u32x4*)(up + 8 * q) = w; }
            } else {
                bf16_t* wp = PROJ + (size_t)r0 * GINP + hv * 128 + (col - 128);
#pragma unroll
                for (int i = 0; i < 64; ++i) wp[(size_t)i * GINP] = (bf16_t)f2bf(r[i]);
            }
        }
        {
            const int dk = tid >> 2, ib = (tid & 3) * 16;
            unsigned wv[8];
#pragma unroll
            for (int q = 0; q < 8; ++q) { const unsigned lo = *(const LAS bf16_t*)(lds + G2_KS + (ib + 2 * q) * 272 + dk * 2), hi = *(const LAS bf16_t*)(lds + G2_KS + (ib + 2 * q + 1) * 272 + dk * 2); wv[q] = lo | (hi << 16); }
            bf16_t* kp = C + (size_t)(r0 + (dk >> 1)) * 8192 + 2048 + hk * 128 + (dk & 1) * 64 + ib;
            *(u32x4*)(kp) = (u32x4){wv[0], wv[1], wv[2], wv[3]}; *(u32x4*)(kp + 8) = (u32x4){wv[4], wv[5], wv[6], wv[7]};
        }
        __syncthreads();
    }
}

constexpr int G3_W = 0, G3_Q = 17408, G3_KT = 34816, G3_A = G3_KT + 128 * 144, G3_UT = G3_A + 64 * 144, G3_GCB = G3_UT + 32 * 144, G3_BUF = G3_GCB + 256;
static_assert(2 * G3_BUF <= MISC_OFF, "G3 LDS");
__device__ __forceinline__ void g3_stage(LAS unsigned char* buf, const bf16_t* PROJ, const bf16_t* C, const bf16_t* ATT, const float* GC, int cgl, int hv, int dq, int t, int nt) {
    const size_t r0 = (size_t)cgl * CH; const int hk = hv >> 1;
    for (int i = t; i < 1024; i += nt) { const int row = i >> 4, ch = i & 15;
        *(LAS u32x4*)(buf + G3_W + row * 272 + ch * 16) = *(const u32x4*)(PROJ + (r0 + row) * GINP + hv * 128 + ch * 8);
        *(LAS u32x4*)(buf + G3_Q + row * 272 + ch * 16) = *(const u32x4*)(C + (r0 + row) * 8192 + hk * 128 + ch * 8); }
    for (int i = t; i < 1024; i += nt) { const int rr = i >> 4, ch = i & 15, dk = 2 * rr + (ch >> 3);
        *(LAS u32x4*)(buf + G3_KT + dk * 144 + (ch & 7) * 16) = *(const u32x4*)(C + (r0 + rr) * 8192 + 2048 + hk * 128 + ch * 8); }
    for (int i = t; i < 512; i += nt) { const int row = i >> 3, ch = i & 7;
        *(LAS u32x4*)(buf + G3_A + row * 144 + ch * 16) = *(const u32x4*)(ATT + ((size_t)(cgl * 32 + hv) * 64 + row) * 64 + ch * 8); }
    for (int i = t; i < 256; i += nt) { const int rr = i >> 4, ch = i & 15, dvl = 2 * rr + (ch >> 3);
        *(LAS u32x4*)(buf + G3_UT + dvl * 144 + (ch & 7) * 16) = *(const u32x4*)(C + (r0 + 16 * dq + rr) * 8192 + 4096 + hv * 128 + ch * 8); }
    if (t < 64) *(LAS float*)(buf + G3_GCB + t * 4) = GC[(r0 + t) * 32 + hv];
}
__device__ __forceinline__ bf16x8 pack8(const f32x16& v, int s) {
    u32x4 w; w.x = cvt_pk_bf16(v[8 * s + 0], v[8 * s + 1]); w.y = cvt_pk_bf16(v[8 * s + 2], v[8 * s + 3]); w.z = cvt_pk_bf16(v[8 * s + 4], v[8 * s + 5]); w.w = cvt_pk_bf16(v[8 * s + 6], v[8 * s + 7]);
    return __builtin_bit_cast(bf16x8, w);
}
__device__ __forceinline__ bf16x8 ld2x8(const LAS unsigned char* p) {
    const u32x2 a = *(const LAS u32x2*)p, b = *(const LAS u32x2*)(p + 16);
    return __builtin_bit_cast(bf16x8, (u32x4){a.x, a.y, b.x, b.y});
}
__device__ __forceinline__ void phase_gdn_scan(const Ctx& c, bf16_t* PROJ, const bf16_t* C, const bf16_t* ATT, const float* GC) {
    LAS unsigned char* lds = c.lds;
    const int lane = c.lane, l31 = lane & 31, hh = lane >> 5;
    constexpr int NITEMS = 2 * GVH * 4;
    for (int wi = c.bid; wi < NITEMS; wi += c.G) {
        const int bl = wi >> 7, hv = (wi >> 2) & 31, dq = wi & 3;
        g3_stage(lds, PROJ, C, ATT, GC, bl * NCH, hv, dq, c.tid, NTHREADS);
        __syncthreads();
        f32x16 Sacc[4];
#pragma unroll
        for (int k = 0; k < 4; ++k)
#pragma unroll
            for (int r = 0; r < 16; ++r) Sacc[k][r] = 0.f;
        for (int ch = 0; ch < NCH; ++ch) {
            LAS unsigned char* buf = lds + (ch & 1) * G3_BUF;
            if (c.wave != 0) { if (ch + 1 < NCH) g3_stage(lds + ((ch + 1) & 1) * G3_BUF, PROJ, C, ATT, GC, bl * NCH + ch + 1, hv, dq, c.tid - 64, NTHREADS - 64); }
            else {
                const LAS float* gcb = (const LAS float*)(buf + G3_GCB);
                const float gl = gcb[63];
                bf16x8 Sb[4][2];
#pragma unroll
                for (int k = 0; k < 4; ++k) { Sb[k][0] = pack8(Sacc[k], 0); Sb[k][1] = pack8(Sacc[k], 1); }
                f32x16 vn[2], oa[2];
#pragma unroll
                for (int rt = 0; rt < 2; ++rt) {
#pragma unroll
                    for (int r = 0; r < 16; ++r) { vn[rt][r] = 0.f; oa[rt][r] = 0.f; }
                    const LAS unsigned char* wp = buf + G3_W + (32 * rt + l31) * 272 + hh * 8;
                    const LAS unsigned char* qp = buf + G3_Q + (32 * rt + l31) * 272 + hh * 8;
#pragma unroll
                    for (int k = 0; k < 4; ++k)
#pragma unroll
                        for (int s = 0; s < 2; ++s) {
                            vn[rt] = __builtin_amdgcn_mfma_f32_32x32x16_bf16(ld2x8(wp + (32 * k + 16 * s) * 2), Sb[k][s], vn[rt], 0, 0, 0);
                            oa[rt] = __builtin_amdgcn_mfma_f32_32x32x16_bf16(ld2x8(qp + (32 * k + 16 * s) * 2), Sb[k][s], oa[rt], 0, 0, 0);
                        }
                }
                bf16x8 Vb[2][2], Vsb[2][2];
#pragma unroll
                for (int rt = 0; rt < 2; ++rt)
#pragma unroll
                    for (int s = 0; s < 2; ++s) {
                        float pv[8], ps[8];
#pragma unroll
                        for (int g2 = 0; g2 < 2; ++g2) {
                            const int g = 2 * s + g2, i0 = 32 * rt + 8 * g + 4 * hh;
                            const u32x2 uu = *(const LAS u32x2*)(buf + G3_UT + l31 * 144 + i0 * 2);
                            const f32x4 gv = *(const LAS f32x4*)(gcb + i0);
                            const float u4[4] = {bflo(uu.x), bfhi(uu.x), bflo(uu.y), bfhi(uu.y)};
#pragma unroll
                            for (int q = 0; q < 4; ++q) { const int r = 4 * g + q; const float v = u4[q] - vn[rt][r]; pv[4 * g2 + q] = v; ps[4 * g2 + q] = v * __expf(gl - gv[q]); oa[rt][r] *= __expf(gv[q]); }
                        }
                        u32x4 w; w.x = cvt_pk_bf16(pv[0], pv[1]); w.y = cvt_pk_bf16(pv[2], pv[3]); w.z = cvt_pk_bf16(pv[4], pv[5]); w.w = cvt_pk_bf16(pv[6], pv[7]); Vb[rt][s] = __builtin_bit_cast(bf16x8, w);
                        w.x = cvt_pk_bf16(ps[0], ps[1]); w.y = cvt_pk_bf16(ps[2], ps[3]); w.z = cvt_pk_bf16(ps[4], ps[5]); w.w = cvt_pk_bf16(ps[6], ps[7]); Vsb[rt][s] = __builtin_bit_cast(bf16x8, w);
                    }
#pragma unroll
                for (int ro = 0; ro < 2; ++ro) { const LAS unsigned char* ap = buf + G3_A + (32 * ro + l31) * 144 + hh * 8;
#pragma unroll
                    for (int rt = 0; rt <= ro; ++rt)
#pragma unroll
                        for (int s = 0; s < 2; ++s) oa[ro] = __builtin_amdgcn_mfma_f32_32x32x16_bf16(ld2x8(ap + (32 * rt + 16 * s) * 2), Vb[rt][s], oa[ro], 0, 0, 0); }
                const float dec = __expf(gl);
#pragma unroll
                for (int k = 0; k < 4; ++k) {
#pragma unroll
                    for (int r = 0; r < 16; ++r) Sacc[k][r] *= dec;
                    const LAS unsigned char* kp = buf + G3_KT + (32 * k + l31) * 144 + hh * 8;
#pragma unroll
                    for (int rt = 0; rt < 2; ++rt)
#pragma unroll
                        for (int s = 0; s < 2; ++s) Sacc[k] = __builtin_amdgcn_mfma_f32_32x32x16_bf16(ld2x8(kp + (32 * rt + 16 * s) * 2), Vsb[rt][s], Sacc[k], 0, 0, 0);
                }
                bf16_t* op = PROJ + ((size_t)(bl * NCH + ch) * CH) * GINP + 4096 + hv * 128 + 32 * dq + l31;
#pragma unroll
                for (int rt = 0; rt < 2; ++rt)
#pragma unroll
                    for (int r = 0; r < 16; ++r) op[(size_t)(32 * rt + (r & 3) + 8 * (r >> 2) + 4 * hh) * GINP] = (bf16_t)f2bf(oa[rt][r]);
            }
            __syncthreads();
        }
    }
}

__device__ __forceinline__ void phase_gdn_onorm(const Ctx& c, bf16_t* PROJ, const float* o_gain) {
    const int gw = c.bid * NWAVES + c.wave, NGW = c.G * NWAVES, sub = c.lane >> 4, ch = c.lane & 15;
    float og[8];
    { const f32x4 a = *(const f32x4*)(o_gain + ch * 8), b = *(const f32x4*)(o_gain + ch * 8 + 4);
#pragma unroll
      for (int k = 0; k < 4; ++k) { og[k] = a[k]; og[4 + k] = b[k]; } }
    const int npairs = MH * GVH / 4;
    for (int it = gw; it < npairs; it += NGW) {
        const int pr = it * 4 + sub, row = pr >> 5, hv = pr & 31;
        bf16_t* op = PROJ + (size_t)row * GINP + 4096 + hv * 128 + ch * 8;
        const u32x4 ov = *(const u32x4*)op, gv = *(const u32x4*)(op + 4096);
        float o[8], g[8]; float ss = 0.f;
#pragma unroll
        for (int k = 0; k < 4; ++k) { o[2 * k] = bflo(ov[k]); o[2 * k + 1] = bfhi(ov[k]); g[2 * k] = bflo(gv[k]); g[2 * k + 1] = bfhi(gv[k]); }
#pragma unroll
        for (int k = 0; k < 8; ++k) ss += o[k] * o[k];
        ss += __shfl_xor(ss, 1); ss += __shfl_xor(ss, 2); ss += __shfl_xor(ss, 4); ss += __shfl_xor(ss, 8);
        const float rs = 1.0f / sqrtf(ss * (1.0f / 128.f) + EPS);
        float y[8];
#pragma unroll
        for (int k = 0; k < 8; ++k) y[k] = o[k] * rs * og[k] * siluf(g[k]);
        u32x4 w; w.x = cvt_pk_bf16(y[0], y[1]); w.y = cvt_pk_bf16(y[2], y[3]); w.z = cvt_pk_bf16(y[4], y[5]); w.w = cvt_pk_bf16(y[6], y[7]);
        *(u32x4*)op = w;
    }
}

typedef const __attribute__((address_space(4))) Args* KArgsP;
__device__ __forceinline__ KArgsP kargs() { const unsigned long long p0 = (unsigned long long)__builtin_amdgcn_kernarg_segment_ptr(); unsigned lo32 = (unsigned)p0, hi32 = (unsigned)(p0 >> 32);
    asm volatile("" : "+v"(lo32), "+v"(hi32)); lo32 = __builtin_amdgcn_readfirstlane(lo32); hi32 = __builtin_amdgcn_readfirstlane(hi32); return (KArgsP)(((unsigned long long)hi32 << 32) | lo32); }
__device__ __forceinline__ Ctx mkctx(LAS unsigned char* lds) { Ctx c; int tid = threadIdx.x; asm volatile("" : "+v"(tid)); c.lds = lds; c.tid = tid; c.lane = tid & 63; c.wave = __builtin_amdgcn_readfirstlane(tid >> 6); c.G = gridDim.x; c.bid = blockIdx.x; return c; }
#ifndef PHASE_EN
#define PHASE_EN 0xFFFFFFFFu
#endif
#define EN(id) (((PHASE_EN) >> (id)) & 1u)

__global__ void __launch_bounds__(NTHREADS, 2) fwd_kernel(Args args) {
    extern __shared__ __attribute__((aligned(16))) unsigned char lds_raw[];
    LAS unsigned char* const lds = (LAS unsigned char*)lds_raw;
    volatile LAS unsigned* MISC = (volatile LAS unsigned*)(lds + MISC_OFF);
    if (threadIdx.x < 64) MISC[threadIdx.x] = 0u;
    __syncthreads();
    XcdBarrier bar; bar.bar = nullptr; bar.x = 0; bar.st = nullptr;
    if (N_LAUNCH_MODE == 1) { KArgsP ap = kargs(); bar = xcd_barrier_post((unsigned*)(ap->ws + WS_CTL) + CW_BAR, MISC + 8); }
    const int lo = args.ph_lo, hi = args.ph_hi;
    int ph = 0;
#define PH_IN (ph >= lo && ph < hi)
#define PH_END do { if (PH_IN && ph + 1 < hi) { if (N_LAUNCH_MODE == 1) xcd_barrier(bar); } ++ph; } while (0)

    if (EN(0) && PH_IN) { const Ctx c = mkctx(lds); phase_weights(c, kargs()); }
    PH_END;

    for (int layer = 0; layer < 4; ++layer) {
        const int kind = layer % 3, j = layer / 3;
        if (EN(1) && PH_IN) { const Ctx c = mkctx(lds); KArgsP ap = kargs(); unsigned char* ws = ap->ws;
            phase_rmsnorm(c, (layer == 0) ? ap->x : (const float*)ap->out, ap->mix_norm + layer * D, (bf16_t*)(ws + WS_H)); }
        PH_END;
        if (kind == 0) {
            if (EN(2) && PH_IN) { const Ctx c = mkctx(lds); KArgsP ap = kargs(); unsigned char* ws = ap->ws;
                pg8::Gemm g{(const bf16_t*)(ws + WS_H), (const bf16_t*)(ws + WS_WQKV) + (size_t)j * 6144 * D, T, 6144, D, D, D, 0}; pg8::StaticOrder S; S.init(T, 6144, c.G, c.bid);
                pg8::EpiBf16 E{(bf16_t*)(ws + WS_QKV), 6144}; pg8::gemm_phase(c.lds, c.tid, g, S, E); }
            PH_END;
            if (EN(3) && PH_IN) { const Ctx c = mkctx(lds); KArgsP ap = kargs(); unsigned char* ws = ap->ws;
                phase_attention(c, (const bf16_t*)(ws + WS_QKV), (bf16_t*)(ws + WS_AO), ap->att_q_gain + j * AHD, ap->att_k_gain + j * AHD, ap->att_rel_bias + (size_t)j * AH * NREL); }
            PH_END;
            if (EN(4) && PH_IN) { const Ctx c = mkctx(lds); KArgsP ap = kargs(); unsigned char* ws = ap->ws;
                pg8::Gemm g{(const bf16_t*)(ws + WS_AO), (const bf16_t*)(ws + WS_WO) + (size_t)j * D * D, T, D, D, D, D, 0}; pg8::StaticOrder S; S.init(T, D, c.G, c.bid);
                pg8::EpiRes E{(layer == 0) ? ap->x : (const float*)ap->out, ap->out, D, nullptr}; pg8::gemm_phase(c.lds, c.tid, g, S, E); }
            PH_END;
        } else if (kind == 1) {
            if (EN(5) && PH_IN) { const Ctx c = mkctx(lds); KArgsP ap = kargs(); unsigned char* ws = ap->ws;
                phase_pool_prep(c, (const bf16_t*)(ws + WS_H), (bf16_t*)(ws + WS_POOLED)); }
            PH_END;
            if (EN(6) && PH_IN) { const Ctx c = mkctx(lds); KArgsP ap = kargs(); unsigned char* ws = ap->ws;
                pg8::Gemm g{(const bf16_t*)(ws + WS_POOLED), (const bf16_t*)(ws + WS_WPOOL), T, D, 512, D, 512, 2}; pg8::StaticOrder S; S.init(T, D, c.G, c.bid);
                pg8::EpiRes E{ap->out, ap->out, D, ap->pool_scale + j * D}; pg8::gemm_phase(c.lds, c.tid, g, S, E); }
            PH_END;
        } else {
            for (int half = 0; half < 2; ++half) {
                if (EN(7) && PH_IN) { const Ctx c = mkctx(lds); KArgsP ap = kargs(); unsigned char* ws = ap->ws;
                    pg8::Gemm g{(const bf16_t*)(ws + WS_H) + (size_t)half * MH * D, (const bf16_t*)(ws + WS_WGIN), MH, GINP, D, D, D, 0}; pg8::StaticOrder S; S.init(MH, GINP, c.G, c.bid);
                    pg8::EpiProj E{(bf16_t*)(ws + WS_PROJ), GINP, (float*)(ws + WS_AB)}; pg8::gemm_phase(c.lds, c.tid, g, S, E); }
                PH_END;
                if (EN(8) && PH_IN) { const Ctx c = mkctx(lds); KArgsP ap = kargs(); unsigned char* ws = ap->ws;
                    phase_gdn_conv(c, (const bf16_t*)(ws + WS_PROJ), (bf16_t*)(ws + WS_C), ap->gdn_conv); }
                PH_END;
                if (EN(9) && PH_IN) { const Ctx c = mkctx(lds); KArgsP ap = kargs(); unsigned char* ws = ap->ws;
                    phase_gdn_local(c, (bf16_t*)(ws + WS_PROJ), (bf16_t*)(ws + WS_C), (bf16_t*)(ws + WS_ATT), (const float*)(ws + WS_AB), (float*)(ws + WS_GC), ap->gdn_a_log, ap->gdn_dt_bias); }
                PH_END;
                if (EN(10) && PH_IN) { const Ctx c = mkctx(lds); KArgsP ap = kargs(); unsigned char* ws = ap->ws;
                    phase_gdn_scan(c, (bf16_t*)(ws + WS_PROJ), (const bf16_t*)(ws + WS_C), (const bf16_t*)(ws + WS_ATT), (const float*)(ws + WS_GC)); }
                PH_END;
                if (EN(11) && PH_IN) { const Ctx c = mkctx(lds); KArgsP ap = kargs(); unsigned char* ws = ap->ws;
                    phase_gdn_onorm(c, (bf16_t*)(ws + WS_PROJ), ap->gdn_o_gain); }
                PH_END;
                if (EN(12) && PH_IN) { const Ctx c = mkctx(lds); KArgsP ap = kargs(); unsigned char* ws = ap->ws;
                    pg8::Gemm g{(const bf16_t*)(ws + WS_PROJ) + 4096, (const bf16_t*)(ws + WS_WGO), MH, D, 4096, GINP, 4096, 0}; pg8::StaticOrder S; S.init(MH, D, c.G, c.bid);
                    pg8::EpiRes E{(const float*)ap->out + (size_t)half * MH * D, ap->out + (size_t)half * MH * D, D, nullptr}; pg8::gemm_phase(c.lds, c.tid, g, S, E); }
                PH_END;
            }
        }
        if (EN(13) && PH_IN) { const Ctx c = mkctx(lds); KArgsP ap = kargs(); unsigned char* ws = ap->ws;
            phase_rmsnorm(c, ap->out, ap->ffn_norm + layer * D, (bf16_t*)(ws + WS_H)); }
        PH_END;
        if (EN(14) && PH_IN) { const Ctx c = mkctx(lds); KArgsP ap = kargs(); unsigned char* ws = ap->ws;
            pg8::Gemm g{(const bf16_t*)(ws + WS_H), (const bf16_t*)(ws + WS_WUP) + (size_t)layer * FF2 * D, T, FF2, D, D, D, 0}; pg8::StaticOrder S; S.init(T, FF2, c.G, c.bid);
            pg8::EpiBf16 E{(bf16_t*)(ws + WS_UP), FF2}; pg8::gemm_phase(c.lds, c.tid, g, S, E); }
        PH_END;
        if (EN(15) && PH_IN) { const Ctx c = mkctx(lds); KArgsP ap = kargs(); unsigned char* ws = ap->ws;
            phase_ffn_act(c, (bf16_t*)(ws + WS_UP), ap->ffn_conv + (size_t)layer * 3 * FF); }
        PH_END;
        if (EN(16) && PH_IN) { const Ctx c = mkctx(lds); KArgsP ap = kargs(); unsigned char* ws = ap->ws;
            pg8::Gemm g{(const bf16_t*)(ws + WS_UP) + FF, (const bf16_t*)(ws + WS_WDN) + (size_t)layer * D * FF, T, D, FF, FF2, FF, 0}; pg8::StaticOrder S; S.init(T, D, c.G, c.bid);
            pg8::EpiRes E{ap->out, ap->out, D, nullptr}; pg8::gemm_phase(c.lds, c.tid, g, S, E); }
        PH_END;
    }
#undef PH_IN
#undef PH_END
}

constexpr int N_PHASES = 1 + 8 + 7 + 17 + 8;

extern "C" void kernel_launch(void* const* d_in, const int* in_sizes, int n_in, void* d_out, int out_size, void* d_ws, size_t ws_size, hipStream_t stream) {
    static int grid = 0;
    if (grid == 0) {
        if (n_in != 19 || out_size != T * D || ws_size < WS_NEED) { fprintf(stderr, "kernel_launch: unexpected problem (n_in %d, out %d, ws %zu, need %zu)\n", n_in, out_size, ws_size, (size_t)WS_NEED); grid = -1; return; }
        int dev = 0, cus = 0, per_cu = 0;
        if (hipGetDevice(&dev) != hipSuccess || hipDeviceGetAttribute(&cus, hipDeviceAttributeMultiprocessorCount, dev) != hipSuccess) { grid = -1; return; }
        if (hipFuncSetAttribute((const void*)fwd_kernel, hipFuncAttributeMaxDynamicSharedMemorySize, LDS_BYTES) != hipSuccess) { fprintf(stderr, "kernel_launch: hipFuncSetAttribute failed\n"); grid = -1; return; }
        if (hipOccupancyMaxActiveBlocksPerMultiprocessor(&per_cu, (const void*)fwd_kernel, NTHREADS, LDS_BYTES) != hipSuccess || per_cu < 1) fprintf(stderr, "kernel_launch: occupancy query says %d\n", per_cu);
        (void)hipGetLastError();
        grid = cus;
    }
    if (grid < 0) return;
    unsigned char* ws = (unsigned char*)d_ws;
    (void)hipMemsetAsync(ws + WS_CTL, 0, CTL_ZERO_BYTES, stream);
    Args a{};
    a.x = (const float*)d_in[0]; a.mix_norm = (const float*)d_in[1]; a.ffn_norm = (const float*)d_in[2];
    a.att_q_gain = (const float*)d_in[4]; a.att_k_gain = (const float*)d_in[5]; a.att_rel_bias = (const float*)d_in[6];
    a.pool_scale = (const float*)d_in[9]; a.gdn_conv = (const float*)d_in[11]; a.gdn_a_log = (const float*)d_in[12]; a.gdn_dt_bias = (const float*)d_in[13];
    a.gdn_o_gain = (const float*)d_in[14]; a.ffn_conv = (const float*)d_in[17];
    a.out = (float*)d_out; a.ws = ws;
    a.wd[0] = WDesc{(const float*)d_in[3],  (bf16_t*)(ws + WS_WQKV), D, 6144, 2, 0};
    a.wd[1] = WDesc{(const float*)d_in[7],  (bf16_t*)(ws + WS_WO),   D, D, 2, 0};
    a.wd[2] = WDesc{(const float*)d_in[8],  (bf16_t*)(ws + WS_WPOOL), 512, 512, 4, 0};
    a.wd[3] = WDesc{(const float*)d_in[10], (bf16_t*)(ws + WS_WGIN), D, GIN, 1, 0};
    a.wd[4] = WDesc{(const float*)d_in[15], (bf16_t*)(ws + WS_WGO),  4096, D, 1, 0};
    a.wd[5] = WDesc{(const float*)d_in[16], (bf16_t*)(ws + WS_WUP),  D, FF2, 4, 0};
    a.wd[6] = WDesc{(const float*)d_in[18], (bf16_t*)(ws + WS_WDN),  FF, D, 4, 0};
    if (N_LAUNCH_MODE == 1) {
        a.ph_lo = 0; a.ph_hi = N_PHASES;
        hipLaunchKernelGGL(fwd_kernel, dim3(grid), dim3(NTHREADS), LDS_BYTES, stream, a);
    } else {
        for (int p = 0; p < N_PHASES; ++p) { a.ph_lo = p; a.ph_hi = p + 1; hipLaunchKernelGGL(fwd_kernel, dim3(grid), dim3(NTHREADS), LDS_BYTES, stream, a); }
    }
}
```

```cpp
#include <hip/hip_runtime.h>
#include <cstdio>
#include <cstdint>

#ifndef N_LAUNCH_MODE
#define N_LAUNCH_MODE 1
#endif

#define LAS __attribute__((address_space(3)))
#define GAS __attribute__((address_space(1)))
typedef unsigned short bf16_t;
typedef short bf16x8 __attribute__((ext_vector_type(8)));
typedef short s16x4 __attribute__((ext_vector_type(4)));
typedef float f32x4 __attribute__((ext_vector_type(4)));
typedef float f32x2 __attribute__((ext_vector_type(2)));
typedef float f32x16 __attribute__((ext_vector_type(16)));
typedef unsigned u32x4 __attribute__((ext_vector_type(4)));
typedef unsigned u32x2 __attribute__((ext_vector_type(2)));

constexpr int D = 2048, BATCH = 4, SEQ = 8192, T = BATCH * SEQ;
constexpr int CH = 64, NCH = SEQ / CH;
constexpr int AH = 16, AHD = 128, NREL = 320;
constexpr int GKH = 16, GVH = 32, GIN = 12352, GINP = 12544;
constexpr int FF = 5504, FF2 = 11008;
constexpr int MH = T / 2;
constexpr float EPS = 1e-6f;
constexpr int NTHREADS = 512, NWAVES = 8;

constexpr size_t MiB = 1u << 20;
constexpr size_t WS_CTL = 0, CTL_ZERO_BYTES = 1 * MiB;
constexpr size_t WS_WQKV = 1 * MiB;
constexpr size_t WS_WO   = WS_WQKV + 48 * MiB;
constexpr size_t WS_WPOOL= WS_WO + 16 * MiB;
constexpr size_t WS_WGIN = WS_WPOOL + 2 * MiB;
constexpr size_t WS_WGO  = WS_WGIN + 49 * MiB;
constexpr size_t WS_WUP  = WS_WGO + 16 * MiB;
constexpr size_t WS_WDN  = WS_WUP + 172 * MiB;
constexpr size_t WS_H    = WS_WDN + 86 * MiB;
constexpr size_t WS_BIG  = WS_H + 128 * MiB;
constexpr size_t WS_QKV  = WS_BIG;
constexpr size_t WS_AO   = WS_QKV + 384 * MiB;
constexpr size_t WS_UP   = WS_BIG;
constexpr size_t WS_POOLED = WS_BIG;
constexpr size_t WS_PROJ = WS_BIG;
constexpr size_t WS_C    = WS_PROJ + 392 * MiB;
constexpr size_t WS_ATT  = WS_C + 256 * MiB;
constexpr size_t WS_AB   = WS_ATT + 64 * MiB;
constexpr size_t WS_GC   = WS_AB + 4 * MiB;
constexpr size_t WS_END  = WS_GC + 2 * MiB;
constexpr size_t WS_NEED = WS_BIG + 718 * MiB;
static_assert(WS_END <= WS_NEED && WS_UP + (size_t)T * FF2 * 2 <= WS_NEED && WS_AO + (size_t)T * D * 2 <= WS_NEED, "map");

constexpr int CW_BAR = 4096;

__device__ __forceinline__ float bf2f(unsigned b) { return __uint_as_float(b << 16); }
__device__ __forceinline__ float bflo(unsigned w) { return __uint_as_float(w << 16); }
__device__ __forceinline__ float bfhi(unsigned w) { return __uint_as_float(w & 0xffff0000u); }
__device__ __forceinline__ unsigned cvt_pk_bf16(float lo, float hi) { unsigned r; asm volatile("v_cvt_pk_bf16_f32 %0, %1, %2" : "=v"(r) : "v"(lo), "v"(hi)); return r; }
__device__ __forceinline__ unsigned f2bf(float f) { return cvt_pk_bf16(f, 0.f) & 0xffffu; }
__device__ __forceinline__ float wave_sum(float v) {
#pragma unroll
    for (int o = 1; o < 64; o <<= 1) v += __shfl_xor(v, o);
    return v;
}
__device__ __forceinline__ float siluf(float x) { return x * __builtin_amdgcn_rcpf(1.0f + __expf(-x)); }
#define LDS_WAIT() asm volatile("s_waitcnt lgkmcnt(0)" ::: "memory")
#define VM_WAIT() asm volatile("s_waitcnt vmcnt(0)" ::: "memory")

namespace pg8 {
constexpr int BM = 256, BK = 64, HALF = 128, HTB = HALF * BK * 2, STAGE_BYTES = 8 * HTB, NXCD = 8, WGM = 8;
__host__ __device__ __forceinline__ int lds_byte(int r, int c) { const int st = (r >> 4) * 2 + (c >> 5), rr = r & 15, cc = c & 31, ob = rr * 64 + cc * 2; return st * 1024 + (ob ^ (((ob >> 9) & 1) << 5)); }
__host__ __device__ __forceinline__ void stage_rc(int b, int& R, int& C) { const int st = b / 1024, sb = b % 1024, swz = sb ^ (((sb >> 9) & 1) << 5); R = (st >> 1) * 16 + swz / 64; C = (st & 1) * 32 + (swz % 64) / 2; }
__host__ __device__ __forceinline__ int perm32(int rho) { const int n = rho >> 4, i = rho & 15; return 8 * (i >> 2) + 4 * n + (i & 3); }

struct Unit { int pm, pn; };
struct Gemm { const bf16_t* A; const bf16_t* Bt; int M, N, K, lda, ldb, grp; };

struct StaticOrder {
    int nM, nN, nwg, G, c;
    __device__ void init(int M, int N, int G_, int c_) { nM = M / BM; nN = N / BM; nwg = nM * nN; G = G_; c = c_; }
    __device__ bool next(int i, Unit& u) const {
        const long L = (long)i * G + c; if (L >= nwg) return false;
        int wgid = (int)L; { const int q = nwg / NXCD, r = nwg % NXCD, xcd = wgid % NXCD, off = wgid / NXCD; wgid = (xcd < r ? xcd * (q + 1) : r * (q + 1) + (xcd - r) * q) + off; }
        const int nig = WGM * nN, gid = wgid / nig, fm = gid * WGM, gsz = (nM - fm) < WGM ? (nM - fm) : WGM;
        u.pm = fm + ((wgid % nig) % gsz); u.pn = (wgid % nig) / gsz; return true;
    }
};

struct EpiBf16 {
    static constexpr bool PERM = true;
    bf16_t* O; int ldc;
    __device__ __forceinline__ void operator()(const f32x4 (&acc)[2][2][4][2], const Unit& u, int wr, int wc, int fr, int fq) const {
        const int row0 = u.pm * BM + wr * 64 + fr, col0 = u.pn * BM + wc * 32 + 8 * fq;
#pragma unroll
        for (int ai = 0; ai < 2; ++ai)
#pragma unroll
            for (int m = 0; m < 4; ++m) { bf16_t* rowp = O + (size_t)(row0 + ai * HALF + m * 16) * ldc + col0;
#pragma unroll
                for (int bj = 0; bj < 2; ++bj) { const f32x4 v0 = acc[ai][bj][m][0], v1 = acc[ai][bj][m][1];
                    u32x4 w; w.x = cvt_pk_bf16(v0[0], v0[1]); w.y = cvt_pk_bf16(v0[2], v0[3]); w.z = cvt_pk_bf16(v1[0], v1[1]); w.w = cvt_pk_bf16(v1[2], v1[3]);
                    *(u32x4*)(rowp + bj * HALF) = w; } }
    }
};
struct EpiProj {
    static constexpr bool PERM = true;
    bf16_t* O; int ldc; float* AB;
    __device__ __forceinline__ void operator()(const f32x4 (&acc)[2][2][4][2], const Unit& u, int wr, int wc, int fr, int fq) const {
        const int row0 = u.pm * BM + wr * 64 + fr;
        if (u.pn == 48) {
            if (wc < 2) {
#pragma unroll
                for (int ai = 0; ai < 2; ++ai)
#pragma unroll
                    for (int m = 0; m < 4; ++m) { float* rp = AB + (size_t)(row0 + ai * HALF + m * 16) * 64 + wc * 32 + 8 * fq;
                        *(f32x4*)(rp) = acc[ai][0][m][0]; *(f32x4*)(rp + 4) = acc[ai][0][m][1]; }
            }
            return;
        }
        const int col0 = u.pn * BM + wc * 32 + 8 * fq;
#pragma unroll
        for (int ai = 0; ai < 2; ++ai)
#pragma unroll
            for (int m = 0; m < 4; ++m) { bf16_t* rowp = O + (size_t)(row0 + ai * HALF + m * 16) * ldc + col0;
#pragma unroll
                for (int bj = 0; bj < 2; ++bj) { const f32x4 v0 = acc[ai][bj][m][0], v1 = acc[ai][bj][m][1];
                    u32x4 w; w.x = cvt_pk_bf16(v0[0], v0[1]); w.y = cvt_pk_bf16(v0[2], v0[3]); w.z = cvt_pk_bf16(v1[0], v1[1]); w.w = cvt_pk_bf16(v1[2], v1[3]);
                    *(u32x4*)(rowp + bj * HALF) = w; } }
    }
};
struct EpiRes {
    static constexpr bool PERM = false;
    const float* base; float* out; int ldc; const float* scale;
    __device__ __forceinline__ void operator()(const f32x4 (&acc)[2][2][4][2], const Unit& u, int wr, int wc, int fr, int fq) const {
        const int row0 = u.pm * BM + wr * 64 + fr, col0 = u.pn * BM + wc * 32 + 4 * fq;
        f32x4 sv[2][2];
#pragma unroll
        for (int bj = 0; bj < 2; ++bj)
#pragma unroll
            for (int n = 0; n < 2; ++n) sv[bj][n] = scale ? *(const f32x4*)(scale + col0 + bj * HALF + n * 16) : (f32x4){1.f, 1.f, 1.f, 1.f};
#pragma unroll
        for (int ai = 0; ai < 2; ++ai)
#pragma unroll
            for (int m = 0; m < 4; ++m) { const size_t off = (size_t)(row0 + ai * HALF + m * 16) * ldc + col0;
#pragma unroll
                for (int bj = 0; bj < 2; ++bj)
#pragma unroll
                    for (int n = 0; n < 2; ++n) { const f32x4 bs = *(const f32x4*)(base + off + bj * HALF + n * 16);
                        *(f32x4*)(out + off + bj * HALF + n * 16) = bs + acc[ai][bj][m][n] * sv[bj][n]; } }
    }
};

template <class Epi, class Sched>
__device__ __forceinline__ void gemm_phase(LAS unsigned char* lds, const int tid, const Gemm g, const Sched& S, const Epi& E) {
    const int wid = __builtin_amdgcn_readfirstlane(tid >> 6), lane = tid & 63, wr = wid >> 2, wc = wid & 3, fr = lane & 15, fq = lane >> 4;
    const int K = g.K, nt = K / BK;
    unsigned voffA[2], voffB[2];
#pragma unroll
    for (int i = 0; i < 2; ++i) { int R, C; stage_rc(tid * 16 + i * 8192, R, C); const int Rb = Epi::PERM ? ((R & ~31) + perm32(R & 31)) : R;
        voffA[i] = (unsigned)(R * g.lda + C) * 2u; voffB[i] = (unsigned)(Rb * g.ldb + C) * 2u; }
    const size_t kstep = (size_t)(BK * 2);
    const size_t hstepA = (size_t)HALF * g.lda * 2, hstepB = (size_t)HALF * g.ldb * 2;
    const size_t tstepA = 2 * hstepA, tstepB = 2 * hstepB;
    const unsigned ldsw = (unsigned)wid * 1024u;
    const int aoff = lds_byte(wr * 64 + fr, fq * 8), boff = lds_byte(wc * 32 + fr, fq * 8);
#define PG8_SA(b, h) (((b) * 2 + (h)) * HTB)
#define PG8_SB(b, h) ((4 + (b) * 2 + (h)) * HTB)
#define PG8_STAGE(bufoff, gbase, voff) do { _Pragma("unroll") for (int _i = 0; _i < 2; ++_i) \
        __builtin_amdgcn_global_load_lds((const unsigned*)((const char*)(gbase) + (voff)[_i]), (LAS unsigned*)(lds + (bufoff) + ldsw + _i * 8192), 16, 0, 0); } while (0)
#define PG8_LDA(dst, b, h) do { _Pragma("unroll") for (int m = 0; m < 4; ++m) _Pragma("unroll") for (int k = 0; k < 2; ++k) dst[m][k] = *(const LAS bf16x8*)(lds + PG8_SA(b, h) + aoff + m * 2048 + k * 1024); } while (0)
#define PG8_LDB(dst, b, h) do { _Pragma("unroll") for (int n = 0; n < 2; ++n) _Pragma("unroll") for (int k = 0; k < 2; ++k) dst[n][k] = *(const LAS bf16x8*)(lds + PG8_SB(b, h) + boff + n * 2048 + k * 1024); } while (0)
#define PG8_MMA(ai, bj, At, Bt) do { __builtin_amdgcn_s_setprio(1); _Pragma("unroll") for (int m = 0; m < 4; ++m) _Pragma("unroll") for (int n = 0; n < 2; ++n) _Pragma("unroll") for (int k = 0; k < 2; ++k) \
        acc[ai][bj][m][n] = __builtin_amdgcn_mfma_f32_16x16x32_bf16(Bt[n][k], At[m][k], acc[ai][bj][m][n], 0, 0, 0); __builtin_amdgcn_s_setprio(0); } while (0)
#define PG8_WAIT_V(n) asm volatile("s_waitcnt vmcnt(" #n ")" ::: "memory")
#define PG8_WAIT_L(n) asm volatile("s_waitcnt lgkmcnt(" #n ")" ::: "memory")
#define PG8_BAR __builtin_amdgcn_s_barrier()
#define PG8_SCHED __builtin_amdgcn_sched_barrier(0)
#define PG8_AOFF(u) ((size_t)(u).pm * tstepA + (g.grp ? (size_t)((u).pn / g.grp) * (size_t)K * 2 : (size_t)0))
    Unit cur, nxt; int ui = 0;
    if (!S.next(0, cur)) return;
    f32x4 acc[2][2][4][2];
#pragma unroll
    for (int a = 0; a < 2; ++a)
#pragma unroll
        for (int b = 0; b < 2; ++b)
#pragma unroll
            for (int m = 0; m < 4; ++m)
#pragma unroll
                for (int n = 0; n < 2; ++n) acc[a][b][m][n] = (f32x4){0.f, 0.f, 0.f, 0.f};
    bf16x8 At[4][2], B0[2][2], B1[2][2];
    const char* cA = (const char*)g.A + PG8_AOFF(cur); const char* cB = (const char*)g.Bt + (size_t)cur.pn * tstepB;
    PG8_STAGE(PG8_SB(0, 0), cB, voffB); PG8_STAGE(PG8_SB(0, 1), cB + hstepB, voffB); PG8_STAGE(PG8_SA(0, 0), cA, voffA); PG8_STAGE(PG8_SA(0, 1), cA + hstepA, voffA);
    if (wr == 1) PG8_BAR;
    PG8_WAIT_V(2); PG8_BAR;
    PG8_STAGE(PG8_SB(1, 0), cB + kstep, voffB); PG8_STAGE(PG8_SA(1, 0), cA + kstep, voffA); PG8_STAGE(PG8_SB(1, 1), cB + hstepB + kstep, voffB);
    PG8_WAIT_V(6); PG8_BAR;
    for (;;) {
        const bool has_next = S.next(ui + 1, nxt);
        const char* nA = has_next ? (const char*)g.A + PG8_AOFF(nxt) : cA; const char* nB = has_next ? (const char*)g.Bt + (size_t)nxt.pn * tstepB : cB;
        for (int t = 0; t < nt; t += 2) {
            const bool last = (t == nt - 2);
            const char* a1 = cA + (size_t)(t + 1) * kstep;
            const char* a2 = last ? nA : cA + (size_t)(t + 2) * kstep; const char* b2 = last ? nB : cB + (size_t)(t + 2) * kstep;
            const char* a3 = a2 + kstep; const char* b3 = b2 + kstep;
            PG8_LDB(B0, 0, 0); PG8_LDB(B1, 0, 1); PG8_SCHED; PG8_LDA(At, 0, 0); PG8_STAGE(PG8_SA(1, 1), a1 + hstepA, voffA);
            PG8_WAIT_V(8); PG8_WAIT_L(0); PG8_BAR; PG8_MMA(0, 0, At, B0); PG8_MMA(0, 1, At, B1); PG8_BAR; PG8_SCHED;
            PG8_LDA(At, 0, 1); PG8_STAGE(PG8_SB(0, 0), b2, voffB); PG8_STAGE(PG8_SB(0, 1), b2 + hstepB, voffB); PG8_STAGE(PG8_SA(0, 0), a2, voffA);
            PG8_WAIT_V(8); PG8_WAIT_L(0); PG8_BAR; PG8_MMA(1, 0, At, B0); PG8_MMA(1, 1, At, B1); PG8_BAR; PG8_SCHED;
            PG8_LDB(B0, 1, 0); PG8_LDB(B1, 1, 1); PG8_SCHED; PG8_LDA(At, 1, 0); PG8_STAGE(PG8_SA(0, 1), a2 + hstepA, voffA);
            PG8_WAIT_V(8); PG8_WAIT_L(0); PG8_BAR; PG8_MMA(0, 0, At, B0); PG8_MMA(0, 1, At, B1); PG8_BAR; PG8_SCHED;
            PG8_LDA(At, 1, 1); PG8_STAGE(PG8_SB(1, 0), b3, voffB); PG8_STAGE(PG8_SB(1, 1), b3 + hstepB, voffB); PG8_STAGE(PG8_SA(1, 0), a3, voffA);
            PG8_WAIT_V(8); PG8_WAIT_L(0); PG8_BAR; PG8_MMA(1, 0, At, B0); PG8_MMA(1, 1, At, B1); PG8_BAR; PG8_SCHED;
        }
        if (wr == 0) PG8_BAR;
        E(acc, cur, wr, wc, fr, fq);
        if (!has_next) break;
#pragma unroll
        for (int a = 0; a < 2; ++a)
#pragma unroll
            for (int b = 0; b < 2; ++b)
#pragma unroll
                for (int m = 0; m < 4; ++m)
#pragma unroll
                    for (int n = 0; n < 2; ++n) acc[a][b][m][n] = (f32x4){0.f, 0.f, 0.f, 0.f};
        cur = nxt; cA = nA; cB = nB; ++ui;
        if (wr == 1) PG8_BAR;
    }
    PG8_WAIT_V(0);
    PG8_BAR;
#undef PG8_SA
#undef PG8_SB
#undef PG8_STAGE
#undef PG8_LDA
#undef PG8_LDB
#undef PG8_MMA
#undef PG8_WAIT_V
#undef PG8_WAIT_L
#undef PG8_BAR
#undef PG8_SCHED
#undef PG8_AOFF
}
}

#define XB_TMO      128
#define XB_XCNT(j)  (256  + 64 * (j))
#define XB_XSUB(j)  (1280 + 64 * (j))
#define XB_XGEN(j)  (2304 + 64 * (j))
#define XB_TOP      3328
#define XB_TOPGEN   3392
#define XCD_BAR_WORDS 3456
#define XB_SPIN_CAP (1u << 18)
__device__ __forceinline__ unsigned xb_ld(unsigned* p)              { return __hip_atomic_load(p, __ATOMIC_RELAXED, __HIP_MEMORY_SCOPE_AGENT); }
__device__ __forceinline__ unsigned xb_add(unsigned* p, unsigned v) { return __hip_atomic_fetch_add(p, v, __ATOMIC_RELAXED, __HIP_MEMORY_SCOPE_AGENT); }
__device__ __forceinline__ unsigned xb_xcc_id() { return (unsigned)__builtin_amdgcn_s_getreg((3 << 11) | 20) & 0xFu; }
#define XB_SPIN(cond, bar) do { unsigned _sp = 0; while (cond) { __builtin_amdgcn_s_sleep(1); \
    if ((++_sp & 255u) == 0u) { if (xb_ld(&(bar)[XB_TMO])) break; if (_sp > XB_SPIN_CAP) { atomicAdd(&(bar)[XB_TMO], 1u); break; } } } } while (0)
struct XcdBarrier { unsigned* bar; unsigned x; volatile LAS unsigned* st; };
__device__ __forceinline__ XcdBarrier xcd_barrier_post(unsigned* bar, volatile LAS unsigned* st) {
    XcdBarrier b; b.bar = bar; b.x = xb_xcc_id(); b.st = st;
    if (threadIdx.x == 0) (void)xb_add(&bar[XB_XCNT(b.x)], 1u);
    return b;
}
__device__ __forceinline__ void xcd_barrier_complete(unsigned* bar, unsigned x, unsigned& nloc, unsigned& nx) {
    const unsigned G = gridDim.x * gridDim.y * gridDim.z;
    unsigned sum, cnt, mine, sp = 0u;
    for (;;) {
        sum = 0u; cnt = 0u; mine = 0u;
#pragma unroll
        for (unsigned j = 0; j < 16; ++j) { const unsigned c = xb_ld(&bar[XB_XCNT(j)]); sum += c; cnt += (c > 0u) ? 1u : 0u; mine = (j == x) ? c : mine; }
        if (sum == G) break;
        __builtin_amdgcn_s_sleep(1);
        if ((++sp & 255u) == 0u) { if (xb_ld(&bar[XB_TMO])) break; if (sp > XB_SPIN_CAP) { atomicAdd(&bar[XB_TMO], 1u); break; } }
    }
    nloc = mine > 0u ? mine : 1u; nx = cnt > 0u ? cnt : 1u;
}
__device__ __forceinline__ void xcd_barrier(const XcdBarrier& b) {
    asm volatile("s_waitcnt vmcnt(0)" ::: "memory");
    __syncthreads();
    if (threadIdx.x == 0) {
        unsigned* bar = b.bar;
        __builtin_amdgcn_s_waitcnt(0);
        unsigned nloc = b.st[0], nx = b.st[1];
        if (nloc == 0u) { xcd_barrier_complete(bar, b.x, nloc, nx); b.st[0] = nloc; b.st[1] = nx; }
        const unsigned old = xb_add(&bar[XB_XSUB(b.x)], 1u);
        const unsigned gen = old / nloc;
        if (old + 1u == (gen + 1u) * nloc) {
            __builtin_amdgcn_fence(__ATOMIC_RELEASE, "agent");
            asm volatile("s_waitcnt vmcnt(0)" ::: "memory");
            const unsigned og = xb_add(&bar[XB_TOP], 1u);
            const unsigned tg = og / nx;
            if (og + 1u == (tg + 1u) * nx) xb_add(&bar[XB_TOPGEN], 1u);
            else XB_SPIN(xb_ld(&bar[XB_TOPGEN]) == tg, bar);
            __builtin_amdgcn_fence(__ATOMIC_ACQUIRE, "agent");
            xb_add(&bar[XB_XGEN(b.x)], 1u);
            asm volatile("s_waitcnt vmcnt(0)" ::: "memory");
        } else {
            XB_SPIN(xb_ld(&bar[XB_XGEN(b.x)]) == gen, bar);
            __builtin_amdgcn_fence(__ATOMIC_ACQUIRE, "agent");
            asm volatile("s_waitcnt vmcnt(0)" ::: "memory");
        }
    }
    __syncthreads();
}

constexpr int LDS_BYTES = 163840;
constexpr int MISC_OFF = LDS_BYTES - 256;

struct WDesc { const float* W; bf16_t* WT; int K, N, nmat, pad; };
struct Args {
    const float* x; const float* mix_norm; const float* ffn_norm;
    const float* att_q_gain; const float* att_k_gain; const float* att_rel_bias;
    const float* pool_scale; const float* gdn_conv; const float* gdn_a_log; const float* gdn_dt_bias; const float* gdn_o_gain; const float* ffn_conv;
    float* out; unsigned char* ws;
    WDesc wd[7];
    int ph_lo, ph_hi;
};

struct Ctx { LAS unsigned char* lds; int tid, lane, wave, G, bid; };

__device__ __forceinline__ void transpose_item(const float* W, int K, int N, bf16_t* WT, LAS float* scr, int item, int lane) {
    const int nblk = N / 32, kb = item / nblk, nb = item % nblk, k0 = 64 * kb, n0 = 32 * nb;
#pragma unroll 8
    for (int i = 0; i < 32; ++i) { const int kk = 2 * i + (lane >> 5); scr[kk * 33 + (lane & 31)] = W[(size_t)(k0 + kk) * N + n0 + (lane & 31)]; }
    LDS_WAIT();
    const int c = lane & 7;
#pragma unroll
    for (int j = 0; j < 4; ++j) { const int n = (lane >> 3) + 8 * j; const LAS float* s = scr + (8 * c) * 33 + n;
        u32x4 o; o.x = cvt_pk_bf16(s[0 * 33], s[1 * 33]); o.y = cvt_pk_bf16(s[2 * 33], s[3 * 33]); o.z = cvt_pk_bf16(s[4 * 33], s[5 * 33]); o.w = cvt_pk_bf16(s[6 * 33], s[7 * 33]);
        *(u32x4*)(WT + (size_t)(n0 + n) * K + k0 + 8 * c) = o; }
    LDS_WAIT();
}
typedef const __attribute__((address_space(4))) struct Args* KArgsP0;
__device__ __forceinline__ void phase_weights(const Ctx& c, KArgsP0 a) {
    LAS float* scr = (LAS float*)(c.lds + c.wave * 16384);
    const int gw = c.bid * NWAVES + c.wave, NGW = c.G * NWAVES;
#pragma unroll
    for (int d = 0; d < 7; ++d) {
        const float* W = a->wd[d].W; bf16_t* WT = a->wd[d].WT; const int K = a->wd[d].K, N = a->wd[d].N, nmat = a->wd[d].nmat;
        const int per = (K / 64) * (N / 32), tot = per * nmat;
        for (int it = gw; it < tot; it += NGW) { const int mat = it / per, r = it - mat * per;
            transpose_item(W + (size_t)mat * K * N, K, N, WT + (size_t)mat * K * N, scr, r, c.lane); }
    }
    { u32x4* z = (u32x4*)(a->ws + WS_WGIN + (size_t)GIN * D * 2); const int n16 = (GINP - GIN) * D * 2 / 16;
      for (int i = c.bid * NTHREADS + c.tid; i < n16; i += c.G * NTHREADS) z[i] = (u32x4){0u, 0u, 0u, 0u}; }
}

__device__ __forceinline__ void phase_rmsnorm(const Ctx& c, const float* x, const float* gain, bf16_t* out) {
    const int gw = c.bid * NWAVES + c.wave, NGW = c.G * NWAVES;
    f32x4 gv[8];
#pragma unroll
    for (int j = 0; j < 8; ++j) gv[j] = *(const f32x4*)(gain + 4 * c.lane + 256 * j);
    for (int m = gw; m < T; m += NGW) {
        const f32x4* xr = (const f32x4*)(x + (size_t)m * D) + c.lane;
        f32x4 v[8]; float s = 0.f;
#pragma unroll
        for (int j = 0; j < 8; ++j) { v[j] = xr[64 * j]; s += (v[j].x * v[j].x + v[j].y * v[j].y) + (v[j].z * v[j].z + v[j].w * v[j].w); }
        const float rstd = 1.0f / sqrtf(wave_sum(s) * (1.0f / D) + EPS);
        u32x2* o8 = (u32x2*)(out + (size_t)m * D) + c.lane;
#pragma unroll
        for (int j = 0; j < 8; ++j) { u32x2 w; w.x = cvt_pk_bf16(v[j].x * rstd * gv[j].x, v[j].y * rstd * gv[j].y); w.y = cvt_pk_bf16(v[j].z * rstd * gv[j].z, v[j].w * rstd * gv[j].w); o8[64 * j] = w; }
    }
}

__device__ __forceinline__ void phase_ffn_act(const Ctx& c, bf16_t* UP, const float* cw) {
    constexpr int NCG = FF / 8;
    constexpr int RB = 32;
    const int nitems = (T / RB) * NCG;
    for (int it = c.bid * NTHREADS + c.tid; it < nitems; it += c.G * NTHREADS) {
        const int rb = it / NCG, cg = it - rb * NCG, t0 = rb * RB, col = cg * 8;
        float w0[8], w1[8], w2[8];
#pragma unroll
        for (int k = 0; k < 8; k += 4) { const f32x4 a0 = *(const f32x4*)(cw + col + k), a1 = *(const f32x4*)(cw + FF + col + k), a2 = *(const f32x4*)(cw + 2 * FF + col + k);
#pragma unroll
            for (int q = 0; q < 4; ++q) { w0[k + q] = a0[q]; w1[k + q] = a1[q]; w2[k + q] = a2[q]; } }
        float p1[8], p2[8];
        if ((t0 % SEQ) == 0) {
#pragma unroll
            for (int k = 0; k < 8; ++k) { p1[k] = 0.f; p2[k] = 0.f; }
        } else {
            const u32x4 a = *(const u32x4*)(UP + (size_t)(t0 - 1) * FF2 + col), b = *(const u32x4*)(UP + (size_t)(t0 - 2) * FF2 + col);
#pragma unroll
            for (int k = 0; k < 4; ++k) { p1[2 * k] = bflo(a[k]); p1[2 * k + 1] = bfhi(a[k]); p2[2 * k] = bflo(b[k]); p2[2 * k + 1] = bfhi(b[k]); }
        }
#pragma unroll 4
        for (int t = t0; t < t0 + RB; ++t) {
            const u32x4 uu = *(const u32x4*)(UP + (size_t)t * FF2 + col), gg = *(const u32x4*)(UP + (size_t)t * FF2 + FF + col);
            float cu[8], gt[8], r[8];
#pragma unroll
            for (int k = 0; k < 4; ++k) { cu[2 * k] = bflo(uu[k]); cu[2 * k + 1] = bfhi(uu[k]); gt[2 * k] = bflo(gg[k]); gt[2 * k + 1] = bfhi(gg[k]); }
#pragma unroll
            for (int k = 0; k < 8; ++k) { const float s = w0[k] * p2[k] + w1[k] * p1[k] + w2[k] * cu[k]; r[k] = siluf(s) * gt[k]; p2[k] = p1[k]; p1[k] = cu[k]; }
            u32x4 o; o.x = cvt_pk_bf16(r[0], r[1]); o.y = cvt_pk_bf16(r[2], r[3]); o.z = cvt_pk_bf16(r[4], r[5]); o.w = cvt_pk_bf16(r[6], r[7]);
            *(u32x4*)(UP + (size_t)t * FF2 + FF + col) = o;
        }
    }
}

__device__ __forceinline__ void phase_pool_prep(const Ctx& c, const bf16_t* H, bf16_t* P) {
    constexpr int NCG = D / 8, RB = 64;
    const int nitems = (T / RB) * NCG;
    for (int it = c.bid * NTHREADS + c.tid; it < nitems; it += c.G * NTHREADS) {
        const int rb = it / NCG, cg = it - rb * NCG, t0 = rb * RB, col = cg * 8, w = 2 << (col >> 9), tp0 = t0 % SEQ;
        float s[8];
#pragma unroll
        for (int k = 0; k < 8; ++k) s[k] = 0.f;
        for (int i = 1; i <= w; ++i) if (tp0 - i >= 0) {   const u32x4 a = *(const u32x4*)(H + (size_t)(t0 - i) * D + col);
#pragma unroll
            for (int k = 0; k < 4; ++k) { s[2 * k] += bflo(a[k]); s[2 * k + 1] += bfhi(a[k]); } }
        for (int t = t0; t < t0 + RB; ++t) {
            const int tp = tp0 + (t - t0);
            const u32x4 a = *(const u32x4*)(H + (size_t)t * D + col);
            float cu[8];
#pragma unroll
            for (int k = 0; k < 4; ++k) { cu[2 * k] = bflo(a[k]); cu[2 * k + 1] = bfhi(a[k]); }
#pragma unroll
            for (int k = 0; k < 8; ++k) s[k] += cu[k];
            if (tp >= w) { const u32x4 b = *(const u32x4*)(H + (size_t)(t - w) * D + col);
#pragma unroll
                for (int k = 0; k < 4; ++k) { s[2 * k] -= bflo(b[k]); s[2 * k + 1] -= bfhi(b[k]); } }
            const float inv = 1.0f / (float)(tp + 1 < w ? tp + 1 : w);
            u32x4 o; o.x = cvt_pk_bf16(s[0] * inv - cu[0], s[1] * inv - cu[1]); o.y = cvt_pk_bf16(s[2] * inv - cu[2], s[3] * inv - cu[3]);
            o.z = cvt_pk_bf16(s[4] * inv - cu[4], s[5] * inv - cu[5]); o.w = cvt_pk_bf16(s[6] * inv - cu[6], s[7] * inv - cu[7]);
            *(u32x4*)(P + (size_t)t * D + col) = o;
        }
    }
}

constexpr int ATT_ROWB = 272;
constexpr int ATT_WAVE_BYTES = 2 * 32 * ATT_ROWB + NREL * 4;
static_assert(ATT_WAVE_BYTES * NWAVES <= MISC_OFF, "attention LDS");
__device__ __forceinline__ void phase_attention(const Ctx& c, const bf16_t* QKV, bf16_t* O, const float* q_gain, const float* k_gain, const float* rel_bias) {
    LAS unsigned char* Kt = c.lds + c.wave * ATT_WAVE_BYTES;
    LAS unsigned char* Vt = Kt + 32 * ATT_ROWB;
    LAS float* bias = (LAS float*)(Vt + 32 * ATT_ROWB);
    const int lane = c.lane, l31 = lane & 31, hh = lane >> 5;
    const int gw = c.bid * NWAVES + c.wave, NGW = c.G * NWAVES;
    constexpr int NU = BATCH * NCH * AH * 2;
    const float scale = 0.08838834764831845f;
    float kg[8];
    { const int ch = lane & 15; const f32x4 a = *(const f32x4*)(k_gain + ch * 8), b = *(const f32x4*)(k_gain + ch * 8 + 4);
#pragma unroll
      for (int k = 0; k < 4; ++k) { kg[k] = a[k]; kg[4 + k] = b[k]; } }
    for (int u = gw; u < NU; u += NGW) {
        const int qh = u & 1, h = (u >> 1) & 15, ck = (u >> 5) & 127, b = u >> 12;
        const size_t row_q0 = (size_t)b * SEQ + (size_t)ck * CH + qh * 32;
        for (int i = lane; i < NREL; i += 64) bias[i] = rel_bias[h * NREL + i];
        bf16x8 qf[8];
        {
            float qv[8][8]; float ss = 0.f;
            const bf16_t* qp = QKV + (row_q0 + l31) * 6144 + h * AHD + hh * 8;
#pragma unroll
            for (int ks = 0; ks < 8; ++ks) { const u32x4 a = *(const u32x4*)(qp + ks * 16);
#pragma unroll
                for (int k = 0; k < 4; ++k) { qv[ks][2 * k] = bflo(a[k]); qv[ks][2 * k + 1] = bfhi(a[k]); }
#pragma unroll
                for (int k = 0; k < 8; ++k) ss += qv[ks][k] * qv[ks][k]; }
            ss += __shfl_xor(ss, 32);
            const float rq = scale / sqrtf(ss * (1.0f / AHD) + EPS);
#pragma unroll
            for (int ks = 0; ks < 8; ++ks) { const f32x4 g0 = *(const f32x4*)(q_gain + ks * 16 + hh * 8), g1 = *(const f32x4*)(q_gain + ks * 16 + hh * 8 + 4);
                u32x4 w; w.x = cvt_pk_bf16(qv[ks][0] * rq * g0[0], qv[ks][1] * rq * g0[1]); w.y = cvt_pk_bf16(qv[ks][2] * rq * g0[2], qv[ks][3] * rq * g0[3]);
                w.z = cvt_pk_bf16(qv[ks][4] * rq * g1[0], qv[ks][5] * rq * g1[1]); w.w = cvt_pk_bf16(qv[ks][6] * rq * g1[2], qv[ks][7] * rq * g1[3]);
                qf[ks] = __builtin_bit_cast(bf16x8, w); }
        }
        float mrun = -1e30f, lsum = 0.f;
        f32x16 oacc[4];
#pragma unroll
        for (int dt = 0; dt < 4; ++dt)
#pragma unroll
            for (int r = 0; r < 16; ++r) oacc[dt][r] = 0.f;
        const int qi = qh * 32 + l31;
        const int kt_first = (ck >= 8) ? 0 : 2 * (8 - ck);
        for (int kt = kt_first; kt < 18; ++kt) {
            const int kj0 = kt * 32;
            const size_t krow0 = (size_t)b * SEQ + (size_t)((ck - 8) * CH + kj0);
            {
                const int ch = lane & 15, rr = lane >> 4;
#pragma unroll
                for (int i = 0; i < 8; ++i) {
                    const int row = rr + 4 * i;
                    const bf16_t* kp = QKV + (krow0 + row) * 6144 + 2048 + h * AHD + ch * 8;
                    const u32x4 a = *(const u32x4*)kp, vv = *(const u32x4*)(kp + 2048);
                    float kv[8]; float ss = 0.f;
#pragma unroll
                    for (int k = 0; k < 4; ++k) { kv[2 * k] = bflo(a[k]); kv[2 * k + 1] = bfhi(a[k]); }
#pragma unroll
                    for (int k = 0; k < 8; ++k) ss += kv[k] * kv[k];
                    ss += __shfl_xor(ss, 1); ss += __shfl_xor(ss, 2); ss += __shfl_xor(ss, 4); ss += __shfl_xor(ss, 8);
                    const float rk = 1.0f / sqrtf(ss * (1.0f / AHD) + EPS);
                    u32x4 w; w.x = cvt_pk_bf16(kv[0] * rk * kg[0], kv[1] * rk * kg[1]); w.y = cvt_pk_bf16(kv[2] * rk * kg[2], kv[3] * rk * kg[3]);
                    w.z = cvt_pk_bf16(kv[4] * rk * kg[4], kv[5] * rk * kg[5]); w.w = cvt_pk_bf16(kv[6] * rk * kg[6], kv[7] * rk * kg[7]);
                    *(LAS u32x4*)(Kt + row * ATT_ROWB + ch * 16) = w;
                    *(LAS u32x4*)(Vt + row * ATT_ROWB + ch * 16) = vv;
                }
            }
            LDS_WAIT();
            f32x16 st;
#pragma unroll
            for (int r = 0; r < 16; ++r) st[r] = 0.f;
#pragma unroll
            for (int ks = 0; ks < 8; ++ks) { const bf16x8 kf = *(const LAS bf16x8*)(Kt + l31 * ATT_ROWB + ks * 32 + hh * 16);
                st = __builtin_amdgcn_mfma_f32_32x32x16_bf16(kf, qf[ks], st, 0, 0, 0); }
            float mt = -1e30f;
#pragma unroll
            for (int r = 0; r < 16; ++r) { const int kj = kj0 + (r & 3) + 8 * (r >> 2) + 4 * hh; int idx = 575 + qi - kj; idx = idx > 319 ? 319 : idx; st[r] += bias[idx]; mt = fmaxf(mt, st[r]); }
            mt = fmaxf(mt, __shfl_xor(mt, 32));
            const float mnew = fmaxf(mrun, mt), alpha = __expf(mrun - mnew);
            mrun = mnew;
            float ps = 0.f;
#pragma unroll
            for (int r = 0; r < 16; ++r) { st[r] = __expf(st[r] - mnew); ps += st[r]; }
            lsum = lsum * alpha + ps;
#pragma unroll
            for (int dt = 0; dt < 4; ++dt)
#pragma unroll
                for (int r = 0; r < 16; ++r) oacc[dt][r] *= alpha;
            bf16x8 pf[2];
#pragma unroll
            for (int s = 0; s < 2; ++s) { u32x4 w; w.x = cvt_pk_bf16(st[8 * s + 0], st[8 * s + 1]); w.y = cvt_pk_bf16(st[8 * s + 2], st[8 * s + 3]); w.z = cvt_pk_bf16(st[8 * s + 4], st[8 * s + 5]); w.w = cvt_pk_bf16(st[8 * s + 6], st[8 * s + 7]);
                pf[s] = __builtin_bit_cast(bf16x8, w); }
            {
                const int i16 = lane & 15, g1 = (lane >> 4) & 1;
                LAS unsigned char* vb = Vt + (4 * hh + (i16 >> 2)) * ATT_ROWB + (16 * g1 + 4 * (i16 & 3)) * 2;
#pragma unroll
                for (int dt = 0; dt < 4; ++dt)
#pragma unroll
                    for (int s = 0; s < 2; ++s) {
                        const s16x4 lo = __builtin_bit_cast(s16x4, __builtin_amdgcn_ds_read_tr16_b64_v4i16((LAS s16x4*)(vb + (16 * s) * ATT_ROWB + dt * 64)));
                        const s16x4 hi = __builtin_bit_cast(s16x4, __builtin_amdgcn_ds_read_tr16_b64_v4i16((LAS s16x4*)(vb + (16 * s + 8) * ATT_ROWB + dt * 64)));
                        const bf16x8 vf = (bf16x8){lo[0], lo[1], lo[2], lo[3], hi[0], hi[1], hi[2], hi[3]};
                        oacc[dt] = __builtin_amdgcn_mfma_f32_32x32x16_bf16(vf, pf[s], oacc[dt], 0, 0, 0);
                    }
            }
            LDS_WAIT();
        }
        lsum += __shfl_xor(lsum, 32);
        const float inv = 1.0f / lsum;
        bf16_t* op = O + (row_q0 + l31) * D + h * AHD + 4 * hh;
#pragma unroll
        for (int dt = 0; dt < 4; ++dt)
#pragma unroll
            for (int g = 0; g < 4; ++g) { u32x2 w; w.x = cvt_pk_bf16(oacc[dt][4 * g] * inv, oacc[dt][4 * g + 1] * inv); w.y = cvt_pk_bf16(oacc[dt][4 * g + 2] * inv, oacc[dt][4 * g + 3] * inv);
                *(u32x2*)(op + dt * 32 + g * 8) = w; }
        LDS_WAIT();
    }
}

__device__ __forceinline__ void phase_gdn_conv(const Ctx& c, const bf16_t* PROJ, bf16_t* C, const float* cw) {
    constexpr int RB = 64;
    const int gw = c.bid * NWAVES + c.wave, NGW = c.G * NWAVES;
    const int nitems = (MH / RB) * 64;
    for (int it = gw; it < nitems; it += NGW) {
        const int rb = it >> 6, sl = it & 63, t0 = rb * RB, col = sl * 128 + 2 * c.lane;
        float w[4][2];
#pragma unroll
        for (int j = 0; j < 4; ++j) { const f32x2 a = *(const f32x2*)(cw + j * 8192 + col); w[j][0] = a.x; w[j][1] = a.y; }
        float p1[2], p2[2], p3[2];
        if ((t0 % SEQ) == 0) { p1[0] = p1[1] = p2[0] = p2[1] = p3[0] = p3[1] = 0.f; }
        else { const unsigned a = *(const unsigned*)(PROJ + (size_t)(t0 - 1) * GINP + col), b = *(const unsigned*)(PROJ + (size_t)(t0 - 2) * GINP + col), d = *(const unsigned*)(PROJ + (size_t)(t0 - 3) * GINP + col);
            p1[0] = bflo(a); p1[1] = bfhi(a); p2[0] = bflo(b); p2[1] = bfhi(b); p3[0] = bflo(d); p3[1] = bfhi(d); }
        const float qs = (sl < 16) ? 0.08838834764831845f : 1.0f;
#pragma unroll 4
        for (int t = t0; t < t0 + RB; ++t) {
            const unsigned a = *(const unsigned*)(PROJ + (size_t)t * GINP + col);
            const float c0 = bflo(a), c1 = bfhi(a);
            float y0 = siluf(w[0][0] * p3[0] + w[1][0] * p2[0] + w[2][0] * p1[0] + w[3][0] * c0);
            float y1 = siluf(w[0][1] * p3[1] + w[1][1] * p2[1] + w[2][1] * p1[1] + w[3][1] * c1);
            p3[0] = p2[0]; p3[1] = p2[1]; p2[0] = p1[0]; p2[1] = p1[1]; p1[0] = c0; p1[1] = c1;
            if (sl < 32) { const float ss = wave_sum(y0 * y0 + y1 * y1); const float r = qs / sqrtf(ss + EPS); y0 *= r; y1 *= r; }
            *(unsigned*)(C + (size_t)t * 8192 + col) = cvt_pk_bf16(y0, y1);
        }
    }
}

constexpr int G2_QS = 0, G2_KS = 17408, G2_KK = 34816, G2_QK = G2_KK + 64 * 65 * 4, G2_AT = G2_QK + 64 * 65 * 4, G2_GC = G2_AT + 2 * 64 * 64 * 4, G2_BETA = G2_GC + 512, G2_END = G2_BETA + 512;
static_assert(G2_END <= MISC_OFF, "G2 LDS");
__device__ __forceinline__ void phase_gdn_local(const Ctx& c, bf16_t* PROJ, bf16_t* C, bf16_t* ATT, const float* AB, float* GC, const float* a_log, const float* dt_bias) {
    LAS unsigned char* lds = c.lds;
    LAS float* KKs = (LAS float*)(lds + G2_KK); LAS float* QKs = (LAS float*)(lds + G2_QK); LAS float* At = (LAS float*)(lds + G2_AT);
    LAS float* gcs = (LAS float*)(lds + G2_GC); LAS float* betas = (LAS float*)(lds + G2_BETA);
    const int tid = c.tid, lane = c.lane, wave = c.wave, l31 = lane & 31, hh = lane >> 5;
    constexpr int NUNITS = (MH / CH) * GKH;
    for (int u = c.bid; u < NUNITS; u += c.G) {
        const int hk = u & 15, cg = u >> 4, r0 = cg * CH;
#pragma unroll
        for (int i = 0; i < 2; ++i) { const int idx = tid + i * 512, row = idx >> 4, ch = idx & 15;
            *(LAS u32x4*)(lds + G2_QS + row * 272 + ch * 16) = *(const u32x4*)(C + (size_t)(r0 + row) * 8192 + hk * 128 + ch * 8);
            *(LAS u32x4*)(lds + G2_KS + row * 272 + ch * 16) = *(const u32x4*)(C + (size_t)(r0 + row) * 8192 + 2048 + hk * 128 + ch * 8); }
        if (wave < 2) {
            const int hv = 2 * hk + wave;
            const float av = AB[(size_t)(r0 + lane) * 64 + hv], bv = AB[(size_t)(r0 + lane) * 64 + 32 + hv];
            const float z = av + dt_bias[hv];
            const float sp = z > 20.f ? z : log1pf(__expf(z));
            float g = -__expf(a_log[hv]) * sp;
#pragma unroll
            for (int o = 1; o < 64; o <<= 1) { const float t = __shfl_up(g, o); if (lane >= o) g += t; }
            gcs[wave * 64 + lane] = g; betas[wave * 64 + lane] = 1.0f / (1.0f + __expf(-bv));
            GC[(size_t)(r0 + lane) * 32 + hv] = g;
        }
        __syncthreads();
        {
            const int mat = wave >> 2, ti = (wave >> 1) & 1, tj = wave & 1;
            LAS unsigned char* xa = lds + (mat ? G2_QS : G2_KS) + (32 * ti + l31) * 272 + hh * 16;
            LAS unsigned char* xb = lds + G2_KS + (32 * tj + l31) * 272 + hh * 16;
            f32x16 acc;
#pragma unroll
            for (int r = 0; r < 16; ++r) acc[r] = 0.f;
#pragma unroll
            for (int ks = 0; ks < 8; ++ks) acc = __builtin_amdgcn_mfma_f32_32x32x16_bf16(*(const LAS bf16x8*)(xa + ks * 32), *(const LAS bf16x8*)(xb + ks * 32), acc, 0, 0, 0);
            LAS float* dst = mat ? QKs : KKs;
#pragma unroll
            for (int r = 0; r < 16; ++r) dst[(32 * ti + (r & 3) + 8 * (r >> 2) + 4 * hh) * 65 + 32 * tj + l31] = acc[r];
        }
        __syncthreads();
        for (int idx = tid; idx < 2 * 4096; idx += 512) { const int e = idx >> 12, j = (idx >> 6) & 63, i = idx & 63;
            At[idx] = (i > j) ? betas[e * 64 + i] * KKs[i * 65 + j] * __expf(gcs[e * 64 + i] - gcs[e * 64 + j]) : 0.f; }
        for (int idx = tid; idx < 2 * 4096; idx += 512) { const int e = idx >> 12, i = (idx >> 6) & 63, j = idx & 63;
            const float v = (i >= j) ? QKs[i * 65 + j] * __expf(gcs[e * 64 + i] - gcs[e * 64 + j]) : 0.f;
            ATT[((size_t)(cg * 32 + 2 * hk + e) * 64 + i) * 64 + j] = (bf16_t)f2bf(v); }
        __syncthreads();
        {
            const int e = tid >> 8, col = tid & 255, hv = 2 * hk + e;
            float r[64];
            if (col < 128) {
#pragma unroll
                for (int i = 0; i < 64; ++i) r[i] = betas[e * 64 + i] * bf2f(C[(size_t)(r0 + i) * 8192 + 4096 + hv * 128 + col]);
            } else {
#pragma unroll
                for (int i = 0; i < 64; ++i) r[i] = betas[e * 64 + i] * __expf(gcs[e * 64 + i]) * bf2f(*(const LAS bf16_t*)(lds + G2_KS + i * 272 + (col - 128) * 2));
            }
            const LAS float* Ae = At + e * 4096;
#pragma unroll
            for (int j = 0; j < 63; ++j) {
                const float xj = r[j];
#pragma unroll
                for (int i4 = ((j + 1) >> 2); i4 < 16; ++i4) { const f32x4 a = *(const LAS f32x4*)(Ae + j * 64 + 4 * i4);
                    r[4 * i4 + 0] -= a[0] * xj; r[4 * i4 + 1] -= a[1] * xj; r[4 * i4 + 2] -= a[2] * xj; r[4 * i4 + 3] -= a[3] * xj; }
            }
            __syncthreads();
            if (col < 128) {
                bf16_t* up = C + (size_t)(r0 + (col >> 1)) * 8192 + 4096 + hv * 128 + (col & 1) * 64;
#pragma unroll
                for (int q = 0; q < 8; ++q) { u32x4 w; w.x = cvt_pk_bf16(r[8 * q], r[8 * q + 1]); w.y = cvt_pk_bf16(r[8 * q + 2], r[8 * q + 3]); w.z = cvt_pk_bf16(r[8 * q + 4], r[8 * q + 5]); w.w = cvt_pk_bf16(r[8 * q + 6], r[8 * q + 7]);
                    *(u32x4*)(up + 8 * q) = w; }
            } else {
                bf16_t* wp = PROJ + (size_t)r0 * GINP + hv * 128 + (col - 128);
#pragma unroll
                for (int i = 0; i < 64; ++i) wp[(size_t)i * GINP] = (bf16_t)f2bf(r[i]);
            }
        }
        {
            const int dk = tid >> 2, ib = (tid & 3) * 16;
            unsigned wv[8];
#pragma unroll
            for (int q = 0; q < 8; ++q) { const unsigned lo = *(const LAS bf16_t*)(lds + G2_KS + (ib + 2 * q) * 272 + dk * 2), hi = *(const LAS bf16_t*)(lds + G2_KS + (ib + 2 * q + 1) * 272 + dk * 2); wv[q] = lo | (hi << 16); }
            bf16_t* kp = C + (size_t)(r0 + (dk >> 1)) * 8192 + 2048 + hk * 128 + (dk & 1) * 64 + ib;
            *(u32x4*)(kp) = (u32x4){wv[0], wv[1], wv[2], wv[3]}; *(u32x4*)(kp + 8) = (u32x4){wv[4], wv[5], wv[6], wv[7]};
        }
        __syncthreads();
    }
}

constexpr int G3_W = 0, G3_Q = 17408, G3_KT = 34816, G3_A = G3_KT + 128 * 144, G3_UT = G3_A + 64 * 144, G3_GCB = G3_UT + 32 * 144, G3_BUF = G3_GCB + 256;
static_assert(2 * G3_BUF <= MISC_OFF, "G3 LDS");
__device__ __forceinline__ void g3_stage(LAS unsigned char* buf, const bf16_t* PROJ, const bf16_t* C, const bf16_t* ATT, const float* GC, int cgl, int hv, int dq, int t, int nt) {
    const size_t r0 = (size_t)cgl * CH; const int hk = hv >> 1;
    for (int i = t; i < 1024; i += nt) { const int row = i >> 4, ch = i & 15;
        *(LAS u32x4*)(buf + G3_W + row * 272 + ch * 16) = *(const u32x4*)(PROJ + (r0 + row) * GINP + hv * 128 + ch * 8);
        *(LAS u32x4*)(buf + G3_Q + row * 272 + ch * 16) = *(const u32x4*)(C + (r0 + row) * 8192 + hk * 128 + ch * 8); }
    for (int i = t; i < 1024; i += nt) { const int rr = i >> 4, ch = i & 15, dk = 2 * rr + (ch >> 3);
        *(LAS u32x4*)(buf + G3_KT + dk * 144 + (ch & 7) * 16) = *(const u32x4*)(C + (r0 + rr) * 8192 + 2048 + hk * 128 + ch * 8); }
    for (int i = t; i < 512; i += nt) { const int row = i >> 3, ch = i & 7;
        *(LAS u32x4*)(buf + G3_A + row * 144 + ch * 16) = *(const u32x4*)(ATT + ((size_t)(cgl * 32 + hv) * 64 + row) * 64 + ch * 8); }
    for (int i = t; i < 256; i += nt) { const int rr = i >> 4, ch = i & 15, dvl = 2 * rr + (ch >> 3);
        *(LAS u32x4*)(buf + G3_UT + dvl * 144 + (ch & 7) * 16) = *(const u32x4*)(C + (r0 + 16 * dq + rr) * 8192 + 4096 + hv * 128 + ch * 8); }
    if (t < 64) *(LAS float*)(buf + G3_GCB + t * 4) = GC[(r0 + t) * 32 + hv];
}
__device__ __forceinline__ bf16x8 pack8(const f32x16& v, int s) {
    u32x4 w; w.x = cvt_pk_bf16(v[8 * s + 0], v[8 * s + 1]); w.y = cvt_pk_bf16(v[8 * s + 2], v[8 * s + 3]); w.z = cvt_pk_bf16(v[8 * s + 4], v[8 * s + 5]); w.w = cvt_pk_bf16(v[8 * s + 6], v[8 * s + 7]);
    return __builtin_bit_cast(bf16x8, w);
}
__device__ __forceinline__ bf16x8 ld2x8(const LAS unsigned char* p) {
    const u32x2 a = *(const LAS u32x2*)p, b = *(const LAS u32x2*)(p + 16);
    return __builtin_bit_cast(bf16x8, (u32x4){a.x, a.y, b.x, b.y});
}
__device__ __forceinline__ void phase_gdn_scan(const Ctx& c, bf16_t* PROJ, const bf16_t* C, const bf16_t* ATT, const float* GC) {
    LAS unsigned char* lds = c.lds;
    const int lane = c.lane, l31 = lane & 31, hh = lane >> 5;
    constexpr int NITEMS = 2 * GVH * 4;
    for (int wi = c.bid; wi < NITEMS; wi += c.G) {
        const int bl = wi >> 7, hv = (wi >> 2) & 31, dq = wi & 3;
        g3_stage(lds, PROJ, C, ATT, GC, bl * NCH, hv, dq, c.tid, NTHREADS);
        __syncthreads();
        f32x16 Sacc[4];
#pragma unroll
        for (int k = 0; k < 4; ++k)
#pragma unroll
            for (int r = 0; r < 16; ++r) Sacc[k][r] = 0.f;
        for (int ch = 0; ch < NCH; ++ch) {
            LAS unsigned char* buf = lds + (ch & 1) * G3_BUF;
            if (c.wave != 0) { if (ch + 1 < NCH) g3_stage(lds + ((ch + 1) & 1) * G3_BUF, PROJ, C, ATT, GC, bl * NCH + ch + 1, hv, dq, c.tid - 64, NTHREADS - 64); }
            else {
                const LAS float* gcb = (const LAS float*)(buf + G3_GCB);
                const float gl = gcb[63];
                bf16x8 Sb[4][2];
#pragma unroll
                for (int k = 0; k < 4; ++k) { Sb[k][0] = pack8(Sacc[k], 0); Sb[k][1] = pack8(Sacc[k], 1); }
                f32x16 vn[2], oa[2];
#pragma unroll
                for (int rt = 0; rt < 2; ++rt) {
#pragma unroll
                    for (int r = 0; r < 16; ++r) { vn[rt][r] = 0.f; oa[rt][r] = 0.f; }
                    const LAS unsigned char* wp = buf + G3_W + (32 * rt + l31) * 272 + hh * 8;
                    const LAS unsigned char* qp = buf + G3_Q + (32 * rt + l31) * 272 + hh * 8;
#pragma unroll
                    for (int k = 0; k < 4; ++k)
#pragma unroll
                        for (int s = 0; s < 2; ++s) {
                            vn[rt] = __builtin_amdgcn_mfma_f32_32x32x16_bf16(ld2x8(wp + (32 * k + 16 * s) * 2), Sb[k][s], vn[rt], 0, 0, 0);
                            oa[rt] = __builtin_amdgcn_mfma_f32_32x32x16_bf16(ld2x8(qp + (32 * k + 16 * s) * 2), Sb[k][s], oa[rt], 0, 0, 0);
                        }
                }
                bf16x8 Vb[2][2], Vsb[2][2];
#pragma unroll
                for (int rt = 0; rt < 2; ++rt)
#pragma unroll
                    for (int s = 0; s < 2; ++s) {
                        float pv[8], ps[8];
#pragma unroll
                        for (int g2 = 0; g2 < 2; ++g2) {
                            const int g = 2 * s + g2, i0 = 32 * rt + 8 * g + 4 * hh;
                            const u32x2 uu = *(const LAS u32x2*)(buf + G3_UT + l31 * 144 + i0 * 2);
                            const f32x4 gv = *(const LAS f32x4*)(gcb + i0);
                            const float u4[4] = {bflo(uu.x), bfhi(uu.x), bflo(uu.y), bfhi(uu.y)};
#pragma unroll
                            for (int q = 0; q < 4; ++q) { const int r = 4 * g + q; const float v = u4[q] - vn[rt][r]; pv[4 * g2 + q] = v; ps[4 * g2 + q] = v * __expf(gl - gv[q]); oa[rt][r] *= __expf(gv[q]); }
                        }
                        u32x4 w; w.x = cvt_pk_bf16(pv[0], pv[1]); w.y = cvt_pk_bf16(pv[2], pv[3]); w.z = cvt_pk_bf16(pv[4], pv[5]); w.w = cvt_pk_bf16(pv[6], pv[7]); Vb[rt][s] = __builtin_bit_cast(bf16x8, w);
                        w.x = cvt_pk_bf16(ps[0], ps[1]); w.y = cvt_pk_bf16(ps[2], ps[3]); w.z = cvt_pk_bf16(ps[4], ps[5]); w.w = cvt_pk_bf16(ps[6], ps[7]); Vsb[rt][s] = __builtin_bit_cast(bf16x8, w);
                    }
#pragma unroll
                for (int ro = 0; ro < 2; ++ro) { const LAS unsigned char* ap = buf + G3_A + (32 * ro + l31) * 144 + hh * 8;
#pragma unroll
                    for (int rt = 0; rt <= ro; ++rt)
#pragma unroll
                        for (int s = 0; s < 2; ++s) oa[ro] = __builtin_amdgcn_mfma_f32_32x32x16_bf16(ld2x8(ap + (32 * rt + 16 * s) * 2), Vb[rt][s], oa[ro], 0, 0, 0); }
                const float dec = __expf(gl);
#pragma unroll
                for (int k = 0; k < 4; ++k) {
#pragma unroll
                    for (int r = 0; r < 16; ++r) Sacc[k][r] *= dec;
                    const LAS unsigned char* kp = buf + G3_KT + (32 * k + l31) * 144 + hh * 8;
#pragma unroll
                    for (int rt = 0; rt < 2; ++rt)
#pragma unroll
                        for (int s = 0; s < 2; ++s) Sacc[k] = __builtin_amdgcn_mfma_f32_32x32x16_bf16(ld2x8(kp + (32 * rt + 16 * s) * 2), Vsb[rt][s], Sacc[k], 0, 0, 0);
                }
                bf16_t* op = PROJ + ((size_t)(bl * NCH + ch) * CH) * GINP + 4096 + hv * 128 + 32 * dq + l31;
#pragma unroll
                for (int rt = 0; rt < 2; ++rt)
#pragma unroll
                    for (int r = 0; r < 16; ++r) op[(size_t)(32 * rt + (r & 3) + 8 * (r >> 2) + 4 * hh) * GINP] = (bf16_t)f2bf(oa[rt][r]);
            }
            __syncthreads();
        }
    }
}

__device__ __forceinline__ void phase_gdn_onorm(const Ctx& c, bf16_t* PROJ, const float* o_gain) {
    const int gw = c.bid * NWAVES + c.wave, NGW = c.G * NWAVES, sub = c.lane >> 4, ch = c.lane & 15;
    float og[8];
    { const f32x4 a = *(const f32x4*)(o_gain + ch * 8), b = *(const f32x4*)(o_gain + ch * 8 + 4);
#pragma unroll
      for (int k = 0; k < 4; ++k) { og[k] = a[k]; og[4 + k] = b[k]; } }
    const int npairs = MH * GVH / 4;
    for (int it = gw; it < npairs; it += NGW) {
        const int pr = it * 4 + sub, row = pr >> 5, hv = pr & 31;
        bf16_t* op = PROJ + (size_t)row * GINP + 4096 + hv * 128 + ch * 8;
        const u32x4 ov = *(const u32x4*)op, gv = *(const u32x4*)(op + 4096);
        float o[8], g[8]; float ss = 0.f;
#pragma unroll
        for (int k = 0; k < 4; ++k) { o[2 * k] = bflo(ov[k]); o[2 * k + 1] = bfhi(ov[k]); g[2 * k] = bflo(gv[k]); g[2 * k + 1] = bfhi(gv[k]); }
#pragma unroll
        for (int k = 0; k < 8; ++k) ss += o[k] * o[k];
        ss += __shfl_xor(ss, 1); ss += __shfl_xor(ss, 2); ss += __shfl_xor(ss, 4); ss += __shfl_xor(ss, 8);
        const float rs = 1.0f / sqrtf(ss * (1.0f / 128.f) + EPS);
        float y[8];
#pragma unroll
        for (int k = 0; k < 8; ++k) y[k] = o[k] * rs * og[k] * siluf(g[k]);
        u32x4 w; w.x = cvt_pk_bf16(y[0], y[1]); w.y = cvt_pk_bf16(y[2], y[3]); w.z = cvt_pk_bf16(y[4], y[5]); w.w = cvt_pk_bf16(y[6], y[7]);
        *(u32x4*)op = w;
    }
}

typedef const __attribute__((address_space(4))) Args* KArgsP;
__device__ __forceinline__ KArgsP kargs() { const unsigned long long p0 = (unsigned long long)__builtin_amdgcn_kernarg_segment_ptr(); unsigned lo32 = (unsigned)p0, hi32 = (unsigned)(p0 >> 32);
    asm volatile("" : "+v"(lo32), "+v"(hi32)); lo32 = __builtin_amdgcn_readfirstlane(lo32); hi32 = __builtin_amdgcn_readfirstlane(hi32); return (KArgsP)(((unsigned long long)hi32 << 32) | lo32); }
__device__ __forceinline__ Ctx mkctx(LAS unsigned char* lds) { Ctx c; int tid = threadIdx.x; asm volatile("" : "+v"(tid)); c.lds = lds; c.tid = tid; c.lane = tid & 63; c.wave = __builtin_amdgcn_readfirstlane(tid >> 6); c.G = gridDim.x; c.bid = blockIdx.x; return c; }
#ifndef PHASE_EN
#define PHASE_EN 0xFFFFFFFFu
#endif
#define EN(id) (((PHASE_EN) >> (id)) & 1u)

__global__ void __launch_bounds__(NTHREADS, 2) fwd_kernel(Args args) {
    extern __shared__ __attribute__((aligned(16))) unsigned char lds_raw[];
    LAS unsigned char* const lds = (LAS unsigned char*)lds_raw;
    volatile LAS unsigned* MISC = (volatile LAS unsigned*)(lds + MISC_OFF);
    if (threadIdx.x < 64) MISC[threadIdx.x] = 0u;
    __syncthreads();
    XcdBarrier bar; bar.bar = nullptr; bar.x = 0; bar.st = nullptr;
    if (N_LAUNCH_MODE == 1) { KArgsP ap = kargs(); bar = xcd_barrier_post((unsigned*)(ap->ws + WS_CTL) + CW_BAR, MISC + 8); }
    const int lo = args.ph_lo, hi = args.ph_hi;
    int ph = 0;
#define PH_IN (ph >= lo && ph < hi)
#define PH_END do { if (PH_IN && ph + 1 < hi) { if (N_LAUNCH_MODE == 1) xcd_barrier(bar); } ++ph; } while (0)

    if (EN(0) && PH_IN) { const Ctx c = mkctx(lds); phase_weights(c, kargs()); }
    PH_END;

    for (int layer = 0; layer < 4; ++layer) {
        const int kind = layer % 3, j = layer / 3;
        if (EN(1) && PH_IN) { const Ctx c = mkctx(lds); KArgsP ap = kargs(); unsigned char* ws = ap->ws;
            phase_rmsnorm(c, (layer == 0) ? ap->x : (const float*)ap->out, ap->mix_norm + layer * D, (bf16_t*)(ws + WS_H)); }
        PH_END;
        if (kind == 0) {
            if (EN(2) && PH_IN) { const Ctx c = mkctx(lds); KArgsP ap = kargs(); unsigned char* ws = ap->ws;
                pg8::Gemm g{(const bf16_t*)(ws + WS_H), (const bf16_t*)(ws + WS_WQKV) + (size_t)j * 6144 * D, T, 6144, D, D, D, 0}; pg8::StaticOrder S; S.init(T, 6144, c.G, c.bid);
                pg8::EpiBf16 E{(bf16_t*)(ws + WS_QKV), 6144}; pg8::gemm_phase(c.lds, c.tid, g, S, E); }
            PH_END;
            if (EN(3) && PH_IN) { const Ctx c = mkctx(lds); KArgsP ap = kargs(); unsigned char* ws = ap->ws;
                phase_attention(c, (const bf16_t*)(ws + WS_QKV), (bf16_t*)(ws + WS_AO), ap->att_q_gain + j * AHD, ap->att_k_gain + j * AHD, ap->att_rel_bias + (size_t)j * AH * NREL); }
            PH_END;
            if (EN(4) && PH_IN) { const Ctx c = mkctx(lds); KArgsP ap = kargs(); unsigned char* ws = ap->ws;
                pg8::Gemm g{(const bf16_t*)(ws + WS_AO), (const bf16_t*)(ws + WS_WO) + (size_t)j * D * D, T, D, D, D, D, 0}; pg8::StaticOrder S; S.init(T, D, c.G, c.bid);
                pg8::EpiRes E{(layer == 0) ? ap->x : (const float*)ap->out, ap->out, D, nullptr}; pg8::gemm_phase(c.lds, c.tid, g, S, E); }
            PH_END;
        } else if (kind == 1) {
            if (EN(5) && PH_IN) { const Ctx c = mkctx(lds); KArgsP ap = kargs(); unsigned char* ws = ap->ws;
                phase_pool_prep(c, (const bf16_t*)(ws + WS_H), (bf16_t*)(ws + WS_POOLED)); }
            PH_END;
            if (EN(6) && PH_IN) { const Ctx c = mkctx(lds); KArgsP ap = kargs(); unsigned char* ws = ap->ws;
                pg8::Gemm g{(const bf16_t*)(ws + WS_POOLED), (const bf16_t*)(ws + WS_WPOOL), T, D, 512, D, 512, 2}; pg8::StaticOrder S; S.init(T, D, c.G, c.bid);
                pg8::EpiRes E{ap->out, ap->out, D, ap->pool_scale + j * D}; pg8::gemm_phase(c.lds, c.tid, g, S, E); }
            PH_END;
        } else {
            for (int half = 0; half < 2; ++half) {
                if (EN(7) && PH_IN) { const Ctx c = mkctx(lds); KArgsP ap = kargs(); unsigned char* ws = ap->ws;
                    pg8::Gemm g{(const bf16_t*)(ws + WS_H) + (size_t)half * MH * D, (const bf16_t*)(ws + WS_WGIN), MH, GINP, D, D, D, 0}; pg8::StaticOrder S; S.init(MH, GINP, c.G, c.bid);
                    pg8::EpiProj E{(bf16_t*)(ws + WS_PROJ), GINP, (float*)(ws + WS_AB)}; pg8::gemm_phase(c.lds, c.tid, g, S, E); }
                PH_END;
                if (EN(8) && PH_IN) { const Ctx c = mkctx(lds); KArgsP ap = kargs(); unsigned char* ws = ap->ws;
                    phase_gdn_conv(c, (const bf16_t*)(ws + WS_PROJ), (bf16_t*)(ws + WS_C), ap->gdn_conv); }
                PH_END;
                if (EN(9) && PH_IN) { const Ctx c = mkctx(lds); KArgsP ap = kargs(); unsigned char* ws = ap->ws;
                    phase_gdn_local(c, (bf16_t*)(ws + WS_PROJ), (bf16_t*)(ws + WS_C), (bf16_t*)(ws + WS_ATT), (const float*)(ws + WS_AB), (float*)(ws + WS_GC), ap->gdn_a_log, ap->gdn_dt_bias); }
                PH_END;
                if (EN(10) && PH_IN) { const Ctx c = mkctx(lds); KArgsP ap = kargs(); unsigned char* ws = ap->ws;
                    phase_gdn_scan(c, (bf16_t*)(ws + WS_PROJ), (const bf16_t*)(ws + WS_C), (const bf16_t*)(ws + WS_ATT), (const float*)(ws + WS_GC)); }
                PH_END;
                if (EN(11) && PH_IN) { const Ctx c = mkctx(lds); KArgsP ap = kargs(); unsigned char* ws = ap->ws;
                    phase_gdn_onorm(c, (bf16_t*)(ws + WS_PROJ), ap->gdn_o_gain); }
                PH_END;
                if (EN(12) && PH_IN) { const Ctx c = mkctx(lds); KArgsP ap = kargs(); unsigned char* ws = ap->ws;
                    pg8::Gemm g{(const bf16_t*)(ws + WS_PROJ) + 4096, (const bf16_t*)(ws + WS_WGO), MH, D, 4096, GINP, 4096, 0}; pg8::StaticOrder S; S.init(MH, D, c.G, c.bid);
                    pg8::EpiRes E{(const float*)ap->out + (size_t)half * MH * D, ap->out + (size_t)half * MH * D, D, nullptr}; pg8::gemm_phase(c.lds, c.tid, g, S, E); }
                PH_END;
            }
        }
        if (EN(13) && PH_IN) { const Ctx c = mkctx(lds); KArgsP ap = kargs(); unsigned char* ws = ap->ws;
            phase_rmsnorm(c, ap->out, ap->ffn_norm + layer * D, (bf16_t*)(ws + WS_H)); }
        PH_END;
        if (EN(14) && PH_IN) { const Ctx c = mkctx(lds); KArgsP ap = kargs(); unsigned char* ws = ap->ws;
            pg8::Gemm g{(const bf16_t*)(ws + WS_H), (const bf16_t*)(ws + WS_WUP) + (size_t)layer * FF2 * D, T, FF2, D, D, D, 0}; pg8::StaticOrder S; S.init(T, FF2, c.G, c.bid);
            pg8::EpiBf16 E{(bf16_t*)(ws + WS_UP), FF2}; pg8::gemm_phase(c.lds, c.tid, g, S, E); }
        PH_END;
        if (EN(15) && PH_IN) { const Ctx c = mkctx(lds); KArgsP ap = kargs(); unsigned char* ws = ap->ws;
            phase_ffn_act(c, (bf16_t*)(ws + WS_UP), ap->ffn_conv + (size_t)layer * 3 * FF); }
        PH_END;
        if (EN(16) && PH_IN) { const Ctx c = mkctx(lds); KArgsP ap = kargs(); unsigned char* ws = ap->ws;
            pg8::Gemm g{(const bf16_t*)(ws + WS_UP) + FF, (const bf16_t*)(ws + WS_WDN) + (size_t)layer * D * FF, T, D, FF, FF2, FF, 0}; pg8::StaticOrder S; S.init(T, D, c.G, c.bid);
            pg8::EpiRes E{ap->out, ap->out, D, nullptr}; pg8::gemm_phase(c.lds, c.tid, g, S, E); }
        PH_END;
    }
#undef PH_IN
#undef PH_END
}

constexpr int N_PHASES = 1 + 8 + 7 + 17 + 8;

extern "C" void kernel_launch(void* const* d_in, const int* in_sizes, int n_in, void* d_out, int out_size, void* d_ws, size_t ws_size, hipStream_t stream) {
    static int grid = 0;
    if (grid == 0) {
        if (n_in != 19 || out_size != T * D || ws_size < WS_NEED) { fprintf(stderr, "kernel_launch: unexpected problem (n_in %d, out %d, ws %zu, need %zu)\n", n_in, out_size, ws_size, (size_t)WS_NEED); grid = -1; return; }
        int dev = 0, cus = 0, per_cu = 0;
        if (hipGetDevice(&dev) != hipSuccess || hipDeviceGetAttribute(&cus, hipDeviceAttributeMultiprocessorCount, dev) != hipSuccess) { grid = -1; return; }
        if (hipFuncSetAttribute((const void*)fwd_kernel, hipFuncAttributeMaxDynamicSharedMemorySize, LDS_BYTES) != hipSuccess) { fprintf(stderr, "kernel_launch: hipFuncSetAttribute failed\n"); grid = -1; return; }
        if (hipOccupancyMaxActiveBlocksPerMultiprocessor(&per_cu, (const void*)fwd_kernel, NTHREADS, LDS_BYTES) != hipSuccess || per_cu < 1) fprintf(stderr, "kernel_launch: occupancy query says %d\n", per_cu);
        (void)hipGetLastError();
        grid = cus;
    }
    if (grid < 0) return;
    unsigned char* ws = (unsigned char*)d_ws;
    (void)hipMemsetAsync(ws + WS_CTL, 0, CTL_ZERO_BYTES, stream);
    Args a{};
    a.x = (const float*)d_in[0]; a.mix_norm = (const float*)d_in[1]; a.ffn_norm = (const float*)d_in[2];
    a.att_q_gain = (const float*)d_in[4]; a.att_k_gain = (const float*)d_in[5]; a.att_rel_bias = (const float*)d_in[6];
    a.pool_scale = (const float*)d_in[9]; a.gdn_conv = (const float*)d_in[11]; a.gdn_a_log = (const float*)d_in[12]; a.gdn_dt_bias = (const float*)d_in[13];
    a.gdn_o_gain = (const float*)d_in[14]; a.ffn_conv = (const float*)d_in[17];
    a.out = (float*)d_out; a.ws = ws;
    a.wd[0] = WDesc{(const float*)d_in[3],  (bf16_t*)(ws + WS_WQKV), D, 6144, 2, 0};
    a.wd[1] = WDesc{(const float*)d_in[7],  (bf16_t*)(ws + WS_WO),   D, D, 2, 0};
    a.wd[2] = WDesc{(const float*)d_in[8],  (bf16_t*)(ws + WS_WPOOL), 512, 512, 4, 0};
    a.wd[3] = WDesc{(const float*)d_in[10], (bf16_t*)(ws + WS_WGIN), D, GIN, 1, 0};
    a.wd[4] = WDesc{(const float*)d_in[15], (bf16_t*)(ws + WS_WGO),  4096, D, 1, 0};
    a.wd[5] = WDesc{(const float*)d_in[16], (bf16_t*)(ws + WS_WUP),  D, FF2, 4, 0};
    a.wd[6] = WDesc{(const float*)d_in[18], (bf16_t*)(ws + WS_WDN),  FF, D, 4, 0};
    if (N_LAUNCH_MODE == 1) {
        a.ph_lo = 0; a.ph_hi = N_PHASES;
        hipLaunchKernelGGL(fwd_kernel, dim3(grid), dim3(NTHREADS), LDS_BYTES, stream, a);
    } else {
        for (int p = 0; p < N_PHASES; ++p) { a.ph_lo = p; a.ph_hi = p + 1; hipLaunchKernelGGL(fwd_kernel, dim3(grid), dim3(NTHREADS), LDS_BYTES, stream, a); }
    }
}
```

```cpp
#include <hip/hip_runtime.h>
#include <cstdio>
#include <cstdint>

#ifndef N_LAUNCH_MODE
#define N_LAUNCH_MODE 1
#endif

#define LAS __attribute__((address_space(3)))
#define GAS __attribute__((address_space(1)))
typedef unsigned short bf16_t;
typedef short bf16x8 __attribute__((ext_vector_type(8)));
typedef short s16x4 __attribute__((ext_vector_type(4)));
typedef float f32x4 __attribute__((ext_vector_type(4)));
typedef float f32x2 __attribute__((ext_vector_type(2)));
typedef float f32x16 __attribute__((ext_vector_type(16)));
typedef unsigned u32x4 __attribute__((ext_vector_type(4)));
typedef unsigned u32x2 __attribute__((ext_vector_type(2)));

constexpr int D = 2048, BATCH = 4, SEQ = 8192, T = BATCH * SEQ;
constexpr int CH = 64, NCH = SEQ / CH;
constexpr int AH = 16, AHD = 128, NREL = 320;
constexpr int GKH = 16, GVH = 32, GIN = 12352, GINP = 12544;
constexpr int FF = 5504, FF2 = 11008;
constexpr int MH = T / 2;
constexpr float EPS = 1e-6f;
constexpr int NTHREADS = 512, NWAVES = 8;

constexpr size_t MiB = 1u << 20;
constexpr size_t WS_CTL = 0, CTL_ZERO_BYTES = 1 * MiB;
constexpr size_t WS_WQKV = 1 * MiB;
constexpr size_t WS_WO   = WS_WQKV + 48 * MiB;
constexpr size_t WS_WPOOL= WS_WO + 16 * MiB;
constexpr size_t WS_WGIN = WS_WPOOL + 2 * MiB;
constexpr size_t WS_WGO  = WS_WGIN + 49 * MiB;
constexpr size_t WS_WUP  = WS_WGO + 16 * MiB;
constexpr size_t WS_WDN  = WS_WUP + 172 * MiB;
constexpr size_t WS_H    = WS_WDN + 86 * MiB;
constexpr size_t WS_BIG  = WS_H + 128 * MiB;
constexpr size_t WS_QKV  = WS_BIG;
constexpr size_t WS_AO   = WS_QKV + 384 * MiB;
constexpr size_t WS_ACT  = WS_BIG;
constexpr size_t WS_TAILU = WS_ACT + 344 * MiB;
constexpr size_t WS_HEADU = WS_TAILU + 11 * MiB;
constexpr size_t WS_HEADG = WS_HEADU + 11 * MiB;
constexpr size_t WS_POOLED = WS_BIG;
constexpr size_t WS_PROJ = WS_BIG;
constexpr size_t WS_C    = WS_PROJ + 392 * MiB;
constexpr size_t WS_ATT  = WS_C + 256 * MiB;
constexpr size_t WS_AB   = WS_ATT + 64 * MiB;
constexpr size_t WS_GC   = WS_AB + 4 * MiB;
constexpr size_t WS_END  = WS_GC + 2 * MiB;
constexpr size_t WS_NEED = WS_BIG + 718 * MiB;
static_assert(WS_END <= WS_NEED && WS_HEADG + 11 * MiB <= WS_NEED && WS_AO + (size_t)T * D * 2 <= WS_NEED, "map");

constexpr int CW_BAR = 4096;

__device__ __forceinline__ float bf2f(unsigned b) { return __uint_as_float(b << 16); }
__device__ __forceinline__ float bflo(unsigned w) { return __uint_as_float(w << 16); }
__device__ __forceinline__ float bfhi(unsigned w) { return __uint_as_float(w & 0xffff0000u); }
__device__ __forceinline__ unsigned cvt_pk_bf16(float lo, float hi) { unsigned r; asm volatile("v_cvt_pk_bf16_f32 %0, %1, %2" : "=v"(r) : "v"(lo), "v"(hi)); return r; }
__device__ __forceinline__ unsigned f2bf(float f) { return cvt_pk_bf16(f, 0.f) & 0xffffu; }
__device__ __forceinline__ float wave_sum(float v) {
#pragma unroll
    for (int o = 1; o < 64; o <<= 1) v += __shfl_xor(v, o);
    return v;
}
__device__ __forceinline__ float siluf(float x) { return x * __builtin_amdgcn_rcpf(1.0f + __expf(-x)); }
#define LDS_WAIT() asm volatile("s_waitcnt lgkmcnt(0)" ::: "memory")
#define VM_WAIT() asm volatile("s_waitcnt vmcnt(0)" ::: "memory")

namespace pg8 {
constexpr int BM = 256, BK = 64, HALF = 128, HTB = HALF * BK * 2, STAGE_BYTES = 8 * HTB, NXCD = 8, WGM = 8;
__host__ __device__ __forceinline__ int lds_byte(int r, int c) { const int st = (r >> 4) * 2 + (c >> 5), rr = r & 15, cc = c & 31, ob = rr * 64 + cc * 2; return st * 1024 + (ob ^ (((ob >> 9) & 1) << 5)); }
__host__ __device__ __forceinline__ void stage_rc(int b, int& R, int& C) { const int st = b / 1024, sb = b % 1024, swz = sb ^ (((sb >> 9) & 1) << 5); R = (st >> 1) * 16 + swz / 64; C = (st & 1) * 32 + (swz % 64) / 2; }
__host__ __device__ __forceinline__ int perm32(int rho) { const int n = rho >> 4, i = rho & 15; return 8 * (i >> 2) + 4 * n + (i & 3); }

struct Unit { int pm, pn; };
struct Gemm { const bf16_t* A; const bf16_t* Bt; int M, N, K, lda, ldb, grp; };

struct StaticOrder {
    int nM, nN, nwg, G, c;
    __device__ void init(int M, int N, int G_, int c_) { nM = M / BM; nN = N / BM; nwg = nM * nN; G = G_; c = c_; }
    __device__ bool next(int i, Unit& u) const {
        const long L = (long)i * G + c; if (L >= nwg) return false;
        int wgid = (int)L; { const int q = nwg / NXCD, r = nwg % NXCD, xcd = wgid % NXCD, off = wgid / NXCD; wgid = (xcd < r ? xcd * (q + 1) : r * (q + 1) + (xcd - r) * q) + off; }
        const int nig = WGM * nN, gid = wgid / nig, fm = gid * WGM, gsz = (nM - fm) < WGM ? (nM - fm) : WGM;
        u.pm = fm + ((wgid % nig) % gsz); u.pn = (wgid % nig) / gsz; return true;
    }
};

struct EpiBf16 {
    static constexpr bool PERM = true;
    bf16_t* O; int ldc;
    __device__ __forceinline__ void operator()(const f32x4 (&acc)[2][2][4][2], const Unit& u, int wr, int wc, int fr, int fq) const {
        const int row0 = u.pm * BM + wr * 64 + fr, col0 = u.pn * BM + wc * 32 + 8 * fq;
#pragma unroll
        for (int ai = 0; ai < 2; ++ai)
#pragma unroll
            for (int m = 0; m < 4; ++m) { bf16_t* rowp = O + (size_t)(row0 + ai * HALF + m * 16) * ldc + col0;
#pragma unroll
                for (int bj = 0; bj < 2; ++bj) { const f32x4 v0 = acc[ai][bj][m][0], v1 = acc[ai][bj][m][1];
                    u32x4 w; w.x = cvt_pk_bf16(v0[0], v0[1]); w.y = cvt_pk_bf16(v0[2], v0[3]); w.z = cvt_pk_bf16(v1[0], v1[1]); w.w = cvt_pk_bf16(v1[2], v1[3]);
                    *(u32x4*)(rowp + bj * HALF) = w; } }
    }
};
struct EpiProj {
    static constexpr bool PERM = true;
    bf16_t* O; int ldc; float* AB;
    __device__ __forceinline__ void operator()(const f32x4 (&acc)[2][2][4][2], const Unit& u, int wr, int wc, int fr, int fq) const {
        const int row0 = u.pm * BM + wr * 64 + fr;
        if (u.pn == 48) {
            if (wc < 2) {
#pragma unroll
                for (int ai = 0; ai < 2; ++ai)
#pragma unroll
                    for (int m = 0; m < 4; ++m) { float* rp = AB + (size_t)(row0 + ai * HALF + m * 16) * 64 + wc * 32 + 8 * fq;
                        *(f32x4*)(rp) = acc[ai][0][m][0]; *(f32x4*)(rp + 4) = acc[ai][0][m][1]; }
            }
            return;
        }
        const int col0 = u.pn * BM + wc * 32 + 8 * fq;
#pragma unroll
        for (int ai = 0; ai < 2; ++ai)
#pragma unroll
            for (int m = 0; m < 4; ++m) { bf16_t* rowp = O + (size_t)(row0 + ai * HALF + m * 16) * ldc + col0;
#pragma unroll
                for (int bj = 0; bj < 2; ++bj) { const f32x4 v0 = acc[ai][bj][m][0], v1 = acc[ai][bj][m][1];
                    u32x4 w; w.x = cvt_pk_bf16(v0[0], v0[1]); w.y = cvt_pk_bf16(v0[2], v0[3]); w.z = cvt_pk_bf16(v1[0], v1[1]); w.w = cvt_pk_bf16(v1[2], v1[3]);
                    *(u32x4*)(rowp + bj * HALF) = w; } }
    }
};
struct EpiRes {
    static constexpr bool PERM = false;
    const float* base; float* out; int ldc; const float* scale;
    __device__ __forceinline__ void operator()(const f32x4 (&acc)[2][2][4][2], const Unit& u, int wr, int wc, int fr, int fq) const {
        const int row0 = u.pm * BM + wr * 64 + fr, col0 = u.pn * BM + wc * 32 + 4 * fq;
        f32x4 sv[2][2];
#pragma unroll
        for (int bj = 0; bj < 2; ++bj)
#pragma unroll
            for (int n = 0; n < 2; ++n) sv[bj][n] = scale ? *(const f32x4*)(scale + col0 + bj * HALF + n * 16) : (f32x4){1.f, 1.f, 1.f, 1.f};
#pragma unroll
        for (int ai = 0; ai < 2; ++ai)
#pragma unroll
            for (int m = 0; m < 4; ++m) { const size_t off = (size_t)(row0 + ai * HALF + m * 16) * ldc + col0;
#pragma unroll
                for (int bj = 0; bj < 2; ++bj)
#pragma unroll
                    for (int n = 0; n < 2; ++n) { const f32x4 bs = *(const f32x4*)(base + off + bj * HALF + n * 16);
                        *(f32x4*)(out + off + bj * HALF + n * 16) = bs + acc[ai][bj][m][n] * sv[bj][n]; } }
    }
};


template <int N> __device__ __forceinline__ float dpp_rowprev(float cur, float prevm) {
    const int t = __builtin_amdgcn_update_dpp(0, __builtin_bit_cast(int, prevm), 0x120 + N, 0xf, 0xf, false);
    return __builtin_bit_cast(float, __builtin_amdgcn_update_dpp(t, __builtin_bit_cast(int, cur), 0x110 + N, 0xf, 0xf, false));
}
struct EpiFfn {
    static constexpr bool PERM = true;
    bf16_t* ACT; const float* cw; bf16_t* TAILU; bf16_t* HEADU; bf16_t* HEADG;
    __device__ __forceinline__ void operator()(const f32x4 (&acc)[2][2][4][2], const Unit& u, int wr, int wc, int fr, int fq) const {
        const int colu = u.pn * 128 + wc * 32 + 8 * fq;
        float w0[8], w1[8], w2[8];
#pragma unroll
        for (int h = 0; h < 2; ++h) { const f32x4 a0 = *(const f32x4*)(cw + colu + 4 * h), a1 = *(const f32x4*)(cw + FF + colu + 4 * h), a2 = *(const f32x4*)(cw + 2 * FF + colu + 4 * h);
#pragma unroll
            for (int k = 0; k < 4; ++k) { w0[4 * h + k] = a0[k]; w1[4 * h + k] = a1[k]; w2[4 * h + k] = a2[k]; } }
#pragma unroll
        for (int ai = 0; ai < 2; ++ai) {
            const int sg = u.pm * 4 + ai * 2 + wr, rowbase = u.pm * BM + ai * HALF + wr * 64;
#pragma unroll
            for (int m = 0; m < 4; ++m) {
                float y[8];
#pragma unroll
                for (int n = 0; n < 2; ++n)
#pragma unroll
                    for (int k = 0; k < 4; ++k) {
                        const float cur = acc[ai][0][m][n][k], pm_ = (m > 0) ? acc[ai][0][m > 0 ? m - 1 : 0][n][k] : 0.f;
                        const float p1 = dpp_rowprev<1>(cur, pm_), p2 = dpp_rowprev<2>(cur, pm_);
                        const float sv = w0[4 * n + k] * p2 + w1[4 * n + k] * p1 + w2[4 * n + k] * cur;
                        y[4 * n + k] = siluf(sv) * acc[ai][1][m][n][k];
                    }
                if (!(m == 0 && fr < 2)) { u32x4 w; w.x = cvt_pk_bf16(y[0], y[1]); w.y = cvt_pk_bf16(y[2], y[3]); w.z = cvt_pk_bf16(y[4], y[5]); w.w = cvt_pk_bf16(y[6], y[7]);
                    *(u32x4*)(ACT + (size_t)(rowbase + 16 * m + fr) * FF + colu) = w; }
                if (m == 0 && fr < 2) {
                    const f32x4 u0 = acc[ai][0][0][0], u1 = acc[ai][0][0][1], g0 = acc[ai][1][0][0], g1 = acc[ai][1][0][1];
                    u32x4 w; w.x = cvt_pk_bf16(u0[0], u0[1]); w.y = cvt_pk_bf16(u0[2], u0[3]); w.z = cvt_pk_bf16(u1[0], u1[1]); w.w = cvt_pk_bf16(u1[2], u1[3]);
                    *(u32x4*)(HEADU + (size_t)(sg * 2 + fr) * FF + colu) = w;
                    w.x = cvt_pk_bf16(g0[0], g0[1]); w.y = cvt_pk_bf16(g0[2], g0[3]); w.z = cvt_pk_bf16(g1[0], g1[1]); w.w = cvt_pk_bf16(g1[2], g1[3]);
                    *(u32x4*)(HEADG + (size_t)(sg * 2 + fr) * FF + colu) = w;
                }
                if (m == 3 && fr >= 14) {
                    const f32x4 u0 = acc[ai][0][3][0], u1 = acc[ai][0][3][1];
                    u32x4 w; w.x = cvt_pk_bf16(u0[0], u0[1]); w.y = cvt_pk_bf16(u0[2], u0[3]); w.z = cvt_pk_bf16(u1[0], u1[1]); w.w = cvt_pk_bf16(u1[2], u1[3]);
                    *(u32x4*)(TAILU + (size_t)(sg * 2 + fr - 14) * FF + colu) = w;
                }
            }
        }
    }
};
template <class Epi, class Sched>
__device__ __forceinline__ void gemm_phase(LAS unsigned char* lds, const int tid, const Gemm g, const Sched& S, const Epi& E) {
    const int wid = __builtin_amdgcn_readfirstlane(tid >> 6), lane = tid & 63, wr = wid >> 2, wc = wid & 3, fr = lane & 15, fq = lane >> 4;
    const int K = g.K, nt = K / BK;
    unsigned voffA[2], voffB[2];
#pragma unroll
    for (int i = 0; i < 2; ++i) { int R, C; stage_rc(tid * 16 + i * 8192, R, C); const int Rb = Epi::PERM ? ((R & ~31) + perm32(R & 31)) : R;
        voffA[i] = (unsigned)(R * g.lda + C) * 2u; voffB[i] = (unsigned)(Rb * g.ldb + C) * 2u; }
    const size_t kstep = (size_t)(BK * 2);
    const size_t hstepA = (size_t)HALF * g.lda * 2, hstepB = (size_t)HALF * g.ldb * 2;
    const size_t tstepA = 2 * hstepA, tstepB = 2 * hstepB;
    const unsigned ldsw = (unsigned)wid * 1024u;
    const int aoff = lds_byte(wr * 64 + fr, fq * 8), boff = lds_byte(wc * 32 + fr, fq * 8);
#define PG8_SA(b, h) (((b) * 2 + (h)) * HTB)
#define PG8_SB(b, h) ((4 + (b) * 2 + (h)) * HTB)
#define PG8_STAGE(bufoff, gbase, voff) do { _Pragma("unroll") for (int _i = 0; _i < 2; ++_i) \
        __builtin_amdgcn_global_load_lds((const unsigned*)((const char*)(gbase) + (voff)[_i]), (LAS unsigned*)(lds + (bufoff) + ldsw + _i * 8192), 16, 0, 0); } while (0)
#define PG8_LDA(dst, b, h) do { _Pragma("unroll") for (int m = 0; m < 4; ++m) _Pragma("unroll") for (int k = 0; k < 2; ++k) dst[m][k] = *(const LAS bf16x8*)(lds + PG8_SA(b, h) + aoff + m * 2048 + k * 1024); } while (0)
#define PG8_LDB(dst, b, h) do { _Pragma("unroll") for (int n = 0; n < 2; ++n) _Pragma("unroll") for (int k = 0; k < 2; ++k) dst[n][k] = *(const LAS bf16x8*)(lds + PG8_SB(b, h) + boff + n * 2048 + k * 1024); } while (0)
#define PG8_MMA(ai, bj, At, Bt) do { __builtin_amdgcn_s_setprio(1); _Pragma("unroll") for (int m = 0; m < 4; ++m) _Pragma("unroll") for (int n = 0; n < 2; ++n) _Pragma("unroll") for (int k = 0; k < 2; ++k) \
        acc[ai][bj][m][n] = __builtin_amdgcn_mfma_f32_16x16x32_bf16(Bt[n][k], At[m][k], acc[ai][bj][m][n], 0, 0, 0); __builtin_amdgcn_s_setprio(0); } while (0)
#define PG8_WAIT_V(n) asm volatile("s_waitcnt vmcnt(" #n ")" ::: "memory")
#define PG8_WAIT_L(n) asm volatile("s_waitcnt lgkmcnt(" #n ")" ::: "memory")
#define PG8_BAR __builtin_amdgcn_s_barrier()
#define PG8_SCHED __builtin_amdgcn_sched_barrier(0)
#define PG8_AOFF(u) ((size_t)(u).pm * tstepA + (g.grp ? (size_t)((u).pn / g.grp) * (size_t)K * 2 : (size_t)0))
    Unit cur, nxt; int ui = 0;
    if (!S.next(0, cur)) return;
    f32x4 acc[2][2][4][2];
#pragma unroll
    for (int a = 0; a < 2; ++a)
#pragma unroll
        for (int b = 0; b < 2; ++b)
#pragma unroll
            for (int m = 0; m < 4; ++m)
#pragma unroll
                for (int n = 0; n < 2; ++n) acc[a][b][m][n] = (f32x4){0.f, 0.f, 0.f, 0.f};
    bf16x8 At[4][2], B0[2][2], B1[2][2];
    const char* cA = (const char*)g.A + PG8_AOFF(cur); const char* cB = (const char*)g.Bt + (size_t)cur.pn * tstepB;
    PG8_STAGE(PG8_SB(0, 0), cB, voffB); PG8_STAGE(PG8_SB(0, 1), cB + hstepB, voffB); PG8_STAGE(PG8_SA(0, 0), cA, voffA); PG8_STAGE(PG8_SA(0, 1), cA + hstepA, voffA);
    if (wr == 1) PG8_BAR;
    PG8_WAIT_V(2); PG8_BAR;
    PG8_STAGE(PG8_SB(1, 0), cB + kstep, voffB); PG8_STAGE(PG8_SA(1, 0), cA + kstep, voffA); PG8_STAGE(PG8_SB(1, 1), cB + hstepB + kstep, voffB);
    PG8_WAIT_V(6); PG8_BAR;
    for (;;) {
        const bool has_next = S.next(ui + 1, nxt);
        const char* nA = has_next ? (const char*)g.A + PG8_AOFF(nxt) : cA; const char* nB = has_next ? (const char*)g.Bt + (size_t)nxt.pn * tstepB : cB;
        for (int t = 0; t < nt; t += 2) {
            const bool last = (t == nt - 2);
            const char* a1 = cA + (size_t)(t + 1) * kstep;
            const char* a2 = last ? nA : cA + (size_t)(t + 2) * kstep; const char* b2 = last ? nB : cB + (size_t)(t + 2) * kstep;
            const char* a3 = a2 + kstep; const char* b3 = b2 + kstep;
            PG8_LDB(B0, 0, 0); PG8_LDB(B1, 0, 1); PG8_SCHED; PG8_LDA(At, 0, 0); PG8_STAGE(PG8_SA(1, 1), a1 + hstepA, voffA);
            PG8_WAIT_V(8); PG8_WAIT_L(0); PG8_BAR; PG8_MMA(0, 0, At, B0); PG8_MMA(0, 1, At, B1); PG8_BAR; PG8_SCHED;
            PG8_LDA(At, 0, 1); PG8_STAGE(PG8_SB(0, 0), b2, voffB); PG8_STAGE(PG8_SB(0, 1), b2 + hstepB, voffB); PG8_STAGE(PG8_SA(0, 0), a2, voffA);
            PG8_WAIT_V(8); PG8_WAIT_L(0); PG8_BAR; PG8_MMA(1, 0, At, B0); PG8_MMA(1, 1, At, B1); PG8_BAR; PG8_SCHED;
            PG8_LDB(B0, 1, 0); PG8_LDB(B1, 1, 1); PG8_SCHED; PG8_LDA(At, 1, 0); PG8_STAGE(PG8_SA(0, 1), a2 + hstepA, voffA);
            PG8_WAIT_V(8); PG8_WAIT_L(0); PG8_BAR; PG8_MMA(0, 0, At, B0); PG8_MMA(0, 1, At, B1); PG8_BAR; PG8_SCHED;
            PG8_LDA(At, 1, 1); PG8_STAGE(PG8_SB(1, 0), b3, voffB); PG8_STAGE(PG8_SB(1, 1), b3 + hstepB, voffB); PG8_STAGE(PG8_SA(1, 0), a3, voffA);
            PG8_WAIT_V(8); PG8_WAIT_L(0); PG8_BAR; PG8_MMA(1, 0, At, B0); PG8_MMA(1, 1, At, B1); PG8_BAR; PG8_SCHED;
        }
        if (wr == 0) PG8_BAR;
        E(acc, cur, wr, wc, fr, fq);
        if (!has_next) break;
#pragma unroll
        for (int a = 0; a < 2; ++a)
#pragma unroll
            for (int b = 0; b < 2; ++b)
#pragma unroll
                for (int m = 0; m < 4; ++m)
#pragma unroll
                    for (int n = 0; n < 2; ++n) acc[a][b][m][n] = (f32x4){0.f, 0.f, 0.f, 0.f};
        cur = nxt; cA = nA; cB = nB; ++ui;
        if (wr == 1) PG8_BAR;
    }
    PG8_WAIT_V(0);
    PG8_BAR;
#undef PG8_SA
#undef PG8_SB
#undef PG8_STAGE
#undef PG8_LDA
#undef PG8_LDB
#undef PG8_MMA
#undef PG8_WAIT_V
#undef PG8_WAIT_L
#undef PG8_BAR
#undef PG8_SCHED
#undef PG8_AOFF
}
}

#define XB_TMO      128
#define XB_XCNT(j)  (256  + 64 * (j))
#define XB_XSUB(j)  (1280 + 64 * (j))
#define XB_XGEN(j)  (2304 + 64 * (j))
#define XB_TOP      3328
#define XB_TOPGEN   3392
#define XCD_BAR_WORDS 3456
#define XB_SPIN_CAP (1u << 18)
__device__ __forceinline__ unsigned xb_ld(unsigned* p)              { return __hip_atomic_load(p, __ATOMIC_RELAXED, __HIP_MEMORY_SCOPE_AGENT); }
__device__ __forceinline__ unsigned xb_add(unsigned* p, unsigned v) { return __hip_atomic_fetch_add(p, v, __ATOMIC_RELAXED, __HIP_MEMORY_SCOPE_AGENT); }
__device__ __forceinline__ unsigned xb_xcc_id() { return (unsigned)__builtin_amdgcn_s_getreg((3 << 11) | 20) & 0xFu; }
#define XB_SPIN(cond, bar) do { unsigned _sp = 0; while (cond) { __builtin_amdgcn_s_sleep(1); \
    if ((++_sp & 255u) == 0u) { if (xb_ld(&(bar)[XB_TMO])) break; if (_sp > XB_SPIN_CAP) { atomicAdd(&(bar)[XB_TMO], 1u); break; } } } } while (0)
struct XcdBarrier { unsigned* bar; unsigned x; volatile LAS unsigned* st; };
__device__ __forceinline__ XcdBarrier xcd_barrier_post(unsigned* bar, volatile LAS unsigned* st) {
    XcdBarrier b; b.bar = bar; b.x = xb_xcc_id(); b.st = st;
    if (threadIdx.x == 0) (void)xb_add(&bar[XB_XCNT(b.x)], 1u);
    return b;
}
__device__ __forceinline__ void xcd_barrier_complete(unsigned* bar, unsigned x, unsigned& nloc, unsigned& nx) {
    const unsigned G = gridDim.x * gridDim.y * gridDim.z;
    unsigned sum, cnt, mine, sp = 0u;
    for (;;) {
        sum = 0u; cnt = 0u; mine = 0u;
#pragma unroll
        for (unsigned j = 0; j < 16; ++j) { const unsigned c = xb_ld(&bar[XB_XCNT(j)]); sum += c; cnt += (c > 0u) ? 1u : 0u; mine = (j == x) ? c : mine; }
        if (sum == G) break;
        __builtin_amdgcn_s_sleep(1);
        if ((++sp & 255u) == 0u) { if (xb_ld(&bar[XB_TMO])) break; if (sp > XB_SPIN_CAP) { atomicAdd(&bar[XB_TMO], 1u); break; } }
    }
    nloc = mine > 0u ? mine : 1u; nx = cnt > 0u ? cnt : 1u;
}
__device__ __forceinline__ void xcd_barrier(const XcdBarrier& b) {
    asm volatile("s_waitcnt vmcnt(0)" ::: "memory");
    __syncthreads();
    if (threadIdx.x == 0) {
        unsigned* bar = b.bar;
        __builtin_amdgcn_s_waitcnt(0);
        unsigned nloc = b.st[0], nx = b.st[1];
        if (nloc == 0u) { xcd_barrier_complete(bar, b.x, nloc, nx); b.st[0] = nloc; b.st[1] = nx; }
        const unsigned old = xb_add(&bar[XB_XSUB(b.x)], 1u);
        const unsigned gen = old / nloc;
        if (old + 1u == (gen + 1u) * nloc) {
            __builtin_amdgcn_fence(__ATOMIC_RELEASE, "agent");
            asm volatile("s_waitcnt vmcnt(0)" ::: "memory");
            const unsigned og = xb_add(&bar[XB_TOP], 1u);
            const unsigned tg = og / nx;
            if (og + 1u == (tg + 1u) * nx) xb_add(&bar[XB_TOPGEN], 1u);
            else XB_SPIN(xb_ld(&bar[XB_TOPGEN]) == tg, bar);
            __builtin_amdgcn_fence(__ATOMIC_ACQUIRE, "agent");
            xb_add(&bar[XB_XGEN(b.x)], 1u);
            asm volatile("s_waitcnt vmcnt(0)" ::: "memory");
        } else {
            XB_SPIN(xb_ld(&bar[XB_XGEN(b.x)]) == gen, bar);
            __builtin_amdgcn_fence(__ATOMIC_ACQUIRE, "agent");
            asm volatile("s_waitcnt vmcnt(0)" ::: "memory");
        }
    }
    __syncthreads();
}

constexpr int LDS_BYTES = 163840;
constexpr int MISC_OFF = LDS_BYTES - 256;

struct WDesc { const float* W; bf16_t* WT; int K, N, nmat, pad; };
struct Args {
    const float* x; const float* mix_norm; const float* ffn_norm;
    const float* att_q_gain; const float* att_k_gain; const float* att_rel_bias;
    const float* pool_scale; const float* gdn_conv; const float* gdn_a_log; const float* gdn_dt_bias; const float* gdn_o_gain; const float* ffn_conv;
    float* out; unsigned char* ws;
    WDesc wd[7];
    int ph_lo, ph_hi;
};

struct Ctx { LAS unsigned char* lds; int tid, lane, wave, G, bid; };

__device__ __forceinline__ void transpose_item(const float* W, int K, int N, bf16_t* WT, LAS float* scr, int item, int lane, int mode) {
    const int nblk = N / 32, kb = item / nblk, nb = item % nblk, k0 = 64 * kb, n0 = 32 * nb;
    const int r0 = (mode == 0) ? n0 : ((n0 < FF) ? 256 * (n0 >> 7) + (n0 & 127) : 256 * ((n0 - FF) >> 7) + 128 + ((n0 - FF) & 127));
#pragma unroll 8
    for (int i = 0; i < 32; ++i) { const int kk = 2 * i + (lane >> 5); scr[kk * 33 + (lane & 31)] = W[(size_t)(k0 + kk) * N + n0 + (lane & 31)]; }
    LDS_WAIT();
    const int c = lane & 7;
#pragma unroll
    for (int j = 0; j < 4; ++j) { const int n = (lane >> 3) + 8 * j; const LAS float* s = scr + (8 * c) * 33 + n;
        u32x4 o; o.x = cvt_pk_bf16(s[0 * 33], s[1 * 33]); o.y = cvt_pk_bf16(s[2 * 33], s[3 * 33]); o.z = cvt_pk_bf16(s[4 * 33], s[5 * 33]); o.w = cvt_pk_bf16(s[6 * 33], s[7 * 33]);
        *(u32x4*)(WT + (size_t)(r0 + n) * K + k0 + 8 * c) = o; }
    LDS_WAIT();
}
typedef const __attribute__((address_space(4))) struct Args* KArgsP0;
__device__ __forceinline__ void phase_weights(const Ctx& c, KArgsP0 a) {
    LAS float* scr = (LAS float*)(c.lds + c.wave * 16384);
    const int gw = c.bid * NWAVES + c.wave, NGW = c.G * NWAVES;
#pragma unroll
    for (int d = 0; d < 7; ++d) {
        const float* W = a->wd[d].W; bf16_t* WT = a->wd[d].WT; const int K = a->wd[d].K, N = a->wd[d].N, nmat = a->wd[d].nmat, mode = a->wd[d].pad;
        const int per = (K / 64) * (N / 32), tot = per * nmat;
        for (int it = gw; it < tot; it += NGW) { const int mat = it / per, r = it - mat * per;
            transpose_item(W + (size_t)mat * K * N, K, N, WT + (size_t)mat * K * N, scr, r, c.lane, mode); }
    }
    { u32x4* z = (u32x4*)(a->ws + WS_WGIN + (size_t)GIN * D * 2); const int n16 = (GINP - GIN) * D * 2 / 16;
      for (int i = c.bid * NTHREADS + c.tid; i < n16; i += c.G * NTHREADS) z[i] = (u32x4){0u, 0u, 0u, 0u}; }
}

__device__ __forceinline__ void phase_rmsnorm(const Ctx& c, const float* x, const float* gain, bf16_t* out) {
    const int gw = c.bid * NWAVES + c.wave, NGW = c.G * NWAVES;
    f32x4 gv[8];
#pragma unroll
    for (int j = 0; j < 8; ++j) gv[j] = *(const f32x4*)(gain + 4 * c.lane + 256 * j);
    for (int m = gw; m < T; m += NGW) {
        const f32x4* xr = (const f32x4*)(x + (size_t)m * D) + c.lane;
        f32x4 v[8]; float s = 0.f;
#pragma unroll
        for (int j = 0; j < 8; ++j) { v[j] = xr[64 * j]; s += (v[j].x * v[j].x + v[j].y * v[j].y) + (v[j].z * v[j].z + v[j].w * v[j].w); }
        const float rstd = 1.0f / sqrtf(wave_sum(s) * (1.0f / D) + EPS);
        u32x2* o8 = (u32x2*)(out + (size_t)m * D) + c.lane;
#pragma unroll
        for (int j = 0; j < 8; ++j) { u32x2 w; w.x = cvt_pk_bf16(v[j].x * rstd * gv[j].x, v[j].y * rstd * gv[j].y); w.y = cvt_pk_bf16(v[j].z * rstd * gv[j].z, v[j].w * rstd * gv[j].w); o8[64 * j] = w; }
    }
}

__device__ __forceinline__ void phase_ffn_fix(const Ctx& c, bf16_t* ACT, const float* cw, const bf16_t* TAILU, const bf16_t* HEADU, const bf16_t* HEADG) {
    constexpr int NCG = FF / 8, NS = T / 64;
    for (int it = c.bid * NTHREADS + c.tid; it < NS * NCG; it += c.G * NTHREADS) {
        const int sg = it / NCG, cg = it - sg * NCG, col = cg * 8; const bool first = ((sg * 64) % SEQ) == 0;
        float w0[8], w1[8], w2[8], um2[8], um1[8], u0[8], u1[8], g0[8], g1[8];
#pragma unroll
        for (int h = 0; h < 2; ++h) { const f32x4 a0 = *(const f32x4*)(cw + col + 4 * h), a1 = *(const f32x4*)(cw + FF + col + 4 * h), a2 = *(const f32x4*)(cw + 2 * FF + col + 4 * h);
#pragma unroll
            for (int k = 0; k < 4; ++k) { w0[4 * h + k] = a0[k]; w1[4 * h + k] = a1[k]; w2[4 * h + k] = a2[k]; } }
        const u32x4 hu0 = *(const u32x4*)(HEADU + (size_t)(sg * 2) * FF + col), hu1 = *(const u32x4*)(HEADU + (size_t)(sg * 2 + 1) * FF + col);
        const u32x4 hg0 = *(const u32x4*)(HEADG + (size_t)(sg * 2) * FF + col), hg1 = *(const u32x4*)(HEADG + (size_t)(sg * 2 + 1) * FF + col);
        u32x4 t0 = (u32x4){0u, 0u, 0u, 0u}, t1 = t0;
        if (!first) { t0 = *(const u32x4*)(TAILU + (size_t)(sg * 2 - 2) * FF + col); t1 = *(const u32x4*)(TAILU + (size_t)(sg * 2 - 1) * FF + col); }
#pragma unroll
        for (int k = 0; k < 4; ++k) { um2[2 * k] = bflo(t0[k]); um2[2 * k + 1] = bfhi(t0[k]); um1[2 * k] = bflo(t1[k]); um1[2 * k + 1] = bfhi(t1[k]);
            u0[2 * k] = bflo(hu0[k]); u0[2 * k + 1] = bfhi(hu0[k]); u1[2 * k] = bflo(hu1[k]); u1[2 * k + 1] = bfhi(hu1[k]);
            g0[2 * k] = bflo(hg0[k]); g0[2 * k + 1] = bfhi(hg0[k]); g1[2 * k] = bflo(hg1[k]); g1[2 * k + 1] = bfhi(hg1[k]); }
        float y0[8], y1[8];
#pragma unroll
        for (int k = 0; k < 8; ++k) { y0[k] = siluf(w0[k] * um2[k] + w1[k] * um1[k] + w2[k] * u0[k]) * g0[k]; y1[k] = siluf(w0[k] * um1[k] + w1[k] * u0[k] + w2[k] * u1[k]) * g1[k]; }
        u32x4 o; o.x = cvt_pk_bf16(y0[0], y0[1]); o.y = cvt_pk_bf16(y0[2], y0[3]); o.z = cvt_pk_bf16(y0[4], y0[5]); o.w = cvt_pk_bf16(y0[6], y0[7]);
        *(u32x4*)(ACT + (size_t)(sg * 64) * FF + col) = o;
        o.x = cvt_pk_bf16(y1[0], y1[1]); o.y = cvt_pk_bf16(y1[2], y1[3]); o.z = cvt_pk_bf16(y1[4], y1[5]); o.w = cvt_pk_bf16(y1[6], y1[7]);
        *(u32x4*)(ACT + (size_t)(sg * 64 + 1) * FF + col) = o;
    }
}

__device__ __forceinline__ void phase_pool_prep(const Ctx& c, const bf16_t* H, bf16_t* P) {
    constexpr int NCG = D / 8, RB = 64;
    const int nitems = (T / RB) * NCG;
    for (int it = c.bid * NTHREADS + c.tid; it < nitems; it += c.G * NTHREADS) {
        const int rb = it / NCG, cg = it - rb * NCG, t0 = rb * RB, col = cg * 8, w = 2 << (col >> 9), tp0 = t0 % SEQ;
        float s[8];
#pragma unroll
        for (int k = 0; k < 8; ++k) s[k] = 0.f;
        for (int i = 1; i <= w; ++i) if (tp0 - i >= 0) {   const u32x4 a = *(const u32x4*)(H + (size_t)(t0 - i) * D + col);
#pragma unroll
            for (int k = 0; k < 4; ++k) { s[2 * k] += bflo(a[k]); s[2 * k + 1] += bfhi(a[k]); } }
        for (int t = t0; t < t0 + RB; ++t) {
            const int tp = tp0 + (t - t0);
            const u32x4 a = *(const u32x4*)(H + (size_t)t * D + col);
            float cu[8];
#pragma unroll
            for (int k = 0; k < 4; ++k) { cu[2 * k] = bflo(a[k]); cu[2 * k + 1] = bfhi(a[k]); }
#pragma unroll
            for (int k = 0; k < 8; ++k) s[k] += cu[k];
            if (tp >= w) { const u32x4 b = *(const u32x4*)(H + (size_t)(t - w) * D + col);
#pragma unroll
                for (int k = 0; k < 4; ++k) { s[2 * k] -= bflo(b[k]); s[2 * k + 1] -= bfhi(b[k]); } }
            const float inv = 1.0f / (float)(tp + 1 < w ? tp + 1 : w);
            u32x4 o; o.x = cvt_pk_bf16(s[0] * inv - cu[0], s[1] * inv - cu[1]); o.y = cvt_pk_bf16(s[2] * inv - cu[2], s[3] * inv - cu[3]);
            o.z = cvt_pk_bf16(s[4] * inv - cu[4], s[5] * inv - cu[5]); o.w = cvt_pk_bf16(s[6] * inv - cu[6], s[7] * inv - cu[7]);
            *(u32x4*)(P + (size_t)t * D + col) = o;
        }
    }
}

constexpr int ATT_ROWB = 272;
constexpr int ATT_WAVE_BYTES = 2 * 32 * ATT_ROWB + NREL * 4;
static_assert(ATT_WAVE_BYTES * NWAVES <= MISC_OFF, "attention LDS");
__device__ __forceinline__ void phase_attention(const Ctx& c, const bf16_t* QKV, bf16_t* O, const float* q_gain, const float* k_gain, const float* rel_bias) {
    LAS unsigned char* Kt = c.lds + c.wave * ATT_WAVE_BYTES;
    LAS unsigned char* Vt = Kt + 32 * ATT_ROWB;
    LAS float* bias = (LAS float*)(Vt + 32 * ATT_ROWB);
    const int lane = c.lane, l31 = lane & 31, hh = lane >> 5;
    const int gw = c.bid * NWAVES + c.wave, NGW = c.G * NWAVES;
    constexpr int NU = BATCH * NCH * AH * 2;
    const float scale = 0.08838834764831845f;
    float kg[8];
    { const int ch = lane & 15; const f32x4 a = *(const f32x4*)(k_gain + ch * 8), b = *(const f32x4*)(k_gain + ch * 8 + 4);
#pragma unroll
      for (int k = 0; k < 4; ++k) { kg[k] = a[k]; kg[4 + k] = b[k]; } }
    for (int u = gw; u < NU; u += NGW) {
        const int qh = u & 1, h = (u >> 1) & 15, ck = (u >> 5) & 127, b = u >> 12;
        const size_t row_q0 = (size_t)b * SEQ + (size_t)ck * CH + qh * 32;
        for (int i = lane; i < NREL; i += 64) bias[i] = rel_bias[h * NREL + i];
        bf16x8 qf[8];
        {
            float qv[8][8]; float ss = 0.f;
            const bf16_t* qp = QKV + (row_q0 + l31) * 6144 + h * AHD + hh * 8;
#pragma unroll
            for (int ks = 0; ks < 8; ++ks) { const u32x4 a = *(const u32x4*)(qp + ks * 16);
#pragma unroll
                for (int k = 0; k < 4; ++k) { qv[ks][2 * k] = bflo(a[k]); qv[ks][2 * k + 1] = bfhi(a[k]); }
#pragma unroll
                for (int k = 0; k < 8; ++k) ss += qv[ks][k] * qv[ks][k]; }
            ss += __shfl_xor(ss, 32);
            const float rq = scale / sqrtf(ss * (1.0f / AHD) + EPS);
#pragma unroll
            for (int ks = 0; ks < 8; ++ks) { const f32x4 g0 = *(const f32x4*)(q_gain + ks * 16 + hh * 8), g1 = *(const f32x4*)(q_gain + ks * 16 + hh * 8 + 4);
                u32x4 w; w.x = cvt_pk_bf16(qv[ks][0] * rq * g0[0], qv[ks][1] * rq * g0[1]); w.y = cvt_pk_bf16(qv[ks][2] * rq * g0[2], qv[ks][3] * rq * g0[3]);
                w.z = cvt_pk_bf16(qv[ks][4] * rq * g1[0], qv[ks][5] * rq * g1[1]); w.w = cvt_pk_bf16(qv[ks][6] * rq * g1[2], qv[ks][7] * rq * g1[3]);
                qf[ks] = __builtin_bit_cast(bf16x8, w); }
        }
        float mrun = -1e30f, lsum = 0.f;
        f32x16 oacc[4];
#pragma unroll
        for (int dt = 0; dt < 4; ++dt)
#pragma unroll
            for (int r = 0; r < 16; ++r) oacc[dt][r] = 0.f;
        const int qi = qh * 32 + l31;
        const int kt_first = (ck >= 8) ? 0 : 2 * (8 - ck);
        for (int kt = kt_first; kt < 18; ++kt) {
            const int kj0 = kt * 32;
            const size_t krow0 = (size_t)b * SEQ + (size_t)((ck - 8) * CH + kj0);
            {
                const int ch = lane & 15, rr = lane >> 4;
#pragma unroll
                for (int i = 0; i < 8; ++i) {
                    const int row = rr + 4 * i;
                    const bf16_t* kp = QKV + (krow0 + row) * 6144 + 2048 + h * AHD + ch * 8;
                    const u32x4 a = *(const u32x4*)kp, vv = *(const u32x4*)(kp + 2048);
                    float kv[8]; float ss = 0.f;
#pragma unroll
                    for (int k = 0; k < 4; ++k) { kv[2 * k] = bflo(a[k]); kv[2 * k + 1] = bfhi(a[k]); }
#pragma unroll
                    for (int k = 0; k < 8; ++k) ss += kv[k] * kv[k];
                    ss += __shfl_xor(ss, 1); ss += __shfl_xor(ss, 2); ss += __shfl_xor(ss, 4); ss += __shfl_xor(ss, 8);
                    const float rk = 1.0f / sqrtf(ss * (1.0f / AHD) + EPS);
                    u32x4 w; w.x = cvt_pk_bf16(kv[0] * rk * kg[0], kv[1] * rk * kg[1]); w.y = cvt_pk_bf16(kv[2] * rk * kg[2], kv[3] * rk * kg[3]);
                    w.z = cvt_pk_bf16(kv[4] * rk * kg[4], kv[5] * rk * kg[5]); w.w = cvt_pk_bf16(kv[6] * rk * kg[6], kv[7] * rk * kg[7]);
                    *(LAS u32x4*)(Kt + row * ATT_ROWB + ch * 16) = w;
                    *(LAS u32x4*)(Vt + row * ATT_ROWB + ch * 16) = vv;
                }
            }
            LDS_WAIT();
            f32x16 st;
#pragma unroll
            for (int r = 0; r < 16; ++r) st[r] = 0.f;
#pragma unroll
            for (int ks = 0; ks < 8; ++ks) { const bf16x8 kf = *(const LAS bf16x8*)(Kt + l31 * ATT_ROWB + ks * 32 + hh * 16);
                st = __builtin_amdgcn_mfma_f32_32x32x16_bf16(kf, qf[ks], st, 0, 0, 0); }
            float mt = -1e30f;
#pragma unroll
            for (int r = 0; r < 16; ++r) { const int kj = kj0 + (r & 3) + 8 * (r >> 2) + 4 * hh; int idx = 575 + qi - kj; idx = idx > 319 ? 319 : idx; st[r] += bias[idx]; mt = fmaxf(mt, st[r]); }
            mt = fmaxf(mt, __shfl_xor(mt, 32));
            const float mnew = fmaxf(mrun, mt), alpha = __expf(mrun - mnew);
            mrun = mnew;
            float ps = 0.f;
#pragma unroll
            for (int r = 0; r < 16; ++r) { st[r] = __expf(st[r] - mnew); ps += st[r]; }
            lsum = lsum * alpha + ps;
#pragma unroll
            for (int dt = 0; dt < 4; ++dt)
#pragma unroll
                for (int r = 0; r < 16; ++r) oacc[dt][r] *= alpha;
            bf16x8 pf[2];
#pragma unroll
            for (int s = 0; s < 2; ++s) { u32x4 w; w.x = cvt_pk_bf16(st[8 * s + 0], st[8 * s + 1]); w.y = cvt_pk_bf16(st[8 * s + 2], st[8 * s + 3]); w.z = cvt_pk_bf16(st[8 * s + 4], st[8 * s + 5]); w.w = cvt_pk_bf16(st[8 * s + 6], st[8 * s + 7]);
                pf[s] = __builtin_bit_cast(bf16x8, w); }
            {
                const int i16 = lane & 15, g1 = (lane >> 4) & 1;
                LAS unsigned char* vb = Vt + (4 * hh + (i16 >> 2)) * ATT_ROWB + (16 * g1 + 4 * (i16 & 3)) * 2;
#pragma unroll
                for (int dt = 0; dt < 4; ++dt)
#pragma unroll
                    for (int s = 0; s < 2; ++s) {
                        const s16x4 lo = __builtin_bit_cast(s16x4, __builtin_amdgcn_ds_read_tr16_b64_v4i16((LAS s16x4*)(vb + (16 * s) * ATT_ROWB + dt * 64)));
                        const s16x4 hi = __builtin_bit_cast(s16x4, __builtin_amdgcn_ds_read_tr16_b64_v4i16((LAS s16x4*)(vb + (16 * s + 8) * ATT_ROWB + dt * 64)));
                        const bf16x8 vf = (bf16x8){lo[0], lo[1], lo[2], lo[3], hi[0], hi[1], hi[2], hi[3]};
                        oacc[dt] = __builtin_amdgcn_mfma_f32_32x32x16_bf16(vf, pf[s], oacc[dt], 0, 0, 0);
                    }
            }
            LDS_WAIT();
        }
        lsum += __shfl_xor(lsum, 32);
        const float inv = 1.0f / lsum;
        bf16_t* op = O + (row_q0 + l31) * D + h * AHD + 4 * hh;
#pragma unroll
        for (int dt = 0; dt < 4; ++dt)
#pragma unroll
            for (int g = 0; g < 4; ++g) { u32x2 w; w.x = cvt_pk_bf16(oacc[dt][4 * g] * inv, oacc[dt][4 * g + 1] * inv); w.y = cvt_pk_bf16(oacc[dt][4 * g + 2] * inv, oacc[dt][4 * g + 3] * inv);
                *(u32x2*)(op + dt * 32 + g * 8) = w; }
        LDS_WAIT();
    }
}

__device__ __forceinline__ void phase_qknorm(const Ctx& c, bf16_t* QKV, const float* q_gain, const float* k_gain) {
    const int gw = c.bid * NWAVES + c.wave, NGW = c.G * NWAVES, sub = c.lane >> 4, ch = c.lane & 15;
    float gq[8], gk[8];
    { const f32x4 a = *(const f32x4*)(q_gain + ch * 8), b = *(const f32x4*)(q_gain + ch * 8 + 4), d = *(const f32x4*)(k_gain + ch * 8), e = *(const f32x4*)(k_gain + ch * 8 + 4);
#pragma unroll
      for (int k = 0; k < 4; ++k) { gq[k] = a[k] * 0.08838834764831845f; gq[4 + k] = b[k] * 0.08838834764831845f; gk[k] = d[k]; gk[4 + k] = e[k]; } }
    const int ngroups = T * 32 / 4;
    for (int it = gw; it < ngroups; it += NGW) {
        const int pr = it * 4 + sub, row = pr >> 5, hd = pr & 31;
        bf16_t* p = QKV + (size_t)row * 6144 + hd * 128 + ch * 8;
        const u32x4 a = *(const u32x4*)p;
        float x[8]; float ss = 0.f;
#pragma unroll
        for (int k = 0; k < 4; ++k) { x[2 * k] = bflo(a[k]); x[2 * k + 1] = bfhi(a[k]); }
#pragma unroll
        for (int k = 0; k < 8; ++k) ss += x[k] * x[k];
        ss += __shfl_xor(ss, 1); ss += __shfl_xor(ss, 2); ss += __shfl_xor(ss, 4); ss += __shfl_xor(ss, 8);
        const float r = 1.0f / sqrtf(ss * (1.0f / AHD) + EPS);
        float y[8];
#pragma unroll
        for (int k = 0; k < 8; ++k) y[k] = x[k] * r * (hd < 16 ? gq[k] : gk[k]);
        u32x4 w; w.x = cvt_pk_bf16(y[0], y[1]); w.y = cvt_pk_bf16(y[2], y[3]); w.z = cvt_pk_bf16(y[4], y[5]); w.w = cvt_pk_bf16(y[6], y[7]);
        *(u32x4*)p = w;
    }
}

constexpr int AT_SLOT = 32768, AT_BIAS = 4 * AT_SLOT;
static_assert(AT_BIAS + NREL * 4 <= MISC_OFF, "attention LDS");
__device__ __forceinline__ void glds16(const void* gsrc, unsigned lds_dst) { unsigned keep;
    asm volatile("s_mov_b32 %0, m0\n\ts_mov_b32 m0, %2\n\ts_nop 0\n\tglobal_load_lds_dwordx4 %1, off\n\ts_mov_b32 m0, %0" : "=&s"(keep) : "v"(gsrc), "s"(lds_dst) : "memory"); }
__device__ __forceinline__ void phase_attention2(const Ctx& c, const bf16_t* QKV, bf16_t* O, const float* rel_bias) {
    LAS unsigned char* lds = c.lds;
    const unsigned lds0 = (unsigned)(size_t)lds;
    LAS float* bias = (LAS float*)(lds + AT_BIAS);
    const int lane = c.lane, w = c.wave, l31 = lane & 31, hh = lane >> 5, i16 = lane & 15, g1 = (lane >> 4) & 1;
    const int wo = w >> 1, qi = 32 * (w & 1) + l31;
    const int fr = ((l31 & 3) << 2) | ((l31 >> 2) & 3);
    constexpr int NU = BATCH * 32 * AH;
    for (int u = c.bid; u < NU; u += c.G) {
        const int h = u & 15, cq = (u >> 4) & 31, b = u >> 9;
        if (c.tid < NREL) bias[c.tid] = rel_bias[h * NREL + c.tid];
        bf16x8 qf[8];
        { const bf16_t* qp = QKV + ((size_t)b * SEQ + 256 * cq + 32 * w + l31) * 6144 + h * AHD + hh * 8;
#pragma unroll
          for (int ks = 0; ks < 8; ++ks) qf[ks] = __builtin_bit_cast(bf16x8, *(const u32x4*)(qp + ks * 16)); }
        __builtin_amdgcn_s_waitcnt(0);
#pragma unroll
        for (int ks = 0; ks < 8; ++ks) asm volatile("" : "+v"(qf[ks]));
        __syncthreads();
        const int jf = (cq >= 2) ? 0 : 8 - 4 * cq;
        const bf16_t* ksrc[2];
#pragma unroll
        for (int pp = 0; pp < 2; ++pp) { const int row = 8 * w + 4 * pp + (lane >> 4), chl = (lane & 15) ^ (((row & 3) << 2) | ((row >> 2) & 3));
            ksrc[pp] = QKV + ((size_t)b * SEQ + (size_t)((4 * cq - 8) * CH + row)) * 6144 + 2048 + h * AHD + chl * 8; }
#define AT_DMA(j) do { const unsigned sl_ = lds0 + (unsigned)(((j) & 3) * AT_SLOT) + (unsigned)(2 * w) * 1024u; const size_t to_ = (size_t)(j) * CH * 6144; \
            glds16(ksrc[0] + to_, sl_); glds16(ksrc[1] + to_, sl_ + 1024u); glds16(ksrc[0] + to_ + 2048, sl_ + 16384u); glds16(ksrc[1] + to_ + 2048, sl_ + 16384u + 1024u); } while (0)
        AT_DMA(jf); AT_DMA(jf + 1); AT_DMA(jf + 2);
        float mrun = -1e30f, lsum = 0.f;
        f32x16 oacc[4];
#pragma unroll
        for (int dt = 0; dt < 4; ++dt)
#pragma unroll
            for (int r = 0; r < 16; ++r) oacc[dt][r] = 0.f;
        for (int j = jf; j < 12; ++j) {
            if (j <= 9) asm volatile("s_waitcnt vmcnt(8)\n\ts_barrier" ::: "memory");
            else if (j == 10) asm volatile("s_waitcnt vmcnt(4)\n\ts_barrier" ::: "memory");
            else asm volatile("s_waitcnt vmcnt(0)\n\ts_barrier" ::: "memory");
            if (j + 3 < 12) AT_DMA(j + 3);
            if (j >= wo && j <= wo + 8) {
                const LAS unsigned char* Kt = lds + (j & 3) * AT_SLOT; const LAS unsigned char* Vt = Kt + 16384;
                const int bp = j - wo;
                f32x16 st[2];
#pragma unroll
                for (int k2 = 0; k2 < 2; ++k2)
#pragma unroll
                    for (int r = 0; r < 16; ++r) st[k2][r] = 0.f;
                {
                    bf16x8 kfa[8], kfb[8];
#pragma unroll
                    for (int ks = 0; ks < 8; ++ks) { kfa[ks] = *(const LAS bf16x8*)(Kt + 256 * l31 + 16 * ((2 * ks + hh) ^ fr)); kfb[ks] = *(const LAS bf16x8*)(Kt + 256 * (32 + l31) + 16 * ((2 * ks + hh) ^ fr)); }
                    __builtin_amdgcn_sched_barrier(0);
#pragma unroll
                    for (int ks = 0; ks < 8; ++ks) { st[0] = __builtin_amdgcn_mfma_f32_32x32x16_bf16(kfa[ks], qf[ks], st[0], 0, 0, 0); st[1] = __builtin_amdgcn_mfma_f32_32x32x16_bf16(kfb[ks], qf[ks], st[1], 0, 0, 0); }
                }
                float mt = -1e30f;
                if (bp <= 3) {
                    const float b0 = bias[319];
#pragma unroll
                    for (int k2 = 0; k2 < 2; ++k2)
#pragma unroll
                        for (int r = 0; r < 16; ++r) { st[k2][r] += b0; mt = fmaxf(mt, st[k2][r]); }
                } else {
                    const int ib = 575 + qi - 64 * bp - 4 * hh;
                    float bv[2][16];
#pragma unroll
                    for (int k2 = 0; k2 < 2; ++k2)
#pragma unroll
                        for (int r = 0; r < 16; ++r) { int idx = ib - 32 * k2 - (r & 3) - 8 * (r >> 2); idx = idx > 319 ? 319 : idx; bv[k2][r] = bias[idx]; }
                    __builtin_amdgcn_sched_barrier(0);
#pragma unroll
                    for (int k2 = 0; k2 < 2; ++k2)
#pragma unroll
                        for (int r = 0; r < 16; ++r) { st[k2][r] += bv[k2][r]; mt = fmaxf(mt, st[k2][r]); }
                }
                mt = fmaxf(mt, __shfl_xor(mt, 32));
                const float mnew = fmaxf(mrun, mt), alpha = __expf(mrun - mnew);
                mrun = mnew;
                float ps = 0.f;
#pragma unroll
                for (int k2 = 0; k2 < 2; ++k2)
#pragma unroll
                    for (int r = 0; r < 16; ++r) { st[k2][r] = __expf(st[k2][r] - mnew); ps += st[k2][r]; }
                lsum = lsum * alpha + ps;
#pragma unroll
                for (int dt = 0; dt < 4; ++dt)
#pragma unroll
                    for (int r = 0; r < 16; ++r) oacc[dt][r] *= alpha;
                bf16x8 pf[4];
#pragma unroll
                for (int s = 0; s < 4; ++s) { const f32x16& sv = st[s >> 1]; const int o8 = 8 * (s & 1);
                    u32x4 wv; wv.x = cvt_pk_bf16(sv[o8 + 0], sv[o8 + 1]); wv.y = cvt_pk_bf16(sv[o8 + 2], sv[o8 + 3]); wv.z = cvt_pk_bf16(sv[o8 + 4], sv[o8 + 5]); wv.w = cvt_pk_bf16(sv[o8 + 6], sv[o8 + 7]);
                    pf[s] = __builtin_bit_cast(bf16x8, wv); }
                const int q4 = i16 >> 2, p4 = i16 & 3;
#pragma unroll
                for (int sp = 0; sp < 2; ++sp) {
                    s16x4 lo[2][4], hi[2][4];
#pragma unroll
                    for (int s2 = 0; s2 < 2; ++s2) { const int s = 2 * sp + s2, rlo = 16 * s + 4 * hh + q4, flo = (q4 << 2) | hh, fhi = (q4 << 2) | (hh + 2);
#pragma unroll
                        for (int dt = 0; dt < 4; ++dt) { const int chl = 4 * dt + 2 * g1 + (p4 >> 1);
                            lo[s2][dt] = __builtin_bit_cast(s16x4, __builtin_amdgcn_ds_read_tr16_b64_v4i16((LAS s16x4*)(Vt + 256 * rlo + 16 * (chl ^ flo) + 8 * (p4 & 1))));
                            hi[s2][dt] = __builtin_bit_cast(s16x4, __builtin_amdgcn_ds_read_tr16_b64_v4i16((LAS s16x4*)(Vt + 256 * (rlo + 8) + 16 * (chl ^ fhi) + 8 * (p4 & 1)))); } }
                    __builtin_amdgcn_sched_barrier(0);
#pragma unroll
                    for (int s2 = 0; s2 < 2; ++s2)
#pragma unroll
                        for (int dt = 0; dt < 4; ++dt) { const bf16x8 vf = (bf16x8){lo[s2][dt][0], lo[s2][dt][1], lo[s2][dt][2], lo[s2][dt][3], hi[s2][dt][0], hi[s2][dt][1], hi[s2][dt][2], hi[s2][dt][3]};
                            oacc[dt] = __builtin_amdgcn_mfma_f32_32x32x16_bf16(vf, pf[2 * sp + s2], oacc[dt], 0, 0, 0); }
                    __builtin_amdgcn_sched_barrier(0);
                }
            }
        }
#undef AT_DMA
        lsum += __shfl_xor(lsum, 32);
        const float inv = 1.0f / lsum;
        bf16_t* op = O + ((size_t)b * SEQ + 256 * cq + 32 * w + l31) * D + h * AHD + 4 * hh;
#pragma unroll
        for (int dt = 0; dt < 4; ++dt)
#pragma unroll
            for (int g = 0; g < 4; ++g) { u32x2 wv; wv.x = cvt_pk_bf16(oacc[dt][4 * g] * inv, oacc[dt][4 * g + 1] * inv); wv.y = cvt_pk_bf16(oacc[dt][4 * g + 2] * inv, oacc[dt][4 * g + 3] * inv);
                *(u32x2*)(op + dt * 32 + g * 8) = wv; }
        asm volatile("s_waitcnt vmcnt(0) lgkmcnt(0)" ::: "memory");
        __syncthreads();
    }
}

__device__ __forceinline__ void phase_gdn_conv(const Ctx& c, const bf16_t* PROJ, bf16_t* C, const float* cw) {
    constexpr int RB = 64;
    const int gw = c.bid * NWAVES + c.wave, NGW = c.G * NWAVES;
    const int nitems = (MH / RB) * 64;
    for (int it = gw; it < nitems; it += NGW) {
        const int rb = it >> 6, sl = it & 63, t0 = rb * RB, col = sl * 128 + 2 * c.lane;
        float w[4][2];
#pragma unroll
        for (int j = 0; j < 4; ++j) { const f32x2 a = *(const f32x2*)(cw + j * 8192 + col); w[j][0] = a.x; w[j][1] = a.y; }
        float p1[2], p2[2], p3[2];
        if ((t0 % SEQ) == 0) { p1[0] = p1[1] = p2[0] = p2[1] = p3[0] = p3[1] = 0.f; }
        else { const unsigned a = *(const unsigned*)(PROJ + (size_t)(t0 - 1) * GINP + col), b = *(const unsigned*)(PROJ + (size_t)(t0 - 2) * GINP + col), d = *(const unsigned*)(PROJ + (size_t)(t0 - 3) * GINP + col);
            p1[0] = bflo(a); p1[1] = bfhi(a); p2[0] = bflo(b); p2[1] = bfhi(b); p3[0] = bflo(d); p3[1] = bfhi(d); }
        const float qs = (sl < 16) ? 0.08838834764831845f : 1.0f;
#pragma unroll 4
        for (int t = t0; t < t0 + RB; ++t) {
            const unsigned a = *(const unsigned*)(PROJ + (size_t)t * GINP + col);
            const float c0 = bflo(a), c1 = bfhi(a);
            float y0 = siluf(w[0][0] * p3[0] + w[1][0] * p2[0] + w[2][0] * p1[0] + w[3][0] * c0);
            float y1 = siluf(w[0][1] * p3[1] + w[1][1] * p2[1] + w[2][1] * p1[1] + w[3][1] * c1);
            p3[0] = p2[0]; p3[1] = p2[1]; p2[0] = p1[0]; p2[1] = p1[1]; p1[0] = c0; p1[1] = c1;
            if (sl < 32) { const float ss = wave_sum(y0 * y0 + y1 * y1); const float r = qs / sqrtf(ss + EPS); y0 *= r; y1 *= r; }
            *(unsigned*)(C + (size_t)t * 8192 + col) = cvt_pk_bf16(y0, y1);
        }
    }
}

constexpr int G2_QS = 0, G2_KS = 17408, G2_KK = 34816, G2_QK = G2_KK + 64 * 65 * 4, G2_AT = G2_QK + 64 * 65 * 4, G2_GC = G2_AT + 2 * 64 * 64 * 4, G2_BETA = G2_GC + 512, G2_END = G2_BETA + 512;
static_assert(G2_END <= MISC_OFF, "G2 LDS");
__device__ __forceinline__ void phase_gdn_local(const Ctx& c, bf16_t* PROJ, bf16_t* C, bf16_t* ATT, const float* AB, float* GC, const float* a_log, const float* dt_bias) {
    LAS unsigned char* lds = c.lds;
    LAS float* KKs = (LAS float*)(lds + G2_KK); LAS float* QKs = (LAS float*)(lds + G2_QK); LAS float* At = (LAS float*)(lds + G2_AT);
    LAS float* gcs = (LAS float*)(lds + G2_GC); LAS float* betas = (LAS float*)(lds + G2_BETA);
    const int tid = c.tid, lane = c.lane, wave = c.wave, l31 = lane & 31, hh = lane >> 5;
    constexpr int NUNITS = (MH / CH) * GKH;
    for (int u = c.bid; u < NUNITS; u += c.G) {
        const int hk = u & 15, cg = u >> 4, r0 = cg * CH;
#pragma unroll
        for (int i = 0; i < 2; ++i) { const int idx = tid + i * 512, row = idx >> 4, ch = idx & 15;
            *(LAS u32x4*)(lds + G2_QS + row * 272 + ch * 16) = *(const u32x4*)(C + (size_t)(r0 + row) * 8192 + hk * 128 + ch * 8);
            *(LAS u32x4*)(lds + G2_KS + row * 272 + ch * 16) = *(const u32x4*)(C + (size_t)(r0 + row) * 8192 + 2048 + hk * 128 + ch * 8); }
        if (wave < 2) {
            const int hv = 2 * hk + wave;
            const float av = AB[(size_t)(r0 + lane) * 64 + hv], bv = AB[(size_t)(r0 + lane) * 64 + 32 + hv];
            const float z = av + dt_bias[hv];
            const float sp = z > 20.f ? z : log1pf(__expf(z));
            float g = -__expf(a_log[hv]) * sp;
#pragma unroll
            for (int o = 1; o < 64; o <<= 1) { const float t = __shfl_up(g, o); if (lane >= o) g += t; }
            gcs[wave * 64 + lane] = g; betas[wave * 64 + lane] = 1.0f / (1.0f + __expf(-bv));
            GC[(size_t)(r0 + lane) * 32 + hv] = g;
        }
        __syncthreads();
        {
            const int mat = wave >> 2, ti = (wave >> 1) & 1, tj = wave & 1;
            LAS unsigned char* xa = lds + (mat ? G2_QS : G2_KS) + (32 * ti + l31) * 272 + hh * 16;
            LAS unsigned char* xb = lds + G2_KS + (32 * tj + l31) * 272 + hh * 16;
            f32x16 acc;
#pragma unroll
            for (int r = 0; r < 16; ++r) acc[r] = 0.f;
#pragma unroll
            for (int ks = 0; ks < 8; ++ks) acc = __builtin_amdgcn_mfma_f32_32x32x16_bf16(*(const LAS bf16x8*)(xa + ks * 32), *(const LAS bf16x8*)(xb + ks * 32), acc, 0, 0, 0);
            LAS float* dst = mat ? QKs : KKs;
#pragma unroll
            for (int r = 0; r < 16; ++r) dst[(32 * ti + (r & 3) + 8 * (r >> 2) + 4 * hh) * 65 + 32 * tj + l31] = acc[r];
        }
        __syncthreads();
        for (int idx = tid; idx < 2 * 4096; idx += 512) { const int e = idx >> 12, j = (idx >> 6) & 63, i = idx & 63;
            At[idx] = (i > j) ? betas[e * 64 + i] * KKs[i * 65 + j] * __expf(gcs[e * 64 + i] - gcs[e * 64 + j]) : 0.f; }
        for (int idx = tid; idx < 2 * 4096; idx += 512) { const int e = idx >> 12, i = (idx >> 6) & 63, j = idx & 63;
            const float v = (i >= j) ? QKs[i * 65 + j] * __expf(gcs[e * 64 + i] - gcs[e * 64 + j]) : 0.f;
            ATT[((size_t)(cg * 32 + 2 * hk + e) * 64 + i) * 64 + j] = (bf16_t)f2bf(v); }
        __syncthreads();
        {
            const int e = tid >> 8, col = tid & 255, hv = 2 * hk + e;
            float r[64];
            if (col < 128) {
#pragma unroll
                for (int i = 0; i < 64; ++i) r[i] = betas[e * 64 + i] * bf2f(C[(size_t)(r0 + i) * 8192 + 4096 + hv * 128 + col]);
            } else {
#pragma unroll
                for (int i = 0; i < 64; ++i) r[i] = betas[e * 64 + i] * __expf(gcs[e * 64 + i]) * bf2f(*(const LAS bf16_t*)(lds + G2_KS + i * 272 + (col - 128) * 2));
            }
            const LAS float* Ae = At + e * 4096;
#pragma unroll
            for (int j = 0; j < 63; ++j) {
                const float xj = r[j];
#pragma unroll
                for (int i4 = ((j + 1) >> 2); i4 < 16; ++i4) { const f32x4 a = *(const LAS f32x4*)(Ae + j * 64 + 4 * i4);
                    r[4 * i4 + 0] -= a[0] * xj; r[4 * i4 + 1] -= a[1] * xj; r[4 * i4 + 2] -= a[2] * xj; r[4 * i4 + 3] -= a[3] * xj; }
            }
            __syncthreads();
            if (col < 128) {
                bf16_t* up = C + (size_t)(r0 + (col >> 1)) * 8192 + 4096 + hv * 128 + (col & 1) * 64;
#pragma unroll
                for (int q = 0; q < 8; ++q) { u32x4 w; w.x = cvt_pk_bf16(r[8 * q], r[8 * q + 1]); w.y = cvt_pk_bf16(r[8 * q + 2], r[8 * q + 3]); w.z = cvt_pk_bf16(r[8 * q + 4], r[8 * q + 5]); w.w = cvt_pk_bf16(r[8 * q + 6], r[8 * q + 7]);
                    *(u32x4*)(up + 8 * q) = w; }
            } else {
                bf16_t* wp = PROJ + (size_t)r0 * GINP + hv * 128 + (col - 128);
#pragma unroll
                for (int i = 0; i < 64; ++i) wp[(size_t)i * GINP] = (bf16_t)f2bf(r[i]);
            }
        }
        {
            const int dk = tid >> 2, ib = (tid & 3) * 16;
            unsigned wv[8];
#pragma unroll
            for (int q = 0; q < 8; ++q) { const unsigned lo = *(const LAS bf16_t*)(lds + G2_KS + (ib + 2 * q) * 272 + dk * 2), hi = *(const LAS bf16_t*)(lds + G2_KS + (ib + 2 * q + 1) * 272 + dk * 2); wv[q] = lo | (hi << 16); }
            bf16_t* kp = C + (size_t)(r0 + (dk >> 1)) * 8192 + 2048 + hk * 128 + (dk & 1) * 64 + ib;
            *(u32x4*)(kp) = (u32x4){wv[0], wv[1], wv[2], wv[3]}; *(u32x4*)(kp + 8) = (u32x4){wv[4], wv[5], wv[6], wv[7]};
        }
        __syncthreads();
    }
}

constexpr int G3_W = 0, G3_Q = 17408, G3_KT = 34816, G3_A = G3_KT + 128 * 144, G3_UT = G3_A + 64 * 144, G3_GCB = G3_UT + 32 * 144, G3_BUF = G3_GCB + 512;
static_assert(2 * G3_BUF <= MISC_OFF, "G3 LDS");
__device__ __forceinline__ void g3_stage(LAS unsigned char* buf, const bf16_t* PROJ, const bf16_t* C, const bf16_t* ATT, const float* GC, int cgl, int hv, int dq, int t, int nt) {
    const size_t r0 = (size_t)cgl * CH; const int hk = hv >> 1;
    for (int i = t; i < 1024; i += nt) { const int row = i >> 4, ch = i & 15;
        *(LAS u32x4*)(buf + G3_W + row * 272 + ch * 16) = *(const u32x4*)(PROJ + (r0 + row) * GINP + hv * 128 + ch * 8);
        *(LAS u32x4*)(buf + G3_Q + row * 272 + ch * 16) = *(const u32x4*)(C + (r0 + row) * 8192 + hk * 128 + ch * 8); }
    for (int i = t; i < 1024; i += nt) { const int rr = i >> 4, ch = i & 15, dk = 2 * rr + (ch >> 3);
        *(LAS u32x4*)(buf + G3_KT + dk * 144 + (ch & 7) * 16) = *(const u32x4*)(C + (r0 + rr) * 8192 + 2048 + hk * 128 + ch * 8); }
    for (int i = t; i < 512; i += nt) { const int row = i >> 3, ch = i & 7;
        *(LAS u32x4*)(buf + G3_A + row * 144 + ch * 16) = *(const u32x4*)(ATT + ((size_t)(cgl * 32 + hv) * 64 + row) * 64 + ch * 8); }
    for (int i = t; i < 256; i += nt) { const int rr = i >> 4, ch = i & 15, dvl = 2 * rr + (ch >> 3);
        *(LAS u32x4*)(buf + G3_UT + dvl * 144 + (ch & 7) * 16) = *(const u32x4*)(C + (r0 + 16 * dq + rr) * 8192 + 4096 + hv * 128 + ch * 8); }
    if (t < 64) { const float gct = GC[(r0 + t) * 32 + hv], gl = GC[(r0 + 63) * 32 + hv];
        *(LAS float*)(buf + G3_GCB + t * 4) = __expf(gct); *(LAS float*)(buf + G3_GCB + 256 + t * 4) = __expf(gl - gct); }
}
__device__ __forceinline__ bf16x8 pack8(const f32x16& v, int s) {
    u32x4 w; w.x = cvt_pk_bf16(v[8 * s + 0], v[8 * s + 1]); w.y = cvt_pk_bf16(v[8 * s + 2], v[8 * s + 3]); w.z = cvt_pk_bf16(v[8 * s + 4], v[8 * s + 5]); w.w = cvt_pk_bf16(v[8 * s + 6], v[8 * s + 7]);
    return __builtin_bit_cast(bf16x8, w);
}
__device__ __forceinline__ bf16x8 ld2x8(const LAS unsigned char* p) {
    const u32x2 a = *(const LAS u32x2*)p, b = *(const LAS u32x2*)(p + 16);
    return __builtin_bit_cast(bf16x8, (u32x4){a.x, a.y, b.x, b.y});
}
constexpr int G3_NL = 448;
__device__ __forceinline__ void phase_gdn_scan(const Ctx& c, bf16_t* PROJ, const bf16_t* C, const bf16_t* ATT, const float* GC) {
    LAS unsigned char* lds = c.lds;
    const int lane = c.lane, l31 = lane & 31, hh = lane >> 5;
    constexpr int NITEMS = 2 * GVH * 4;
    for (int wi = c.bid; wi < NITEMS; wi += c.G) {
        const int bl = wi >> 7, hv = (wi >> 2) & 31, dq = wi & 3;
        g3_stage(lds, PROJ, C, ATT, GC, bl * NCH, hv, dq, c.tid, NTHREADS);
        __syncthreads();
        if (c.wave != 0) {
            const int lt = c.tid - 64, hk = hv >> 1;
            const int row16 = lt >> 4, ch16 = lt & 15, row8 = lt >> 3, ch8 = lt & 7;
            u32x4 pW[3], pQ[3], pK[3], pA[2], pU; float pg0 = 0.f, pg1 = 0.f;
#define G3_LOADS(cgl_) do { const size_t r0_ = (size_t)(cgl_) * CH; \
                _Pragma("unroll") for (int j = 0; j < 3; ++j) { const int row = row16 + 28 * j; if (row < 64) { \
                    pW[j] = *(const u32x4*)(PROJ + (r0_ + row) * GINP + hv * 128 + ch16 * 8); \
                    pQ[j] = *(const u32x4*)(C + (r0_ + row) * 8192 + hk * 128 + ch16 * 8); \
                    pK[j] = *(const u32x4*)(C + (r0_ + row) * 8192 + 2048 + hk * 128 + ch16 * 8); } } \
                _Pragma("unroll") for (int j = 0; j < 2; ++j) { const int row = row8 + 56 * j; if (row < 64) pA[j] = *(const u32x4*)(ATT + ((size_t)((cgl_) * 32 + hv) * 64 + row) * 64 + ch8 * 8); } \
                if (row16 < 16) pU = *(const u32x4*)(C + (r0_ + 16 * dq + row16) * 8192 + 4096 + hv * 128 + ch16 * 8); \
                if (lt < 64) { pg0 = GC[(r0_ + lt) * 32 + hv]; pg1 = GC[(r0_ + 63) * 32 + hv]; } } while (0)
#define G3_WRITES(nb_) do { \
                _Pragma("unroll") for (int j = 0; j < 3; ++j) { const int row = row16 + 28 * j; if (row < 64) { \
                    *(LAS u32x4*)((nb_) + G3_W + row * 272 + ch16 * 16) = pW[j]; \
                    *(LAS u32x4*)((nb_) + G3_Q + row * 272 + ch16 * 16) = pQ[j]; \
                    *(LAS u32x4*)((nb_) + G3_KT + (2 * row + (ch16 >> 3)) * 144 + (ch16 & 7) * 16) = pK[j]; } } \
                _Pragma("unroll") for (int j = 0; j < 2; ++j) { const int row = row8 + 56 * j; if (row < 64) *(LAS u32x4*)((nb_) + G3_A + row * 144 + ch8 * 16) = pA[j]; } \
                if (row16 < 16) *(LAS u32x4*)((nb_) + G3_UT + (2 * row16 + (ch16 >> 3)) * 144 + (ch16 & 7) * 16) = pU; \
                if (lt < 64) { *(LAS float*)((nb_) + G3_GCB + lt * 4) = __expf(pg0); *(LAS float*)((nb_) + G3_GCB + 256 + lt * 4) = __expf(pg1 - pg0); } } while (0)
#pragma unroll
            for (int j = 0; j < 3; ++j) { pW[j] = (u32x4){0u, 0u, 0u, 0u}; pQ[j] = pW[j]; pK[j] = pW[j]; }
            pA[0] = (u32x4){0u, 0u, 0u, 0u}; pA[1] = pA[0]; pU = pA[0];
            G3_LOADS(bl * NCH + 1);
            for (int ch = 0; ch < NCH; ++ch) {
                if (ch + 1 < NCH) {
                    LAS unsigned char* nb = lds + ((ch + 1) & 1) * G3_BUF;
                    G3_WRITES(nb);
                    if (ch + 2 < NCH) G3_LOADS(bl * NCH + ch + 2);
                }
                asm volatile("s_waitcnt lgkmcnt(0)\n\ts_barrier" ::: "memory");
            }
#undef G3_LOADS
#undef G3_WRITES
        } else {
            f32x16 Sacc[4];
#pragma unroll
            for (int k = 0; k < 4; ++k)
#pragma unroll
                for (int r = 0; r < 16; ++r) Sacc[k][r] = 0.f;
            for (int ch = 0; ch < NCH; ++ch) {
                LAS unsigned char* buf = lds + (ch & 1) * G3_BUF;
                const LAS float* gcb = (const LAS float*)(buf + G3_GCB);
                f32x16 vn[2];
#pragma unroll
                for (int rt = 0; rt < 2; ++rt)
#pragma unroll
                    for (int r = 0; r < 16; ++r) vn[rt][r] = 0.f;
#pragma unroll
                for (int k = 0; k < 4; ++k)
#pragma unroll
                    for (int s = 0; s < 2; ++s) {
                        const bf16x8 Sbks = pack8(Sacc[k], s);
#pragma unroll
                        for (int rt = 0; rt < 2; ++rt)
                            vn[rt] = __builtin_amdgcn_mfma_f32_32x32x16_bf16(ld2x8(buf + G3_W + (32 * rt + l31) * 272 + hh * 8 + (32 * k + 16 * s) * 2), Sbks, vn[rt], 0, 0, 0);
                    }
                bf16x8 Vb[2][2], Vsb[2][2];
#pragma unroll
                for (int rt = 0; rt < 2; ++rt)
#pragma unroll
                    for (int s = 0; s < 2; ++s) {
                        float pv[8], ps[8];
#pragma unroll
                        for (int g2 = 0; g2 < 2; ++g2) {
                            const int g = 2 * s + g2, i0 = 32 * rt + 8 * g + 4 * hh;
                            const u32x2 uu = *(const LAS u32x2*)(buf + G3_UT + l31 * 144 + i0 * 2);
                            const f32x4 e2 = *(const LAS f32x4*)(gcb + 64 + i0);
                            const float u4[4] = {bflo(uu.x), bfhi(uu.x), bflo(uu.y), bfhi(uu.y)};
#pragma unroll
                            for (int q = 0; q < 4; ++q) { const float v = u4[q] - vn[rt][4 * g + q]; pv[4 * g2 + q] = v; ps[4 * g2 + q] = v * e2[q]; }
                        }
                        u32x4 w; w.x = cvt_pk_bf16(pv[0], pv[1]); w.y = cvt_pk_bf16(pv[2], pv[3]); w.z = cvt_pk_bf16(pv[4], pv[5]); w.w = cvt_pk_bf16(pv[6], pv[7]); Vb[rt][s] = __builtin_bit_cast(bf16x8, w);
                        w.x = cvt_pk_bf16(ps[0], ps[1]); w.y = cvt_pk_bf16(ps[2], ps[3]); w.z = cvt_pk_bf16(ps[4], ps[5]); w.w = cvt_pk_bf16(ps[6], ps[7]); Vsb[rt][s] = __builtin_bit_cast(bf16x8, w);
                    }
                __builtin_amdgcn_sched_barrier(0);
                f32x16 oa[2];
#pragma unroll
                for (int rt = 0; rt < 2; ++rt)
#pragma unroll
                    for (int r = 0; r < 16; ++r) oa[rt][r] = 0.f;
#pragma unroll
                for (int k = 0; k < 4; ++k)
#pragma unroll
                    for (int s = 0; s < 2; ++s) {
                        const bf16x8 Sbks = pack8(Sacc[k], s);
#pragma unroll
                        for (int rt = 0; rt < 2; ++rt)
                            oa[rt] = __builtin_amdgcn_mfma_f32_32x32x16_bf16(ld2x8(buf + G3_Q + (32 * rt + l31) * 272 + hh * 8 + (32 * k + 16 * s) * 2), Sbks, oa[rt], 0, 0, 0);
                    }
#pragma unroll
                for (int rt = 0; rt < 2; ++rt)
#pragma unroll
                    for (int g = 0; g < 4; ++g) { const f32x4 e1 = *(const LAS f32x4*)(gcb + 32 * rt + 8 * g + 4 * hh);
#pragma unroll
                        for (int q = 0; q < 4; ++q) oa[rt][4 * g + q] *= e1[q]; }
#pragma unroll
                for (int ro = 0; ro < 2; ++ro) { const LAS unsigned char* ap = buf + G3_A + (32 * ro + l31) * 144 + hh * 8;
#pragma unroll
                    for (int rt = 0; rt <= ro; ++rt)
#pragma unroll
                        for (int s = 0; s < 2; ++s) oa[ro] = __builtin_amdgcn_mfma_f32_32x32x16_bf16(ld2x8(ap + (32 * rt + 16 * s) * 2), Vb[rt][s], oa[ro], 0, 0, 0); }
                { bf16_t* op = PROJ + ((size_t)(bl * NCH + ch) * CH) * GINP + 4096 + hv * 128 + 32 * dq + l31;
#pragma unroll
                  for (int rt = 0; rt < 2; ++rt)
#pragma unroll
                    for (int r = 0; r < 16; ++r) op[(size_t)(32 * rt + (r & 3) + 8 * (r >> 2) + 4 * hh) * GINP] = (bf16_t)f2bf(oa[rt][r]); }
                __builtin_amdgcn_sched_barrier(0);
                const float dec = gcb[63];
#pragma unroll
                for (int k = 0; k < 4; ++k) {
#pragma unroll
                    for (int r = 0; r < 16; ++r) Sacc[k][r] *= dec;
                    const LAS unsigned char* kp = buf + G3_KT + (32 * k + l31) * 144 + hh * 8;
#pragma unroll
                    for (int rt = 0; rt < 2; ++rt)
#pragma unroll
                        for (int s = 0; s < 2; ++s) Sacc[k] = __builtin_amdgcn_mfma_f32_32x32x16_bf16(ld2x8(kp + (32 * rt + 16 * s) * 2), Vsb[rt][s], Sacc[k], 0, 0, 0);
                }
                asm volatile("s_waitcnt lgkmcnt(0)\n\ts_barrier" ::: "memory");
            }
        }
        __syncthreads();
    }
}

__device__ __forceinline__ void phase_gdn_onorm(const Ctx& c, bf16_t* PROJ, const float* o_gain) {
    const int gw = c.bid * NWAVES + c.wave, NGW = c.G * NWAVES, sub = c.lane >> 4, ch = c.lane & 15;
    float og[8];
    { const f32x4 a = *(const f32x4*)(o_gain + ch * 8), b = *(const f32x4*)(o_gain + ch * 8 + 4);
#pragma unroll
      for (int k = 0; k < 4; ++k) { og[k] = a[k]; og[4 + k] = b[k]; } }
    const int npairs = MH * GVH / 4;
    for (int it = gw; it < npairs; it += NGW) {
        const int pr = it * 4 + sub, row = pr >> 5, hv = pr & 31;
        bf16_t* op = PROJ + (size_t)row * GINP + 4096 + hv * 128 + ch * 8;
        const u32x4 ov = *(const u32x4*)op, gv = *(const u32x4*)(op + 4096);
        float o[8], g[8]; float ss = 0.f;
#pragma unroll
        for (int k = 0; k < 4; ++k) { o[2 * k] = bflo(ov[k]); o[2 * k + 1] = bfhi(ov[k]); g[2 * k] = bflo(gv[k]); g[2 * k + 1] = bfhi(gv[k]); }
#pragma unroll
        for (int k = 0; k < 8; ++k) ss += o[k] * o[k];
        ss += __shfl_xor(ss, 1); ss += __shfl_xor(ss, 2); ss += __shfl_xor(ss, 4); ss += __shfl_xor(ss, 8);
        const float rs = 1.0f / sqrtf(ss * (1.0f / 128.f) + EPS);
        float y[8];
#pragma unroll
        for (int k = 0; k < 8; ++k) y[k] = o[k] * rs * og[k] * siluf(g[k]);
        u32x4 w; w.x = cvt_pk_bf16(y[0], y[1]); w.y = cvt_pk_bf16(y[2], y[3]); w.z = cvt_pk_bf16(y[4], y[5]); w.w = cvt_pk_bf16(y[6], y[7]);
        *(u32x4*)op = w;
    }
}

typedef const __attribute__((address_space(4))) Args* KArgsP;
__device__ __forceinline__ KArgsP kargs() { const unsigned long long p0 = (unsigned long long)__builtin_amdgcn_kernarg_segment_ptr(); unsigned lo32 = (unsigned)p0, hi32 = (unsigned)(p0 >> 32);
    asm volatile("" : "+v"(lo32), "+v"(hi32)); lo32 = __builtin_amdgcn_readfirstlane(lo32); hi32 = __builtin_amdgcn_readfirstlane(hi32); return (KArgsP)(((unsigned long long)hi32 << 32) | lo32); }
__device__ __forceinline__ Ctx mkctx(LAS unsigned char* lds) { Ctx c; int tid = threadIdx.x; asm volatile("" : "+v"(tid)); c.lds = lds; c.tid = tid; c.lane = tid & 63; c.wave = __builtin_amdgcn_readfirstlane(tid >> 6); c.G = gridDim.x; c.bid = blockIdx.x; return c; }
#ifndef PHASE_EN
#define PHASE_EN 0xFFFFFFFFu
#endif
#define EN(id) (((PHASE_EN) >> (id)) & 1u)
#ifndef DUP_MASK
#define DUP_MASK 0u
#endif
#define DUP(id) (((DUP_MASK) >> (id)) & 1u)

__global__ void __launch_bounds__(NTHREADS, 2) fwd_kernel(Args args) {
    extern __shared__ __attribute__((aligned(16))) unsigned char lds_raw[];
    LAS unsigned char* const lds = (LAS unsigned char*)lds_raw;
    volatile LAS unsigned* MISC = (volatile LAS unsigned*)(lds + MISC_OFF);
    if (threadIdx.x < 64) MISC[threadIdx.x] = 0u;
    __syncthreads();
    XcdBarrier bar; bar.bar = nullptr; bar.x = 0; bar.st = nullptr;
    if (N_LAUNCH_MODE == 1) { KArgsP ap = kargs(); bar = xcd_barrier_post((unsigned*)(ap->ws + WS_CTL) + CW_BAR, MISC + 8); }
    const int lo = args.ph_lo, hi = args.ph_hi;
    int ph = 0;
#define PH_IN (ph >= lo && ph < hi)
#define PH_END do { if (PH_IN && ph + 1 < hi) { if (N_LAUNCH_MODE == 1) xcd_barrier(bar); } ++ph; } while (0)

    if (EN(0) && PH_IN) { const Ctx c = mkctx(lds); phase_weights(c, kargs()); if (DUP(0)) { __syncthreads(); phase_weights(c, kargs()); } }
    PH_END;

    for (int layer = 0; layer < 4; ++layer) {
        const int kind = layer % 3, j = layer / 3;
        if (EN(1) && PH_IN) { const Ctx c = mkctx(lds); KArgsP ap = kargs(); unsigned char* ws = ap->ws;
            phase_rmsnorm(c, (layer == 0) ? ap->x : (const float*)ap->out, ap->mix_norm + layer * D, (bf16_t*)(ws + WS_H));
            if (DUP(1)) phase_rmsnorm(c, (layer == 0) ? ap->x : (const float*)ap->out, ap->mix_norm + layer * D, (bf16_t*)(ws + WS_H)); }
        PH_END;
        if (kind == 0) {
            if (EN(2) && PH_IN) { const Ctx c = mkctx(lds); KArgsP ap = kargs(); unsigned char* ws = ap->ws;
                pg8::Gemm g{(const bf16_t*)(ws + WS_H), (const bf16_t*)(ws + WS_WQKV) + (size_t)j * 6144 * D, T, 6144, D, D, D, 0}; pg8::StaticOrder S; S.init(T, 6144, c.G, c.bid);
                pg8::EpiBf16 E{(bf16_t*)(ws + WS_QKV), 6144}; pg8::gemm_phase(c.lds, c.tid, g, S, E); if (DUP(2)) pg8::gemm_phase(c.lds, c.tid, g, S, E); }
            PH_END;
            if (EN(3) && PH_IN) { const Ctx c = mkctx(lds); KArgsP ap = kargs(); unsigned char* ws = ap->ws;
                phase_qknorm(c, (bf16_t*)(ws + WS_QKV), ap->att_q_gain + j * AHD, ap->att_k_gain + j * AHD); }
            PH_END;
            if (EN(3) && PH_IN) { const Ctx c = mkctx(lds); KArgsP ap = kargs(); unsigned char* ws = ap->ws;
                phase_attention2(c, (const bf16_t*)(ws + WS_QKV), (bf16_t*)(ws + WS_AO), ap->att_rel_bias + (size_t)j * AH * NREL);
                if (DUP(3)) phase_attention2(c, (const bf16_t*)(ws + WS_QKV), (bf16_t*)(ws + WS_AO), ap->att_rel_bias + (size_t)j * AH * NREL); }
            PH_END;
            if (EN(4) && PH_IN) { const Ctx c = mkctx(lds); KArgsP ap = kargs(); unsigned char* ws = ap->ws;
                pg8::Gemm g{(const bf16_t*)(ws + WS_AO), (const bf16_t*)(ws + WS_WO) + (size_t)j * D * D, T, D, D, D, D, 0}; pg8::StaticOrder S; S.init(T, D, c.G, c.bid);
                pg8::EpiRes E{(layer == 0) ? ap->x : (const float*)ap->out, ap->out, D, nullptr}; pg8::gemm_phase(c.lds, c.tid, g, S, E);
                if (DUP(4)) { pg8::EpiBf16 E2{(bf16_t*)(ws + WS_H), D}; pg8::gemm_phase(c.lds, c.tid, g, S, E2); } }
            PH_END;
        } else if (kind == 1) {
            if (EN(5) && PH_IN) { const Ctx c = mkctx(lds); KArgsP ap = kargs(); unsigned char* ws = ap->ws;
                phase_pool_prep(c, (const bf16_t*)(ws + WS_H), (bf16_t*)(ws + WS_POOLED)); if (DUP(5)) phase_pool_prep(c, (const bf16_t*)(ws + WS_H), (bf16_t*)(ws + WS_POOLED)); }
            PH_END;
            if (EN(6) && PH_IN) { const Ctx c = mkctx(lds); KArgsP ap = kargs(); unsigned char* ws = ap->ws;
                pg8::Gemm g{(const bf16_t*)(ws + WS_POOLED), (const bf16_t*)(ws + WS_WPOOL), T, D, 512, D, 512, 2}; pg8::StaticOrder S; S.init(T, D, c.G, c.bid);
                pg8::EpiRes E{ap->out, ap->out, D, ap->pool_scale + j * D}; pg8::gemm_phase(c.lds, c.tid, g, S, E); }
            PH_END;
        } else {
            for (int half = 0; half < 2; ++half) {
                if (EN(7) && PH_IN) { const Ctx c = mkctx(lds); KArgsP ap = kargs(); unsigned char* ws = ap->ws;
                    pg8::Gemm g{(const bf16_t*)(ws + WS_H) + (size_t)half * MH * D, (const bf16_t*)(ws + WS_WGIN), MH, GINP, D, D, D, 0}; pg8::StaticOrder S; S.init(MH, GINP, c.G, c.bid);
                    pg8::EpiProj E{(bf16_t*)(ws + WS_PROJ), GINP, (float*)(ws + WS_AB)}; pg8::gemm_phase(c.lds, c.tid, g, S, E); if (DUP(7)) pg8::gemm_phase(c.lds, c.tid, g, S, E); }
                PH_END;
                if (EN(8) && PH_IN) { const Ctx c = mkctx(lds); KArgsP ap = kargs(); unsigned char* ws = ap->ws;
                    phase_gdn_conv(c, (const bf16_t*)(ws + WS_PROJ), (bf16_t*)(ws + WS_C), ap->gdn_conv); if (DUP(8)) phase_gdn_conv(c, (const bf16_t*)(ws + WS_PROJ), (bf16_t*)(ws + WS_C), ap->gdn_conv); }
                PH_END;
                if (EN(9) && PH_IN) { const Ctx c = mkctx(lds); KArgsP ap = kargs(); unsigned char* ws = ap->ws;
                    phase_gdn_local(c, (bf16_t*)(ws + WS_PROJ), (bf16_t*)(ws + WS_C), (bf16_t*)(ws + WS_ATT), (const float*)(ws + WS_AB), (float*)(ws + WS_GC), ap->gdn_a_log, ap->gdn_dt_bias); }
                PH_END;
                if (EN(10) && PH_IN) { const Ctx c = mkctx(lds); KArgsP ap = kargs(); unsigned char* ws = ap->ws;
                    phase_gdn_scan(c, (bf16_t*)(ws + WS_PROJ), (const bf16_t*)(ws + WS_C), (const bf16_t*)(ws + WS_ATT), (const float*)(ws + WS_GC));
                    if (DUP(10)) phase_gdn_scan(c, (bf16_t*)(ws + WS_PROJ), (const bf16_t*)(ws + WS_C), (const bf16_t*)(ws + WS_ATT), (const float*)(ws + WS_GC)); }
                PH_END;
                if (EN(11) && PH_IN) { const Ctx c = mkctx(lds); KArgsP ap = kargs(); unsigned char* ws = ap->ws;
                    phase_gdn_onorm(c, (bf16_t*)(ws + WS_PROJ), ap->gdn_o_gain); }
                PH_END;
                if (EN(12) && PH_IN) { const Ctx c = mkctx(lds); KArgsP ap = kargs(); unsigned char* ws = ap->ws;
                    pg8::Gemm g{(const bf16_t*)(ws + WS_PROJ) + 4096, (const bf16_t*)(ws + WS_WGO), MH, D, 4096, GINP, 4096, 0}; pg8::StaticOrder S; S.init(MH, D, c.G, c.bid);
                    pg8::EpiRes E{(const float*)ap->out + (size_t)half * MH * D, ap->out + (size_t)half * MH * D, D, nullptr}; pg8::gemm_phase(c.lds, c.tid, g, S, E); }
                PH_END;
            }
        }
        if (EN(13) && PH_IN) { const Ctx c = mkctx(lds); KArgsP ap = kargs(); unsigned char* ws = ap->ws;
            phase_rmsnorm(c, ap->out, ap->ffn_norm + layer * D, (bf16_t*)(ws + WS_H)); if (DUP(13)) phase_rmsnorm(c, ap->out, ap->ffn_norm + layer * D, (bf16_t*)(ws + WS_H)); }
        PH_END;
        if (EN(14) && PH_IN) { const Ctx c = mkctx(lds); KArgsP ap = kargs(); unsigned char* ws = ap->ws;
            pg8::Gemm g{(const bf16_t*)(ws + WS_H), (const bf16_t*)(ws + WS_WUP) + (size_t)layer * FF2 * D, T, FF2, D, D, D, 0}; pg8::StaticOrder S; S.init(T, FF2, c.G, c.bid);
            pg8::EpiFfn E{(bf16_t*)(ws + WS_ACT), ap->ffn_conv + (size_t)layer * 3 * FF, (bf16_t*)(ws + WS_TAILU), (bf16_t*)(ws + WS_HEADU), (bf16_t*)(ws + WS_HEADG)};
            pg8::gemm_phase(c.lds, c.tid, g, S, E); if (DUP(14)) pg8::gemm_phase(c.lds, c.tid, g, S, E); }
        PH_END;
        if (EN(15) && PH_IN) { const Ctx c = mkctx(lds); KArgsP ap = kargs(); unsigned char* ws = ap->ws;
            phase_ffn_fix(c, (bf16_t*)(ws + WS_ACT), ap->ffn_conv + (size_t)layer * 3 * FF, (const bf16_t*)(ws + WS_TAILU), (const bf16_t*)(ws + WS_HEADU), (const bf16_t*)(ws + WS_HEADG)); }
        PH_END;
        if (EN(16) && PH_IN) { const Ctx c = mkctx(lds); KArgsP ap = kargs(); unsigned char* ws = ap->ws;
            pg8::Gemm g{(const bf16_t*)(ws + WS_ACT), (const bf16_t*)(ws + WS_WDN) + (size_t)layer * D * FF, T, D, FF, FF, FF, 0}; pg8::StaticOrder S; S.init(T, D, c.G, c.bid);
            pg8::EpiRes E{ap->out, ap->out, D, nullptr}; pg8::gemm_phase(c.lds, c.tid, g, S, E);
            if (DUP(16)) { pg8::EpiBf16 E2{(bf16_t*)(ws + WS_H), D}; pg8::gemm_phase(c.lds, c.tid, g, S, E2); } }
        PH_END;
    }
#undef PH_IN
#undef PH_END
}

constexpr int N_PHASES = 1 + 9 + 7 + 17 + 9;

extern "C" void kernel_launch(void* const* d_in, const int* in_sizes, int n_in, void* d_out, int out_size, void* d_ws, size_t ws_size, hipStream_t stream) {
    static int grid = 0;
    if (grid == 0) {
        if (n_in != 19 || out_size != T * D || ws_size < WS_NEED) { fprintf(stderr, "kernel_launch: unexpected problem (n_in %d, out %d, ws %zu, need %zu)\n", n_in, out_size, ws_size, (size_t)WS_NEED); grid = -1; return; }
        int dev = 0, cus = 0, per_cu = 0;
        if (hipGetDevice(&dev) != hipSuccess || hipDeviceGetAttribute(&cus, hipDeviceAttributeMultiprocessorCount, dev) != hipSuccess) { grid = -1; return; }
        if (hipFuncSetAttribute((const void*)fwd_kernel, hipFuncAttributeMaxDynamicSharedMemorySize, LDS_BYTES) != hipSuccess) { fprintf(stderr, "kernel_launch: hipFuncSetAttribute failed\n"); grid = -1; return; }
        if (hipOccupancyMaxActiveBlocksPerMultiprocessor(&per_cu, (const void*)fwd_kernel, NTHREADS, LDS_BYTES) != hipSuccess || per_cu < 1) fprintf(stderr, "kernel_launch: occupancy query says %d\n", per_cu);
        (void)hipGetLastError();
        grid = cus;
    }
    if (grid < 0) return;
    unsigned char* ws = (unsigned char*)d_ws;
    (void)hipMemsetAsync(ws + WS_CTL, 0, CTL_ZERO_BYTES, stream);
    Args a{};
    a.x = (const float*)d_in[0]; a.mix_norm = (const float*)d_in[1]; a.ffn_norm = (const float*)d_in[2];
    a.att_q_gain = (const float*)d_in[4]; a.att_k_gain = (const float*)d_in[5]; a.att_rel_bias = (const float*)d_in[6];
    a.pool_scale = (const float*)d_in[9]; a.gdn_conv = (const float*)d_in[11]; a.gdn_a_log = (const float*)d_in[12]; a.gdn_dt_bias = (const float*)d_in[13];
    a.gdn_o_gain = (const float*)d_in[14]; a.ffn_conv = (const float*)d_in[17];
    a.out = (float*)d_out; a.ws = ws;
    a.wd[0] = WDesc{(const float*)d_in[3],  (bf16_t*)(ws + WS_WQKV), D, 6144, 2, 0};
    a.wd[1] = WDesc{(const float*)d_in[7],  (bf16_t*)(ws + WS_WO),   D, D, 2, 0};
    a.wd[2] = WDesc{(const float*)d_in[8],  (bf16_t*)(ws + WS_WPOOL), 512, 512, 4, 0};
    a.wd[3] = WDesc{(const float*)d_in[10], (bf16_t*)(ws + WS_WGIN), D, GIN, 1, 0};
    a.wd[4] = WDesc{(const float*)d_in[15], (bf16_t*)(ws + WS_WGO),  4096, D, 1, 0};
    a.wd[5] = WDesc{(const float*)d_in[16], (bf16_t*)(ws + WS_WUP),  D, FF2, 4, 1};
    a.wd[6] = WDesc{(const float*)d_in[18], (bf16_t*)(ws + WS_WDN),  FF, D, 4, 0};
    if (N_LAUNCH_MODE == 1) {
        a.ph_lo = 0; a.ph_hi = N_PHASES;
        hipLaunchKernelGGL(fwd_kernel, dim3(grid), dim3(NTHREADS), LDS_BYTES, stream, a);
    } else {
        for (int p = 0; p < N_PHASES; ++p) { a.ph_lo = p; a.ph_hi = p + 1; hipLaunchKernelGGL(fwd_kernel, dim3(grid), dim3(NTHREADS), LDS_BYTES, stream, a); }
    }
}
```

```cpp
#include <hip/hip_runtime.h>
#include <cstdio>
#include <cstdint>

#ifndef N_LAUNCH_MODE
#define N_LAUNCH_MODE 1
#endif

#define LAS __attribute__((address_space(3)))
#define GAS __attribute__((address_space(1)))
typedef unsigned short bf16_t;
typedef short bf16x8 __attribute__((ext_vector_type(8)));
typedef short s16x4 __attribute__((ext_vector_type(4)));
typedef float f32x4 __attribute__((ext_vector_type(4)));
typedef float f32x2 __attribute__((ext_vector_type(2)));
typedef float f32x16 __attribute__((ext_vector_type(16)));
typedef unsigned u32x4 __attribute__((ext_vector_type(4)));
typedef unsigned u32x2 __attribute__((ext_vector_type(2)));

constexpr int D = 2048, BATCH = 4, SEQ = 8192, T = BATCH * SEQ;
constexpr int CH = 64, NCH = SEQ / CH;
constexpr int AH = 16, AHD = 128, NREL = 320;
constexpr int GKH = 16, GVH = 32, GIN = 12352, GINP = 12544;
constexpr int FF = 5504, FF2 = 11008;
constexpr int MH = T / 2;
constexpr float EPS = 1e-6f;
constexpr int NTHREADS = 512, NWAVES = 8;

constexpr size_t MiB = 1u << 20;
constexpr size_t WS_CTL = 0, CTL_ZERO_BYTES = 1 * MiB;
constexpr size_t WS_WQKV = 1 * MiB;
constexpr size_t WS_WO   = WS_WQKV + 48 * MiB;
constexpr size_t WS_WPOOL= WS_WO + 16 * MiB;
constexpr size_t WS_WGIN = WS_WPOOL + 2 * MiB;
constexpr size_t WS_WGO  = WS_WGIN + 49 * MiB;
constexpr size_t WS_WUP  = WS_WGO + 16 * MiB;
constexpr size_t WS_WDN  = WS_WUP + 172 * MiB;
constexpr size_t WS_H    = WS_WDN + 86 * MiB;
constexpr size_t WS_BIG  = WS_H + 128 * MiB;
constexpr size_t WS_QKV  = WS_BIG;
constexpr size_t WS_AO   = WS_QKV + 384 * MiB;
constexpr size_t WS_PART = WS_AO + 128 * MiB;
constexpr size_t WS_ACT  = WS_BIG;
constexpr size_t WS_TAILU = WS_ACT + 344 * MiB;
constexpr size_t WS_HEADU = WS_TAILU + 11 * MiB;
constexpr size_t WS_HEADG = WS_HEADU + 11 * MiB;
constexpr size_t WS_POOLED = WS_BIG;
constexpr size_t WS_C    = WS_BIG;
constexpr size_t WS_GATE = WS_C + 256 * MiB;
constexpr size_t WS_W    = WS_GATE + 128 * MiB;
constexpr size_t WS_O    = WS_W + 128 * MiB;
constexpr size_t WS_ATT  = WS_O + 128 * MiB;
constexpr size_t WS_AB   = WS_ATT + 64 * MiB;
constexpr size_t WS_GC   = WS_AB + 4 * MiB;
constexpr size_t WS_HEAD3 = WS_GC + 2 * MiB;
constexpr size_t WS_TAIL3 = WS_HEAD3 + 13 * MiB;
constexpr size_t WS_END  = WS_TAIL3 + 13 * MiB;
constexpr size_t WS_NEED = WS_BIG + 736 * MiB;
static_assert(WS_END <= WS_NEED && WS_HEADG + 11 * MiB <= WS_NEED && WS_AO + (size_t)T * D * 2 <= WS_NEED, "map");

constexpr int CW_BAR = 4096;

__device__ __forceinline__ float bf2f(unsigned b) { return __uint_as_float(b << 16); }
__device__ __forceinline__ float bflo(unsigned w) { return __uint_as_float(w << 16); }
__device__ __forceinline__ float bfhi(unsigned w) { return __uint_as_float(w & 0xffff0000u); }
__device__ __forceinline__ unsigned cvt_pk_bf16(float lo, float hi) { unsigned r; asm volatile("v_cvt_pk_bf16_f32 %0, %1, %2" : "=v"(r) : "v"(lo), "v"(hi)); return r; }
typedef float f32x2_cv __attribute__((ext_vector_type(2))); typedef __bf16 bf16x2_cv __attribute__((ext_vector_type(2)));
__device__ __forceinline__ unsigned cvt_pk_bf16_op(float lo, float hi) { const f32x2_cv v = {lo, hi}; const bf16x2_cv b = __builtin_convertvector(v, bf16x2_cv); return __builtin_bit_cast(unsigned, b); }
__device__ __forceinline__ unsigned f2bf(float f) { return cvt_pk_bf16(f, 0.f) & 0xffffu; }
template <int CTRL, int RMASK, bool BC> __device__ __forceinline__ float dpp_get(float oldv, float v) { return __builtin_bit_cast(float, __builtin_amdgcn_update_dpp(__builtin_bit_cast(int, oldv), __builtin_bit_cast(int, v), CTRL, RMASK, 0xf, BC)); }
__device__ __forceinline__ float sum16(float v) {
    v += dpp_get<0xB1, 0xf, false>(v, v); v += dpp_get<0x4E, 0xf, false>(v, v); v += dpp_get<0x141, 0xf, false>(v, v); v += dpp_get<0x140, 0xf, false>(v, v); return v; }
__device__ __forceinline__ float scan64(float v) {
    v += dpp_get<0x111, 0xf, true>(0.f, v); v += dpp_get<0x112, 0xf, true>(0.f, v); v += dpp_get<0x114, 0xf, true>(0.f, v); v += dpp_get<0x118, 0xf, true>(0.f, v);
    v += dpp_get<0x142, 0xa, false>(0.f, v); v += dpp_get<0x143, 0xc, false>(0.f, v); return v; }
__device__ __forceinline__ float wave_sum(float v) {
#pragma unroll
    for (int o = 1; o < 64; o <<= 1) v += __shfl_xor(v, o);
    return v;
}
__device__ __forceinline__ float siluf(float x) { return x * __builtin_amdgcn_rcpf(1.0f + __expf(-x)); }
#define LDS_WAIT() asm volatile("s_waitcnt lgkmcnt(0)" ::: "memory")
#define MFMA_SETTLE() do { __builtin_amdgcn_sched_barrier(0); asm volatile("s_nop 15\n\ts_nop 15\n\ts_nop 15\n\ts_nop 15\n\ts_nop 15" ::: "memory"); __builtin_amdgcn_sched_barrier(0); } while (0)
#define VM_WAIT() asm volatile("s_waitcnt vmcnt(0)" ::: "memory")

namespace pg8 {
constexpr int BM = 256, BK = 64, HALF = 128, HTB = HALF * BK * 2, STAGE_BYTES = 8 * HTB, NXCD = 8, WGM = 8;
__host__ __device__ __forceinline__ int lds_byte(int r, int c) { const int st = (r >> 4) * 2 + (c >> 5), rr = r & 15, cc = c & 31, ob = rr * 64 + cc * 2; return st * 1024 + (ob ^ (((ob >> 9) & 1) << 5)); }
__host__ __device__ __forceinline__ void stage_rc(int b, int& R, int& C) { const int st = b / 1024, sb = b % 1024, swz = sb ^ (((sb >> 9) & 1) << 5); R = (st >> 1) * 16 + swz / 64; C = (st & 1) * 32 + (swz % 64) / 2; }
__host__ __device__ __forceinline__ int perm32(int rho) { const int n = rho >> 4, i = rho & 15; return 8 * (i >> 2) + 4 * n + (i & 3); }

struct Unit { int pm, pn; };
struct Gemm { const bf16_t* A; const bf16_t* Bt; int M, N, K, lda, ldb, grp; };

struct StaticOrder {
    int nM, nN, nwg, G, c;
    __device__ void init(int M, int N, int G_, int c_) { nM = M / BM; nN = N / BM; nwg = nM * nN; G = G_; c = c_; }
    __device__ bool next(int i, Unit& u) const {
        const long L = (long)i * G + c; if (L >= nwg) return false;
        int wgid = (int)L; { const int q = nwg / NXCD, r = nwg % NXCD, xcd = wgid % NXCD, off = wgid / NXCD; wgid = (xcd < r ? xcd * (q + 1) : r * (q + 1) + (xcd - r) * q) + off; }
        const int nig = WGM * nN, gid = wgid / nig, fm = gid * WGM, gsz = (nM - fm) < WGM ? (nM - fm) : WGM;
        u.pm = fm + ((wgid % nig) % gsz); u.pn = (wgid % nig) / gsz; return true;
    }
};

struct EpiBf16 {
    static constexpr bool PERM = true;
    bf16_t* O; int ldc;
    __device__ __forceinline__ void operator()(const f32x4 (&acc)[2][2][4][2], const Unit& u, int wr, int wc, int fr, int fq) const {
        const int row0 = u.pm * BM + wr * 64 + fr, col0 = u.pn * BM + wc * 32 + 8 * fq;
#pragma unroll
        for (int ai = 0; ai < 2; ++ai)
#pragma unroll
            for (int m = 0; m < 4; ++m) { bf16_t* rowp = O + (size_t)(row0 + ai * HALF + m * 16) * ldc + col0;
#pragma unroll
                for (int bj = 0; bj < 2; ++bj) { const f32x4 v0 = acc[ai][bj][m][0], v1 = acc[ai][bj][m][1];
                    u32x4 w; w.x = cvt_pk_bf16(v0[0], v0[1]); w.y = cvt_pk_bf16(v0[2], v0[3]); w.z = cvt_pk_bf16(v1[0], v1[1]); w.w = cvt_pk_bf16(v1[2], v1[3]);
                    *(u32x4*)(rowp + bj * HALF) = w; } }
    }
};
struct EpiQkv {
    static constexpr bool PERM = true;
    bf16_t* O; int ldc; float* PART;
    __device__ __forceinline__ void operator()(const f32x4 (&acc)[2][2][4][2], const Unit& u, int wr, int wc, int fr, int fq) const {
        const int row0 = u.pm * BM + wr * 64 + fr, col0 = u.pn * BM + wc * 32 + 8 * fq;
#pragma unroll
        for (int ai = 0; ai < 2; ++ai)
#pragma unroll
            for (int m = 0; m < 4; ++m) { bf16_t* rowp = O + (size_t)(row0 + ai * HALF + m * 16) * ldc + col0;
#pragma unroll
                for (int bj = 0; bj < 2; ++bj) { const f32x4 v0 = acc[ai][bj][m][0], v1 = acc[ai][bj][m][1];
                    u32x4 w; w.x = cvt_pk_bf16(v0[0], v0[1]); w.y = cvt_pk_bf16(v0[2], v0[3]); w.z = cvt_pk_bf16(v1[0], v1[1]); w.w = cvt_pk_bf16(v1[2], v1[3]);
                    *(u32x4*)(rowp + bj * HALF) = w; } }
        if (u.pn < 16) {
#pragma unroll
            for (int ai = 0; ai < 2; ++ai)
#pragma unroll
                for (int m = 0; m < 4; ++m)
#pragma unroll
                    for (int bj = 0; bj < 2; ++bj) { const f32x4 v0 = acc[ai][bj][m][0], v1 = acc[ai][bj][m][1];
                        float ss = (v0[0] * v0[0] + v0[1] * v0[1]) + (v0[2] * v0[2] + v0[3] * v0[3]) + (v1[0] * v1[0] + v1[1] * v1[1]) + (v1[2] * v1[2] + v1[3] * v1[3]);
                        ss += __shfl_xor(ss, 16); ss += __shfl_xor(ss, 32);
                        if (fq == 0) PART[(((size_t)u.pn * T + (row0 + ai * HALF + m * 16)) * 2 + bj) * 4 + wc] = ss; }
        }
    }
};
template <int CTRL> __device__ __forceinline__ float dpp0(float v) {
    return __builtin_bit_cast(float, __builtin_amdgcn_update_dpp(0, __builtin_bit_cast(int, v), CTRL, 0xf, 0xf, true)); }
#define DEF_FMAC_DPP(NAME, CTRL) __device__ __forceinline__ void NAME(float& a, float src, float w) { asm("v_fmac_f32_dpp %0, %1, %2 " CTRL " row_mask:0xf bank_mask:0xf bound_ctrl:1" : "+v"(a) : "v"(src), "v"(w)); }
DEF_FMAC_DPP(fmac_shr1, "row_shr:1")
DEF_FMAC_DPP(fmac_shr2, "row_shr:2")
DEF_FMAC_DPP(fmac_ror1, "row_ror:1")
DEF_FMAC_DPP(fmac_ror2, "row_ror:2")
DEF_FMAC_DPP(fmac_shr3, "row_shr:3")
DEF_FMAC_DPP(fmac_ror3, "row_ror:3")
#undef DEF_FMAC_DPP
template <int N> __device__ __forceinline__ float dpp_rowprev(float cur, float prevm) {
    const int t = __builtin_amdgcn_update_dpp(0, __builtin_bit_cast(int, prevm), 0x120 + N, 0xf, 0xf, false);
    return __builtin_bit_cast(float, __builtin_amdgcn_update_dpp(t, __builtin_bit_cast(int, cur), 0x110 + N, 0xf, 0xf, false));
}
struct EpiGdn {
    static constexpr bool PERM = true;
    bf16_t* C; bf16_t* GATE; float* AB; const float* cw; bf16_t* HEAD3; bf16_t* TAIL3;
    __device__ __forceinline__ void operator()(const f32x4 (&acc)[2][2][4][2], const Unit& u, int wr, int wc, int fr, int fq) const {
        const int row0 = u.pm * BM + wr * 64 + fr;
        if (u.pn == 48) {
            if (wc < 2) {
#pragma unroll
                for (int ai = 0; ai < 2; ++ai)
#pragma unroll
                    for (int m = 0; m < 4; ++m) { float* rp = AB + (size_t)(row0 + ai * HALF + m * 16) * 64 + wc * 32 + 8 * fq;
                        *(f32x4*)(rp) = acc[ai][0][m][0]; *(f32x4*)(rp + 4) = acc[ai][0][m][1]; }
            }
            return;
        }
        if (u.pn >= 32) {
            const int col0 = (u.pn - 32) * BM + wc * 32 + 8 * fq;
#pragma unroll
            for (int ai = 0; ai < 2; ++ai)
#pragma unroll
                for (int m = 0; m < 4; ++m) { bf16_t* rowp = GATE + (size_t)(row0 + ai * HALF + m * 16) * 4096 + col0;
#pragma unroll
                    for (int bj = 0; bj < 2; ++bj) { const f32x4 v0 = acc[ai][bj][m][0], v1 = acc[ai][bj][m][1];
                        u32x4 w; w.x = cvt_pk_bf16(v0[0], v0[1]); w.y = cvt_pk_bf16(v0[2], v0[3]); w.z = cvt_pk_bf16(v1[0], v1[1]); w.w = cvt_pk_bf16(v1[2], v1[3]);
                        *(u32x4*)(rowp + bj * HALF) = w; } }
            return;
        }
#pragma unroll
        for (int bj = 0; bj < 2; ++bj)
#pragma unroll
            for (int n = 0; n < 2; ++n) {
                const int colc = u.pn * BM + bj * HALF + wc * 32 + 8 * fq + 4 * n;
                const f32x4 w0 = *(const f32x4*)(cw + colc), w1 = *(const f32x4*)(cw + 8192 + colc), w2 = *(const f32x4*)(cw + 2 * 8192 + colc), w3 = *(const f32x4*)(cw + 3 * 8192 + colc);
                f32x4 w0m, w1m, w2m;
#pragma unroll
                for (int k = 0; k < 4; ++k) { w0m[k] = (fr < 3) ? w0[k] : 0.f; w1m[k] = (fr < 2) ? w1[k] : 0.f; w2m[k] = (fr < 1) ? w2[k] : 0.f; }
#pragma unroll
                for (int ai = 0; ai < 2; ++ai) {
                    const int sg = u.pm * 4 + ai * 2 + wr, rowbase = u.pm * BM + ai * HALF + wr * 64;
#pragma unroll
                    for (int m = 0; m < 4; ++m) {
                        float y[4];
#pragma unroll
                        for (int k = 0; k < 4; ++k) {
                            const float cur = acc[ai][bj][m][n][k];
                            float sv = w3[k] * cur;
                            fmac_shr1(sv, cur, w2[k]); fmac_shr2(sv, cur, w1[k]); fmac_shr3(sv, cur, w0[k]);
                            if (m > 0) { const float pv = acc[ai][bj][m > 0 ? m - 1 : 0][n][k];
                                fmac_ror1(sv, pv, w2m[k]); fmac_ror2(sv, pv, w1m[k]); fmac_ror3(sv, pv, w0m[k]); }
                            y[k] = siluf(sv);
                        }
                        if (!(m == 0 && fr < 3)) { u32x2 w; w.x = cvt_pk_bf16(y[0], y[1]); w.y = cvt_pk_bf16(y[2], y[3]);
                            *(u32x2*)(C + (size_t)(rowbase + 16 * m + fr) * 8192 + colc) = w; }
                        if (m == 0 && fr < 3) { const f32x4 u0 = acc[ai][bj][0][n];
                            u32x2 w; w.x = cvt_pk_bf16(u0[0], u0[1]); w.y = cvt_pk_bf16(u0[2], u0[3]);
                            *(u32x2*)(HEAD3 + (size_t)(sg * 3 + fr) * 8192 + colc) = w; }
                        if (m == 3 && fr >= 13) { const f32x4 u0 = acc[ai][bj][3][n];
                            u32x2 w; w.x = cvt_pk_bf16(u0[0], u0[1]); w.y = cvt_pk_bf16(u0[2], u0[3]);
                            *(u32x2*)(TAIL3 + (size_t)(sg * 3 + fr - 13) * 8192 + colc) = w; }
                    }
                }
            }
    }
};
struct EpiRes {
    static constexpr bool PERM = false;
    const float* base; float* out; int ldc; const float* scale;
    __device__ __forceinline__ void operator()(const f32x4 (&acc)[2][2][4][2], const Unit& u, int wr, int wc, int fr, int fq) const {
        const int row0 = u.pm * BM + wr * 64 + fr, col0 = u.pn * BM + wc * 32 + 4 * fq;
        f32x4 sv[2][2];
#pragma unroll
        for (int bj = 0; bj < 2; ++bj)
#pragma unroll
            for (int n = 0; n < 2; ++n) sv[bj][n] = scale ? *(const f32x4*)(scale + col0 + bj * HALF + n * 16) : (f32x4){1.f, 1.f, 1.f, 1.f};
#pragma unroll
        for (int ai = 0; ai < 2; ++ai) {
            f32x4 bs[4][2][2];
#pragma unroll
            for (int m = 0; m < 4; ++m) { const size_t off = (size_t)(row0 + ai * HALF + m * 16) * ldc + col0;
#pragma unroll
                for (int bj = 0; bj < 2; ++bj)
#pragma unroll
                    for (int n = 0; n < 2; ++n) bs[m][bj][n] = *(const f32x4*)(base + off + bj * HALF + n * 16); }
#pragma unroll
            for (int m = 0; m < 4; ++m) { const size_t off = (size_t)(row0 + ai * HALF + m * 16) * ldc + col0;
#pragma unroll
                for (int bj = 0; bj < 2; ++bj)
#pragma unroll
                    for (int n = 0; n < 2; ++n) *(f32x4*)(out + off + bj * HALF + n * 16) = bs[m][bj][n] + acc[ai][bj][m][n] * sv[bj][n]; }
        }
    }
};


struct EpiFfn {
    static constexpr bool PERM = true;
    bf16_t* ACT; const float* cw; bf16_t* TAILU; bf16_t* HEADU; bf16_t* HEADG;
    __device__ __forceinline__ void operator()(const f32x4 (&acc)[2][2][4][2], const Unit& u, int wr, int wc, int fr, int fq) const {
        const int colu = u.pn * 128 + wc * 32 + 8 * fq;
        float w0[8], w1[8], w2[8];
#pragma unroll
        for (int h = 0; h < 2; ++h) { const f32x4 a0 = *(const f32x4*)(cw + colu + 4 * h), a1 = *(const f32x4*)(cw + FF + colu + 4 * h), a2 = *(const f32x4*)(cw + 2 * FF + colu + 4 * h);
#pragma unroll
            for (int k = 0; k < 4; ++k) { w0[4 * h + k] = a0[k]; w1[4 * h + k] = a1[k]; w2[4 * h + k] = a2[k]; } }
        float w1m[8], w0m[8];
#pragma unroll
        for (int k = 0; k < 8; ++k) { w1m[k] = (fr < 1) ? w1[k] : 0.f; w0m[k] = (fr < 2) ? w0[k] : 0.f; }
#pragma unroll
        for (int ai = 0; ai < 2; ++ai) {
            const int sg = u.pm * 4 + ai * 2 + wr, rowbase = u.pm * BM + ai * HALF + wr * 64;
#pragma unroll
            for (int m = 0; m < 4; ++m) {
                float y[8];
#pragma unroll
                for (int n = 0; n < 2; ++n)
#pragma unroll
                    for (int k = 0; k < 4; ++k) {
                        const int ci = 4 * n + k;
                        const float cur = acc[ai][0][m][n][k];
                        float sv = w2[ci] * cur;
                        fmac_shr1(sv, cur, w1[ci]);
                        fmac_shr2(sv, cur, w0[ci]);
                        if (m > 0) { const float pv = acc[ai][0][m > 0 ? m - 1 : 0][n][k];
                            fmac_ror1(sv, pv, w1m[ci]);
                            fmac_ror2(sv, pv, w0m[ci]); }
                        y[ci] = siluf(sv) * acc[ai][1][m][n][k];
                    }
                if (!(m == 0 && fr < 2)) { u32x4 w; w.x = cvt_pk_bf16(y[0], y[1]); w.y = cvt_pk_bf16(y[2], y[3]); w.z = cvt_pk_bf16(y[4], y[5]); w.w = cvt_pk_bf16(y[6], y[7]);
                    *(u32x4*)(ACT + (size_t)(rowbase + 16 * m + fr) * FF + colu) = w; }
                if (m == 0 && fr < 2) {
                    const f32x4 u0 = acc[ai][0][0][0], u1 = acc[ai][0][0][1], g0 = acc[ai][1][0][0], g1 = acc[ai][1][0][1];
                    u32x4 w; w.x = cvt_pk_bf16(u0[0], u0[1]); w.y = cvt_pk_bf16(u0[2], u0[3]); w.z = cvt_pk_bf16(u1[0], u1[1]); w.w = cvt_pk_bf16(u1[2], u1[3]);
                    *(u32x4*)(HEADU + (size_t)(sg * 2 + fr) * FF + colu) = w;
                    w.x = cvt_pk_bf16(g0[0], g0[1]); w.y = cvt_pk_bf16(g0[2], g0[3]); w.z = cvt_pk_bf16(g1[0], g1[1]); w.w = cvt_pk_bf16(g1[2], g1[3]);
                    *(u32x4*)(HEADG + (size_t)(sg * 2 + fr) * FF + colu) = w;
                }
                if (m == 3 && fr >= 14) {
                    const f32x4 u0 = acc[ai][0][3][0], u1 = acc[ai][0][3][1];
                    u32x4 w; w.x = cvt_pk_bf16(u0[0], u0[1]); w.y = cvt_pk_bf16(u0[2], u0[3]); w.z = cvt_pk_bf16(u1[0], u1[1]); w.w = cvt_pk_bf16(u1[2], u1[3]);
                    *(u32x4*)(TAILU + (size_t)(sg * 2 + fr - 14) * FF + colu) = w;
                }
            }
        }
    }
};
template <class Epi, class Sched>
__device__ __forceinline__ void gemm_phase(LAS unsigned char* lds, const int tid, const Gemm g, const Sched& S, const Epi& E) {
    const int wid = __builtin_amdgcn_readfirstlane(tid >> 6), lane = tid & 63, wr = wid >> 2, wc = wid & 3, fr = lane & 15, fq = lane >> 4;
    const int K = g.K, nt = K / BK;
    unsigned voffA[2], voffB[2];
#pragma unroll
    for (int i = 0; i < 2; ++i) { int R, C; stage_rc(tid * 16 + i * 8192, R, C); const int Rb = Epi::PERM ? ((R & ~31) + perm32(R & 31)) : R;
        voffA[i] = (unsigned)(R * g.lda + C) * 2u; voffB[i] = (unsigned)(Rb * g.ldb + C) * 2u; }
    const size_t kstep = (size_t)(BK * 2);
    const size_t hstepA = (size_t)HALF * g.lda * 2, hstepB = (size_t)HALF * g.ldb * 2;
    const size_t tstepA = 2 * hstepA, tstepB = 2 * hstepB;
    const unsigned ldsw = (unsigned)wid * 1024u;
    const int aoff = lds_byte(wr * 64 + fr, fq * 8), boff = lds_byte(wc * 32 + fr, fq * 8);
#define PG8_SA(b, h) (((b) * 2 + (h)) * HTB)
#define PG8_SB(b, h) ((4 + (b) * 2 + (h)) * HTB)
#define PG8_STAGE(bufoff, gbase, voff) do { _Pragma("unroll") for (int _i = 0; _i < 2; ++_i) \
        __builtin_amdgcn_global_load_lds((const unsigned*)((const char*)(gbase) + (voff)[_i]), (LAS unsigned*)(lds + (bufoff) + ldsw + _i * 8192), 16, 0, 0); } while (0)
#define PG8_LDA(dst, b, h) do { _Pragma("unroll") for (int m = 0; m < 4; ++m) _Pragma("unroll") for (int k = 0; k < 2; ++k) dst[m][k] = *(const LAS bf16x8*)(lds + PG8_SA(b, h) + aoff + m * 2048 + k * 1024); } while (0)
#define PG8_LDB(dst, b, h) do { _Pragma("unroll") for (int n = 0; n < 2; ++n) _Pragma("unroll") for (int k = 0; k < 2; ++k) dst[n][k] = *(const LAS bf16x8*)(lds + PG8_SB(b, h) + boff + n * 2048 + k * 1024); } while (0)
#define PG8_MMA(ai, bj, At, Bt) do { __builtin_amdgcn_s_setprio(1); _Pragma("unroll") for (int m = 0; m < 4; ++m) _Pragma("unroll") for (int n = 0; n < 2; ++n) _Pragma("unroll") for (int k = 0; k < 2; ++k) \
        acc[ai][bj][m][n] = __builtin_amdgcn_mfma_f32_16x16x32_bf16(Bt[n][k], At[m][k], acc[ai][bj][m][n], 0, 0, 0); __builtin_amdgcn_s_setprio(0); } while (0)
#define PG8_WAIT_V(n) asm volatile("s_waitcnt vmcnt(" #n ")" ::: "memory")
#define PG8_WAIT_L(n) asm volatile("s_waitcnt lgkmcnt(" #n ")" ::: "memory")
#define PG8_BAR __builtin_amdgcn_s_barrier()
#define PG8_SCHED __builtin_amdgcn_sched_barrier(0)
#define PG8_AOFF(u) ((size_t)(u).pm * tstepA + (g.grp ? (size_t)((u).pn / g.grp) * (size_t)K * 2 : (size_t)0))
    Unit cur, nxt; int ui = 0;
    if (!S.next(0, cur)) return;
    f32x4 acc[2][2][4][2];
#pragma unroll
    for (int a = 0; a < 2; ++a)
#pragma unroll
        for (int b = 0; b < 2; ++b)
#pragma unroll
            for (int m = 0; m < 4; ++m)
#pragma unroll
                for (int n = 0; n < 2; ++n) acc[a][b][m][n] = (f32x4){0.f, 0.f, 0.f, 0.f};
    bf16x8 At[4][2], B0[2][2], B1[2][2];
    const char* cA = (const char*)g.A + PG8_AOFF(cur); const char* cB = (const char*)g.Bt + (size_t)cur.pn * tstepB;
    PG8_STAGE(PG8_SB(0, 0), cB, voffB); PG8_STAGE(PG8_SB(0, 1), cB + hstepB, voffB); PG8_STAGE(PG8_SA(0, 0), cA, voffA); PG8_STAGE(PG8_SA(0, 1), cA + hstepA, voffA);
    if (wr == 1) PG8_BAR;
    PG8_WAIT_V(2); PG8_BAR;
    PG8_STAGE(PG8_SB(1, 0), cB + kstep, voffB); PG8_STAGE(PG8_SA(1, 0), cA + kstep, voffA); PG8_STAGE(PG8_SB(1, 1), cB + hstepB + kstep, voffB);
    PG8_WAIT_V(6); PG8_BAR;
    for (;;) {
        const bool has_next = S.next(ui + 1, nxt);
        const char* nA = has_next ? (const char*)g.A + PG8_AOFF(nxt) : cA; const char* nB = has_next ? (const char*)g.Bt + (size_t)nxt.pn * tstepB : cB;
        for (int t = 0; t < nt; t += 2) {
            const bool last = (t == nt - 2);
            const char* a1 = cA + (size_t)(t + 1) * kstep;
            const char* a2 = last ? nA : cA + (size_t)(t + 2) * kstep; const char* b2 = last ? nB : cB + (size_t)(t + 2) * kstep;
            const char* a3 = a2 + kstep; const char* b3 = b2 + kstep;
            PG8_LDB(B0, 0, 0); PG8_LDB(B1, 0, 1); PG8_SCHED; PG8_LDA(At, 0, 0); PG8_STAGE(PG8_SA(1, 1), a1 + hstepA, voffA);
            PG8_WAIT_V(8); PG8_WAIT_L(0); PG8_BAR; PG8_MMA(0, 0, At, B0); PG8_MMA(0, 1, At, B1); PG8_BAR; PG8_SCHED;
            PG8_LDA(At, 0, 1); PG8_STAGE(PG8_SB(0, 0), b2, voffB); PG8_STAGE(PG8_SB(0, 1), b2 + hstepB, voffB); PG8_STAGE(PG8_SA(0, 0), a2, voffA);
            PG8_WAIT_V(8); PG8_WAIT_L(0); PG8_BAR; PG8_MMA(1, 0, At, B0); PG8_MMA(1, 1, At, B1); PG8_BAR; PG8_SCHED;
            PG8_LDB(B0, 1, 0); PG8_LDB(B1, 1, 1); PG8_SCHED; PG8_LDA(At, 1, 0); PG8_STAGE(PG8_SA(0, 1), a2 + hstepA, voffA);
            PG8_WAIT_V(8); PG8_WAIT_L(0); PG8_BAR; PG8_MMA(0, 0, At, B0); PG8_MMA(0, 1, At, B1); PG8_BAR; PG8_SCHED;
            PG8_LDA(At, 1, 1); PG8_STAGE(PG8_SB(1, 0), b3, voffB); PG8_STAGE(PG8_SB(1, 1), b3 + hstepB, voffB); PG8_STAGE(PG8_SA(1, 0), a3, voffA);
            PG8_WAIT_V(8); PG8_WAIT_L(0); PG8_BAR; PG8_MMA(1, 0, At, B0); PG8_MMA(1, 1, At, B1); PG8_BAR; PG8_SCHED;
        }
        if (wr == 0) PG8_BAR;
        asm volatile("s_nop 15\n\ts_nop 15\n\ts_nop 15" ::: "memory");
        E(acc, cur, wr, wc, fr, fq);
        if (!has_next) break;
#pragma unroll
        for (int a = 0; a < 2; ++a)
#pragma unroll
            for (int b = 0; b < 2; ++b)
#pragma unroll
                for (int m = 0; m < 4; ++m)
#pragma unroll
                    for (int n = 0; n < 2; ++n) acc[a][b][m][n] = (f32x4){0.f, 0.f, 0.f, 0.f};
        cur = nxt; cA = nA; cB = nB; ++ui;
        if (wr == 1) PG8_BAR;
    }
    PG8_WAIT_V(0);
    PG8_BAR;
#undef PG8_SA
#undef PG8_SB
#undef PG8_STAGE
#undef PG8_LDA
#undef PG8_LDB
#undef PG8_MMA
#undef PG8_WAIT_V
#undef PG8_WAIT_L
#undef PG8_BAR
#undef PG8_SCHED
#undef PG8_AOFF
}
}

#define XB_TMO      128
#define XB_XCNT(j)  (256  + 64 * (j))
#define XB_XSUB(j)  (1280 + 64 * (j))
#define XB_XGEN(j)  (2304 + 64 * (j))
#define XB_TOP      3328
#define XB_TOPGEN   3392
#define XCD_BAR_WORDS 3456
#define XB_SPIN_CAP (1u << 18)
__device__ __forceinline__ unsigned xb_ld(unsigned* p)              { return __hip_atomic_load(p, __ATOMIC_RELAXED, __HIP_MEMORY_SCOPE_AGENT); }
__device__ __forceinline__ unsigned xb_add(unsigned* p, unsigned v) { return __hip_atomic_fetch_add(p, v, __ATOMIC_RELAXED, __HIP_MEMORY_SCOPE_AGENT); }
__device__ __forceinline__ unsigned xb_xcc_id() { return (unsigned)__builtin_amdgcn_s_getreg((3 << 11) | 20) & 0xFu; }
#define XB_SPIN(cond, bar) do { unsigned _sp = 0; while (cond) { __builtin_amdgcn_s_sleep(1); \
    if ((++_sp & 255u) == 0u) { if (xb_ld(&(bar)[XB_TMO])) break; if (_sp > XB_SPIN_CAP) { atomicAdd(&(bar)[XB_TMO], 1u); break; } } } } while (0)
__device__ __forceinline__ int lane_id() { int l; asm volatile("v_mbcnt_lo_u32_b32 %0, -1, 0\n\tv_mbcnt_hi_u32_b32 %0, -1, %0" : "=v"(l)); return l; }
struct XcdBarrier { unsigned* bar; unsigned x; volatile LAS unsigned* st; int wv; };
__device__ __forceinline__ XcdBarrier xcd_barrier_post(unsigned* bar, volatile LAS unsigned* st, int wv) {
    XcdBarrier b; b.bar = bar; b.x = xb_xcc_id(); b.st = st; b.wv = wv;
    if (b.wv == 0 && lane_id() == 0) (void)xb_add(&bar[XB_XCNT(b.x)], 1u);
    return b;
}
__device__ __forceinline__ void xcd_barrier_complete(unsigned* bar, unsigned x, unsigned& nloc, unsigned& nx) {
    const unsigned G = gridDim.x * gridDim.y * gridDim.z;
    unsigned sum, cnt, mine, sp = 0u;
    for (;;) {
        sum = 0u; cnt = 0u; mine = 0u;
#pragma unroll
        for (unsigned j = 0; j < 16; ++j) { const unsigned c = xb_ld(&bar[XB_XCNT(j)]); sum += c; cnt += (c > 0u) ? 1u : 0u; mine = (j == x) ? c : mine; }
        if (sum == G) break;
        __builtin_amdgcn_s_sleep(1);
        if ((++sp & 255u) == 0u) { if (xb_ld(&bar[XB_TMO])) break; if (sp > XB_SPIN_CAP) { atomicAdd(&bar[XB_TMO], 1u); break; } }
    }
    nloc = mine > 0u ? mine : 1u; nx = cnt > 0u ? cnt : 1u;
}
__device__ __forceinline__ void xcd_barrier(const XcdBarrier& b) {
    asm volatile("s_waitcnt vmcnt(0)" ::: "memory");
    __syncthreads();
    if (b.wv == 0 && lane_id() == 0) {
        unsigned* bar = b.bar;
        __builtin_amdgcn_s_waitcnt(0);
        unsigned nloc = b.st[0], nx = b.st[1];
        if (nloc == 0u) { xcd_barrier_complete(bar, b.x, nloc, nx); b.st[0] = nloc; b.st[1] = nx; }
        const unsigned old = xb_add(&bar[XB_XSUB(b.x)], 1u);
        const unsigned gen = old / nloc;
        if (old + 1u == (gen + 1u) * nloc) {
            __builtin_amdgcn_fence(__ATOMIC_RELEASE, "agent");
            asm volatile("s_waitcnt vmcnt(0)" ::: "memory");
            const unsigned og = xb_add(&bar[XB_TOP], 1u);
            const unsigned tg = og / nx;
            if (og + 1u == (tg + 1u) * nx) xb_add(&bar[XB_TOPGEN], 1u);
            else XB_SPIN(xb_ld(&bar[XB_TOPGEN]) == tg, bar);
            __builtin_amdgcn_fence(__ATOMIC_ACQUIRE, "agent");
            xb_add(&bar[XB_XGEN(b.x)], 1u);
            asm volatile("s_waitcnt vmcnt(0)" ::: "memory");
        } else {
            XB_SPIN(xb_ld(&bar[XB_XGEN(b.x)]) == gen, bar);
            __builtin_amdgcn_fence(__ATOMIC_ACQUIRE, "agent");
            asm volatile("s_waitcnt vmcnt(0)" ::: "memory");
        }
    }
    __syncthreads();
}

constexpr int LDS_BYTES = 163840;
constexpr int MISC_OFF = LDS_BYTES - 256;

struct WDesc { const float* W; bf16_t* WT; int K, N, nmat, pad; };
struct Args {
    const float* x; const float* mix_norm; const float* ffn_norm;
    const float* att_q_gain; const float* att_k_gain; const float* att_rel_bias;
    const float* pool_scale; const float* gdn_conv; const float* gdn_a_log; const float* gdn_dt_bias; const float* gdn_o_gain; const float* ffn_conv;
    float* out; unsigned char* ws;
    WDesc wd[7];
    int ph_lo, ph_hi;
};

struct Ctx { LAS unsigned char* lds; int tid, lane, wave, G, bid; };

__device__ __forceinline__ void transpose_item(const float* W, int K, int N, bf16_t* WT, LAS float* scr, int item, int lane, int mode) {
    const int nblk = N / 64, kb = item / nblk, nb = item % nblk, k0 = 64 * kb, n0 = 64 * nb;
    const int r0 = (mode == 0) ? n0 : ((n0 < FF) ? 256 * (n0 >> 7) + (n0 & 127) : 256 * ((n0 - FF) >> 7) + 128 + ((n0 - FF) & 127));
    f32x4 v[16];
#pragma unroll
    for (int i = 0; i < 16; ++i) v[i] = *(const f32x4*)(W + (size_t)(k0 + 4 * i + (lane >> 4)) * N + n0 + 4 * (lane & 15));
#pragma unroll
    for (int i = 0; i < 16; ++i) *(LAS f32x4*)(scr + (4 * i + (lane >> 4)) * 68 + 4 * (lane & 15)) = v[i];
    LDS_WAIT();
    const int c = lane & 7;
#pragma unroll
    for (int j = 0; j < 8; ++j) { const int n = (lane >> 3) + 8 * j; const LAS float* sp = scr + (8 * c) * 68 + n;
        u32x4 o; o.x = cvt_pk_bf16(sp[0 * 68], sp[1 * 68]); o.y = cvt_pk_bf16(sp[2 * 68], sp[3 * 68]); o.z = cvt_pk_bf16(sp[4 * 68], sp[5 * 68]); o.w = cvt_pk_bf16(sp[6 * 68], sp[7 * 68]);
        *(u32x4*)(WT + (size_t)(r0 + n) * K + k0 + 8 * c) = o; }
    LDS_WAIT();
}
typedef const __attribute__((address_space(4))) struct Args* KArgsP0;
__device__ __forceinline__ void phase_weights(const Ctx& c, KArgsP0 a) {
    LAS float* scr = (LAS float*)(c.lds + c.wave * 17408);
    const int gw = c.bid * NWAVES + c.wave, NGW = c.G * NWAVES;
#pragma unroll
    for (int d = 0; d < 7; ++d) {
        const float* W = a->wd[d].W; bf16_t* WT = a->wd[d].WT; const int K = a->wd[d].K, N = a->wd[d].N, nmat = a->wd[d].nmat, mode = a->wd[d].pad;
        const int per = (K / 64) * (N / 64), tot = per * nmat;
        for (int it = gw; it < tot; it += NGW) { const int mat = it / per, r = it - mat * per;
            transpose_item(W + (size_t)mat * K * N, K, N, WT + (size_t)mat * K * N, scr, r, c.lane, mode); }
    }
    { u32x4* z = (u32x4*)(a->ws + WS_WGIN + (size_t)GIN * D * 2); const int n16 = (GINP - GIN) * D * 2 / 16;
      for (int i = c.bid * NTHREADS + c.tid; i < n16; i += c.G * NTHREADS) z[i] = (u32x4){0u, 0u, 0u, 0u}; }
}

__device__ __forceinline__ void phase_rmsnorm(const Ctx& c, const float* x, const float* gain, bf16_t* out) {
    const int gw = c.bid * NWAVES + c.wave, NGW = c.G * NWAVES;
    f32x4 gv[8];
#pragma unroll
    for (int j = 0; j < 8; ++j) gv[j] = *(const f32x4*)(gain + 4 * c.lane + 256 * j);
    f32x4 v[8], vn[8];
    if (gw < T) {
#pragma unroll
        for (int j = 0; j < 8; ++j) v[j] = ((const f32x4*)(x + (size_t)gw * D) + c.lane)[64 * j];
    }
    for (int m = gw; m < T; m += NGW) {
        const int mn = (m + NGW < T) ? m + NGW : m;
        const f32x4* xn = (const f32x4*)(x + (size_t)mn * D) + c.lane;
#pragma unroll
        for (int j = 0; j < 8; ++j) vn[j] = xn[64 * j];
        float s = 0.f;
#pragma unroll
        for (int j = 0; j < 8; ++j) s += (v[j].x * v[j].x + v[j].y * v[j].y) + (v[j].z * v[j].z + v[j].w * v[j].w);
        const float rstd = 1.0f / sqrtf(wave_sum(s) * (1.0f / D) + EPS);
        u32x2* o8 = (u32x2*)(out + (size_t)m * D) + c.lane;
#pragma unroll
        for (int j = 0; j < 8; ++j) { u32x2 w; w.x = cvt_pk_bf16(v[j].x * rstd * gv[j].x, v[j].y * rstd * gv[j].y); w.y = cvt_pk_bf16(v[j].z * rstd * gv[j].z, v[j].w * rstd * gv[j].w); o8[64 * j] = w; }
#pragma unroll
        for (int j = 0; j < 8; ++j) v[j] = vn[j];
    }
}
__device__ __forceinline__ void phase_ffn_fix(const Ctx& c, bf16_t* ACT, const float* cw, const bf16_t* TAILU, const bf16_t* HEADU, const bf16_t* HEADG) {
    constexpr int NCG = FF / 8, NS = T / 64;
    for (int it = c.bid * NTHREADS + c.tid; it < NS * NCG; it += c.G * NTHREADS) {
        const int sg = it / NCG, cg = it - sg * NCG, col = cg * 8; const bool first = ((sg * 64) % SEQ) == 0;
        float w0[8], w1[8], w2[8], um2[8], um1[8], u0[8], u1[8], g0[8], g1[8];
#pragma unroll
        for (int h = 0; h < 2; ++h) { const f32x4 a0 = *(const f32x4*)(cw + col + 4 * h), a1 = *(const f32x4*)(cw + FF + col + 4 * h), a2 = *(const f32x4*)(cw + 2 * FF + col + 4 * h);
#pragma unroll
            for (int k = 0; k < 4; ++k) { w0[4 * h + k] = a0[k]; w1[4 * h + k] = a1[k]; w2[4 * h + k] = a2[k]; } }
        const u32x4 hu0 = *(const u32x4*)(HEADU + (size_t)(sg * 2) * FF + col), hu1 = *(const u32x4*)(HEADU + (size_t)(sg * 2 + 1) * FF + col);
        const u32x4 hg0 = *(const u32x4*)(HEADG + (size_t)(sg * 2) * FF + col), hg1 = *(const u32x4*)(HEADG + (size_t)(sg * 2 + 1) * FF + col);
        u32x4 t0 = (u32x4){0u, 0u, 0u, 0u}, t1 = t0;
        if (!first) { t0 = *(const u32x4*)(TAILU + (size_t)(sg * 2 - 2) * FF + col); t1 = *(const u32x4*)(TAILU + (size_t)(sg * 2 - 1) * FF + col); }
#pragma unroll
        for (int k = 0; k < 4; ++k) { um2[2 * k] = bflo(t0[k]); um2[2 * k + 1] = bfhi(t0[k]); um1[2 * k] = bflo(t1[k]); um1[2 * k + 1] = bfhi(t1[k]);
            u0[2 * k] = bflo(hu0[k]); u0[2 * k + 1] = bfhi(hu0[k]); u1[2 * k] = bflo(hu1[k]); u1[2 * k + 1] = bfhi(hu1[k]);
            g0[2 * k] = bflo(hg0[k]); g0[2 * k + 1] = bfhi(hg0[k]); g1[2 * k] = bflo(hg1[k]); g1[2 * k + 1] = bfhi(hg1[k]); }
        float y0[8], y1[8];
#pragma unroll
        for (int k = 0; k < 8; ++k) { y0[k] = siluf(w0[k] * um2[k] + w1[k] * um1[k] + w2[k] * u0[k]) * g0[k]; y1[k] = siluf(w0[k] * um1[k] + w1[k] * u0[k] + w2[k] * u1[k]) * g1[k]; }
        u32x4 o; o.x = cvt_pk_bf16(y0[0], y0[1]); o.y = cvt_pk_bf16(y0[2], y0[3]); o.z = cvt_pk_bf16(y0[4], y0[5]); o.w = cvt_pk_bf16(y0[6], y0[7]);
        *(u32x4*)(ACT + (size_t)(sg * 64) * FF + col) = o;
        o.x = cvt_pk_bf16(y1[0], y1[1]); o.y = cvt_pk_bf16(y1[2], y1[3]); o.z = cvt_pk_bf16(y1[4], y1[5]); o.w = cvt_pk_bf16(y1[6], y1[7]);
        *(u32x4*)(ACT + (size_t)(sg * 64 + 1) * FF + col) = o;
    }
}

__device__ __forceinline__ void phase_pool_prep(const Ctx& c, const bf16_t* H, bf16_t* P) {
    constexpr int NCG = D / 8, RB = 64;
    const int nitems = (T / RB) * NCG;
    for (int it = c.bid * NTHREADS + c.tid; it < nitems; it += c.G * NTHREADS) {
        const int rb = it / NCG, cg = it - rb * NCG, t0 = rb * RB, col = cg * 8, w = 2 << (col >> 9), tp0 = t0 % SEQ;
        float s[8];
#pragma unroll
        for (int k = 0; k < 8; ++k) s[k] = 0.f;
        for (int i = 1; i <= w; ++i) if (tp0 - i >= 0) {   const u32x4 a = *(const u32x4*)(H + (size_t)(t0 - i) * D + col);
#pragma unroll
            for (int k = 0; k < 4; ++k) { s[2 * k] += bflo(a[k]); s[2 * k + 1] += bfhi(a[k]); } }
        for (int tb = t0; tb < t0 + RB; tb += 8) {
            u32x4 ar[8], br[8];
#pragma unroll
            for (int q = 0; q < 8; ++q) { const int t = tb + q, tp = tp0 + (t - t0);
                ar[q] = *(const u32x4*)(H + (size_t)t * D + col);
                br[q] = (tp >= w) ? *(const u32x4*)(H + (size_t)(t - w) * D + col) : (u32x4){0u, 0u, 0u, 0u}; }
#pragma unroll
            for (int q = 0; q < 8; ++q) { const int t = tb + q, tp = tp0 + (t - t0);
                const u32x4 a = ar[q], b = br[q];
                float cu[8];
#pragma unroll
                for (int k = 0; k < 4; ++k) { cu[2 * k] = bflo(a[k]); cu[2 * k + 1] = bfhi(a[k]); }
#pragma unroll
                for (int k = 0; k < 8; ++k) s[k] += cu[k];
#pragma unroll
                for (int k = 0; k < 4; ++k) { s[2 * k] -= bflo(b[k]); s[2 * k + 1] -= bfhi(b[k]); }
                const float inv = 1.0f / (float)(tp + 1 < w ? tp + 1 : w);
                u32x4 o; o.x = cvt_pk_bf16(s[0] * inv - cu[0], s[1] * inv - cu[1]); o.y = cvt_pk_bf16(s[2] * inv - cu[2], s[3] * inv - cu[3]);
                o.z = cvt_pk_bf16(s[4] * inv - cu[4], s[5] * inv - cu[5]); o.w = cvt_pk_bf16(s[6] * inv - cu[6], s[7] * inv - cu[7]);
                *(u32x4*)(P + (size_t)t * D + col) = o;
            }
        }
    }
}

constexpr int ATT_ROWB = 272;
constexpr int ATT_WAVE_BYTES = 2 * 32 * ATT_ROWB + NREL * 4;
static_assert(ATT_WAVE_BYTES * NWAVES <= MISC_OFF, "attention LDS");
__device__ __forceinline__ void phase_attention(const Ctx& c, const bf16_t* QKV, bf16_t* O, const float* q_gain, const float* k_gain, const float* rel_bias) {
    LAS unsigned char* Kt = c.lds + c.wave * ATT_WAVE_BYTES;
    LAS unsigned char* Vt = Kt + 32 * ATT_ROWB;
    LAS float* bias = (LAS float*)(Vt + 32 * ATT_ROWB);
    const int lane = c.lane, l31 = lane & 31, hh = lane >> 5;
    const int gw = c.bid * NWAVES + c.wave, NGW = c.G * NWAVES;
    constexpr int NU = BATCH * NCH * AH * 2;
    const float scale = 0.08838834764831845f;
    float kg[8];
    { const int ch = lane & 15; const f32x4 a = *(const f32x4*)(k_gain + ch * 8), b = *(const f32x4*)(k_gain + ch * 8 + 4);
#pragma unroll
      for (int k = 0; k < 4; ++k) { kg[k] = a[k]; kg[4 + k] = b[k]; } }
    for (int u = gw; u < NU; u += NGW) {
        const int qh = u & 1, h = (u >> 1) & 15, ck = (u >> 5) & 127, b = u >> 12;
        const size_t row_q0 = (size_t)b * SEQ + (size_t)ck * CH + qh * 32;
        for (int i = lane; i < NREL; i += 64) bias[i] = rel_bias[h * NREL + i];
        bf16x8 qf[8];
        {
            float qv[8][8]; float ss = 0.f;
            const bf16_t* qp = QKV + (row_q0 + l31) * 6144 + h * AHD + hh * 8;
#pragma unroll
            for (int ks = 0; ks < 8; ++ks) { const u32x4 a = *(const u32x4*)(qp + ks * 16);
#pragma unroll
                for (int k = 0; k < 4; ++k) { qv[ks][2 * k] = bflo(a[k]); qv[ks][2 * k + 1] = bfhi(a[k]); }
#pragma unroll
                for (int k = 0; k < 8; ++k) ss += qv[ks][k] * qv[ks][k]; }
            ss += __shfl_xor(ss, 32);
            const float rq = scale / sqrtf(ss * (1.0f / AHD) + EPS);
#pragma unroll
            for (int ks = 0; ks < 8; ++ks) { const f32x4 g0 = *(const f32x4*)(q_gain + ks * 16 + hh * 8), g1 = *(const f32x4*)(q_gain + ks * 16 + hh * 8 + 4);
                u32x4 w; w.x = cvt_pk_bf16(qv[ks][0] * rq * g0[0], qv[ks][1] * rq * g0[1]); w.y = cvt_pk_bf16(qv[ks][2] * rq * g0[2], qv[ks][3] * rq * g0[3]);
                w.z = cvt_pk_bf16(qv[ks][4] * rq * g1[0], qv[ks][5] * rq * g1[1]); w.w = cvt_pk_bf16(qv[ks][6] * rq * g1[2], qv[ks][7] * rq * g1[3]);
                qf[ks] = __builtin_bit_cast(bf16x8, w); }
        }
        float mrun = -1e30f, lsum = 0.f;
        f32x16 oacc[4];
#pragma unroll
        for (int dt = 0; dt < 4; ++dt)
#pragma unroll
            for (int r = 0; r < 16; ++r) oacc[dt][r] = 0.f;
        const int qi = qh * 32 + l31;
        const int kt_first = (ck >= 8) ? 0 : 2 * (8 - ck);
        for (int kt = kt_first; kt < 18; ++kt) {
            const int kj0 = kt * 32;
            const size_t krow0 = (size_t)b * SEQ + (size_t)((ck - 8) * CH + kj0);
            {
                const int ch = lane & 15, rr = lane >> 4;
#pragma unroll
                for (int i = 0; i < 8; ++i) {
                    const int row = rr + 4 * i;
                    const bf16_t* kp = QKV + (krow0 + row) * 6144 + 2048 + h * AHD + ch * 8;
                    const u32x4 a = *(const u32x4*)kp, vv = *(const u32x4*)(kp + 2048);
                    float kv[8]; float ss = 0.f;
#pragma unroll
                    for (int k = 0; k < 4; ++k) { kv[2 * k] = bflo(a[k]); kv[2 * k + 1] = bfhi(a[k]); }
#pragma unroll
                    for (int k = 0; k < 8; ++k) ss += kv[k] * kv[k];
                    ss += __shfl_xor(ss, 1); ss += __shfl_xor(ss, 2); ss += __shfl_xor(ss, 4); ss += __shfl_xor(ss, 8);
                    const float rk = 1.0f / sqrtf(ss * (1.0f / AHD) + EPS);
                    u32x4 w; w.x = cvt_pk_bf16(kv[0] * rk * kg[0], kv[1] * rk * kg[1]); w.y = cvt_pk_bf16(kv[2] * rk * kg[2], kv[3] * rk * kg[3]);
                    w.z = cvt_pk_bf16(kv[4] * rk * kg[4], kv[5] * rk * kg[5]); w.w = cvt_pk_bf16(kv[6] * rk * kg[6], kv[7] * rk * kg[7]);
                    *(LAS u32x4*)(Kt + row * ATT_ROWB + ch * 16) = w;
                    *(LAS u32x4*)(Vt + row * ATT_ROWB + ch * 16) = vv;
                }
            }
            LDS_WAIT();
            f32x16 st;
#pragma unroll
            for (int r = 0; r < 16; ++r) st[r] = 0.f;
#pragma unroll
            for (int ks = 0; ks < 8; ++ks) { const bf16x8 kf = *(const LAS bf16x8*)(Kt + l31 * ATT_ROWB + ks * 32 + hh * 16);
                st = __builtin_amdgcn_mfma_f32_32x32x16_bf16(kf, qf[ks], st, 0, 0, 0); }
            float mt = -1e30f;
#pragma unroll
            for (int r = 0; r < 16; ++r) { const int kj = kj0 + (r & 3) + 8 * (r >> 2) + 4 * hh; int idx = 575 + qi - kj; idx = idx > 319 ? 319 : idx; st[r] += bias[idx]; mt = fmaxf(mt, st[r]); }
            mt = fmaxf(mt, __shfl_xor(mt, 32));
            const float mnew = fmaxf(mrun, mt), alpha = __expf(mrun - mnew);
            mrun = mnew;
            float ps = 0.f;
#pragma unroll
            for (int r = 0; r < 16; ++r) { st[r] = __expf(st[r] - mnew); ps += st[r]; }
            lsum = lsum * alpha + ps;
#pragma unroll
            for (int dt = 0; dt < 4; ++dt)
#pragma unroll
                for (int r = 0; r < 16; ++r) oacc[dt][r] *= alpha;
            bf16x8 pf[2];
#pragma unroll
            for (int s = 0; s < 2; ++s) { u32x4 w; w.x = cvt_pk_bf16(st[8 * s + 0], st[8 * s + 1]); w.y = cvt_pk_bf16(st[8 * s + 2], st[8 * s + 3]); w.z = cvt_pk_bf16(st[8 * s + 4], st[8 * s + 5]); w.w = cvt_pk_bf16(st[8 * s + 6], st[8 * s + 7]);
                pf[s] = __builtin_bit_cast(bf16x8, w); }
            {
                const int i16 = lane & 15, g1 = (lane >> 4) & 1;
                LAS unsigned char* vb = Vt + (4 * hh + (i16 >> 2)) * ATT_ROWB + (16 * g1 + 4 * (i16 & 3)) * 2;
#pragma unroll
                for (int dt = 0; dt < 4; ++dt)
#pragma unroll
                    for (int s = 0; s < 2; ++s) {
                        const s16x4 lo = __builtin_bit_cast(s16x4, __builtin_amdgcn_ds_read_tr16_b64_v4i16((LAS s16x4*)(vb + (16 * s) * ATT_ROWB + dt * 64)));
                        const s16x4 hi = __builtin_bit_cast(s16x4, __builtin_amdgcn_ds_read_tr16_b64_v4i16((LAS s16x4*)(vb + (16 * s + 8) * ATT_ROWB + dt * 64)));
                        const bf16x8 vf = (bf16x8){lo[0], lo[1], lo[2], lo[3], hi[0], hi[1], hi[2], hi[3]};
                        oacc[dt] = __builtin_amdgcn_mfma_f32_32x32x16_bf16(vf, pf[s], oacc[dt], 0, 0, 0);
                    }
            }
            LDS_WAIT();
        }
        lsum += __shfl_xor(lsum, 32);
        const float inv = 1.0f / lsum;
        bf16_t* op = O + (row_q0 + l31) * D + h * AHD + 4 * hh;
#pragma unroll
        for (int dt = 0; dt < 4; ++dt)
#pragma unroll
            for (int g = 0; g < 4; ++g) { u32x2 w; w.x = cvt_pk_bf16(oacc[dt][4 * g] * inv, oacc[dt][4 * g + 1] * inv); w.y = cvt_pk_bf16(oacc[dt][4 * g + 2] * inv, oacc[dt][4 * g + 3] * inv);
                *(u32x2*)(op + dt * 32 + g * 8) = w; }
        LDS_WAIT();
    }
}

constexpr int AT_SLOT = 32768, AT_BIAS = 4 * AT_SLOT, AT_NB = 640, AT_RK = AT_BIAS + AT_NB * 4, AT_END = AT_RK + 768 * 4;
static_assert(AT_END <= MISC_OFF, "attention LDS");
__device__ __forceinline__ void glds16(const void* gsrc, unsigned lds_dst) { unsigned keep;
    asm volatile("s_mov_b32 %0, m0\n\ts_mov_b32 m0, %2\n\ts_nop 0\n\tglobal_load_lds_dwordx4 %1, off\n\ts_mov_b32 m0, %0" : "=&s"(keep) : "v"(gsrc), "s"(lds_dst) : "memory"); }
__device__ __forceinline__ void phase_attention3(const Ctx& c, const bf16_t* QKV, bf16_t* O, const float* PART, const float* q_gain, const float* k_gain, const float* rel_bias) {
    LAS unsigned char* lds = c.lds;
    const unsigned lds0 = (unsigned)(size_t)lds;
    LAS float* bias = (LAS float*)(lds + AT_BIAS);
    LAS float* rkt = (LAS float*)(lds + AT_RK);
    const int lane = c.lane, w = c.wave, l31 = lane & 31, hh = lane >> 5, i16 = lane & 15, g1 = (lane >> 4) & 1;
    const int wo = w >> 1, qi = 32 * (w & 1) + l31;
    const int fr = ((l31 & 3) << 2) | ((l31 >> 2) & 3);
    constexpr float LOG2E = 1.4426950408889634f;
    constexpr int NU = BATCH * 32 * AH;
    for (int u = c.bid; u < NU; u += c.G) {
        const int h = u & 15, cq = (u >> 4) & 31, b = u >> 9;
        const int jf = (cq >= 2) ? 0 : 8 - 4 * cq;
        const bf16_t* ksrc[2];
#pragma unroll
        for (int pp = 0; pp < 2; ++pp) { const int row = 8 * w + 4 * pp + (lane >> 4), chl = (lane & 15) ^ (((row & 3) << 2) | ((row >> 2) & 3));
            ksrc[pp] = QKV + ((size_t)b * SEQ + (size_t)((4 * cq - 8) * CH + row)) * 6144 + 2048 + h * AHD + chl * 8; }
#define AT_DMA(j) do { const unsigned sl_ = lds0 + (unsigned)(((j) & 3) * AT_SLOT) + (unsigned)(2 * w) * 1024u; const size_t to_ = (size_t)(j) * CH * 6144; \
            glds16(ksrc[0] + to_, sl_); glds16(ksrc[1] + to_, sl_ + 1024u); glds16(ksrc[0] + to_ + 2048, sl_ + 16384u); glds16(ksrc[1] + to_ + 2048, sl_ + 16384u + 1024u); } while (0)
        AT_DMA(jf); AT_DMA(jf + 1); AT_DMA(jf + 2);
        for (int i = c.tid; i < AT_NB; i += NTHREADS) bias[i] = rel_bias[h * NREL + (i < NREL - 1 ? i : NREL - 1)] * LOG2E;
        for (int i = c.tid; i < 768; i += NTHREADS) { const int kr = (4 * cq - 8) * CH + i;
            if (kr >= 0) { const f32x4 p = *(const f32x4*)(PART + (((size_t)(8 + (h >> 1)) * T + ((size_t)b * SEQ + kr)) * 2 + (h & 1)) * 4); rkt[i] = 1.0f / sqrtf(((p[0] + p[1]) + (p[2] + p[3])) * (1.0f / AHD) + EPS); } }
        bf16x8 qf[8];
        { const size_t qrow = (size_t)b * SEQ + 256 * cq + 32 * w + l31;
          const f32x4 pq = *(const f32x4*)(PART + (((size_t)(h >> 1) * T + qrow) * 2 + (h & 1)) * 4);
          const float rq = 0.08838834764831845f * LOG2E / sqrtf(((pq[0] + pq[1]) + (pq[2] + pq[3])) * (1.0f / AHD) + EPS);
          const bf16_t* qp = QKV + qrow * 6144 + h * AHD + hh * 8;
#pragma unroll
          for (int ks = 0; ks < 8; ++ks) { const u32x4 a = *(const u32x4*)(qp + ks * 16);
              const f32x4 gq0 = *(const f32x4*)(q_gain + ks * 16 + hh * 8), gq1 = *(const f32x4*)(q_gain + ks * 16 + hh * 8 + 4), gk0 = *(const f32x4*)(k_gain + ks * 16 + hh * 8), gk1 = *(const f32x4*)(k_gain + ks * 16 + hh * 8 + 4);
              u32x4 wv; wv.x = cvt_pk_bf16_op(bflo(a.x) * rq * gq0[0] * gk0[0], bfhi(a.x) * rq * gq0[1] * gk0[1]); wv.y = cvt_pk_bf16_op(bflo(a.y) * rq * gq0[2] * gk0[2], bfhi(a.y) * rq * gq0[3] * gk0[3]);
              wv.z = cvt_pk_bf16_op(bflo(a.z) * rq * gq1[0] * gk1[0], bfhi(a.z) * rq * gq1[1] * gk1[1]); wv.w = cvt_pk_bf16_op(bflo(a.w) * rq * gq1[2] * gk1[2], bfhi(a.w) * rq * gq1[3] * gk1[3]);
              qf[ks] = __builtin_bit_cast(bf16x8, wv); } }
        __builtin_amdgcn_s_waitcnt(0);
#pragma unroll
        for (int ks = 0; ks < 8; ++ks) asm volatile("" : "+v"(qf[ks]));
        __syncthreads();
        float mrun = -1e30f, lsum = 0.f;
        f32x16 oacc[4];
#pragma unroll
        for (int dt = 0; dt < 4; ++dt)
#pragma unroll
            for (int r = 0; r < 16; ++r) oacc[dt][r] = 0.f;
        for (int j = jf; j < 12; ++j) {
            if (j <= 9) asm volatile("s_waitcnt vmcnt(8)\n\ts_barrier" ::: "memory");
            else if (j == 10) asm volatile("s_waitcnt vmcnt(4)\n\ts_barrier" ::: "memory");
            else asm volatile("s_waitcnt vmcnt(0)\n\ts_barrier" ::: "memory");
            if (j + 3 < 12) AT_DMA(j + 3);
            if (j >= wo && j <= wo + 8) {
                const LAS unsigned char* Kt = lds + (j & 3) * AT_SLOT; const LAS unsigned char* Vt = Kt + 16384;
                const int bp = j - wo;
                f32x16 st[2];
#pragma unroll
                for (int k2 = 0; k2 < 2; ++k2)
#pragma unroll
                    for (int r = 0; r < 16; ++r) st[k2][r] = 0.f;
                {
                    bf16x8 kfa[8], kfb[8];
#pragma unroll
                    for (int ks = 0; ks < 8; ++ks) { kfa[ks] = *(const LAS bf16x8*)(Kt + 256 * l31 + 16 * ((2 * ks + hh) ^ fr)); kfb[ks] = *(const LAS bf16x8*)(Kt + 256 * (32 + l31) + 16 * ((2 * ks + hh) ^ fr)); }
                    __builtin_amdgcn_sched_barrier(0);
#pragma unroll
                    for (int ks = 0; ks < 8; ++ks) { st[0] = __builtin_amdgcn_mfma_f32_32x32x16_bf16(kfa[ks], qf[ks], st[0], 0, 0, 0); st[1] = __builtin_amdgcn_mfma_f32_32x32x16_bf16(kfb[ks], qf[ks], st[1], 0, 0, 0); }
                }
                float mt = -1e30f;
                {
                    const LAS float* rkp = rkt + 64 * j + 4 * hh;
                    const LAS float* bp_ = bias + (575 + qi - 64 * bp - 4 * hh - 59);
#pragma unroll
                    for (int k2 = 0; k2 < 2; ++k2) {
                        f32x4 rkv[4]; float bv[16];
#pragma unroll
                        for (int g = 0; g < 4; ++g) rkv[g] = *(const LAS f32x4*)(rkp + 32 * k2 + 8 * g);
#pragma unroll
                        for (int r = 0; r < 16; ++r) bv[r] = bp_[59 - (32 * k2 + (r & 3) + 8 * (r >> 2))];
                        __builtin_amdgcn_sched_barrier(0);
                        if (k2 == 0) asm volatile("s_nop 15\n\ts_nop 15\n\ts_nop 15" ::: "memory");
#pragma unroll
                        for (int r = 0; r < 16; ++r) { st[k2][r] = st[k2][r] * rkv[r >> 2][r & 3] + bv[r]; mt = fmaxf(mt, st[k2][r]); }
                        __builtin_amdgcn_sched_barrier(0);
                    }
                }
                mt = fmaxf(mt, __shfl_xor(mt, 32));
                if (__builtin_amdgcn_ballot_w64(mt > mrun + 8.0f) != 0ull) {
                    const float mnew = (mt > mrun + 8.0f) ? mt : mrun, alpha = __builtin_amdgcn_exp2f(mrun - mnew);
                    mrun = mnew; lsum *= alpha;
#pragma unroll
                    for (int dt = 0; dt < 4; ++dt)
#pragma unroll
                        for (int r = 0; r < 16; ++r) oacc[dt][r] *= alpha;
                }
                float ps = 0.f;
#pragma unroll
                for (int k2 = 0; k2 < 2; ++k2)
#pragma unroll
                    for (int r = 0; r < 16; ++r) { st[k2][r] = __builtin_amdgcn_exp2f(st[k2][r] - mrun); ps += st[k2][r]; }
                lsum += ps;
                bf16x8 pf[4];
#pragma unroll
                for (int s = 0; s < 4; ++s) { const f32x16& sv = st[s >> 1]; const int o8 = 8 * (s & 1);
                    u32x4 wv; wv.x = cvt_pk_bf16_op(sv[o8 + 0], sv[o8 + 1]); wv.y = cvt_pk_bf16_op(sv[o8 + 2], sv[o8 + 3]); wv.z = cvt_pk_bf16_op(sv[o8 + 4], sv[o8 + 5]); wv.w = cvt_pk_bf16_op(sv[o8 + 6], sv[o8 + 7]);
                    pf[s] = __builtin_bit_cast(bf16x8, wv); }
                const int q4 = i16 >> 2, p4 = i16 & 3;
#pragma unroll
                for (int sp = 0; sp < 2; ++sp) {
                    s16x4 lo[2][4], hi[2][4];
#pragma unroll
                    for (int s2 = 0; s2 < 2; ++s2) { const int s = 2 * sp + s2, rlo = 16 * s + 4 * hh + q4, flo = (q4 << 2) | hh, fhi = (q4 << 2) | (hh + 2);
#pragma unroll
                        for (int dt = 0; dt < 4; ++dt) { const int chl = 4 * dt + 2 * g1 + (p4 >> 1);
                            lo[s2][dt] = __builtin_bit_cast(s16x4, __builtin_amdgcn_ds_read_tr16_b64_v4i16((LAS s16x4*)(Vt + 256 * rlo + 16 * (chl ^ flo) + 8 * (p4 & 1))));
                            hi[s2][dt] = __builtin_bit_cast(s16x4, __builtin_amdgcn_ds_read_tr16_b64_v4i16((LAS s16x4*)(Vt + 256 * (rlo + 8) + 16 * (chl ^ fhi) + 8 * (p4 & 1)))); } }
                    __builtin_amdgcn_sched_barrier(0);
#pragma unroll
                    for (int s2 = 0; s2 < 2; ++s2)
#pragma unroll
                        for (int dt = 0; dt < 4; ++dt) { const bf16x8 vf = (bf16x8){lo[s2][dt][0], lo[s2][dt][1], lo[s2][dt][2], lo[s2][dt][3], hi[s2][dt][0], hi[s2][dt][1], hi[s2][dt][2], hi[s2][dt][3]};
                            oacc[dt] = __builtin_amdgcn_mfma_f32_32x32x16_bf16(vf, pf[2 * sp + s2], oacc[dt], 0, 0, 0); }
                    __builtin_amdgcn_sched_barrier(0);
                }
            }
        }
#undef AT_DMA
        MFMA_SETTLE();
        lsum += __shfl_xor(lsum, 32);
        const float inv = 1.0f / lsum;
        bf16_t* op = O + ((size_t)b * SEQ + 256 * cq + 32 * w + l31) * D + h * AHD + 4 * hh;
#pragma unroll
        for (int dt = 0; dt < 4; ++dt)
#pragma unroll
            for (int g = 0; g < 4; ++g) { u32x2 wv; wv.x = cvt_pk_bf16(oacc[dt][4 * g] * inv, oacc[dt][4 * g + 1] * inv); wv.y = cvt_pk_bf16(oacc[dt][4 * g + 2] * inv, oacc[dt][4 * g + 3] * inv);
                *(u32x2*)(op + dt * 32 + g * 8) = wv; }
        asm volatile("s_waitcnt vmcnt(0) lgkmcnt(0)" ::: "memory");
        __syncthreads();
    }
}

constexpr int G2_QS = 0, G2_KS = 17408, G2_VS = 34816, G2_KK = G2_VS + 64 * 528, G2_QK = G2_KK + 64 * 65 * 4, G2_AT = G2_QK + 64 * 65 * 4, G2_GC = G2_AT + 2 * 64 * 64 * 4, G2_BETA = G2_GC + 512, G2_END = G2_BETA + 512;
constexpr int G2_TI = G2_END, G2_FBW = G2_TI + 8192, G2_END2 = G2_FBW + 512;
static_assert(G2_END2 <= MISC_OFF && (G2_AT % 16) == 0 && (G2_TI % 16) == 0, "G2 LDS");
#define G2_CL16(x) ((x) < 0 ? 0 : ((x) > 16 ? 16 : (x)))
#define G2_ORD(j) (4 * ((j) < 15 ? (j) : 15) + 3 * G2_CL16((j) - 15) + 2 * G2_CL16((j) - 31) + G2_CL16((j) - 47))
#define G2_SUBST_LOOP(SG_LO, SG_HI) \
_Pragma("unroll") \
            for (int sg = SG_LO; sg < SG_HI; ++sg) { \
                const int j = sg >> 2, cq = sg & 3, lo = ((j + 1) >> 2) + 4 * cq; \
                if (lo < 16) { \
                    const int ord = G2_ORD(j) + cq; \
                    const bool m1 = (lo + 4 < 16);  const int j1 = m1 ? j : j + 1,   l1 = m1 ? lo + 4 : ((j + 2) >> 2); \
                    const bool m2 = (l1 + 4 < 16);  const int j2 = m2 ? j1 : j1 + 1, l2 = m2 ? l1 + 4 : ((j1 + 2) >> 2); \
                    if (j2 < 63) { \
_Pragma("unroll") \
                        for (int g = 0; g < 4; ++g) if (l2 + g < 16) cb[(ord + 2) % 3][g] = *(const LAS f32x4*)(Ae + j2 * 64 + 4 * (l2 + g)); \
                    } \
                    __builtin_amdgcn_sched_barrier(0); \
                    const float xu = ru[j], xw = rw[j]; \
_Pragma("unroll") \
                    for (int g = 0; g < 4; ++g) if (lo + g < 16) { const f32x4 a = cb[ord % 3][g]; const int r_ = 4 * (lo + g); \
                        ru[r_ + 0] -= a[0] * xu; ru[r_ + 1] -= a[1] * xu; ru[r_ + 2] -= a[2] * xu; ru[r_ + 3] -= a[3] * xu; \
                        rw[r_ + 0] -= a[0] * xw; rw[r_ + 1] -= a[1] * xw; rw[r_ + 2] -= a[2] * xw; rw[r_ + 3] -= a[3] * xw; } \
                    __builtin_amdgcn_sched_barrier(0); \
                } \
            }

__device__ __forceinline__ void phase_gdn_local(const Ctx& c, bf16_t* C, bf16_t* W, bf16_t* ATT, const float* AB, float* GC, const bf16_t* HEAD3, const bf16_t* TAIL3, const float* cw, const float* a_log, const float* dt_bias) {
    LAS unsigned char* lds = c.lds;
    LAS float* KKs = (LAS float*)(lds + G2_KK); LAS float* QKs = (LAS float*)(lds + G2_QK); LAS float* At = (LAS float*)(lds + G2_AT);
    LAS float* gcs = (LAS float*)(lds + G2_GC); LAS float* betas = (LAS float*)(lds + G2_BETA);
    LAS float* TI = (LAS float*)(lds + G2_TI); LAS float* fbw = (LAS float*)(lds + G2_FBW);
    const int wave = c.wave;
    constexpr int NUNITS = (MH / CH) * GKH;
    u32x4 pQ[2], pK[2], pV[4]; float pcw[4]; unsigned short ph3[3], pt3[3]; float pav = 0.f, pbv = 0.f;
#define G2_PREFETCH(un_) do { int tp_ = c.tid; asm volatile("" : "+v"(tp_)); const int hk_ = (un_) & 15, cg_ = (un_) >> 4, r0_ = cg_ * CH; \
        _Pragma("unroll") for (int i = 0; i < 2; ++i) { const int idx = tp_ + i * 512, row = idx >> 4, ch = idx & 15; \
            pQ[i] = *(const u32x4*)(C + (size_t)(r0_ + row) * 8192 + hk_ * 128 + ch * 8); pK[i] = *(const u32x4*)(C + (size_t)(r0_ + row) * 8192 + 2048 + hk_ * 128 + ch * 8); } \
        _Pragma("unroll") for (int i = 0; i < 4; ++i) { const int idx = tp_ + i * 512, row = idx >> 5, ch = idx & 31; \
            pV[i] = *(const u32x4*)(C + (size_t)(r0_ + row) * 8192 + 4096 + hk_ * 256 + ch * 8); } \
        { const int chg = (tp_ < 128) ? hk_ * 128 + tp_ : (tp_ < 256) ? 2048 + hk_ * 128 + (tp_ - 128) : 4096 + hk_ * 256 + (tp_ - 256); \
          _Pragma("unroll") for (int q = 0; q < 4; ++q) pcw[q] = cw[q * 8192 + chg]; \
          _Pragma("unroll") for (int q = 0; q < 3; ++q) { ph3[q] = HEAD3[(size_t)(cg_ * 3 + q) * 8192 + chg]; pt3[q] = ((r0_ % SEQ) != 0) ? TAIL3[(size_t)(cg_ * 3 - 3 + q) * 8192 + chg] : (unsigned short)0; } } \
        if (tp_ < 128) { const int hv_ = 2 * hk_ + (tp_ >> 6), ln_ = tp_ & 63; pav = AB[(size_t)(r0_ + ln_) * 64 + hv_]; pbv = AB[(size_t)(r0_ + ln_) * 64 + 32 + hv_]; } } while (0)
    if (c.bid < NUNITS) G2_PREFETCH(c.bid);
    for (int u = c.bid; u < NUNITS; u += c.G) {
        int tid = c.tid; asm volatile("" : "+v"(tid));
        const int lane = tid & 63, l31 = lane & 31, hh = lane >> 5;
        const int hk = u & 15, cg = u >> 4, r0 = cg * CH;
#pragma unroll
        for (int i = 0; i < 2; ++i) { const int idx = tid + i * 512, row = idx >> 4, ch = idx & 15;
#pragma unroll
            for (int tile = 0; tile < 2; ++tile) { const u32x4 a = tile ? pK[i] : pQ[i];
                float x[8]; float ss = 0.f;
#pragma unroll
                for (int k = 0; k < 4; ++k) { x[2 * k] = bflo(a[k]); x[2 * k + 1] = bfhi(a[k]); }
#pragma unroll
                for (int k = 0; k < 8; ++k) ss += x[k] * x[k];
                ss = sum16(ss);
                const float rr = (tile ? 1.0f : 0.08838834764831845f) / sqrtf(ss + EPS);
                u32x4 w; w.x = cvt_pk_bf16(x[0] * rr, x[1] * rr); w.y = cvt_pk_bf16(x[2] * rr, x[3] * rr); w.z = cvt_pk_bf16(x[4] * rr, x[5] * rr); w.w = cvt_pk_bf16(x[6] * rr, x[7] * rr);
                if (row >= 3) { *(LAS u32x4*)(lds + (tile ? G2_KS : G2_QS) + row * 272 + ch * 16) = w;
                    if (tile == 0) *(u32x4*)(C + (size_t)(r0 + row) * 8192 + hk * 128 + ch * 8) = w; } } }
#pragma unroll
        for (int i = 0; i < 4; ++i) { const int idx = tid + i * 512, row = idx >> 5, ch = idx & 31;
            if (row >= 3) *(LAS u32x4*)(lds + G2_VS + row * 528 + ch * 16) = pV[i]; }
        {
            const float w0 = pcw[0], w1 = pcw[1], w2 = pcw[2], w3 = pcw[3];
            const float h0 = bf2f(ph3[0]), h1 = bf2f(ph3[1]), h2 = bf2f(ph3[2]), t0 = bf2f(pt3[0]), t1 = bf2f(pt3[1]), t2 = bf2f(pt3[2]);
            const float y0 = siluf(w0 * t0 + w1 * t1 + w2 * t2 + w3 * h0), y1 = siluf(w0 * t1 + w1 * t2 + w2 * h0 + w3 * h1), y2 = siluf(w0 * t2 + w1 * h0 + w2 * h1 + w3 * h2);
            LAS unsigned char* dst = (tid < 128) ? lds + G2_QS + tid * 2 : (tid < 256) ? lds + G2_KS + (tid - 128) * 2 : lds + G2_VS + (tid - 256) * 2;
            const int rs = (tid < 256) ? 272 : 528;
            *(LAS bf16_t*)(dst) = (bf16_t)f2bf(y0); *(LAS bf16_t*)(dst + rs) = (bf16_t)f2bf(y1); *(LAS bf16_t*)(dst + 2 * rs) = (bf16_t)f2bf(y2);
        }
        if (wave < 2) {
            const int hv = 2 * hk + wave;
            const float z = pav + dt_bias[hv];
            const float sp = z > 20.f ? z : log1pf(__expf(z));
            float g = -__expf(a_log[hv]) * sp;
            g = scan64(g);
            gcs[wave * 64 + lane] = g; betas[wave * 64 + lane] = 1.0f / (1.0f + __expf(-pbv));
            GC[(size_t)hv * MH + r0 + lane] = g;
        }
        __syncthreads();
        if (tid < 96) {
            const int tile = tid / 48, row = (tid % 48) >> 4, ch = tid & 15;
            LAS unsigned char* p = lds + (tile ? G2_KS : G2_QS) + row * 272 + ch * 16;
            const u32x4 a = *(const LAS u32x4*)p;
            float x[8]; float ss = 0.f;
#pragma unroll
            for (int k = 0; k < 4; ++k) { x[2 * k] = bflo(a[k]); x[2 * k + 1] = bfhi(a[k]); }
#pragma unroll
            for (int k = 0; k < 8; ++k) ss += x[k] * x[k];
            ss = sum16(ss);
            const float rr = (tile ? 1.0f : 0.08838834764831845f) / sqrtf(ss + EPS);
            u32x4 w; w.x = cvt_pk_bf16(x[0] * rr, x[1] * rr); w.y = cvt_pk_bf16(x[2] * rr, x[3] * rr); w.z = cvt_pk_bf16(x[4] * rr, x[5] * rr); w.w = cvt_pk_bf16(x[6] * rr, x[7] * rr);
            *(LAS u32x4*)p = w;
            if (tile == 0) *(u32x4*)(C + (size_t)(r0 + row) * 8192 + hk * 128 + ch * 8) = w;
        }
        __syncthreads();
        {
            const int mat = wave >> 2, ti = (wave >> 1) & 1, tj = wave & 1;
            LAS unsigned char* xa = lds + (mat ? G2_QS : G2_KS) + (32 * ti + l31) * 272 + hh * 16;
            LAS unsigned char* xb = lds + G2_KS + (32 * tj + l31) * 272 + hh * 16;
            f32x16 acc;
#pragma unroll
            for (int r = 0; r < 16; ++r) acc[r] = 0.f;
#pragma unroll
            for (int ks = 0; ks < 8; ++ks) acc = __builtin_amdgcn_mfma_f32_32x32x16_bf16(*(const LAS bf16x8*)(xa + ks * 32), *(const LAS bf16x8*)(xb + ks * 32), acc, 0, 0, 0);
            MFMA_SETTLE();
            const int j = 32 * tj + l31;
            if (mat == 0) {
                if (ti >= tj) {
#pragma unroll
                    for (int e = 0; e < 2; ++e) { const float gj = gcs[e * 64 + j];
#pragma unroll
                        for (int g = 0; g < 4; ++g) { const int i0 = 32 * ti + 8 * g + 4 * hh;
                            const f32x4 gi = *(const LAS f32x4*)(gcs + e * 64 + i0), bi = *(const LAS f32x4*)(betas + e * 64 + i0);
#pragma unroll
                            for (int q = 0; q < 4; ++q) { const int i = i0 + q;
                                At[e * 4096 + i * 64 + j] = (i > j) ? -bi[q] * acc[4 * g + q] * __expf(gi[q] - gj) : 0.f; } } }
                } else {
                    fbw[lane] = betas[lane] * __expf(gcs[lane]); fbw[64 + lane] = betas[64 + lane] * __expf(gcs[64 + lane]);
                }
            } else {
#pragma unroll
                for (int e = 0; e < 2; ++e) { const float gj = gcs[e * 64 + j];
                    bf16_t* ap = ATT + ((size_t)(cg * 32 + 2 * hk + e) * 64) * 64 + j;
#pragma unroll
                    for (int g = 0; g < 4; ++g) { const int i0 = 32 * ti + 8 * g + 4 * hh;
                        const f32x4 gi = *(const LAS f32x4*)(gcs + e * 64 + i0);
#pragma unroll
                        for (int q = 0; q < 4; ++q) { const int i = i0 + q;
                            const float v = (i >= j) ? acc[4 * g + q] * __expf(gi[q] - gj) : 0.f;
                            ap[(size_t)i * 64] = (bf16_t)f2bf(v); } } }
            }
        }
        __syncthreads();
        { const int un = (u + c.G < NUNITS) ? u + c.G : u; G2_PREFETCH(un); }
        if (wave < 2) {
            const int e = tid >> 6, b = (tid >> 4) & 3, cc = tid & 15;
            const LAS float* An = At + e * 4096 + (16 * b) * 64 + 16 * b;
            float x[16];
#pragma unroll
            for (int r = 0; r < 16; ++r) x[r] = (r == cc) ? 1.f : 0.f;
            f32x4 ca[4], cn[4];
            ca[0] = *(const LAS f32x4*)(An + 1 * 64);
#pragma unroll
            for (int r = 1; r < 16; ++r) {
                if (r + 1 < 16) {
#pragma unroll
                    for (int k4 = 0; k4 < (r + 4) / 4; ++k4) cn[k4] = *(const LAS f32x4*)(An + (r + 1) * 64 + 4 * k4);
                }
                __builtin_amdgcn_sched_barrier(0);
                float acc = x[r];
#pragma unroll
                for (int k4 = 0; k4 < (r + 3) / 4; ++k4)
#pragma unroll
                    for (int q = 0; q < 4; ++q) if (4 * k4 + q < r) acc += ca[k4][q] * x[4 * k4 + q];
                x[r] = acc;
                __builtin_amdgcn_sched_barrier(0);
#pragma unroll
                for (int k4 = 0; k4 < 4; ++k4) ca[k4] = cn[k4];
            }
#pragma unroll
            for (int r = 0; r < 16; ++r) TI[((e * 4 + b) * 16 + r) * 16 + cc] = x[r];
        } else if (wave >= 4) {
            const int t2 = tid - 256;
#pragma unroll
            for (int p = 0; p < 2; ++p) {
                const int t3 = t2 + 256 * p, dk = t3 >> 2, ib = (t3 & 3) * 16;
                unsigned wv[8];
#pragma unroll
                for (int q = 0; q < 8; ++q) { const unsigned lo = *(const LAS bf16_t*)(lds + G2_KS + (ib + 2 * q) * 272 + dk * 2), hi = *(const LAS bf16_t*)(lds + G2_KS + (ib + 2 * q + 1) * 272 + dk * 2); wv[q] = lo | (hi << 16); }
                bf16_t* kp = C + (size_t)(r0 + (dk >> 1)) * 8192 + 2048 + hk * 128 + (dk & 1) * 64 + ib;
                *(u32x4*)(kp) = (u32x4){wv[0], wv[1], wv[2], wv[3]}; *(u32x4*)(kp + 8) = (u32x4){wv[4], wv[5], wv[6], wv[7]};
            }
        }
        __syncthreads();
        {
            const int e = wave >> 2, fr = lane & 15, fq = lane >> 4, hv = 2 * hk + e, ct0 = (wave & 1) * 4;
            const bool isw = (wave & 2) != 0;
            f32x4 ti[4], an[6];
#pragma unroll
            for (int b = 0; b < 4; ++b) ti[b] = *(const LAS f32x4*)(TI + ((e * 4 + b) * 16 + fr) * 16 + 4 * fq);
            an[0] = *(const LAS f32x4*)(At + e * 4096 + (16 + fr) * 64 + 0 + 4 * fq);
            an[1] = *(const LAS f32x4*)(At + e * 4096 + (32 + fr) * 64 + 0 + 4 * fq);  an[2] = *(const LAS f32x4*)(At + e * 4096 + (32 + fr) * 64 + 16 + 4 * fq);
            an[3] = *(const LAS f32x4*)(At + e * 4096 + (48 + fr) * 64 + 0 + 4 * fq);  an[4] = *(const LAS f32x4*)(At + e * 4096 + (48 + fr) * 64 + 16 + 4 * fq);
            an[5] = *(const LAS f32x4*)(At + e * 4096 + (48 + fr) * 64 + 32 + 4 * fq);
            f32x4 R[4][4], X[4][4];
#pragma unroll
            for (int b = 0; b < 4; ++b) { const f32x4 fac = *(const LAS f32x4*)((isw ? fbw : betas) + e * 64 + 16 * b + 4 * fq);
#pragma unroll
                for (int t = 0; t < 4; ++t) { const int col = 16 * (ct0 + t) + fr;
#pragma unroll
                    for (int q = 0; q < 4; ++q) { const int i = 16 * b + 4 * fq + q;
                        const unsigned short raw = isw ? *(const LAS bf16_t*)(lds + G2_KS + i * 272 + col * 2) : *(const LAS bf16_t*)(lds + G2_VS + i * 528 + (e * 128 + col) * 2);
                        R[t][b][q] = fac[q] * bf2f(raw); } } }
#define G2_MM(dst, av, bv) do { _Pragma("unroll") for (int q = 0; q < 4; ++q) dst = __builtin_amdgcn_mfma_f32_16x16x4f32(av[q], bv[q], dst, 0, 0, 0); } while (0)
#pragma unroll
            for (int t = 0; t < 4; ++t) { X[t][0] = (f32x4){0.f, 0.f, 0.f, 0.f}; G2_MM(X[t][0], ti[0], R[t][0]); }
#pragma unroll
            for (int t = 0; t < 4; ++t) G2_MM(R[t][1], an[0], X[t][0]);
#pragma unroll
            for (int t = 0; t < 4; ++t) { X[t][1] = (f32x4){0.f, 0.f, 0.f, 0.f}; G2_MM(X[t][1], ti[1], R[t][1]); }
#pragma unroll
            for (int t = 0; t < 4; ++t) { G2_MM(R[t][2], an[1], X[t][0]); G2_MM(R[t][2], an[2], X[t][1]); }
#pragma unroll
            for (int t = 0; t < 4; ++t) { X[t][2] = (f32x4){0.f, 0.f, 0.f, 0.f}; G2_MM(X[t][2], ti[2], R[t][2]); }
#pragma unroll
            for (int t = 0; t < 4; ++t) { G2_MM(R[t][3], an[3], X[t][0]); G2_MM(R[t][3], an[4], X[t][1]); G2_MM(R[t][3], an[5], X[t][2]); }
#pragma unroll
            for (int t = 0; t < 4; ++t) { X[t][3] = (f32x4){0.f, 0.f, 0.f, 0.f}; G2_MM(X[t][3], ti[3], R[t][3]); }
#undef G2_MM
            MFMA_SETTLE();
            if (!isw) {
#pragma unroll
                for (int t = 0; t < 4; ++t) { const int dv = 16 * (ct0 + t) + fr;
                    bf16_t* up = C + (size_t)(r0 + (dv >> 1)) * 8192 + 4096 + hv * 128 + (dv & 1) * 64 + 4 * fq;
#pragma unroll
                    for (int b = 0; b < 4; ++b) { u32x2 w; w.x = cvt_pk_bf16(X[t][b][0], X[t][b][1]); w.y = cvt_pk_bf16(X[t][b][2], X[t][b][3]); *(u32x2*)(up + 16 * b) = w; } }
            } else {
#pragma unroll
                for (int t = 0; t < 4; ++t) { bf16_t* wp = W + (size_t)(r0 + 4 * fq) * 4096 + hv * 128 + 16 * (ct0 + t) + fr;
#pragma unroll
                    for (int b = 0; b < 4; ++b)
#pragma unroll
                        for (int q = 0; q < 4; ++q) wp[(size_t)(16 * b + q) * 4096] = (bf16_t)f2bf(X[t][b][q]); }
            }
        }
        __syncthreads();
    }
}

#undef G2_PREFETCH
constexpr int G3_W = 0, G3_Q = 17408, G3_KT = 34816, G3_A = G3_KT + 128 * 144, G3_UT = G3_A + 64 * 144, G3_GCB = G3_UT + 32 * 144, G3_BUF = G3_GCB + 512;
static_assert(2 * G3_BUF <= MISC_OFF, "G3 LDS");
__device__ __forceinline__ void g3_stage(LAS unsigned char* buf, const bf16_t* PROJ, const bf16_t* C, const bf16_t* ATT, const float* GC, int cgl, int hv, int dq, int t, int nt) {
    const size_t r0 = (size_t)cgl * CH; const int hk = hv >> 1;
    for (int i = t; i < 1024; i += nt) { const int row = i >> 4, ch = i & 15;
        *(LAS u32x4*)(buf + G3_W + row * 272 + ch * 16) = *(const u32x4*)(PROJ + (r0 + row) * 4096 + hv * 128 + ch * 8);
        *(LAS u32x4*)(buf + G3_Q + row * 272 + ch * 16) = *(const u32x4*)(C + (r0 + row) * 8192 + hk * 128 + ch * 8); }
    for (int i = t; i < 1024; i += nt) { const int rr = i >> 4, ch = i & 15, dk = 2 * rr + (ch >> 3);
        *(LAS u32x4*)(buf + G3_KT + dk * 144 + (ch & 7) * 16) = *(const u32x4*)(C + (r0 + rr) * 8192 + 2048 + hk * 128 + ch * 8); }
    for (int i = t; i < 512; i += nt) { const int row = i >> 3, ch = i & 7;
        *(LAS u32x4*)(buf + G3_A + row * 144 + ch * 16) = *(const u32x4*)(ATT + ((size_t)(cgl * 32 + hv) * 64 + row) * 64 + ch * 8); }
    for (int i = t; i < 256; i += nt) { const int rr = i >> 4, ch = i & 15, dvl = 2 * rr + (ch >> 3);
        *(LAS u32x4*)(buf + G3_UT + dvl * 144 + (ch & 7) * 16) = *(const u32x4*)(C + (r0 + 16 * dq + rr) * 8192 + 4096 + hv * 128 + ch * 8); }
    if (t < 64) { const float gct = GC[(size_t)hv * MH + r0 + t], gl = GC[(size_t)hv * MH + r0 + 63];
        *(LAS float*)(buf + G3_GCB + t * 4) = __expf(gct); *(LAS float*)(buf + G3_GCB + 256 + t * 4) = __expf(gl - gct); }
}
__device__ __forceinline__ bf16x8 pack8(const f32x16& v, int s) {
    u32x4 w; w.x = cvt_pk_bf16_op(v[8 * s + 0], v[8 * s + 1]); w.y = cvt_pk_bf16_op(v[8 * s + 2], v[8 * s + 3]); w.z = cvt_pk_bf16_op(v[8 * s + 4], v[8 * s + 5]); w.w = cvt_pk_bf16_op(v[8 * s + 6], v[8 * s + 7]);
    return __builtin_bit_cast(bf16x8, w);
}
__device__ __forceinline__ bf16x8 ld2x8(const LAS unsigned char* p) {
    const u32x2 a = *(const LAS u32x2*)p, b = *(const LAS u32x2*)(p + 16);
    return __builtin_bit_cast(bf16x8, (u32x4){a.x, a.y, b.x, b.y});
}
__device__ __forceinline__ u32x4 gld16(const void* p) { u32x4 r; asm volatile("global_load_dwordx4 %0, %1, off" : "=v"(r) : "v"(p) : "memory"); return r; }
__device__ __forceinline__ float gld4(const void* p) { float r; asm volatile("global_load_dword %0, %1, off" : "=v"(r) : "v"(p) : "memory"); return r; }
constexpr int G3_SX = 2 * G3_BUF;
constexpr int G3_VX = G3_SX + 8192;
static_assert(G3_VX + 4096 <= MISC_OFF, "G3 LDS (exchange)");
#define G3_BAR() asm volatile("s_waitcnt lgkmcnt(0)\n\ts_barrier" ::: "memory")
__device__ __forceinline__ void phase_gdn_scan(const Ctx& c, const bf16_t* PROJ  , bf16_t* OUT, const bf16_t* C, const bf16_t* ATT, const float* GC) {
    LAS unsigned char* lds = c.lds;
    constexpr int NITEMS = 2 * GVH * 4;
    for (int wi = c.bid; wi < NITEMS; wi += c.G) {
        int tid = c.tid; asm volatile("" : "+v"(tid));
        const int xslot = wi >> 3, grp = (wi & 7) * 8 + (xslot >> 2), bl = grp >> 5, hv = grp & 31, dq = xslot & 3;
        g3_stage(lds, PROJ, C, ATT, GC, bl * NCH, hv, dq, tid, NTHREADS);
        { unsigned zz = 0u; asm volatile("" : "+v"(zz)); *(LAS u32x4*)(lds + G3_SX + tid * 16) = (u32x4){zz, zz, zz, zz}; }
        __syncthreads();
        if (c.wave >= 2) {
            int t2 = c.tid; asm volatile("" : "+v"(t2));
            const int hk = hv >> 1;
#define G3_CLAMP(x) ((x) < NCH ? (x) : NCH - 1)
#define G3_LOOP2(LD_, WR_) do { LD_(sa, bl * NCH + 1); LD_(sb, bl * NCH + 2); \
                for (int ch = 0; ch < NCH; ch += 2) { \
                    G3_BAR(); WR_(sa, lds + G3_BUF); LD_(sa, bl * NCH + G3_CLAMP(ch + 3)); G3_BAR();     \
                    G3_BAR(); WR_(sb, lds); LD_(sb, bl * NCH + G3_CLAMP(ch + 4)); G3_BAR(); } \
                asm volatile("s_waitcnt vmcnt(0)" ::: "memory"); } while (0)
            if (c.wave <= 5) {
                const int l4 = t2 - 128, row0 = l4 >> 4, ch16 = l4 & 15;
                struct S3 { u32x4 W[4], Q[4], K[4]; }; S3 sa, sb;
#define G3_LD3(P, cgl_) do { const size_t r0_ = (size_t)(cgl_) * CH; _Pragma("unroll") for (int j = 0; j < 4; ++j) { const int row = row0 + 16 * j; \
                    P.W[j] = gld16(PROJ + (r0_ + row) * 4096 + hv * 128 + ch16 * 8); \
                    P.Q[j] = gld16(C + (r0_ + row) * 8192 + hk * 128 + ch16 * 8); \
                    P.K[j] = gld16(C + (r0_ + row) * 8192 + 2048 + hk * 128 + ch16 * 8); } } while (0)
#define G3_WR3(P, nb_) do { asm volatile("s_waitcnt vmcnt(12)" : "+v"(P.W[0]), "+v"(P.W[1]), "+v"(P.W[2]), "+v"(P.W[3]), "+v"(P.Q[0]), "+v"(P.Q[1]), "+v"(P.Q[2]), "+v"(P.Q[3]), \
                                                                  "+v"(P.K[0]), "+v"(P.K[1]), "+v"(P.K[2]), "+v"(P.K[3]) :: "memory"); \
                _Pragma("unroll") for (int j = 0; j < 4; ++j) { const int row = row0 + 16 * j; \
                    *(LAS u32x4*)((nb_) + G3_W + row * 272 + ch16 * 16) = P.W[j]; \
                    *(LAS u32x4*)((nb_) + G3_Q + row * 272 + ch16 * 16) = P.Q[j]; \
                    *(LAS u32x4*)((nb_) + G3_KT + (2 * row + (ch16 >> 3)) * 144 + (ch16 & 7) * 16) = P.K[j]; } } while (0)
                G3_LOOP2(G3_LD3, G3_WR3);
#undef G3_LD3
#undef G3_WR3
            } else if (c.wave == 6) {
                const int l2 = t2 - 384, row0 = l2 >> 3, ch8 = l2 & 7;
                struct S1 { u32x4 A[8]; }; S1 sa, sb;
#define G3_LD1(P, cgl_) do { _Pragma("unroll") for (int j = 0; j < 8; ++j) P.A[j] = gld16(ATT + ((size_t)((cgl_) * 32 + hv) * 64 + row0 + 8 * j) * 64 + ch8 * 8); } while (0)
#define G3_WR1(P, nb_) do { asm volatile("s_waitcnt vmcnt(8)" : "+v"(P.A[0]), "+v"(P.A[1]), "+v"(P.A[2]), "+v"(P.A[3]), "+v"(P.A[4]), "+v"(P.A[5]), "+v"(P.A[6]), "+v"(P.A[7]) :: "memory"); \
                _Pragma("unroll") for (int j = 0; j < 8; ++j) *(LAS u32x4*)((nb_) + G3_A + (row0 + 8 * j) * 144 + ch8 * 16) = P.A[j]; } while (0)
                G3_LOOP2(G3_LD1, G3_WR1);
#undef G3_LD1
#undef G3_WR1
            } else {
                const int l1 = t2 - 448, rr0 = l1 >> 4, ch16 = l1 & 15;
                struct SU { u32x4 U[4]; float g0, g1; }; SU sa, sb;
#define G3_LDU(P, cgl_) do { const size_t r0_ = (size_t)(cgl_) * CH; _Pragma("unroll") for (int j = 0; j < 4; ++j) P.U[j] = gld16(C + (r0_ + 16 * dq + rr0 + 4 * j) * 8192 + 4096 + hv * 128 + ch16 * 8); \
                    P.g0 = gld4(GC + (size_t)hv * MH + r0_ + l1); P.g1 = gld4(GC + (size_t)hv * MH + r0_ + 63); } while (0)
#define G3_WRU(P, nb_) do { asm volatile("s_waitcnt vmcnt(6)" : "+v"(P.U[0]), "+v"(P.U[1]), "+v"(P.U[2]), "+v"(P.U[3]), "+v"(P.g0), "+v"(P.g1) :: "memory"); \
                _Pragma("unroll") for (int j = 0; j < 4; ++j) *(LAS u32x4*)((nb_) + G3_UT + (2 * (rr0 + 4 * j) + (ch16 >> 3)) * 144 + (ch16 & 7) * 16) = P.U[j]; \
                    *(LAS float*)((nb_) + G3_GCB + l1 * 4) = __expf(P.g0); *(LAS float*)((nb_) + G3_GCB + 256 + l1 * 4) = __expf(P.g1 - P.g0); } while (0)
                G3_LOOP2(G3_LDU, G3_WRU);
#undef G3_LDU
#undef G3_WRU
            }
#undef G3_LOOP2
#undef G3_CLAMP
        } else if (c.wave == 0) {
            f32x16 Sacc[4];
#pragma unroll
            for (int k = 0; k < 4; ++k)
#pragma unroll
                for (int r = 0; r < 16; ++r) Sacc[k][r] = 0.f;
            bf16x8 Sb[8];
#pragma unroll
            for (int ks = 0; ks < 8; ++ks) Sb[ks] = pack8(Sacc[ks >> 1], ks & 1);
            for (int ch = 0; ch < NCH; ++ch) {
                int ln = c.tid & 63; asm volatile("" : "+v"(ln));
                const int l31 = ln & 31, hh = ln >> 5;
                LAS unsigned char* buf = lds + (ch & 1) * G3_BUF;
                const LAS float* gcb = (const LAS float*)(buf + G3_GCB);
                f32x16 vn[2];
#pragma unroll
                for (int rt = 0; rt < 2; ++rt)
#pragma unroll
                    for (int r = 0; r < 16; ++r) vn[rt][r] = 0.f;
                bf16x8 fa[8], fb[8];
#pragma unroll
                for (int i = 0; i < 8; ++i) { const int rt = i & 1;
                    fa[i] = ld2x8(buf + G3_W + (32 * rt + l31) * 272 + hh * 8 + (16 * (i >> 1)) * 2);
                    fb[i] = ld2x8(buf + G3_W + (32 * rt + l31) * 272 + hh * 8 + (16 * (4 + (i >> 1))) * 2); }
                __builtin_amdgcn_sched_barrier(0);
#pragma unroll
                for (int i = 0; i < 8; ++i) vn[i & 1] = __builtin_amdgcn_mfma_f32_32x32x16_bf16(fa[i], Sb[i >> 1], vn[i & 1], 0, 0, 0);
#pragma unroll
                for (int i = 0; i < 8; ++i) vn[i & 1] = __builtin_amdgcn_mfma_f32_32x32x16_bf16(fb[i], Sb[4 + (i >> 1)], vn[i & 1], 0, 0, 0);
                __builtin_amdgcn_sched_barrier(0);
#pragma unroll
                for (int i = 0; i < 8; ++i) { const int k = i >> 2, rt = (i >> 1) & 1, s = i & 1;
                    fa[i] = ld2x8(buf + G3_KT + (32 * k + l31) * 144 + hh * 8 + (32 * rt + 16 * s) * 2);
                    fb[i] = ld2x8(buf + G3_KT + (32 * (k + 2) + l31) * 144 + hh * 8 + (32 * rt + 16 * s) * 2); }
                const float dec = gcb[63];
                MFMA_SETTLE();
                bf16x8 Vsb[2][2];
#pragma unroll
                for (int rt = 0; rt < 2; ++rt)
#pragma unroll
                    for (int s = 0; s < 2; ++s) {
                        float pv[8], ps[8];
#pragma unroll
                        for (int g2 = 0; g2 < 2; ++g2) {
                            const int g = 2 * s + g2, i0 = 32 * rt + 8 * g + 4 * hh;
                            const u32x2 uu = *(const LAS u32x2*)(buf + G3_UT + l31 * 144 + i0 * 2);
                            const f32x4 e2 = *(const LAS f32x4*)(gcb + 64 + i0);
                            const float u4[4] = {bflo(uu.x), bfhi(uu.x), bflo(uu.y), bfhi(uu.y)};
#pragma unroll
                            for (int q = 0; q < 4; ++q) { const float v = u4[q] - vn[rt][4 * g + q]; pv[4 * g2 + q] = v; ps[4 * g2 + q] = v * e2[q]; }
                        }
                        u32x4 w; w.x = cvt_pk_bf16_op(pv[0], pv[1]); w.y = cvt_pk_bf16_op(pv[2], pv[3]); w.z = cvt_pk_bf16_op(pv[4], pv[5]); w.w = cvt_pk_bf16_op(pv[6], pv[7]);
                        *(LAS u32x4*)(lds + G3_VX + ((rt * 2 + s) * 64 + ln) * 16) = w;
                        w.x = cvt_pk_bf16_op(ps[0], ps[1]); w.y = cvt_pk_bf16_op(ps[2], ps[3]); w.z = cvt_pk_bf16_op(ps[4], ps[5]); w.w = cvt_pk_bf16_op(ps[6], ps[7]); Vsb[rt][s] = __builtin_bit_cast(bf16x8, w);
                    }
                __builtin_amdgcn_sched_barrier(0);
                G3_BAR();
#pragma unroll
                for (int k = 0; k < 4; ++k)
#pragma unroll
                    for (int r = 0; r < 16; ++r) Sacc[k][r] *= dec;
                __builtin_amdgcn_sched_barrier(0);
#pragma unroll
                for (int k = 0; k < 4; ++k)
#pragma unroll
                    for (int rt = 0; rt < 2; ++rt)
#pragma unroll
                        for (int s = 0; s < 2; ++s) Sacc[k] = __builtin_amdgcn_mfma_f32_32x32x16_bf16((k < 2 ? fa : fb)[(k & 1) * 4 + rt * 2 + s], Vsb[rt][s], Sacc[k], 0, 0, 0);
                MFMA_SETTLE();
#pragma unroll
                for (int ks = 0; ks < 8; ++ks) { Sb[ks] = pack8(Sacc[ks >> 1], ks & 1); *(LAS bf16x8*)(lds + G3_SX + (ks * 64 + ln) * 16) = Sb[ks]; }
                __builtin_amdgcn_sched_barrier(0);
                G3_BAR();
            }
        } else {
            for (int ch = 0; ch < NCH; ++ch) {
                int ln = c.tid & 63; asm volatile("" : "+v"(ln));
                const int l31 = ln & 31, hh = ln >> 5;
                LAS unsigned char* buf = lds + (ch & 1) * G3_BUF;
                const LAS float* gcb = (const LAS float*)(buf + G3_GCB);
                f32x16 oa[2];
#pragma unroll
                for (int rt = 0; rt < 2; ++rt)
#pragma unroll
                    for (int r = 0; r < 16; ++r) oa[rt][r] = 0.f;
                bf16x8 fa[8], fb[8], Sb[8];
#pragma unroll
                for (int ks = 0; ks < 8; ++ks) Sb[ks] = *(const LAS bf16x8*)(lds + G3_SX + (ks * 64 + ln) * 16);
#pragma unroll
                for (int i = 0; i < 8; ++i) { const int rt = i & 1;
                    fa[i] = ld2x8(buf + G3_Q + (32 * rt + l31) * 272 + hh * 8 + (16 * (i >> 1)) * 2);
                    fb[i] = ld2x8(buf + G3_Q + (32 * rt + l31) * 272 + hh * 8 + (16 * (4 + (i >> 1))) * 2); }
                __builtin_amdgcn_sched_barrier(0);
#pragma unroll
                for (int i = 0; i < 8; ++i) oa[i & 1] = __builtin_amdgcn_mfma_f32_32x32x16_bf16(fa[i], Sb[i >> 1], oa[i & 1], 0, 0, 0);
#pragma unroll
                for (int i = 0; i < 8; ++i) oa[i & 1] = __builtin_amdgcn_mfma_f32_32x32x16_bf16(fb[i], Sb[4 + (i >> 1)], oa[i & 1], 0, 0, 0);
                __builtin_amdgcn_sched_barrier(0);
                bf16x8 af[6];
#pragma unroll
                for (int ro = 0; ro < 2; ++ro)
#pragma unroll
                    for (int rt = 0; rt <= ro; ++rt)
#pragma unroll
                        for (int s = 0; s < 2; ++s) af[(ro ? 2 + 2 * rt : 0) + s] = ld2x8(buf + G3_A + (32 * ro + l31) * 144 + hh * 8 + (32 * rt + 16 * s) * 2);
                f32x4 e1v[2][4];
#pragma unroll
                for (int rt = 0; rt < 2; ++rt)
#pragma unroll
                    for (int g = 0; g < 4; ++g) e1v[rt][g] = *(const LAS f32x4*)(gcb + 32 * rt + 8 * g + 4 * hh);
                MFMA_SETTLE();
#pragma unroll
                for (int rt = 0; rt < 2; ++rt)
#pragma unroll
                    for (int g = 0; g < 4; ++g)
#pragma unroll
                        for (int q = 0; q < 4; ++q) oa[rt][4 * g + q] *= e1v[rt][g][q];
                __builtin_amdgcn_sched_barrier(0);
                G3_BAR();
                bf16x8 Vb[2][2];
#pragma unroll
                for (int rt = 0; rt < 2; ++rt)
#pragma unroll
                    for (int s = 0; s < 2; ++s) Vb[rt][s] = *(const LAS bf16x8*)(lds + G3_VX + ((rt * 2 + s) * 64 + ln) * 16);
                __builtin_amdgcn_sched_barrier(0);
#pragma unroll
                for (int ro = 0; ro < 2; ++ro)
#pragma unroll
                    for (int rt = 0; rt <= ro; ++rt)
#pragma unroll
                        for (int s = 0; s < 2; ++s) oa[ro] = __builtin_amdgcn_mfma_f32_32x32x16_bf16(af[(ro ? 2 + 2 * rt : 0) + s], Vb[rt][s], oa[ro], 0, 0, 0);
                MFMA_SETTLE();
                { bf16_t* op = OUT + ((size_t)(bl * NCH + ch) * CH) * 4096 + hv * 128 + 32 * dq + l31;
#pragma unroll
                  for (int rt = 0; rt < 2; ++rt)
#pragma unroll
                    for (int r = 0; r < 16; ++r) op[(size_t)(32 * rt + (r & 3) + 8 * (r >> 2) + 4 * hh) * 4096] = (bf16_t)(cvt_pk_bf16(oa[rt][r], oa[rt][r]) & 0xffffu); }
                __builtin_amdgcn_sched_barrier(0);
                G3_BAR();
            }
        }
        __syncthreads();
    }
}
#undef G3_BAR

__device__ __forceinline__ void phase_gdn_onorm(const Ctx& c, bf16_t* OUT, const bf16_t* GATE, const float* o_gain) {
    const int gw = c.bid * NWAVES + c.wave, NGW = c.G * NWAVES, sub = c.lane >> 4, ch = c.lane & 15;
    float og[8];
    { const f32x4 a = *(const f32x4*)(o_gain + ch * 8), b = *(const f32x4*)(o_gain + ch * 8 + 4);
#pragma unroll
      for (int k = 0; k < 4; ++k) { og[k] = a[k]; og[4 + k] = b[k]; } }
    const int npairs = MH * GVH / 4;
    for (int it0 = gw; it0 < npairs; it0 += 4 * NGW) {
        u32x4 ovr[4], gvr[4];
#pragma unroll
        for (int q = 0; q < 4; ++q) { const int it = it0 + q * NGW;
            if (it < npairs) { const int pr = it * 4 + sub, row = pr >> 5, hv = pr & 31;
                ovr[q] = *(const u32x4*)(OUT + (size_t)row * 4096 + hv * 128 + ch * 8); gvr[q] = *(const u32x4*)(GATE + (size_t)row * 4096 + hv * 128 + ch * 8); } }
#pragma unroll
        for (int q = 0; q < 4; ++q) { const int it = it0 + q * NGW;
            if (it < npairs) { const int pr = it * 4 + sub, row = pr >> 5, hv = pr & 31;
                bf16_t* op = OUT + (size_t)row * 4096 + hv * 128 + ch * 8;
                const u32x4 ov = ovr[q], gv = gvr[q];
                float o[8], g[8]; float ss = 0.f;
#pragma unroll
                for (int k = 0; k < 4; ++k) { o[2 * k] = bflo(ov[k]); o[2 * k + 1] = bfhi(ov[k]); g[2 * k] = bflo(gv[k]); g[2 * k + 1] = bfhi(gv[k]); }
#pragma unroll
                for (int k = 0; k < 8; ++k) ss += o[k] * o[k];
                ss = sum16(ss);
                const float rs = 1.0f / sqrtf(ss * (1.0f / 128.f) + EPS);
                float y[8];
#pragma unroll
                for (int k = 0; k < 8; ++k) y[k] = o[k] * rs * og[k] * siluf(g[k]);
                u32x4 w; w.x = cvt_pk_bf16(y[0], y[1]); w.y = cvt_pk_bf16(y[2], y[3]); w.z = cvt_pk_bf16(y[4], y[5]); w.w = cvt_pk_bf16(y[6], y[7]);
                *(u32x4*)op = w; } }
    }
}

typedef const __attribute__((address_space(4))) Args* KArgsP;
__device__ __forceinline__ KArgsP kargs() { const unsigned long long p0 = (unsigned long long)__builtin_amdgcn_kernarg_segment_ptr(); unsigned lo32 = (unsigned)p0, hi32 = (unsigned)(p0 >> 32);
    asm volatile("" : "+v"(lo32), "+v"(hi32)); lo32 = __builtin_amdgcn_readfirstlane(lo32); hi32 = __builtin_amdgcn_readfirstlane(hi32); return (KArgsP)(((unsigned long long)hi32 << 32) | lo32); }
__device__ __forceinline__ Ctx mkctx(LAS unsigned char* lds, int wv0) { Ctx c; int tid = wv0 * 64 + lane_id(); asm volatile("" : "+v"(tid)); c.lds = lds; c.tid = tid; c.lane = tid & 63; c.wave = __builtin_amdgcn_readfirstlane(tid >> 6); c.G = gridDim.x; c.bid = blockIdx.x; return c; }
#ifndef PHASE_EN
#define PHASE_EN 0xFFFFFFFFu
#endif
#define EN(id) (((PHASE_EN) >> (id)) & 1u)
#ifndef DUP_MASK
#define DUP_MASK 0u
#endif
#define DUP(id) (((DUP_MASK) >> (id)) & 1u)
#ifndef STAMP_ID
#define STAMP_ID (-1)
#endif
#define ST0(id) do { if (STAMP_ID == (id)) st_t0 = __builtin_amdgcn_s_memrealtime(); } while (0)
#define ST1(id) do { if (STAMP_ID == (id)) st_acc += __builtin_amdgcn_s_memrealtime() - st_t0; } while (0)

__global__ void __launch_bounds__(NTHREADS, 2) fwd_kernel(Args args) {
    extern __shared__ __attribute__((aligned(16))) unsigned char lds_raw[];
    LAS unsigned char* const lds = (LAS unsigned char*)lds_raw;
    volatile LAS unsigned* MISC = (volatile LAS unsigned*)(lds + MISC_OFF);
    const int wv0 = __builtin_amdgcn_readfirstlane((int)threadIdx.x >> 6);
    if (wv0 == 0) MISC[lane_id()] = 0u;
    __syncthreads();
    XcdBarrier bar; bar.bar = nullptr; bar.x = 0; bar.st = nullptr; bar.wv = wv0;
    if (N_LAUNCH_MODE == 1) { KArgsP ap = kargs(); bar = xcd_barrier_post((unsigned*)(ap->ws + WS_CTL) + CW_BAR, MISC + 8, wv0); }
    const int lo = args.ph_lo, hi = args.ph_hi;
    int ph = 0;
    unsigned long long st_t0 = 0ull, st_acc = 0ull;
#define PH_IN (ph >= lo && ph < hi)
#define PH_END do { if (PH_IN && ph + 1 < hi) { if (N_LAUNCH_MODE == 1) xcd_barrier(bar); } ++ph; } while (0)

    ST0(0);
    if (EN(0) && PH_IN) { const Ctx c = mkctx(lds, wv0); phase_weights(c, kargs()); if (DUP(0)) { __syncthreads(); phase_weights(c, kargs()); } }
    PH_END;
    ST1(0);

    for (int layer = 0; layer < 4; ++layer) {
        const int kind = layer % 3, j = layer / 3;
        ST0(1);
        if (EN(1) && PH_IN) { const Ctx c = mkctx(lds, wv0); KArgsP ap = kargs(); unsigned char* ws = ap->ws;
            phase_rmsnorm(c, (layer == 0) ? ap->x : (const float*)ap->out, ap->mix_norm + layer * D, (bf16_t*)(ws + WS_H));
            if (DUP(1)) phase_rmsnorm(c, (layer == 0) ? ap->x : (const float*)ap->out, ap->mix_norm + layer * D, (bf16_t*)(ws + WS_H)); }
        PH_END;
        ST1(1);
        if (kind == 0) {
            ST0(2);
            if (EN(2) && PH_IN) { const Ctx c = mkctx(lds, wv0); KArgsP ap = kargs(); unsigned char* ws = ap->ws;
                pg8::Gemm g{(const bf16_t*)(ws + WS_H), (const bf16_t*)(ws + WS_WQKV) + (size_t)j * 6144 * D, T, 6144, D, D, D, 0}; pg8::StaticOrder S; S.init(T, 6144, c.G, c.bid);
                pg8::EpiQkv E{(bf16_t*)(ws + WS_QKV), 6144, (float*)(ws + WS_PART)}; pg8::gemm_phase(c.lds, c.tid, g, S, E); if (DUP(2)) pg8::gemm_phase(c.lds, c.tid, g, S, E); }
            PH_END;
            ST1(2);
            ST0(3);
            if (EN(3) && PH_IN) { const Ctx c = mkctx(lds, wv0); KArgsP ap = kargs(); unsigned char* ws = ap->ws;
                phase_attention3(c, (const bf16_t*)(ws + WS_QKV), (bf16_t*)(ws + WS_AO), (const float*)(ws + WS_PART), ap->att_q_gain + j * AHD, ap->att_k_gain + j * AHD, ap->att_rel_bias + (size_t)j * AH * NREL);
                if (DUP(3)) phase_attention3(c, (const bf16_t*)(ws + WS_QKV), (bf16_t*)(ws + WS_AO), (const float*)(ws + WS_PART), ap->att_q_gain + j * AHD, ap->att_k_gain + j * AHD, ap->att_rel_bias + (size_t)j * AH * NREL); }
            PH_END;
            ST1(3);
            ST0(4);
            if (EN(4) && PH_IN) { const Ctx c = mkctx(lds, wv0); KArgsP ap = kargs(); unsigned char* ws = ap->ws;
                pg8::Gemm g{(const bf16_t*)(ws + WS_AO), (const bf16_t*)(ws + WS_WO) + (size_t)j * D * D, T, D, D, D, D, 0}; pg8::StaticOrder S; S.init(T, D, c.G, c.bid);
                pg8::EpiRes E{(layer == 0) ? ap->x : (const float*)ap->out, ap->out, D, nullptr}; pg8::gemm_phase(c.lds, c.tid, g, S, E);
                if (DUP(4)) { pg8::EpiBf16 E2{(bf16_t*)(ws + WS_H), D}; pg8::gemm_phase(c.lds, c.tid, g, S, E2); } }
            PH_END;
            ST1(4);
        } else if (kind == 1) {
            ST0(5);
            if (EN(5) && PH_IN) { const Ctx c = mkctx(lds, wv0); KArgsP ap = kargs(); unsigned char* ws = ap->ws;
                phase_pool_prep(c, (const bf16_t*)(ws + WS_H), (bf16_t*)(ws + WS_POOLED)); if (DUP(5)) phase_pool_prep(c, (const bf16_t*)(ws + WS_H), (bf16_t*)(ws + WS_POOLED)); }
            PH_END;
            ST1(5);
            ST0(6);
            if (EN(6) && PH_IN) { const Ctx c = mkctx(lds, wv0); KArgsP ap = kargs(); unsigned char* ws = ap->ws;
                pg8::Gemm g{(const bf16_t*)(ws + WS_POOLED), (const bf16_t*)(ws + WS_WPOOL), T, D, 512, D, 512, 2}; pg8::StaticOrder S; S.init(T, D, c.G, c.bid);
                pg8::EpiRes E{ap->out, ap->out, D, ap->pool_scale + j * D}; pg8::gemm_phase(c.lds, c.tid, g, S, E); }
            PH_END;
            ST1(6);
        } else {
            for (int half = 0; half < 2; ++half) {
                ST0(7);
                if (EN(7) && PH_IN) { const Ctx c = mkctx(lds, wv0); KArgsP ap = kargs(); unsigned char* ws = ap->ws;
                    pg8::Gemm g{(const bf16_t*)(ws + WS_H) + (size_t)half * MH * D, (const bf16_t*)(ws + WS_WGIN), MH, GINP, D, D, D, 0}; pg8::StaticOrder S; S.init(MH, GINP, c.G, c.bid);
                    pg8::EpiGdn E{(bf16_t*)(ws + WS_C), (bf16_t*)(ws + WS_GATE), (float*)(ws + WS_AB), ap->gdn_conv, (bf16_t*)(ws + WS_HEAD3), (bf16_t*)(ws + WS_TAIL3)};
                    pg8::gemm_phase(c.lds, c.tid, g, S, E); if (DUP(7)) pg8::gemm_phase(c.lds, c.tid, g, S, E); }
                PH_END;
                ST1(7);
                ST0(9);
                if (EN(9) && PH_IN) { const Ctx c = mkctx(lds, wv0); KArgsP ap = kargs(); unsigned char* ws = ap->ws;
                    phase_gdn_local(c, (bf16_t*)(ws + WS_C), (bf16_t*)(ws + WS_W), (bf16_t*)(ws + WS_ATT), (const float*)(ws + WS_AB), (float*)(ws + WS_GC), (const bf16_t*)(ws + WS_HEAD3), (const bf16_t*)(ws + WS_TAIL3),
                                    ap->gdn_conv, ap->gdn_a_log, ap->gdn_dt_bias); }
                PH_END;
                ST1(9);
                ST0(10);
                if (EN(10) && PH_IN) { const Ctx c = mkctx(lds, wv0); KArgsP ap = kargs(); unsigned char* ws = ap->ws;
                    phase_gdn_scan(c, (const bf16_t*)(ws + WS_W), (bf16_t*)(ws + WS_O), (const bf16_t*)(ws + WS_C), (const bf16_t*)(ws + WS_ATT), (const float*)(ws + WS_GC));
                    if (DUP(10)) phase_gdn_scan(c, (const bf16_t*)(ws + WS_W), (bf16_t*)(ws + WS_O), (const bf16_t*)(ws + WS_C), (const bf16_t*)(ws + WS_ATT), (const float*)(ws + WS_GC)); }
                PH_END;
                ST1(10);
                ST0(11);
                if (EN(11) && PH_IN) { const Ctx c = mkctx(lds, wv0); KArgsP ap = kargs(); unsigned char* ws = ap->ws;
                    phase_gdn_onorm(c, (bf16_t*)(ws + WS_O), (const bf16_t*)(ws + WS_GATE), ap->gdn_o_gain); }
                PH_END;
                ST1(11);
                ST0(12);
                if (EN(12) && PH_IN) { const Ctx c = mkctx(lds, wv0); KArgsP ap = kargs(); unsigned char* ws = ap->ws;
                    pg8::Gemm g{(const bf16_t*)(ws + WS_O), (const bf16_t*)(ws + WS_WGO), MH, D, 4096, 4096, 4096, 0}; pg8::StaticOrder S; S.init(MH, D, c.G, c.bid);
                    pg8::EpiRes E{(const float*)ap->out + (size_t)half * MH * D, ap->out + (size_t)half * MH * D, D, nullptr}; pg8::gemm_phase(c.lds, c.tid, g, S, E); }
                PH_END;
                ST1(12);
            }
        }
        ST0(13);
        if (EN(13) && PH_IN) { const Ctx c = mkctx(lds, wv0); KArgsP ap = kargs(); unsigned char* ws = ap->ws;
            phase_rmsnorm(c, ap->out, ap->ffn_norm + layer * D, (bf16_t*)(ws + WS_H)); if (DUP(13)) phase_rmsnorm(c, ap->out, ap->ffn_norm + layer * D, (bf16_t*)(ws + WS_H)); }
        PH_END;
        ST1(13);
        ST0(14);
        if (EN(14) && PH_IN) { const Ctx c = mkctx(lds, wv0); KArgsP ap = kargs(); unsigned char* ws = ap->ws;
            pg8::Gemm g{(const bf16_t*)(ws + WS_H), (const bf16_t*)(ws + WS_WUP) + (size_t)layer * FF2 * D, T, FF2, D, D, D, 0}; pg8::StaticOrder S; S.init(T, FF2, c.G, c.bid);
            pg8::EpiFfn E{(bf16_t*)(ws + WS_ACT), ap->ffn_conv + (size_t)layer * 3 * FF, (bf16_t*)(ws + WS_TAILU), (bf16_t*)(ws + WS_HEADU), (bf16_t*)(ws + WS_HEADG)};
            pg8::gemm_phase(c.lds, c.tid, g, S, E); if (DUP(14)) pg8::gemm_phase(c.lds, c.tid, g, S, E); }
        PH_END;
        ST1(14);
        ST0(15);
        if (EN(15) && PH_IN) { const Ctx c = mkctx(lds, wv0); KArgsP ap = kargs(); unsigned char* ws = ap->ws;
            phase_ffn_fix(c, (bf16_t*)(ws + WS_ACT), ap->ffn_conv + (size_t)layer * 3 * FF, (const bf16_t*)(ws + WS_TAILU), (const bf16_t*)(ws + WS_HEADU), (const bf16_t*)(ws + WS_HEADG)); }
        PH_END;
        ST1(15);
        ST0(16);
        if (EN(16) && PH_IN) { const Ctx c = mkctx(lds, wv0); KArgsP ap = kargs(); unsigned char* ws = ap->ws;
            pg8::Gemm g{(const bf16_t*)(ws + WS_ACT), (const bf16_t*)(ws + WS_WDN) + (size_t)layer * D * FF, T, D, FF, FF, FF, 0}; pg8::StaticOrder S; S.init(T, D, c.G, c.bid);
            pg8::EpiRes E{ap->out, ap->out, D, nullptr}; pg8::gemm_phase(c.lds, c.tid, g, S, E);
            if (DUP(16)) { pg8::EpiBf16 E2{(bf16_t*)(ws + WS_H), D}; pg8::gemm_phase(c.lds, c.tid, g, S, E2); } }
        PH_END;
        ST1(16);
    }
#undef PH_IN
#undef PH_END
    if (STAMP_ID >= 0 && blockIdx.x == 0 && wv0 == 0 && lane_id() == 0) kargs()->out[0] = (float)st_acc * 0.01f;
}

constexpr int N_PHASES = 1 + 8 + 7 + 15 + 8;

extern "C" void kernel_launch(void* const* d_in, const int* in_sizes, int n_in, void* d_out, int out_size, void* d_ws, size_t ws_size, hipStream_t stream) {
    static int grid = 0;
    if (grid == 0) {
        if (n_in != 19 || out_size != T * D || ws_size < WS_NEED) { fprintf(stderr, "kernel_launch: unexpected problem (n_in %d, out %d, ws %zu, need %zu)\n", n_in, out_size, ws_size, (size_t)WS_NEED); grid = -1; return; }
        int dev = 0, cus = 0, per_cu = 0;
        if (hipGetDevice(&dev) != hipSuccess || hipDeviceGetAttribute(&cus, hipDeviceAttributeMultiprocessorCount, dev) != hipSuccess) { grid = -1; return; }
        if (hipFuncSetAttribute((const void*)fwd_kernel, hipFuncAttributeMaxDynamicSharedMemorySize, LDS_BYTES) != hipSuccess) { fprintf(stderr, "kernel_launch: hipFuncSetAttribute failed\n"); grid = -1; return; }
        if (hipOccupancyMaxActiveBlocksPerMultiprocessor(&per_cu, (const void*)fwd_kernel, NTHREADS, LDS_BYTES) != hipSuccess || per_cu < 1) fprintf(stderr, "kernel_launch: occupancy query says %d\n", per_cu);
        (void)hipGetLastError();
        grid = cus;
    }
    if (grid < 0) return;
    unsigned char* ws = (unsigned char*)d_ws;
    (void)hipMemsetAsync(ws + WS_CTL, 0, CTL_ZERO_BYTES, stream);
    Args a{};
    a.x = (const float*)d_in[0]; a.mix_norm = (const float*)d_in[1]; a.ffn_norm = (const float*)d_in[2];
    a.att_q_gain = (const float*)d_in[4]; a.att_k_gain = (const float*)d_in[5]; a.att_rel_bias = (const float*)d_in[6];
    a.pool_scale = (const float*)d_in[9]; a.gdn_conv = (const float*)d_in[11]; a.gdn_a_log = (const float*)d_in[12]; a.gdn_dt_bias = (const float*)d_in[13];
    a.gdn_o_gain = (const float*)d_in[14]; a.ffn_conv = (const float*)d_in[17];
    a.out = (float*)d_out; a.ws = ws;
    a.wd[0] = WDesc{(const float*)d_in[3],  (bf16_t*)(ws + WS_WQKV), D, 6144, 2, 0};
    a.wd[1] = WDesc{(const float*)d_in[7],  (bf16_t*)(ws + WS_WO),   D, D, 2, 0};
    a.wd[2] = WDesc{(const float*)d_in[8],  (bf16_t*)(ws + WS_WPOOL), 512, 512, 4, 0};
    a.wd[3] = WDesc{(const float*)d_in[10], (bf16_t*)(ws + WS_WGIN), D, GIN, 1, 0};
    a.wd[4] = WDesc{(const float*)d_in[15], (bf16_t*)(ws + WS_WGO),  4096, D, 1, 0};
    a.wd[5] = WDesc{(const float*)d_in[16], (bf16_t*)(ws + WS_WUP),  D, FF2, 4, 1};
    a.wd[6] = WDesc{(const float*)d_in[18], (bf16_t*)(ws + WS_WDN),  FF, D, 4, 0};
    if (N_LAUNCH_MODE == 1) {
        a.ph_lo = 0; a.ph_hi = N_PHASES;
        hipLaunchKernelGGL(fwd_kernel, dim3(grid), dim3(NTHREADS), LDS_BYTES, stream, a);
    } else {
        for (int p = 0; p < N_PHASES; ++p) { a.ph_lo = p; a.ph_hi = p + 1; hipLaunchKernelGGL(fwd_kernel, dim3(grid), dim3(NTHREADS), LDS_BYTES, stream, a); }
    }
}
```

```cpp
#include <hip/hip_runtime.h>
#include <cstdio>
#include <cstdint>

#ifndef N_LAUNCH_MODE
#define N_LAUNCH_MODE 1
#endif

#define LAS __attribute__((address_space(3)))
#define GAS __attribute__((address_space(1)))
typedef unsigned short bf16_t;
typedef short bf16x8 __attribute__((ext_vector_type(8)));
typedef short s16x4 __attribute__((ext_vector_type(4)));
typedef float f32x4 __attribute__((ext_vector_type(4)));
typedef float f32x2 __attribute__((ext_vector_type(2)));
typedef float f32x16 __attribute__((ext_vector_type(16)));
typedef unsigned u32x4 __attribute__((ext_vector_type(4)));
typedef unsigned u32x2 __attribute__((ext_vector_type(2)));

constexpr int D = 2048, BATCH = 4, SEQ = 8192, T = BATCH * SEQ;
constexpr int CH = 64, NCH = SEQ / CH;
constexpr int AH = 16, AHD = 128, NREL = 320;
constexpr int GKH = 16, GVH = 32, GIN = 12352, GINP = 12544;
constexpr int FF = 5504, FF2 = 11008;
constexpr int MH = T / 2;
constexpr float EPS = 1e-6f;
constexpr int NTHREADS = 512, NWAVES = 8;

constexpr size_t MiB = 1u << 20;
constexpr size_t WS_CTL = 0, CTL_ZERO_BYTES = 1 * MiB;
constexpr size_t WS_WQKV = 1 * MiB;
constexpr size_t WS_WO   = WS_WQKV + 48 * MiB;
constexpr size_t WS_WPOOL= WS_WO + 16 * MiB;
constexpr size_t WS_WGIN = WS_WPOOL + 2 * MiB;
constexpr size_t WS_WGO  = WS_WGIN + 49 * MiB;
constexpr size_t WS_WUP  = WS_WGO + 16 * MiB;
constexpr size_t WS_WDN  = WS_WUP + 172 * MiB;
constexpr size_t WS_H    = WS_WDN + 86 * MiB;
constexpr size_t WS_BIG  = WS_H + 128 * MiB;
constexpr size_t WS_QKV  = WS_BIG;
constexpr size_t WS_AO   = WS_QKV + 384 * MiB;
constexpr size_t WS_PART = WS_AO + 128 * MiB;
constexpr size_t WS_ACT  = WS_BIG;
constexpr size_t WS_TAILU = WS_ACT + 344 * MiB;
constexpr size_t WS_HEADU = WS_TAILU + 11 * MiB;
constexpr size_t WS_HEADG = WS_HEADU + 11 * MiB;
constexpr size_t WS_POOLED = WS_BIG;
constexpr size_t WS_C    = WS_BIG;
constexpr size_t WS_GATE = WS_C + 256 * MiB;
constexpr size_t WS_W    = WS_GATE + 128 * MiB;
constexpr size_t WS_O    = WS_W + 128 * MiB;
constexpr size_t WS_ATT  = WS_O + 128 * MiB;
constexpr size_t WS_AB   = WS_ATT + 64 * MiB;
constexpr size_t WS_GC   = WS_AB + 4 * MiB;
constexpr size_t WS_HEAD3 = WS_GC + 2 * MiB;
constexpr size_t WS_TAIL3 = WS_HEAD3 + 13 * MiB;
constexpr size_t WS_END  = WS_TAIL3 + 13 * MiB;
constexpr size_t WS_NEED = WS_BIG + 736 * MiB;
static_assert(WS_END <= WS_NEED && WS_HEADG + 11 * MiB <= WS_NEED && WS_AO + (size_t)T * D * 2 <= WS_NEED, "map");

constexpr int CW_BAR = 4096;

__device__ __forceinline__ float bf2f(unsigned b) { return __uint_as_float(b << 16); }
__device__ __forceinline__ float bflo(unsigned w) { return __uint_as_float(w << 16); }
__device__ __forceinline__ float bfhi(unsigned w) { return __uint_as_float(w & 0xffff0000u); }
__device__ __forceinline__ unsigned cvt_pk_bf16(float lo, float hi) { unsigned r; asm volatile("v_cvt_pk_bf16_f32 %0, %1, %2" : "=v"(r) : "v"(lo), "v"(hi)); return r; }
typedef float f32x2_cv __attribute__((ext_vector_type(2))); typedef __bf16 bf16x2_cv __attribute__((ext_vector_type(2)));
__device__ __forceinline__ unsigned cvt_pk_bf16_op(float lo, float hi) { const f32x2_cv v = {lo, hi}; const bf16x2_cv b = __builtin_convertvector(v, bf16x2_cv); return __builtin_bit_cast(unsigned, b); }
__device__ __forceinline__ unsigned f2bf(float f) { return cvt_pk_bf16(f, 0.f) & 0xffffu; }
__device__ __forceinline__ float wave_sum(float v) {
#pragma unroll
    for (int o = 1; o < 64; o <<= 1) v += __shfl_xor(v, o);
    return v;
}
__device__ __forceinline__ float siluf(float x) { return x * __builtin_amdgcn_rcpf(1.0f + __expf(-x)); }
#define LDS_WAIT() asm volatile("s_waitcnt lgkmcnt(0)" ::: "memory")
#define MFMA_SETTLE() do { __builtin_amdgcn_sched_barrier(0); asm volatile("s_nop 15\n\ts_nop 15\n\ts_nop 15\n\ts_nop 15\n\ts_nop 15" ::: "memory"); __builtin_amdgcn_sched_barrier(0); } while (0)
#define VM_WAIT() asm volatile("s_waitcnt vmcnt(0)" ::: "memory")

namespace pg8 {
constexpr int BM = 256, BK = 64, HALF = 128, HTB = HALF * BK * 2, STAGE_BYTES = 8 * HTB, NXCD = 8, WGM = 8;
__host__ __device__ __forceinline__ int lds_byte(int r, int c) { const int st = (r >> 4) * 2 + (c >> 5), rr = r & 15, cc = c & 31, ob = rr * 64 + cc * 2; return st * 1024 + (ob ^ (((ob >> 9) & 1) << 5)); }
__host__ __device__ __forceinline__ void stage_rc(int b, int& R, int& C) { const int st = b / 1024, sb = b % 1024, swz = sb ^ (((sb >> 9) & 1) << 5); R = (st >> 1) * 16 + swz / 64; C = (st & 1) * 32 + (swz % 64) / 2; }
__host__ __device__ __forceinline__ int perm32(int rho) { const int n = rho >> 4, i = rho & 15; return 8 * (i >> 2) + 4 * n + (i & 3); }

struct Unit { int pm, pn; };
struct Gemm { const bf16_t* A; const bf16_t* Bt; int M, N, K, lda, ldb, grp; };

struct StaticOrder {
    int nM, nN, nwg, G, c;
    __device__ void init(int M, int N, int G_, int c_) { nM = M / BM; nN = N / BM; nwg = nM * nN; G = G_; c = c_; }
    __device__ bool next(int i, Unit& u) const {
        const long L = (long)i * G + c; if (L >= nwg) return false;
        int wgid = (int)L; { const int q = nwg / NXCD, r = nwg % NXCD, xcd = wgid % NXCD, off = wgid / NXCD; wgid = (xcd < r ? xcd * (q + 1) : r * (q + 1) + (xcd - r) * q) + off; }
        const int nig = WGM * nN, gid = wgid / nig, fm = gid * WGM, gsz = (nM - fm) < WGM ? (nM - fm) : WGM;
        u.pm = fm + ((wgid % nig) % gsz); u.pn = (wgid % nig) / gsz; return true;
    }
};

struct EpiBf16 {
    static constexpr bool PERM = true;
    bf16_t* O; int ldc;
    __device__ __forceinline__ void operator()(const f32x4 (&acc)[2][2][4][2], const Unit& u, int wr, int wc, int fr, int fq) const {
        const int row0 = u.pm * BM + wr * 64 + fr, col0 = u.pn * BM + wc * 32 + 8 * fq;
#pragma unroll
        for (int ai = 0; ai < 2; ++ai)
#pragma unroll
            for (int m = 0; m < 4; ++m) { bf16_t* rowp = O + (size_t)(row0 + ai * HALF + m * 16) * ldc + col0;
#pragma unroll
                for (int bj = 0; bj < 2; ++bj) { const f32x4 v0 = acc[ai][bj][m][0], v1 = acc[ai][bj][m][1];
                    u32x4 w; w.x = cvt_pk_bf16(v0[0], v0[1]); w.y = cvt_pk_bf16(v0[2], v0[3]); w.z = cvt_pk_bf16(v1[0], v1[1]); w.w = cvt_pk_bf16(v1[2], v1[3]);
                    *(u32x4*)(rowp + bj * HALF) = w; } }
    }
};
struct EpiQkv {
    static constexpr bool PERM = true;
    bf16_t* O; int ldc; float* PART;
    __device__ __forceinline__ void operator()(const f32x4 (&acc)[2][2][4][2], const Unit& u, int wr, int wc, int fr, int fq) const {
        const int row0 = u.pm * BM + wr * 64 + fr, col0 = u.pn * BM + wc * 32 + 8 * fq;
#pragma unroll
        for (int ai = 0; ai < 2; ++ai)
#pragma unroll
            for (int m = 0; m < 4; ++m) { bf16_t* rowp = O + (size_t)(row0 + ai * HALF + m * 16) * ldc + col0;
#pragma unroll
                for (int bj = 0; bj < 2; ++bj) { const f32x4 v0 = acc[ai][bj][m][0], v1 = acc[ai][bj][m][1];
                    u32x4 w; w.x = cvt_pk_bf16(v0[0], v0[1]); w.y = cvt_pk_bf16(v0[2], v0[3]); w.z = cvt_pk_bf16(v1[0], v1[1]); w.w = cvt_pk_bf16(v1[2], v1[3]);
                    *(u32x4*)(rowp + bj * HALF) = w; } }
        if (u.pn < 16) {
#pragma unroll
            for (int ai = 0; ai < 2; ++ai)
#pragma unroll
                for (int m = 0; m < 4; ++m)
#pragma unroll
                    for (int bj = 0; bj < 2; ++bj) { const f32x4 v0 = acc[ai][bj][m][0], v1 = acc[ai][bj][m][1];
                        float ss = (v0[0] * v0[0] + v0[1] * v0[1]) + (v0[2] * v0[2] + v0[3] * v0[3]) + (v1[0] * v1[0] + v1[1] * v1[1]) + (v1[2] * v1[2] + v1[3] * v1[3]);
                        ss += __shfl_xor(ss, 16); ss += __shfl_xor(ss, 32);
                        if (fq == 0) PART[(((size_t)u.pn * T + (row0 + ai * HALF + m * 16)) * 2 + bj) * 4 + wc] = ss; }
        }
    }
};
template <int CTRL> __device__ __forceinline__ float dpp0(float v) {
    return __builtin_bit_cast(float, __builtin_amdgcn_update_dpp(0, __builtin_bit_cast(int, v), CTRL, 0xf, 0xf, true)); }
#define DEF_FMAC_DPP(NAME, CTRL) __device__ __forceinline__ void NAME(float& a, float src, float w) { asm("v_fmac_f32_dpp %0, %1, %2 " CTRL " row_mask:0xf bank_mask:0xf bound_ctrl:1" : "+v"(a) : "v"(src), "v"(w)); }
DEF_FMAC_DPP(fmac_shr1, "row_shr:1")
DEF_FMAC_DPP(fmac_shr2, "row_shr:2")
DEF_FMAC_DPP(fmac_ror1, "row_ror:1")
DEF_FMAC_DPP(fmac_ror2, "row_ror:2")
DEF_FMAC_DPP(fmac_shr3, "row_shr:3")
DEF_FMAC_DPP(fmac_ror3, "row_ror:3")
#undef DEF_FMAC_DPP
template <int N> __device__ __forceinline__ float dpp_rowprev(float cur, float prevm) {
    const int t = __builtin_amdgcn_update_dpp(0, __builtin_bit_cast(int, prevm), 0x120 + N, 0xf, 0xf, false);
    return __builtin_bit_cast(float, __builtin_amdgcn_update_dpp(t, __builtin_bit_cast(int, cur), 0x110 + N, 0xf, 0xf, false));
}
struct EpiGdn {
    static constexpr bool PERM = true;
    bf16_t* C; bf16_t* GATE; float* AB; const float* cw; bf16_t* HEAD3; bf16_t* TAIL3;
    __device__ __forceinline__ void operator()(const f32x4 (&acc)[2][2][4][2], const Unit& u, int wr, int wc, int fr, int fq) const {
        const int row0 = u.pm * BM + wr * 64 + fr;
        if (u.pn == 48) {
            if (wc < 2) {
#pragma unroll
                for (int ai = 0; ai < 2; ++ai)
#pragma unroll
                    for (int m = 0; m < 4; ++m) { float* rp = AB + (size_t)(row0 + ai * HALF + m * 16) * 64 + wc * 32 + 8 * fq;
                        *(f32x4*)(rp) = acc[ai][0][m][0]; *(f32x4*)(rp + 4) = acc[ai][0][m][1]; }
            }
            return;
        }
        if (u.pn >= 32) {
            const int col0 = (u.pn - 32) * BM + wc * 32 + 8 * fq;
#pragma unroll
            for (int ai = 0; ai < 2; ++ai)
#pragma unroll
                for (int m = 0; m < 4; ++m) { bf16_t* rowp = GATE + (size_t)(row0 + ai * HALF + m * 16) * 4096 + col0;
#pragma unroll
                    for (int bj = 0; bj < 2; ++bj) { const f32x4 v0 = acc[ai][bj][m][0], v1 = acc[ai][bj][m][1];
                        u32x4 w; w.x = cvt_pk_bf16(v0[0], v0[1]); w.y = cvt_pk_bf16(v0[2], v0[3]); w.z = cvt_pk_bf16(v1[0], v1[1]); w.w = cvt_pk_bf16(v1[2], v1[3]);
                        *(u32x4*)(rowp + bj * HALF) = w; } }
            return;
        }
#pragma unroll
        for (int bj = 0; bj < 2; ++bj)
#pragma unroll
            for (int n = 0; n < 2; ++n) {
                const int colc = u.pn * BM + bj * HALF + wc * 32 + 8 * fq + 4 * n;
                const f32x4 w0 = *(const f32x4*)(cw + colc), w1 = *(const f32x4*)(cw + 8192 + colc), w2 = *(const f32x4*)(cw + 2 * 8192 + colc), w3 = *(const f32x4*)(cw + 3 * 8192 + colc);
                f32x4 w0m, w1m, w2m;
#pragma unroll
                for (int k = 0; k < 4; ++k) { w0m[k] = (fr < 3) ? w0[k] : 0.f; w1m[k] = (fr < 2) ? w1[k] : 0.f; w2m[k] = (fr < 1) ? w2[k] : 0.f; }
#pragma unroll
                for (int ai = 0; ai < 2; ++ai) {
                    const int sg = u.pm * 4 + ai * 2 + wr, rowbase = u.pm * BM + ai * HALF + wr * 64;
#pragma unroll
                    for (int m = 0; m < 4; ++m) {
                        float y[4];
#pragma unroll
                        for (int k = 0; k < 4; ++k) {
                            const float cur = acc[ai][bj][m][n][k];
                            float sv = w3[k] * cur;
                            fmac_shr1(sv, cur, w2[k]); fmac_shr2(sv, cur, w1[k]); fmac_shr3(sv, cur, w0[k]);
                            if (m > 0) { const float pv = acc[ai][bj][m > 0 ? m - 1 : 0][n][k];
                                fmac_ror1(sv, pv, w2m[k]); fmac_ror2(sv, pv, w1m[k]); fmac_ror3(sv, pv, w0m[k]); }
                            y[k] = siluf(sv);
                        }
                        if (!(m == 0 && fr < 3)) { u32x2 w; w.x = cvt_pk_bf16(y[0], y[1]); w.y = cvt_pk_bf16(y[2], y[3]);
                            *(u32x2*)(C + (size_t)(rowbase + 16 * m + fr) * 8192 + colc) = w; }
                        if (m == 0 && fr < 3) { const f32x4 u0 = acc[ai][bj][0][n];
                            u32x2 w; w.x = cvt_pk_bf16(u0[0], u0[1]); w.y = cvt_pk_bf16(u0[2], u0[3]);
                            *(u32x2*)(HEAD3 + (size_t)(sg * 3 + fr) * 8192 + colc) = w; }
                        if (m == 3 && fr >= 13) { const f32x4 u0 = acc[ai][bj][3][n];
                            u32x2 w; w.x = cvt_pk_bf16(u0[0], u0[1]); w.y = cvt_pk_bf16(u0[2], u0[3]);
                            *(u32x2*)(TAIL3 + (size_t)(sg * 3 + fr - 13) * 8192 + colc) = w; }
                    }
                }
            }
    }
};
struct EpiRes {
    static constexpr bool PERM = false;
    const float* base; float* out; int ldc; const float* scale;
    __device__ __forceinline__ void operator()(const f32x4 (&acc)[2][2][4][2], const Unit& u, int wr, int wc, int fr, int fq) const {
        const int row0 = u.pm * BM + wr * 64 + fr, col0 = u.pn * BM + wc * 32 + 4 * fq;
        f32x4 sv[2][2];
#pragma unroll
        for (int bj = 0; bj < 2; ++bj)
#pragma unroll
            for (int n = 0; n < 2; ++n) sv[bj][n] = scale ? *(const f32x4*)(scale + col0 + bj * HALF + n * 16) : (f32x4){1.f, 1.f, 1.f, 1.f};
#pragma unroll
        for (int ai = 0; ai < 2; ++ai) {
            f32x4 bs[4][2][2];
#pragma unroll
            for (int m = 0; m < 4; ++m) { const size_t off = (size_t)(row0 + ai * HALF + m * 16) * ldc + col0;
#pragma unroll
                for (int bj = 0; bj < 2; ++bj)
#pragma unroll
                    for (int n = 0; n < 2; ++n) bs[m][bj][n] = *(const f32x4*)(base + off + bj * HALF + n * 16); }
#pragma unroll
            for (int m = 0; m < 4; ++m) { const size_t off = (size_t)(row0 + ai * HALF + m * 16) * ldc + col0;
#pragma unroll
                for (int bj = 0; bj < 2; ++bj)
#pragma unroll
                    for (int n = 0; n < 2; ++n) *(f32x4*)(out + off + bj * HALF + n * 16) = bs[m][bj][n] + acc[ai][bj][m][n] * sv[bj][n]; }
        }
    }
};


struct EpiFfn {
    static constexpr bool PERM = true;
    bf16_t* ACT; const float* cw; bf16_t* TAILU; bf16_t* HEADU; bf16_t* HEADG;
    __device__ __forceinline__ void operator()(const f32x4 (&acc)[2][2][4][2], const Unit& u, int wr, int wc, int fr, int fq) const {
        const int colu = u.pn * 128 + wc * 32 + 8 * fq;
        float w0[8], w1[8], w2[8];
#pragma unroll
        for (int h = 0; h < 2; ++h) { const f32x4 a0 = *(const f32x4*)(cw + colu + 4 * h), a1 = *(const f32x4*)(cw + FF + colu + 4 * h), a2 = *(const f32x4*)(cw + 2 * FF + colu + 4 * h);
#pragma unroll
            for (int k = 0; k < 4; ++k) { w0[4 * h + k] = a0[k]; w1[4 * h + k] = a1[k]; w2[4 * h + k] = a2[k]; } }
        float w1m[8], w0m[8];
#pragma unroll
        for (int k = 0; k < 8; ++k) { w1m[k] = (fr < 1) ? w1[k] : 0.f; w0m[k] = (fr < 2) ? w0[k] : 0.f; }
#pragma unroll
        for (int ai = 0; ai < 2; ++ai) {
            const int sg = u.pm * 4 + ai * 2 + wr, rowbase = u.pm * BM + ai * HALF + wr * 64;
#pragma unroll
            for (int m = 0; m < 4; ++m) {
                float y[8];
#pragma unroll
                for (int n = 0; n < 2; ++n)
#pragma unroll
                    for (int k = 0; k < 4; ++k) {
                        const int ci = 4 * n + k;
                        const float cur = acc[ai][0][m][n][k];
                        float sv = w2[ci] * cur;
                        fmac_shr1(sv, cur, w1[ci]);
                        fmac_shr2(sv, cur, w0[ci]);
                        if (m > 0) { const float pv = acc[ai][0][m > 0 ? m - 1 : 0][n][k];
                            fmac_ror1(sv, pv, w1m[ci]);
                            fmac_ror2(sv, pv, w0m[ci]); }
                        y[ci] = siluf(sv) * acc[ai][1][m][n][k];
                    }
                if (!(m == 0 && fr < 2)) { u32x4 w; w.x = cvt_pk_bf16(y[0], y[1]); w.y = cvt_pk_bf16(y[2], y[3]); w.z = cvt_pk_bf16(y[4], y[5]); w.w = cvt_pk_bf16(y[6], y[7]);
                    *(u32x4*)(ACT + (size_t)(rowbase + 16 * m + fr) * FF + colu) = w; }
                if (m == 0 && fr < 2) {
                    const f32x4 u0 = acc[ai][0][0][0], u1 = acc[ai][0][0][1], g0 = acc[ai][1][0][0], g1 = acc[ai][1][0][1];
                    u32x4 w; w.x = cvt_pk_bf16(u0[0], u0[1]); w.y = cvt_pk_bf16(u0[2], u0[3]); w.z = cvt_pk_bf16(u1[0], u1[1]); w.w = cvt_pk_bf16(u1[2], u1[3]);
                    *(u32x4*)(HEADU + (size_t)(sg * 2 + fr) * FF + colu) = w;
                    w.x = cvt_pk_bf16(g0[0], g0[1]); w.y = cvt_pk_bf16(g0[2], g0[3]); w.z = cvt_pk_bf16(g1[0], g1[1]); w.w = cvt_pk_bf16(g1[2], g1[3]);
                    *(u32x4*)(HEADG + (size_t)(sg * 2 + fr) * FF + colu) = w;
                }
                if (m == 3 && fr >= 14) {
                    const f32x4 u0 = acc[ai][0][3][0], u1 = acc[ai][0][3][1];
                    u32x4 w; w.x = cvt_pk_bf16(u0[0], u0[1]); w.y = cvt_pk_bf16(u0[2], u0[3]); w.z = cvt_pk_bf16(u1[0], u1[1]); w.w = cvt_pk_bf16(u1[2], u1[3]);
                    *(u32x4*)(TAILU + (size_t)(sg * 2 + fr - 14) * FF + colu) = w;
                }
            }
        }
    }
};
template <class Epi, class Sched>
__device__ __forceinline__ void gemm_phase(LAS unsigned char* lds, const int tid, const Gemm g, const Sched& S, const Epi& E) {
    const int wid = __builtin_amdgcn_readfirstlane(tid >> 6), lane = tid & 63, wr = wid >> 2, wc = wid & 3, fr = lane & 15, fq = lane >> 4;
    const int K = g.K, nt = K / BK;
    unsigned voffA[2], voffB[2];
#pragma unroll
    for (int i = 0; i < 2; ++i) { int R, C; stage_rc(tid * 16 + i * 8192, R, C); const int Rb = Epi::PERM ? ((R & ~31) + perm32(R & 31)) : R;
        voffA[i] = (unsigned)(R * g.lda + C) * 2u; voffB[i] = (unsigned)(Rb * g.ldb + C) * 2u; }
    const size_t kstep = (size_t)(BK * 2);
    const size_t hstepA = (size_t)HALF * g.lda * 2, hstepB = (size_t)HALF * g.ldb * 2;
    const size_t tstepA = 2 * hstepA, tstepB = 2 * hstepB;
    const unsigned ldsw = (unsigned)wid * 1024u;
    const int aoff = lds_byte(wr * 64 + fr, fq * 8), boff = lds_byte(wc * 32 + fr, fq * 8);
#define PG8_SA(b, h) (((b) * 2 + (h)) * HTB)
#define PG8_SB(b, h) ((4 + (b) * 2 + (h)) * HTB)
#define PG8_STAGE(bufoff, gbase, voff) do { _Pragma("unroll") for (int _i = 0; _i < 2; ++_i) \
        __builtin_amdgcn_global_load_lds((const unsigned*)((const char*)(gbase) + (voff)[_i]), (LAS unsigned*)(lds + (bufoff) + ldsw + _i * 8192), 16, 0, 0); } while (0)
#define PG8_LDA(dst, b, h) do { _Pragma("unroll") for (int m = 0; m < 4; ++m) _Pragma("unroll") for (int k = 0; k < 2; ++k) dst[m][k] = *(const LAS bf16x8*)(lds + PG8_SA(b, h) + aoff + m * 2048 + k * 1024); } while (0)
#define PG8_LDB(dst, b, h) do { _Pragma("unroll") for (int n = 0; n < 2; ++n) _Pragma("unroll") for (int k = 0; k < 2; ++k) dst[n][k] = *(const LAS bf16x8*)(lds + PG8_SB(b, h) + boff + n * 2048 + k * 1024); } while (0)
#define PG8_MMA(ai, bj, At, Bt) do { __builtin_amdgcn_s_setprio(1); _Pragma("unroll") for (int m = 0; m < 4; ++m) _Pragma("unroll") for (int n = 0; n < 2; ++n) _Pragma("unroll") for (int k = 0; k < 2; ++k) \
        acc[ai][bj][m][n] = __builtin_amdgcn_mfma_f32_16x16x32_bf16(Bt[n][k], At[m][k], acc[ai][bj][m][n], 0, 0, 0); __builtin_amdgcn_s_setprio(0); } while (0)
#define PG8_WAIT_V(n) asm volatile("s_waitcnt vmcnt(" #n ")" ::: "memory")
#define PG8_WAIT_L(n) asm volatile("s_waitcnt lgkmcnt(" #n ")" ::: "memory")
#define PG8_BAR __builtin_amdgcn_s_barrier()
#define PG8_SCHED __builtin_amdgcn_sched_barrier(0)
#define PG8_AOFF(u) ((size_t)(u).pm * tstepA + (g.grp ? (size_t)((u).pn / g.grp) * (size_t)K * 2 : (size_t)0))
    Unit cur, nxt; int ui = 0;
    if (!S.next(0, cur)) return;
    f32x4 acc[2][2][4][2];
#pragma unroll
    for (int a = 0; a < 2; ++a)
#pragma unroll
        for (int b = 0; b < 2; ++b)
#pragma unroll
            for (int m = 0; m < 4; ++m)
#pragma unroll
                for (int n = 0; n < 2; ++n) acc[a][b][m][n] = (f32x4){0.f, 0.f, 0.f, 0.f};
    bf16x8 At[4][2], B0[2][2], B1[2][2];
    const char* cA = (const char*)g.A + PG8_AOFF(cur); const char* cB = (const char*)g.Bt + (size_t)cur.pn * tstepB;
    PG8_STAGE(PG8_SB(0, 0), cB, voffB); PG8_STAGE(PG8_SB(0, 1), cB + hstepB, voffB); PG8_STAGE(PG8_SA(0, 0), cA, voffA); PG8_STAGE(PG8_SA(0, 1), cA + hstepA, voffA);
    if (wr == 1) PG8_BAR;
    PG8_WAIT_V(2); PG8_BAR;
    PG8_STAGE(PG8_SB(1, 0), cB + kstep, voffB); PG8_STAGE(PG8_SA(1, 0), cA + kstep, voffA); PG8_STAGE(PG8_SB(1, 1), cB + hstepB + kstep, voffB);
    PG8_WAIT_V(6); PG8_BAR;
    for (;;) {
        const bool has_next = S.next(ui + 1, nxt);
        const char* nA = has_next ? (const char*)g.A + PG8_AOFF(nxt) : cA; const char* nB = has_next ? (const char*)g.Bt + (size_t)nxt.pn * tstepB : cB;
        for (int t = 0; t < nt; t += 2) {
            const bool last = (t == nt - 2);
            const char* a1 = cA + (size_t)(t + 1) * kstep;
            const char* a2 = last ? nA : cA + (size_t)(t + 2) * kstep; const char* b2 = last ? nB : cB + (size_t)(t + 2) * kstep;
            const char* a3 = a2 + kstep; const char* b3 = b2 + kstep;
            PG8_LDB(B0, 0, 0); PG8_LDB(B1, 0, 1); PG8_SCHED; PG8_LDA(At, 0, 0); PG8_STAGE(PG8_SA(1, 1), a1 + hstepA, voffA);
            PG8_WAIT_V(8); PG8_WAIT_L(0); PG8_BAR; PG8_MMA(0, 0, At, B0); PG8_MMA(0, 1, At, B1); PG8_BAR; PG8_SCHED;
            PG8_LDA(At, 0, 1); PG8_STAGE(PG8_SB(0, 0), b2, voffB); PG8_STAGE(PG8_SB(0, 1), b2 + hstepB, voffB); PG8_STAGE(PG8_SA(0, 0), a2, voffA);
            PG8_WAIT_V(8); PG8_WAIT_L(0); PG8_BAR; PG8_MMA(1, 0, At, B0); PG8_MMA(1, 1, At, B1); PG8_BAR; PG8_SCHED;
            PG8_LDB(B0, 1, 0); PG8_LDB(B1, 1, 1); PG8_SCHED; PG8_LDA(At, 1, 0); PG8_STAGE(PG8_SA(0, 1), a2 + hstepA, voffA);
            PG8_WAIT_V(8); PG8_WAIT_L(0); PG8_BAR; PG8_MMA(0, 0, At, B0); PG8_MMA(0, 1, At, B1); PG8_BAR; PG8_SCHED;
            PG8_LDA(At, 1, 1); PG8_STAGE(PG8_SB(1, 0), b3, voffB); PG8_STAGE(PG8_SB(1, 1), b3 + hstepB, voffB); PG8_STAGE(PG8_SA(1, 0), a3, voffA);
            PG8_WAIT_V(8); PG8_WAIT_L(0); PG8_BAR; PG8_MMA(1, 0, At, B0); PG8_MMA(1, 1, At, B1); PG8_BAR; PG8_SCHED;
        }
        if (wr == 0) PG8_BAR;
        asm volatile("s_nop 15\n\ts_nop 15\n\ts_nop 15" ::: "memory");
        E(acc, cur, wr, wc, fr, fq);
        if (!has_next) break;
#pragma unroll
        for (int a = 0; a < 2; ++a)
#pragma unroll
            for (int b = 0; b < 2; ++b)
#pragma unroll
                for (int m = 0; m < 4; ++m)
#pragma unroll
                    for (int n = 0; n < 2; ++n) acc[a][b][m][n] = (f32x4){0.f, 0.f, 0.f, 0.f};
        cur = nxt; cA = nA; cB = nB; ++ui;
        if (wr == 1) PG8_BAR;
    }
    PG8_WAIT_V(0);
    PG8_BAR;
#undef PG8_SA
#undef PG8_SB
#undef PG8_STAGE
#undef PG8_LDA
#undef PG8_LDB
#undef PG8_MMA
#undef PG8_WAIT_V
#undef PG8_WAIT_L
#undef PG8_BAR
#undef PG8_SCHED
#undef PG8_AOFF
}
}

#define XB_TMO      128
#define XB_XCNT(j)  (256  + 64 * (j))
#define XB_XSUB(j)  (1280 + 64 * (j))
#define XB_XGEN(j)  (2304 + 64 * (j))
#define XB_TOP      3328
#define XB_TOPGEN   3392
#define XCD_BAR_WORDS 3456
#define XB_SPIN_CAP (1u << 18)
__device__ __forceinline__ unsigned xb_ld(unsigned* p)              { return __hip_atomic_load(p, __ATOMIC_RELAXED, __HIP_MEMORY_SCOPE_AGENT); }
__device__ __forceinline__ unsigned xb_add(unsigned* p, unsigned v) { return __hip_atomic_fetch_add(p, v, __ATOMIC_RELAXED, __HIP_MEMORY_SCOPE_AGENT); }
__device__ __forceinline__ unsigned xb_xcc_id() { return (unsigned)__builtin_amdgcn_s_getreg((3 << 11) | 20) & 0xFu; }
#define XB_SPIN(cond, bar) do { unsigned _sp = 0; while (cond) { __builtin_amdgcn_s_sleep(1); \
    if ((++_sp & 255u) == 0u) { if (xb_ld(&(bar)[XB_TMO])) break; if (_sp > XB_SPIN_CAP) { atomicAdd(&(bar)[XB_TMO], 1u); break; } } } } while (0)
__device__ __forceinline__ int lane_id() { return (int)__builtin_amdgcn_mbcnt_hi(~0u, __builtin_amdgcn_mbcnt_lo(~0u, 0u)); }
struct XcdBarrier { unsigned* bar; unsigned x; volatile LAS unsigned* st; int wv; };
__device__ __forceinline__ XcdBarrier xcd_barrier_post(unsigned* bar, volatile LAS unsigned* st, int wv) {
    XcdBarrier b; b.bar = bar; b.x = xb_xcc_id(); b.st = st; b.wv = wv;
    if (b.wv == 0 && lane_id() == 0) (void)xb_add(&bar[XB_XCNT(b.x)], 1u);
    return b;
}
__device__ __forceinline__ void xcd_barrier_complete(unsigned* bar, unsigned x, unsigned& nloc, unsigned& nx) {
    const unsigned G = gridDim.x * gridDim.y * gridDim.z;
    unsigned sum, cnt, mine, sp = 0u;
    for (;;) {
        sum = 0u; cnt = 0u; mine = 0u;
#pragma unroll
        for (unsigned j = 0; j < 16; ++j) { const unsigned c = xb_ld(&bar[XB_XCNT(j)]); sum += c; cnt += (c > 0u) ? 1u : 0u; mine = (j == x) ? c : mine; }
        if (sum == G) break;
        __builtin_amdgcn_s_sleep(1);
        if ((++sp & 255u) == 0u) { if (xb_ld(&bar[XB_TMO])) break; if (sp > XB_SPIN_CAP) { atomicAdd(&bar[XB_TMO], 1u); break; } }
    }
    nloc = mine > 0u ? mine : 1u; nx = cnt > 0u ? cnt : 1u;
}
__device__ __forceinline__ void xcd_barrier(const XcdBarrier& b) {
    asm volatile("s_waitcnt vmcnt(0)" ::: "memory");
    __syncthreads();
    if (b.wv == 0 && lane_id() == 0) {
        unsigned* bar = b.bar;
        __builtin_amdgcn_s_waitcnt(0);
        unsigned nloc = b.st[0], nx = b.st[1];
        if (nloc == 0u) { xcd_barrier_complete(bar, b.x, nloc, nx); b.st[0] = nloc; b.st[1] = nx; }
        const unsigned old = xb_add(&bar[XB_XSUB(b.x)], 1u);
        const unsigned gen = old / nloc;
        if (old + 1u == (gen + 1u) * nloc) {
            __builtin_amdgcn_fence(__ATOMIC_RELEASE, "agent");
            asm volatile("s_waitcnt vmcnt(0)" ::: "memory");
            const unsigned og = xb_add(&bar[XB_TOP], 1u);
            const unsigned tg = og / nx;
            if (og + 1u == (tg + 1u) * nx) xb_add(&bar[XB_TOPGEN], 1u);
            else XB_SPIN(xb_ld(&bar[XB_TOPGEN]) == tg, bar);
            __builtin_amdgcn_fence(__ATOMIC_ACQUIRE, "agent");
            xb_add(&bar[XB_XGEN(b.x)], 1u);
            asm volatile("s_waitcnt vmcnt(0)" ::: "memory");
        } else {
            XB_SPIN(xb_ld(&bar[XB_XGEN(b.x)]) == gen, bar);
            __builtin_amdgcn_fence(__ATOMIC_ACQUIRE, "agent");
            asm volatile("s_waitcnt vmcnt(0)" ::: "memory");
        }
    }
    __syncthreads();
}

constexpr int LDS_BYTES = 163840;
constexpr int MISC_OFF = LDS_BYTES - 256;

struct WDesc { const float* W; bf16_t* WT; int K, N, nmat, pad; };
struct Args {
    const float* x; const float* mix_norm; const float* ffn_norm;
    const float* att_q_gain; const float* att_k_gain; const float* att_rel_bias;
    const float* pool_scale; const float* gdn_conv; const float* gdn_a_log; const float* gdn_dt_bias; const float* gdn_o_gain; const float* ffn_conv;
    float* out; unsigned char* ws;
    WDesc wd[7];
    int ph_lo, ph_hi;
};

struct Ctx { LAS unsigned char* lds; int tid, lane, wave, G, bid; };

__device__ __forceinline__ void transpose_item(const float* W, int K, int N, bf16_t* WT, LAS float* scr, int item, int lane, int mode) {
    const int nblk = N / 64, kb = item / nblk, nb = item % nblk, k0 = 64 * kb, n0 = 64 * nb;
    const int r0 = (mode == 0) ? n0 : ((n0 < FF) ? 256 * (n0 >> 7) + (n0 & 127) : 256 * ((n0 - FF) >> 7) + 128 + ((n0 - FF) & 127));
    f32x4 v[16];
#pragma unroll
    for (int i = 0; i < 16; ++i) v[i] = *(const f32x4*)(W + (size_t)(k0 + 4 * i + (lane >> 4)) * N + n0 + 4 * (lane & 15));
#pragma unroll
    for (int i = 0; i < 16; ++i) *(LAS f32x4*)(scr + (4 * i + (lane >> 4)) * 68 + 4 * (lane & 15)) = v[i];
    LDS_WAIT();
    const int c = lane & 7;
#pragma unroll
    for (int j = 0; j < 8; ++j) { const int n = (lane >> 3) + 8 * j; const LAS float* sp = scr + (8 * c) * 68 + n;
        u32x4 o; o.x = cvt_pk_bf16(sp[0 * 68], sp[1 * 68]); o.y = cvt_pk_bf16(sp[2 * 68], sp[3 * 68]); o.z = cvt_pk_bf16(sp[4 * 68], sp[5 * 68]); o.w = cvt_pk_bf16(sp[6 * 68], sp[7 * 68]);
        *(u32x4*)(WT + (size_t)(r0 + n) * K + k0 + 8 * c) = o; }
    LDS_WAIT();
}
typedef const __attribute__((address_space(4))) struct Args* KArgsP0;
__device__ __forceinline__ void phase_weights(const Ctx& c, KArgsP0 a) {
    LAS float* scr = (LAS float*)(c.lds + c.wave * 17408);
    const int gw = c.bid * NWAVES + c.wave, NGW = c.G * NWAVES;
#pragma unroll
    for (int d = 0; d < 7; ++d) {
        const float* W = a->wd[d].W; bf16_t* WT = a->wd[d].WT; const int K = a->wd[d].K, N = a->wd[d].N, nmat = a->wd[d].nmat, mode = a->wd[d].pad;
        const int per = (K / 64) * (N / 64), tot = per * nmat;
        for (int it = gw; it < tot; it += NGW) { const int mat = it / per, r = it - mat * per;
            transpose_item(W + (size_t)mat * K * N, K, N, WT + (size_t)mat * K * N, scr, r, c.lane, mode); }
    }
    { u32x4* z = (u32x4*)(a->ws + WS_WGIN + (size_t)GIN * D * 2); const int n16 = (GINP - GIN) * D * 2 / 16;
      for (int i = c.bid * NTHREADS + c.tid; i < n16; i += c.G * NTHREADS) z[i] = (u32x4){0u, 0u, 0u, 0u}; }
}

__device__ __forceinline__ void phase_rmsnorm(const Ctx& c, const float* x, const float* gain, bf16_t* out) {
    const int gw = c.bid * NWAVES + c.wave, NGW = c.G * NWAVES;
    f32x4 gv[8];
#pragma unroll
    for (int j = 0; j < 8; ++j) gv[j] = *(const f32x4*)(gain + 4 * c.lane + 256 * j);
    f32x4 v[8], vn[8];
    if (gw < T) {
#pragma unroll
        for (int j = 0; j < 8; ++j) v[j] = ((const f32x4*)(x + (size_t)gw * D) + c.lane)[64 * j];
    }
    for (int m = gw; m < T; m += NGW) {
        const int mn = (m + NGW < T) ? m + NGW : m;
        const f32x4* xn = (const f32x4*)(x + (size_t)mn * D) + c.lane;
#pragma unroll
        for (int j = 0; j < 8; ++j) vn[j] = xn[64 * j];
        float s = 0.f;
#pragma unroll
        for (int j = 0; j < 8; ++j) s += (v[j].x * v[j].x + v[j].y * v[j].y) + (v[j].z * v[j].z + v[j].w * v[j].w);
        const float rstd = 1.0f / sqrtf(wave_sum(s) * (1.0f / D) + EPS);
        u32x2* o8 = (u32x2*)(out + (size_t)m * D) + c.lane;
#pragma unroll
        for (int j = 0; j < 8; ++j) { u32x2 w; w.x = cvt_pk_bf16(v[j].x * rstd * gv[j].x, v[j].y * rstd * gv[j].y); w.y = cvt_pk_bf16(v[j].z * rstd * gv[j].z, v[j].w * rstd * gv[j].w); o8[64 * j] = w; }
#pragma unroll
        for (int j = 0; j < 8; ++j) v[j] = vn[j];
    }
}
__device__ __forceinline__ void phase_ffn_fix(const Ctx& c, bf16_t* ACT, const float* cw, const bf16_t* TAILU, const bf16_t* HEADU, const bf16_t* HEADG) {
    constexpr int NCG = FF / 8, NS = T / 64;
    for (int it = c.bid * NTHREADS + c.tid; it < NS * NCG; it += c.G * NTHREADS) {
        const int sg = it / NCG, cg = it - sg * NCG, col = cg * 8; const bool first = ((sg * 64) % SEQ) == 0;
        float w0[8], w1[8], w2[8], um2[8], um1[8], u0[8], u1[8], g0[8], g1[8];
#pragma unroll
        for (int h = 0; h < 2; ++h) { const f32x4 a0 = *(const f32x4*)(cw + col + 4 * h), a1 = *(const f32x4*)(cw + FF + col + 4 * h), a2 = *(const f32x4*)(cw + 2 * FF + col + 4 * h);
#pragma unroll
            for (int k = 0; k < 4; ++k) { w0[4 * h + k] = a0[k]; w1[4 * h + k] = a1[k]; w2[4 * h + k] = a2[k]; } }
        const u32x4 hu0 = *(const u32x4*)(HEADU + (size_t)(sg * 2) * FF + col), hu1 = *(const u32x4*)(HEADU + (size_t)(sg * 2 + 1) * FF + col);
        const u32x4 hg0 = *(const u32x4*)(HEADG + (size_t)(sg * 2) * FF + col), hg1 = *(const u32x4*)(HEADG + (size_t)(sg * 2 + 1) * FF + col);
        u32x4 t0 = (u32x4){0u, 0u, 0u, 0u}, t1 = t0;
        if (!first) { t0 = *(const u32x4*)(TAILU + (size_t)(sg * 2 - 2) * FF + col); t1 = *(const u32x4*)(TAILU + (size_t)(sg * 2 - 1) * FF + col); }
#pragma unroll
        for (int k = 0; k < 4; ++k) { um2[2 * k] = bflo(t0[k]); um2[2 * k + 1] = bfhi(t0[k]); um1[2 * k] = bflo(t1[k]); um1[2 * k + 1] = bfhi(t1[k]);
            u0[2 * k] = bflo(hu0[k]); u0[2 * k + 1] = bfhi(hu0[k]); u1[2 * k] = bflo(hu1[k]); u1[2 * k + 1] = bfhi(hu1[k]);
            g0[2 * k] = bflo(hg0[k]); g0[2 * k + 1] = bfhi(hg0[k]); g1[2 * k] = bflo(hg1[k]); g1[2 * k + 1] = bfhi(hg1[k]); }
        float y0[8], y1[8];
#pragma unroll
        for (int k = 0; k < 8; ++k) { y0[k] = siluf(w0[k] * um2[k] + w1[k] * um1[k] + w2[k] * u0[k]) * g0[k]; y1[k] = siluf(w0[k] * um1[k] + w1[k] * u0[k] + w2[k] * u1[k]) * g1[k]; }
        u32x4 o; o.x = cvt_pk_bf16(y0[0], y0[1]); o.y = cvt_pk_bf16(y0[2], y0[3]); o.z = cvt_pk_bf16(y0[4], y0[5]); o.w = cvt_pk_bf16(y0[6], y0[7]);
        *(u32x4*)(ACT + (size_t)(sg * 64) * FF + col) = o;
        o.x = cvt_pk_bf16(y1[0], y1[1]); o.y = cvt_pk_bf16(y1[2], y1[3]); o.z = cvt_pk_bf16(y1[4], y1[5]); o.w = cvt_pk_bf16(y1[6], y1[7]);
        *(u32x4*)(ACT + (size_t)(sg * 64 + 1) * FF + col) = o;
    }
}

__device__ __forceinline__ void phase_pool_prep(const Ctx& c, const bf16_t* H, bf16_t* P) {
    constexpr int NCG = D / 8, RB = 64;
    const int nitems = (T / RB) * NCG;
    for (int it = c.bid * NTHREADS + c.tid; it < nitems; it += c.G * NTHREADS) {
        const int rb = it / NCG, cg = it - rb * NCG, t0 = rb * RB, col = cg * 8, w = 2 << (col >> 9), tp0 = t0 % SEQ;
        float s[8];
#pragma unroll
        for (int k = 0; k < 8; ++k) s[k] = 0.f;
        for (int i = 1; i <= w; ++i) if (tp0 - i >= 0) {   const u32x4 a = *(const u32x4*)(H + (size_t)(t0 - i) * D + col);
#pragma unroll
            for (int k = 0; k < 4; ++k) { s[2 * k] += bflo(a[k]); s[2 * k + 1] += bfhi(a[k]); } }
        for (int tb = t0; tb < t0 + RB; tb += 8) {
            u32x4 ar[8], br[8];
#pragma unroll
            for (int q = 0; q < 8; ++q) { const int t = tb + q, tp = tp0 + (t - t0);
                ar[q] = *(const u32x4*)(H + (size_t)t * D + col);
                br[q] = (tp >= w) ? *(const u32x4*)(H + (size_t)(t - w) * D + col) : (u32x4){0u, 0u, 0u, 0u}; }
#pragma unroll
            for (int q = 0; q < 8; ++q) { const int t = tb + q, tp = tp0 + (t - t0);
                const u32x4 a = ar[q], b = br[q];
                float cu[8];
#pragma unroll
                for (int k = 0; k < 4; ++k) { cu[2 * k] = bflo(a[k]); cu[2 * k + 1] = bfhi(a[k]); }
#pragma unroll
                for (int k = 0; k < 8; ++k) s[k] += cu[k];
#pragma unroll
                for (int k = 0; k < 4; ++k) { s[2 * k] -= bflo(b[k]); s[2 * k + 1] -= bfhi(b[k]); }
                const float inv = 1.0f / (float)(tp + 1 < w ? tp + 1 : w);
                u32x4 o; o.x = cvt_pk_bf16(s[0] * inv - cu[0], s[1] * inv - cu[1]); o.y = cvt_pk_bf16(s[2] * inv - cu[2], s[3] * inv - cu[3]);
                o.z = cvt_pk_bf16(s[4] * inv - cu[4], s[5] * inv - cu[5]); o.w = cvt_pk_bf16(s[6] * inv - cu[6], s[7] * inv - cu[7]);
                *(u32x4*)(P + (size_t)t * D + col) = o;
            }
        }
    }
}

constexpr int ATT_ROWB = 272;
constexpr int ATT_WAVE_BYTES = 2 * 32 * ATT_ROWB + NREL * 4;
static_assert(ATT_WAVE_BYTES * NWAVES <= MISC_OFF, "attention LDS");
__device__ __forceinline__ void phase_attention(const Ctx& c, const bf16_t* QKV, bf16_t* O, const float* q_gain, const float* k_gain, const float* rel_bias) {
    LAS unsigned char* Kt = c.lds + c.wave * ATT_WAVE_BYTES;
    LAS unsigned char* Vt = Kt + 32 * ATT_ROWB;
    LAS float* bias = (LAS float*)(Vt + 32 * ATT_ROWB);
    const int lane = c.lane, l31 = lane & 31, hh = lane >> 5;
    const int gw = c.bid * NWAVES + c.wave, NGW = c.G * NWAVES;
    constexpr int NU = BATCH * NCH * AH * 2;
    const float scale = 0.08838834764831845f;
    float kg[8];
    { const int ch = lane & 15; const f32x4 a = *(const f32x4*)(k_gain + ch * 8), b = *(const f32x4*)(k_gain + ch * 8 + 4);
#pragma unroll
      for (int k = 0; k < 4; ++k) { kg[k] = a[k]; kg[4 + k] = b[k]; } }
    for (int u = gw; u < NU; u += NGW) {
        const int qh = u & 1, h = (u >> 1) & 15, ck = (u >> 5) & 127, b = u >> 12;
        const size_t row_q0 = (size_t)b * SEQ + (size_t)ck * CH + qh * 32;
        for (int i = lane; i < NREL; i += 64) bias[i] = rel_bias[h * NREL + i];
        bf16x8 qf[8];
        {
            float qv[8][8]; float ss = 0.f;
            const bf16_t* qp = QKV + (row_q0 + l31) * 6144 + h * AHD + hh * 8;
#pragma unroll
            for (int ks = 0; ks < 8; ++ks) { const u32x4 a = *(const u32x4*)(qp + ks * 16);
#pragma unroll
                for (int k = 0; k < 4; ++k) { qv[ks][2 * k] = bflo(a[k]); qv[ks][2 * k + 1] = bfhi(a[k]); }
#pragma unroll
                for (int k = 0; k < 8; ++k) ss += qv[ks][k] * qv[ks][k]; }
            ss += __shfl_xor(ss, 32);
            const float rq = scale / sqrtf(ss * (1.0f / AHD) + EPS);
#pragma unroll
            for (int ks = 0; ks < 8; ++ks) { const f32x4 g0 = *(const f32x4*)(q_gain + ks * 16 + hh * 8), g1 = *(const f32x4*)(q_gain + ks * 16 + hh * 8 + 4);
                u32x4 w; w.x = cvt_pk_bf16(qv[ks][0] * rq * g0[0], qv[ks][1] * rq * g0[1]); w.y = cvt_pk_bf16(qv[ks][2] * rq * g0[2], qv[ks][3] * rq * g0[3]);
                w.z = cvt_pk_bf16(qv[ks][4] * rq * g1[0], qv[ks][5] * rq * g1[1]); w.w = cvt_pk_bf16(qv[ks][6] * rq * g1[2], qv[ks][7] * rq * g1[3]);
                qf[ks] = __builtin_bit_cast(bf16x8, w); }
        }
        float mrun = -1e30f, lsum = 0.f;
        f32x16 oacc[4];
#pragma unroll
        for (int dt = 0; dt < 4; ++dt)
#pragma unroll
            for (int r = 0; r < 16; ++r) oacc[dt][r] = 0.f;
        const int qi = qh * 32 + l31;
        const int kt_first = (ck >= 8) ? 0 : 2 * (8 - ck);
        for (int kt = kt_first; kt < 18; ++kt) {
            const int kj0 = kt * 32;
            const size_t krow0 = (size_t)b * SEQ + (size_t)((ck - 8) * CH + kj0);
            {
                const int ch = lane & 15, rr = lane >> 4;
#pragma unroll
                for (int i = 0; i < 8; ++i) {
                    const int row = rr + 4 * i;
                    const bf16_t* kp = QKV + (krow0 + row) * 6144 + 2048 + h * AHD + ch * 8;
                    const u32x4 a = *(const u32x4*)kp, vv = *(const u32x4*)(kp + 2048);
                    float kv[8]; float ss = 0.f;
#pragma unroll
                    for (int k = 0; k < 4; ++k) { kv[2 * k] = bflo(a[k]); kv[2 * k + 1] = bfhi(a[k]); }
#pragma unroll
                    for (int k = 0; k < 8; ++k) ss += kv[k] * kv[k];
                    ss += __shfl_xor(ss, 1); ss += __shfl_xor(ss, 2); ss += __shfl_xor(ss, 4); ss += __shfl_xor(ss, 8);
                    const float rk = 1.0f / sqrtf(ss * (1.0f / AHD) + EPS);
                    u32x4 w; w.x = cvt_pk_bf16(kv[0] * rk * kg[0], kv[1] * rk * kg[1]); w.y = cvt_pk_bf16(kv[2] * rk * kg[2], kv[3] * rk * kg[3]);
                    w.z = cvt_pk_bf16(kv[4] * rk * kg[4], kv[5] * rk * kg[5]); w.w = cvt_pk_bf16(kv[6] * rk * kg[6], kv[7] * rk * kg[7]);
                    *(LAS u32x4*)(Kt + row * ATT_ROWB + ch * 16) = w;
                    *(LAS u32x4*)(Vt + row * ATT_ROWB + ch * 16) = vv;
                }
            }
            LDS_WAIT();
            f32x16 st;
#pragma unroll
            for (int r = 0; r < 16; ++r) st[r] = 0.f;
#pragma unroll
            for (int ks = 0; ks < 8; ++ks) { const bf16x8 kf = *(const LAS bf16x8*)(Kt + l31 * ATT_ROWB + ks * 32 + hh * 16);
                st = __builtin_amdgcn_mfma_f32_32x32x16_bf16(kf, qf[ks], st, 0, 0, 0); }
            float mt = -1e30f;
#pragma unroll
            for (int r = 0; r < 16; ++r) { const int kj = kj0 + (r & 3) + 8 * (r >> 2) + 4 * hh; int idx = 575 + qi - kj; idx = idx > 319 ? 319 : idx; st[r] += bias[idx]; mt = fmaxf(mt, st[r]); }
            mt = fmaxf(mt, __shfl_xor(mt, 32));
            const float mnew = fmaxf(mrun, mt), alpha = __expf(mrun - mnew);
            mrun = mnew;
            float ps = 0.f;
#pragma unroll
            for (int r = 0; r < 16; ++r) { st[r] = __expf(st[r] - mnew); ps += st[r]; }
            lsum = lsum * alpha + ps;
#pragma unroll
            for (int dt = 0; dt < 4; ++dt)
#pragma unroll
                for (int r = 0; r < 16; ++r) oacc[dt][r] *= alpha;
            bf16x8 pf[2];
#pragma unroll
            for (int s = 0; s < 2; ++s) { u32x4 w; w.x = cvt_pk_bf16(st[8 * s + 0], st[8 * s + 1]); w.y = cvt_pk_bf16(st[8 * s + 2], st[8 * s + 3]); w.z = cvt_pk_bf16(st[8 * s + 4], st[8 * s + 5]); w.w = cvt_pk_bf16(st[8 * s + 6], st[8 * s + 7]);
                pf[s] = __builtin_bit_cast(bf16x8, w); }
            {
                const int i16 = lane & 15, g1 = (lane >> 4) & 1;
                LAS unsigned char* vb = Vt + (4 * hh + (i16 >> 2)) * ATT_ROWB + (16 * g1 + 4 * (i16 & 3)) * 2;
#pragma unroll
                for (int dt = 0; dt < 4; ++dt)
#pragma unroll
                    for (int s = 0; s < 2; ++s) {
                        const s16x4 lo = __builtin_bit_cast(s16x4, __builtin_amdgcn_ds_read_tr16_b64_v4i16((LAS s16x4*)(vb + (16 * s) * ATT_ROWB + dt * 64)));
                        const s16x4 hi = __builtin_bit_cast(s16x4, __builtin_amdgcn_ds_read_tr16_b64_v4i16((LAS s16x4*)(vb + (16 * s + 8) * ATT_ROWB + dt * 64)));
                        const bf16x8 vf = (bf16x8){lo[0], lo[1], lo[2], lo[3], hi[0], hi[1], hi[2], hi[3]};
                        oacc[dt] = __builtin_amdgcn_mfma_f32_32x32x16_bf16(vf, pf[s], oacc[dt], 0, 0, 0);
                    }
            }
            LDS_WAIT();
        }
        lsum += __shfl_xor(lsum, 32);
        const float inv = 1.0f / lsum;
        bf16_t* op = O + (row_q0 + l31) * D + h * AHD + 4 * hh;
#pragma unroll
        for (int dt = 0; dt < 4; ++dt)
#pragma unroll
            for (int g = 0; g < 4; ++g) { u32x2 w; w.x = cvt_pk_bf16(oacc[dt][4 * g] * inv, oacc[dt][4 * g + 1] * inv); w.y = cvt_pk_bf16(oacc[dt][4 * g + 2] * inv, oacc[dt][4 * g + 3] * inv);
                *(u32x2*)(op + dt * 32 + g * 8) = w; }
        LDS_WAIT();
    }
}

constexpr int AT_SLOT = 32768, AT_BIAS = 4 * AT_SLOT, AT_NB = 640, AT_RK = AT_BIAS + AT_NB * 4, AT_END = AT_RK + 768 * 4;
static_assert(AT_END <= MISC_OFF, "attention LDS");
__device__ __forceinline__ void glds16(const void* gsrc, unsigned lds_dst) { unsigned keep;
    asm volatile("s_mov_b32 %0, m0\n\ts_mov_b32 m0, %2\n\ts_nop 0\n\tglobal_load_lds_dwordx4 %1, off\n\ts_mov_b32 m0, %0" : "=&s"(keep) : "v"(gsrc), "s"(lds_dst) : "memory"); }
__device__ __forceinline__ void phase_attention3(const Ctx& c, const bf16_t* QKV, bf16_t* O, const float* PART, const float* q_gain, const float* k_gain, const float* rel_bias) {
    LAS unsigned char* lds = c.lds;
    const unsigned lds0 = (unsigned)(size_t)lds;
    LAS float* bias = (LAS float*)(lds + AT_BIAS);
    LAS float* rkt = (LAS float*)(lds + AT_RK);
    const int lane = c.lane, w = c.wave, l31 = lane & 31, hh = lane >> 5, i16 = lane & 15, g1 = (lane >> 4) & 1;
    const int wo = w >> 1, qi = 32 * (w & 1) + l31;
    const int fr = ((l31 & 3) << 2) | ((l31 >> 2) & 3);
    constexpr float LOG2E = 1.4426950408889634f;
    constexpr int NU = BATCH * 32 * AH;
    for (int u = c.bid; u < NU; u += c.G) {
        const int h = u & 15, cq = (u >> 4) & 31, b = u >> 9;
        const int jf = (cq >= 2) ? 0 : 8 - 4 * cq;
        const bf16_t* ksrc[2];
#pragma unroll
        for (int pp = 0; pp < 2; ++pp) { const int row = 8 * w + 4 * pp + (lane >> 4), chl = (lane & 15) ^ (((row & 3) << 2) | ((row >> 2) & 3));
            ksrc[pp] = QKV + ((size_t)b * SEQ + (size_t)((4 * cq - 8) * CH + row)) * 6144 + 2048 + h * AHD + chl * 8; }
#define AT_DMA(j) do { const unsigned sl_ = lds0 + (unsigned)(((j) & 3) * AT_SLOT) + (unsigned)(2 * w) * 1024u; const size_t to_ = (size_t)(j) * CH * 6144; \
            glds16(ksrc[0] + to_, sl_); glds16(ksrc[1] + to_, sl_ + 1024u); glds16(ksrc[0] + to_ + 2048, sl_ + 16384u); glds16(ksrc[1] + to_ + 2048, sl_ + 16384u + 1024u); } while (0)
        AT_DMA(jf); AT_DMA(jf + 1); AT_DMA(jf + 2);
        for (int i = c.tid; i < AT_NB; i += NTHREADS) bias[i] = rel_bias[h * NREL + (i < NREL - 1 ? i : NREL - 1)] * LOG2E;
        for (int i = c.tid; i < 768; i += NTHREADS) { const int kr = (4 * cq - 8) * CH + i;
            if (kr >= 0) { const f32x4 p = *(const f32x4*)(PART + (((size_t)(8 + (h >> 1)) * T + ((size_t)b * SEQ + kr)) * 2 + (h & 1)) * 4); rkt[i] = 1.0f / sqrtf(((p[0] + p[1]) + (p[2] + p[3])) * (1.0f / AHD) + EPS); } }
        bf16x8 qf[8];
        { const size_t qrow = (size_t)b * SEQ + 256 * cq + 32 * w + l31;
          const f32x4 pq = *(const f32x4*)(PART + (((size_t)(h >> 1) * T + qrow) * 2 + (h & 1)) * 4);
          const float rq = 0.08838834764831845f * LOG2E / sqrtf(((pq[0] + pq[1]) + (pq[2] + pq[3])) * (1.0f / AHD) + EPS);
          const bf16_t* qp = QKV + qrow * 6144 + h * AHD + hh * 8;
#pragma unroll
          for (int ks = 0; ks < 8; ++ks) { const u32x4 a = *(const u32x4*)(qp + ks * 16);
              const f32x4 gq0 = *(const f32x4*)(q_gain + ks * 16 + hh * 8), gq1 = *(const f32x4*)(q_gain + ks * 16 + hh * 8 + 4), gk0 = *(const f32x4*)(k_gain + ks * 16 + hh * 8), gk1 = *(const f32x4*)(k_gain + ks * 16 + hh * 8 + 4);
              u32x4 wv; wv.x = cvt_pk_bf16_op(bflo(a.x) * rq * gq0[0] * gk0[0], bfhi(a.x) * rq * gq0[1] * gk0[1]); wv.y = cvt_pk_bf16_op(bflo(a.y) * rq * gq0[2] * gk0[2], bfhi(a.y) * rq * gq0[3] * gk0[3]);
              wv.z = cvt_pk_bf16_op(bflo(a.z) * rq * gq1[0] * gk1[0], bfhi(a.z) * rq * gq1[1] * gk1[1]); wv.w = cvt_pk_bf16_op(bflo(a.w) * rq * gq1[2] * gk1[2], bfhi(a.w) * rq * gq1[3] * gk1[3]);
              qf[ks] = __builtin_bit_cast(bf16x8, wv); } }
        __builtin_amdgcn_s_waitcnt(0);
#pragma unroll
        for (int ks = 0; ks < 8; ++ks) asm volatile("" : "+v"(qf[ks]));
        __syncthreads();
        float mrun = -1e30f, lsum = 0.f;
        f32x16 oacc[4];
#pragma unroll
        for (int dt = 0; dt < 4; ++dt)
#pragma unroll
            for (int r = 0; r < 16; ++r) oacc[dt][r] = 0.f;
        for (int j = jf; j < 12; ++j) {
            if (j <= 9) asm volatile("s_waitcnt vmcnt(8)\n\ts_barrier" ::: "memory");
            else if (j == 10) asm volatile("s_waitcnt vmcnt(4)\n\ts_barrier" ::: "memory");
            else asm volatile("s_waitcnt vmcnt(0)\n\ts_barrier" ::: "memory");
            if (j + 3 < 12) AT_DMA(j + 3);
            if (j >= wo && j <= wo + 8) {
                const LAS unsigned char* Kt = lds + (j & 3) * AT_SLOT; const LAS unsigned char* Vt = Kt + 16384;
                const int bp = j - wo;
                f32x16 st[2];
#pragma unroll
                for (int k2 = 0; k2 < 2; ++k2)
#pragma unroll
                    for (int r = 0; r < 16; ++r) st[k2][r] = 0.f;
                {
                    bf16x8 kfa[8], kfb[8];
#pragma unroll
                    for (int ks = 0; ks < 8; ++ks) { kfa[ks] = *(const LAS bf16x8*)(Kt + 256 * l31 + 16 * ((2 * ks + hh) ^ fr)); kfb[ks] = *(const LAS bf16x8*)(Kt + 256 * (32 + l31) + 16 * ((2 * ks + hh) ^ fr)); }
                    __builtin_amdgcn_sched_barrier(0);
#pragma unroll
                    for (int ks = 0; ks < 8; ++ks) { st[0] = __builtin_amdgcn_mfma_f32_32x32x16_bf16(kfa[ks], qf[ks], st[0], 0, 0, 0); st[1] = __builtin_amdgcn_mfma_f32_32x32x16_bf16(kfb[ks], qf[ks], st[1], 0, 0, 0); }
                }
                float mt = -1e30f;
                {
                    const LAS float* rkp = rkt + 64 * j + 4 * hh;
                    const LAS float* bp_ = bias + (575 + qi - 64 * bp - 4 * hh - 59);
#pragma unroll
                    for (int k2 = 0; k2 < 2; ++k2) {
                        f32x4 rkv[4]; float bv[16];
#pragma unroll
                        for (int g = 0; g < 4; ++g) rkv[g] = *(const LAS f32x4*)(rkp + 32 * k2 + 8 * g);
#pragma unroll
                        for (int r = 0; r < 16; ++r) bv[r] = bp_[59 - (32 * k2 + (r & 3) + 8 * (r >> 2))];
                        __builtin_amdgcn_sched_barrier(0);
                        if (k2 == 0) asm volatile("s_nop 15\n\ts_nop 15\n\ts_nop 15" ::: "memory");
#pragma unroll
                        for (int r = 0; r < 16; ++r) { st[k2][r] = st[k2][r] * rkv[r >> 2][r & 3] + bv[r]; mt = fmaxf(mt, st[k2][r]); }
                        __builtin_amdgcn_sched_barrier(0);
                    }
                }
                mt = fmaxf(mt, __shfl_xor(mt, 32));
                if (__builtin_amdgcn_ballot_w64(mt > mrun + 8.0f) != 0ull) {
                    const float mnew = (mt > mrun + 8.0f) ? mt : mrun, alpha = __builtin_amdgcn_exp2f(mrun - mnew);
                    mrun = mnew; lsum *= alpha;
#pragma unroll
                    for (int dt = 0; dt < 4; ++dt)
#pragma unroll
                        for (int r = 0; r < 16; ++r) oacc[dt][r] *= alpha;
                }
                float ps = 0.f;
#pragma unroll
                for (int k2 = 0; k2 < 2; ++k2)
#pragma unroll
                    for (int r = 0; r < 16; ++r) { st[k2][r] = __builtin_amdgcn_exp2f(st[k2][r] - mrun); ps += st[k2][r]; }
                lsum += ps;
                bf16x8 pf[4];
#pragma unroll
                for (int s = 0; s < 4; ++s) { const f32x16& sv = st[s >> 1]; const int o8 = 8 * (s & 1);
                    u32x4 wv; wv.x = cvt_pk_bf16_op(sv[o8 + 0], sv[o8 + 1]); wv.y = cvt_pk_bf16_op(sv[o8 + 2], sv[o8 + 3]); wv.z = cvt_pk_bf16_op(sv[o8 + 4], sv[o8 + 5]); wv.w = cvt_pk_bf16_op(sv[o8 + 6], sv[o8 + 7]);
                    pf[s] = __builtin_bit_cast(bf16x8, wv); }
                const int q4 = i16 >> 2, p4 = i16 & 3;
#pragma unroll
                for (int sp = 0; sp < 2; ++sp) {
                    s16x4 lo[2][4], hi[2][4];
#pragma unroll
                    for (int s2 = 0; s2 < 2; ++s2) { const int s = 2 * sp + s2, rlo = 16 * s + 4 * hh + q4, flo = (q4 << 2) | hh, fhi = (q4 << 2) | (hh + 2);
#pragma unroll
                        for (int dt = 0; dt < 4; ++dt) { const int chl = 4 * dt + 2 * g1 + (p4 >> 1);
                            lo[s2][dt] = __builtin_bit_cast(s16x4, __builtin_amdgcn_ds_read_tr16_b64_v4i16((LAS s16x4*)(Vt + 256 * rlo + 16 * (chl ^ flo) + 8 * (p4 & 1))));
                            hi[s2][dt] = __builtin_bit_cast(s16x4, __builtin_amdgcn_ds_read_tr16_b64_v4i16((LAS s16x4*)(Vt + 256 * (rlo + 8) + 16 * (chl ^ fhi) + 8 * (p4 & 1)))); } }
                    __builtin_amdgcn_sched_barrier(0);
#pragma unroll
                    for (int s2 = 0; s2 < 2; ++s2)
#pragma unroll
                        for (int dt = 0; dt < 4; ++dt) { const bf16x8 vf = (bf16x8){lo[s2][dt][0], lo[s2][dt][1], lo[s2][dt][2], lo[s2][dt][3], hi[s2][dt][0], hi[s2][dt][1], hi[s2][dt][2], hi[s2][dt][3]};
                            oacc[dt] = __builtin_amdgcn_mfma_f32_32x32x16_bf16(vf, pf[2 * sp + s2], oacc[dt], 0, 0, 0); }
                    __builtin_amdgcn_sched_barrier(0);
                }
            }
        }
#undef AT_DMA
        MFMA_SETTLE();
        lsum += __shfl_xor(lsum, 32);
        const float inv = 1.0f / lsum;
        bf16_t* op = O + ((size_t)b * SEQ + 256 * cq + 32 * w + l31) * D + h * AHD + 4 * hh;
#pragma unroll
        for (int dt = 0; dt < 4; ++dt)
#pragma unroll
            for (int g = 0; g < 4; ++g) { u32x2 wv; wv.x = cvt_pk_bf16(oacc[dt][4 * g] * inv, oacc[dt][4 * g + 1] * inv); wv.y = cvt_pk_bf16(oacc[dt][4 * g + 2] * inv, oacc[dt][4 * g + 3] * inv);
                *(u32x2*)(op + dt * 32 + g * 8) = wv; }
        asm volatile("s_waitcnt vmcnt(0) lgkmcnt(0)" ::: "memory");
        __syncthreads();
    }
}

constexpr int G2_QS = 0, G2_KS = 17408, G2_VS = 34816, G2_KK = G2_VS + 64 * 528, G2_QK = G2_KK + 64 * 65 * 4, G2_AT = G2_QK + 64 * 65 * 4, G2_GC = G2_AT + 2 * 64 * 64 * 4, G2_BETA = G2_GC + 512, G2_END = G2_BETA + 512;
constexpr int G2_TI = G2_END, G2_FBW = G2_TI + 8192, G2_END2 = G2_FBW + 512;
static_assert(G2_END2 <= MISC_OFF && (G2_AT % 16) == 0 && (G2_TI % 16) == 0, "G2 LDS");
#define G2_CL16(x) ((x) < 0 ? 0 : ((x) > 16 ? 16 : (x)))
#define G2_ORD(j) (4 * ((j) < 15 ? (j) : 15) + 3 * G2_CL16((j) - 15) + 2 * G2_CL16((j) - 31) + G2_CL16((j) - 47))
#define G2_SUBST_LOOP(SG_LO, SG_HI) \
_Pragma("unroll") \
            for (int sg = SG_LO; sg < SG_HI; ++sg) { \
                const int j = sg >> 2, cq = sg & 3, lo = ((j + 1) >> 2) + 4 * cq; \
                if (lo < 16) { \
                    const int ord = G2_ORD(j) + cq; \
                    const bool m1 = (lo + 4 < 16);  const int j1 = m1 ? j : j + 1,   l1 = m1 ? lo + 4 : ((j + 2) >> 2); \
                    const bool m2 = (l1 + 4 < 16);  const int j2 = m2 ? j1 : j1 + 1, l2 = m2 ? l1 + 4 : ((j1 + 2) >> 2); \
                    if (j2 < 63) { \
_Pragma("unroll") \
                        for (int g = 0; g < 4; ++g) if (l2 + g < 16) cb[(ord + 2) % 3][g] = *(const LAS f32x4*)(Ae + j2 * 64 + 4 * (l2 + g)); \
                    } \
                    __builtin_amdgcn_sched_barrier(0); \
                    const float xu = ru[j], xw = rw[j]; \
_Pragma("unroll") \
                    for (int g = 0; g < 4; ++g) if (lo + g < 16) { const f32x4 a = cb[ord % 3][g]; const int r_ = 4 * (lo + g); \
                        ru[r_ + 0] -= a[0] * xu; ru[r_ + 1] -= a[1] * xu; ru[r_ + 2] -= a[2] * xu; ru[r_ + 3] -= a[3] * xu; \
                        rw[r_ + 0] -= a[0] * xw; rw[r_ + 1] -= a[1] * xw; rw[r_ + 2] -= a[2] * xw; rw[r_ + 3] -= a[3] * xw; } \
                    __builtin_amdgcn_sched_barrier(0); \
                } \
            }

__device__ __forceinline__ void phase_gdn_local(const Ctx& c, bf16_t* C, bf16_t* W, bf16_t* ATT, const float* AB, float* GC, const bf16_t* HEAD3, const bf16_t* TAIL3, const float* cw, const float* a_log, const float* dt_bias) {
    LAS unsigned char* lds = c.lds;
    LAS float* KKs = (LAS float*)(lds + G2_KK); LAS float* QKs = (LAS float*)(lds + G2_QK); LAS float* At = (LAS float*)(lds + G2_AT);
    LAS float* gcs = (LAS float*)(lds + G2_GC); LAS float* betas = (LAS float*)(lds + G2_BETA);
    LAS float* TI = (LAS float*)(lds + G2_TI); LAS float* fbw = (LAS float*)(lds + G2_FBW);
    const int wave = c.wave;
    constexpr int NUNITS = (MH / CH) * GKH;
    u32x4 pQ[2], pK[2], pV[4]; float pcw[4]; unsigned short ph3[3], pt3[3]; float pav = 0.f, pbv = 0.f;
#define G2_PREFETCH(un_) do { int tp_ = c.tid; asm volatile("" : "+v"(tp_)); const int hk_ = (un_) & 15, cg_ = (un_) >> 4, r0_ = cg_ * CH; \
        _Pragma("unroll") for (int i = 0; i < 2; ++i) { const int idx = tp_ + i * 512, row = idx >> 4, ch = idx & 15; \
            pQ[i] = *(const u32x4*)(C + (size_t)(r0_ + row) * 8192 + hk_ * 128 + ch * 8); pK[i] = *(const u32x4*)(C + (size_t)(r0_ + row) * 8192 + 2048 + hk_ * 128 + ch * 8); } \
        _Pragma("unroll") for (int i = 0; i < 4; ++i) { const int idx = tp_ + i * 512, row = idx >> 5, ch = idx & 31; \
            pV[i] = *(const u32x4*)(C + (size_t)(r0_ + row) * 8192 + 4096 + hk_ * 256 + ch * 8); } \
        { const int chg = (tp_ < 128) ? hk_ * 128 + tp_ : (tp_ < 256) ? 2048 + hk_ * 128 + (tp_ - 128) : 4096 + hk_ * 256 + (tp_ - 256); \
          _Pragma("unroll") for (int q = 0; q < 4; ++q) pcw[q] = cw[q * 8192 + chg]; \
          _Pragma("unroll") for (int q = 0; q < 3; ++q) { ph3[q] = HEAD3[(size_t)(cg_ * 3 + q) * 8192 + chg]; pt3[q] = ((r0_ % SEQ) != 0) ? TAIL3[(size_t)(cg_ * 3 - 3 + q) * 8192 + chg] : (unsigned short)0; } } \
        if (tp_ < 128) { const int hv_ = 2 * hk_ + (tp_ >> 6), ln_ = tp_ & 63; pav = AB[(size_t)(r0_ + ln_) * 64 + hv_]; pbv = AB[(size_t)(r0_ + ln_) * 64 + 32 + hv_]; } } while (0)
    if (c.bid < NUNITS) G2_PREFETCH(c.bid);
    for (int u = c.bid; u < NUNITS; u += c.G) {
        int tid = c.tid; asm volatile("" : "+v"(tid));
        const int lane = tid & 63, l31 = lane & 31, hh = lane >> 5;
        const int hk = u & 15, cg = u >> 4, r0 = cg * CH;
#pragma unroll
        for (int i = 0; i < 2; ++i) { const int idx = tid + i * 512, row = idx >> 4, ch = idx & 15;
            if (row >= 3) { *(LAS u32x4*)(lds + G2_QS + row * 272 + ch * 16) = pQ[i]; *(LAS u32x4*)(lds + G2_KS + row * 272 + ch * 16) = pK[i]; } }
#pragma unroll
        for (int i = 0; i < 4; ++i) { const int idx = tid + i * 512, row = idx >> 5, ch = idx & 31;
            if (row >= 3) *(LAS u32x4*)(lds + G2_VS + row * 528 + ch * 16) = pV[i]; }
        {
            const float w0 = pcw[0], w1 = pcw[1], w2 = pcw[2], w3 = pcw[3];
            const float h0 = bf2f(ph3[0]), h1 = bf2f(ph3[1]), h2 = bf2f(ph3[2]), t0 = bf2f(pt3[0]), t1 = bf2f(pt3[1]), t2 = bf2f(pt3[2]);
            const float y0 = siluf(w0 * t0 + w1 * t1 + w2 * t2 + w3 * h0), y1 = siluf(w0 * t1 + w1 * t2 + w2 * h0 + w3 * h1), y2 = siluf(w0 * t2 + w1 * h0 + w2 * h1 + w3 * h2);
            LAS unsigned char* dst = (tid < 128) ? lds + G2_QS + tid * 2 : (tid < 256) ? lds + G2_KS + (tid - 128) * 2 : lds + G2_VS + (tid - 256) * 2;
            const int rs = (tid < 256) ? 272 : 528;
            *(LAS bf16_t*)(dst) = (bf16_t)f2bf(y0); *(LAS bf16_t*)(dst + rs) = (bf16_t)f2bf(y1); *(LAS bf16_t*)(dst + 2 * rs) = (bf16_t)f2bf(y2);
        }
        if (wave < 2) {
            const int hv = 2 * hk + wave;
            const float z = pav + dt_bias[hv];
            const float sp = z > 20.f ? z : log1pf(__expf(z));
            float g = -__expf(a_log[hv]) * sp;
#pragma unroll
            for (int o = 1; o < 64; o <<= 1) { const float t = __shfl_up(g, o); if (lane >= o) g += t; }
            gcs[wave * 64 + lane] = g; betas[wave * 64 + lane] = 1.0f / (1.0f + __expf(-pbv));
            GC[(size_t)hv * MH + r0 + lane] = g;
        }
        __syncthreads();
#pragma unroll
        for (int it = 0; it < 4; ++it) {
            const int rt = it * 32 + wave * 4 + (lane >> 4), tile = rt >> 6, row = rt & 63, ch = lane & 15;
            LAS unsigned char* p = lds + (tile ? G2_KS : G2_QS) + row * 272 + ch * 16;
            const u32x4 a = *(const LAS u32x4*)p;
            float x[8]; float ss = 0.f;
#pragma unroll
            for (int k = 0; k < 4; ++k) { x[2 * k] = bflo(a[k]); x[2 * k + 1] = bfhi(a[k]); }
#pragma unroll
            for (int k = 0; k < 8; ++k) ss += x[k] * x[k];
            ss += __shfl_xor(ss, 1); ss += __shfl_xor(ss, 2); ss += __shfl_xor(ss, 4); ss += __shfl_xor(ss, 8);
            const float rr = (tile ? 1.0f : 0.08838834764831845f) / sqrtf(ss + EPS);
            u32x4 w; w.x = cvt_pk_bf16(x[0] * rr, x[1] * rr); w.y = cvt_pk_bf16(x[2] * rr, x[3] * rr); w.z = cvt_pk_bf16(x[4] * rr, x[5] * rr); w.w = cvt_pk_bf16(x[6] * rr, x[7] * rr);
            *(LAS u32x4*)p = w;
            if (tile == 0) *(u32x4*)(C + (size_t)(r0 + row) * 8192 + hk * 128 + ch * 8) = w;
        }
        __syncthreads();
        {
            const int mat = wave >> 2, ti = (wave >> 1) & 1, tj = wave & 1;
            LAS unsigned char* xa = lds + (mat ? G2_QS : G2_KS) + (32 * ti + l31) * 272 + hh * 16;
            LAS unsigned char* xb = lds + G2_KS + (32 * tj + l31) * 272 + hh * 16;
            f32x16 acc;
#pragma unroll
            for (int r = 0; r < 16; ++r) acc[r] = 0.f;
#pragma unroll
            for (int ks = 0; ks < 8; ++ks) acc = __builtin_amdgcn_mfma_f32_32x32x16_bf16(*(const LAS bf16x8*)(xa + ks * 32), *(const LAS bf16x8*)(xb + ks * 32), acc, 0, 0, 0);
            MFMA_SETTLE();
            const int j = 32 * tj + l31;
            if (mat == 0) {
                if (ti >= tj) {
#pragma unroll
                    for (int e = 0; e < 2; ++e) { const float gj = gcs[e * 64 + j];
#pragma unroll
                        for (int g = 0; g < 4; ++g) { const int i0 = 32 * ti + 8 * g + 4 * hh;
                            const f32x4 gi = *(const LAS f32x4*)(gcs + e * 64 + i0), bi = *(const LAS f32x4*)(betas + e * 64 + i0);
#pragma unroll
                            for (int q = 0; q < 4; ++q) { const int i = i0 + q;
                                At[e * 4096 + i * 64 + j] = (i > j) ? -bi[q] * acc[4 * g + q] * __expf(gi[q] - gj) : 0.f; } } }
                } else {
                    fbw[lane] = betas[lane] * __expf(gcs[lane]); fbw[64 + lane] = betas[64 + lane] * __expf(gcs[64 + lane]);
                }
            } else {
#pragma unroll
                for (int e = 0; e < 2; ++e) { const float gj = gcs[e * 64 + j];
                    bf16_t* ap = ATT + ((size_t)(cg * 32 + 2 * hk + e) * 64) * 64 + j;
#pragma unroll
                    for (int g = 0; g < 4; ++g) { const int i0 = 32 * ti + 8 * g + 4 * hh;
                        const f32x4 gi = *(const LAS f32x4*)(gcs + e * 64 + i0);
#pragma unroll
                        for (int q = 0; q < 4; ++q) { const int i = i0 + q;
                            const float v = (i >= j) ? acc[4 * g + q] * __expf(gi[q] - gj) : 0.f;
                            ap[(size_t)i * 64] = (bf16_t)f2bf(v); } } }
            }
        }
        __syncthreads();
        { const int un = (u + c.G < NUNITS) ? u + c.G : u; G2_PREFETCH(un); }
        if (wave < 2) {
            const int e = tid >> 6, b = (tid >> 4) & 3, cc = tid & 15;
            const LAS float* An = At + e * 4096 + (16 * b) * 64 + 16 * b;
            float x[16];
#pragma unroll
            for (int r = 0; r < 16; ++r) x[r] = (r == cc) ? 1.f : 0.f;
#pragma unroll
            for (int r = 1; r < 16; ++r) {
                float acc = x[r];
#pragma unroll
                for (int k4 = 0; k4 < (r + 3) / 4; ++k4) { const f32x4 a = *(const LAS f32x4*)(An + r * 64 + 4 * k4);
#pragma unroll
                    for (int q = 0; q < 4; ++q) if (4 * k4 + q < r) acc += a[q] * x[4 * k4 + q]; }
                x[r] = acc;
            }
#pragma unroll
            for (int r = 0; r < 16; ++r) TI[((e * 4 + b) * 16 + r) * 16 + cc] = x[r];
        } else if (wave >= 4) {
            const int t2 = tid - 256;
#pragma unroll
            for (int p = 0; p < 2; ++p) {
                const int t3 = t2 + 256 * p, dk = t3 >> 2, ib = (t3 & 3) * 16;
                unsigned wv[8];
#pragma unroll
                for (int q = 0; q < 8; ++q) { const unsigned lo = *(const LAS bf16_t*)(lds + G2_KS + (ib + 2 * q) * 272 + dk * 2), hi = *(const LAS bf16_t*)(lds + G2_KS + (ib + 2 * q + 1) * 272 + dk * 2); wv[q] = lo | (hi << 16); }
                bf16_t* kp = C + (size_t)(r0 + (dk >> 1)) * 8192 + 2048 + hk * 128 + (dk & 1) * 64 + ib;
                *(u32x4*)(kp) = (u32x4){wv[0], wv[1], wv[2], wv[3]}; *(u32x4*)(kp + 8) = (u32x4){wv[4], wv[5], wv[6], wv[7]};
            }
        }
        __syncthreads();
        {
            const int e = wave >> 2, fr = lane & 15, fq = lane >> 4, hv = 2 * hk + e, ct0 = (wave & 1) * 4;
            const bool isw = (wave & 2) != 0;
            f32x4 ti[4], an[6];
#pragma unroll
            for (int b = 0; b < 4; ++b) ti[b] = *(const LAS f32x4*)(TI + ((e * 4 + b) * 16 + fr) * 16 + 4 * fq);
            an[0] = *(const LAS f32x4*)(At + e * 4096 + (16 + fr) * 64 + 0 + 4 * fq);
            an[1] = *(const LAS f32x4*)(At + e * 4096 + (32 + fr) * 64 + 0 + 4 * fq);  an[2] = *(const LAS f32x4*)(At + e * 4096 + (32 + fr) * 64 + 16 + 4 * fq);
            an[3] = *(const LAS f32x4*)(At + e * 4096 + (48 + fr) * 64 + 0 + 4 * fq);  an[4] = *(const LAS f32x4*)(At + e * 4096 + (48 + fr) * 64 + 16 + 4 * fq);
            an[5] = *(const LAS f32x4*)(At + e * 4096 + (48 + fr) * 64 + 32 + 4 * fq);
            f32x4 R[4][4], X[4][4];
#pragma unroll
            for (int b = 0; b < 4; ++b) { const f32x4 fac = *(const LAS f32x4*)((isw ? fbw : betas) + e * 64 + 16 * b + 4 * fq);
#pragma unroll
                for (int t = 0; t < 4; ++t) { const int col = 16 * (ct0 + t) + fr;
#pragma unroll
                    for (int q = 0; q < 4; ++q) { const int i = 16 * b + 4 * fq + q;
                        const unsigned short raw = isw ? *(const LAS bf16_t*)(lds + G2_KS + i * 272 + col * 2) : *(const LAS bf16_t*)(lds + G2_VS + i * 528 + (e * 128 + col) * 2);
                        R[t][b][q] = fac[q] * bf2f(raw); } } }
#define G2_MM(dst, av, bv) do { _Pragma("unroll") for (int q = 0; q < 4; ++q) dst = __builtin_amdgcn_mfma_f32_16x16x4f32(av[q], bv[q], dst, 0, 0, 0); } while (0)
#pragma unroll
            for (int t = 0; t < 4; ++t) { X[t][0] = (f32x4){0.f, 0.f, 0.f, 0.f}; G2_MM(X[t][0], ti[0], R[t][0]); }
#pragma unroll
            for (int t = 0; t < 4; ++t) G2_MM(R[t][1], an[0], X[t][0]);
#pragma unroll
            for (int t = 0; t < 4; ++t) { X[t][1] = (f32x4){0.f, 0.f, 0.f, 0.f}; G2_MM(X[t][1], ti[1], R[t][1]); }
#pragma unroll
            for (int t = 0; t < 4; ++t) { G2_MM(R[t][2], an[1], X[t][0]); G2_MM(R[t][2], an[2], X[t][1]); }
#pragma unroll
            for (int t = 0; t < 4; ++t) { X[t][2] = (f32x4){0.f, 0.f, 0.f, 0.f}; G2_MM(X[t][2], ti[2], R[t][2]); }
#pragma unroll
            for (int t = 0; t < 4; ++t) { G2_MM(R[t][3], an[3], X[t][0]); G2_MM(R[t][3], an[4], X[t][1]); G2_MM(R[t][3], an[5], X[t][2]); }
#pragma unroll
            for (int t = 0; t < 4; ++t) { X[t][3] = (f32x4){0.f, 0.f, 0.f, 0.f}; G2_MM(X[t][3], ti[3], R[t][3]); }
#undef G2_MM
            MFMA_SETTLE();
            if (!isw) {
#pragma unroll
                for (int t = 0; t < 4; ++t) { const int dv = 16 * (ct0 + t) + fr;
                    bf16_t* up = C + (size_t)(r0 + (dv >> 1)) * 8192 + 4096 + hv * 128 + (dv & 1) * 64 + 4 * fq;
#pragma unroll
                    for (int b = 0; b < 4; ++b) { u32x2 w; w.x = cvt_pk_bf16(X[t][b][0], X[t][b][1]); w.y = cvt_pk_bf16(X[t][b][2], X[t][b][3]); *(u32x2*)(up + 16 * b) = w; } }
            } else {
#pragma unroll
                for (int t = 0; t < 4; ++t) { bf16_t* wp = W + (size_t)(r0 + 4 * fq) * 4096 + hv * 128 + 16 * (ct0 + t) + fr;
#pragma unroll
                    for (int b = 0; b < 4; ++b)
#pragma unroll
                        for (int q = 0; q < 4; ++q) wp[(size_t)(16 * b + q) * 4096] = (bf16_t)f2bf(X[t][b][q]); }
            }
        }
        __syncthreads();
    }
}

#undef G2_PREFETCH
constexpr int G3_W = 0, G3_Q = 17408, G3_KT = 34816, G3_A = G3_KT + 128 * 144, G3_UT = G3_A + 64 * 144, G3_GCB = G3_UT + 32 * 144, G3_BUF = G3_GCB + 512;
static_assert(2 * G3_BUF <= MISC_OFF, "G3 LDS");
__device__ __forceinline__ void g3_wperm(LAS unsigned char* rowp, int cidx, u32x4 v) {
    LAS unsigned char* p = rowp + (cidx >> 2) * 64 + (((cidx & 1) << 2) + ((cidx >> 1) & 1)) * 8;
    *(LAS u32x2*)p = (u32x2){v.x, v.y}; *(LAS u32x2*)(p + 16) = (u32x2){v.z, v.w};
}
__device__ __forceinline__ void g3_stage(LAS unsigned char* buf, const bf16_t* PROJ, const bf16_t* C, const bf16_t* ATT, const float* GC, int cgl, int hv, int dq, int t, int nt) {
    const size_t r0 = (size_t)cgl * CH; const int hk = hv >> 1;
    for (int i = t; i < 1024; i += nt) { const int row = i >> 4, ch = i & 15;
        g3_wperm(buf + G3_W + row * 272, ch, *(const u32x4*)(PROJ + (r0 + row) * 4096 + hv * 128 + ch * 8));
        g3_wperm(buf + G3_Q + row * 272, ch, *(const u32x4*)(C + (r0 + row) * 8192 + hk * 128 + ch * 8)); }
    for (int i = t; i < 1024; i += nt) { const int rr = i >> 4, ch = i & 15, dk = 2 * rr + (ch >> 3);
        g3_wperm(buf + G3_KT + dk * 144, ch & 7, *(const u32x4*)(C + (r0 + rr) * 8192 + 2048 + hk * 128 + ch * 8)); }
    for (int i = t; i < 512; i += nt) { const int row = i >> 3, ch = i & 7;
        g3_wperm(buf + G3_A + row * 144, ch, *(const u32x4*)(ATT + ((size_t)(cgl * 32 + hv) * 64 + row) * 64 + ch * 8)); }
    for (int i = t; i < 256; i += nt) { const int rr = i >> 4, ch = i & 15, dvl = 2 * rr + (ch >> 3);
        *(LAS u32x4*)(buf + G3_UT + dvl * 144 + (ch & 7) * 16) = *(const u32x4*)(C + (r0 + 16 * dq + rr) * 8192 + 4096 + hv * 128 + ch * 8); }
    if (t < 64) { const float gct = GC[(size_t)hv * MH + r0 + t], gl = GC[(size_t)hv * MH + r0 + 63];
        *(LAS float*)(buf + G3_GCB + t * 4) = __expf(gct); *(LAS float*)(buf + G3_GCB + 256 + t * 4) = __expf(gl - gct); }
}
__device__ __forceinline__ bf16x8 pack8(const f32x16& v, int s) {
    u32x4 w; w.x = cvt_pk_bf16_op(v[8 * s + 0], v[8 * s + 1]); w.y = cvt_pk_bf16_op(v[8 * s + 2], v[8 * s + 3]); w.z = cvt_pk_bf16_op(v[8 * s + 4], v[8 * s + 5]); w.w = cvt_pk_bf16_op(v[8 * s + 6], v[8 * s + 7]);
    return __builtin_bit_cast(bf16x8, w);
}
__device__ __forceinline__ bf16x8 ld2x8(const LAS unsigned char* p) {
    const u32x2 a = *(const LAS u32x2*)p, b = *(const LAS u32x2*)(p + 16);
    return __builtin_bit_cast(bf16x8, (u32x4){a.x, a.y, b.x, b.y});
}
__device__ __forceinline__ u32x4 gld16(const void* p) { u32x4 r; asm volatile("global_load_dwordx4 %0, %1, off" : "=v"(r) : "v"(p) : "memory"); return r; }
__device__ __forceinline__ float gld4(const void* p) { float r; asm volatile("global_load_dword %0, %1, off" : "=v"(r) : "v"(p) : "memory"); return r; }
#define G3_BAR() asm volatile("s_waitcnt lgkmcnt(0)\n\ts_barrier" ::: "memory")
__device__ __forceinline__ bf16x8 ldfrag(const LAS unsigned char* rowp, int s32, int fq) {
    return *(const LAS bf16x8*)(rowp + s32 * 64 + fq * 16);
}
__device__ __forceinline__ bf16x8 pack44(const f32x4& lo, const f32x4& hi) {
    u32x4 w; w.x = cvt_pk_bf16_op(lo[0], lo[1]); w.y = cvt_pk_bf16_op(lo[2], lo[3]); w.z = cvt_pk_bf16_op(hi[0], hi[1]); w.w = cvt_pk_bf16_op(hi[2], hi[3]);
    return __builtin_bit_cast(bf16x8, w);
}
__device__ __forceinline__ void phase_gdn_scan(const Ctx& c, const bf16_t* PROJ  , bf16_t* OUT, const bf16_t* C, const bf16_t* ATT, const float* GC) {
    LAS unsigned char* lds = c.lds;
    constexpr int NITEMS = 2 * GVH * 4;
    for (int wi = c.bid; wi < NITEMS; wi += c.G) {
        int tid = c.tid; asm volatile("" : "+v"(tid));
        const int xslot = wi >> 3, grp = (wi & 7) * 8 + (xslot >> 2), bl = grp >> 5, hv = grp & 31, dq = xslot & 3;
        g3_stage(lds, PROJ, C, ATT, GC, bl * NCH, hv, dq, tid, NTHREADS);
        __syncthreads();
        if (c.wave >= 2) {
            int t2 = c.tid; asm volatile("" : "+v"(t2));
            const int hk = hv >> 1;
#define G3_CLAMP(x) ((x) < NCH ? (x) : NCH - 1)
#define G3_LOOP2(LD_, WR_) do { LD_(sa, bl * NCH + 1); LD_(sb, bl * NCH + 2); \
                for (int ch = 0; ch < NCH; ch += 2) { \
                    asm volatile("s_sleep 8" ::: "memory"); WR_(sa, lds + G3_BUF); LD_(sa, bl * NCH + G3_CLAMP(ch + 3)); G3_BAR(); \
                    asm volatile("s_sleep 8" ::: "memory"); WR_(sb, lds); LD_(sb, bl * NCH + G3_CLAMP(ch + 4)); G3_BAR(); } \
                asm volatile("s_waitcnt vmcnt(0)" ::: "memory"); } while (0)
            if (c.wave <= 5) {
                const int l4 = t2 - 128, row0 = l4 >> 4, ch16 = l4 & 15;
                struct S3 { u32x4 W[4], Q[4], K[4]; }; S3 sa, sb;
#define G3_LD3(P, cgl_) do { const size_t r0_ = (size_t)(cgl_) * CH; _Pragma("unroll") for (int j = 0; j < 4; ++j) { const int row = row0 + 16 * j; \
                    P.W[j] = gld16(PROJ + (r0_ + row) * 4096 + hv * 128 + ch16 * 8); \
                    P.Q[j] = gld16(C + (r0_ + row) * 8192 + hk * 128 + ch16 * 8); \
                    P.K[j] = gld16(C + (r0_ + row) * 8192 + 2048 + hk * 128 + ch16 * 8); } } while (0)
#define G3_WR3(P, nb_) do { asm volatile("s_waitcnt vmcnt(12)" : "+v"(P.W[0]), "+v"(P.W[1]), "+v"(P.W[2]), "+v"(P.W[3]), "+v"(P.Q[0]), "+v"(P.Q[1]), "+v"(P.Q[2]), "+v"(P.Q[3]), \
                                                                  "+v"(P.K[0]), "+v"(P.K[1]), "+v"(P.K[2]), "+v"(P.K[3]) :: "memory"); \
                _Pragma("unroll") for (int j = 0; j < 4; ++j) { const int row = row0 + 16 * j; \
                    g3_wperm((nb_) + G3_W + row * 272, ch16, P.W[j]); \
                    g3_wperm((nb_) + G3_Q + row * 272, ch16, P.Q[j]); \
                    g3_wperm((nb_) + G3_KT + (2 * row + (ch16 >> 3)) * 144, ch16 & 7, P.K[j]); } } while (0)
                G3_LOOP2(G3_LD3, G3_WR3);
#undef G3_LD3
#undef G3_WR3
            } else if (c.wave == 6) {
                const int l2 = t2 - 384, row0 = l2 >> 3, ch8 = l2 & 7;
                struct S1 { u32x4 A[8]; }; S1 sa, sb;
#define G3_LD1(P, cgl_) do { _Pragma("unroll") for (int j = 0; j < 8; ++j) P.A[j] = gld16(ATT + ((size_t)((cgl_) * 32 + hv) * 64 + row0 + 8 * j) * 64 + ch8 * 8); } while (0)
#define G3_WR1(P, nb_) do { asm volatile("s_waitcnt vmcnt(8)" : "+v"(P.A[0]), "+v"(P.A[1]), "+v"(P.A[2]), "+v"(P.A[3]), "+v"(P.A[4]), "+v"(P.A[5]), "+v"(P.A[6]), "+v"(P.A[7]) :: "memory"); \
                _Pragma("unroll") for (int j = 0; j < 8; ++j) g3_wperm((nb_) + G3_A + (row0 + 8 * j) * 144, ch8, P.A[j]); } while (0)
                G3_LOOP2(G3_LD1, G3_WR1);
#undef G3_LD1
#undef G3_WR1
            } else {
                const int l1 = t2 - 448, rr0 = l1 >> 4, ch16 = l1 & 15;
                struct SU { u32x4 U[4]; float g0, g1; }; SU sa, sb;
#define G3_LDU(P, cgl_) do { const size_t r0_ = (size_t)(cgl_) * CH; _Pragma("unroll") for (int j = 0; j < 4; ++j) P.U[j] = gld16(C + (r0_ + 16 * dq + rr0 + 4 * j) * 8192 + 4096 + hv * 128 + ch16 * 8); \
                    P.g0 = gld4(GC + (size_t)hv * MH + r0_ + l1); P.g1 = gld4(GC + (size_t)hv * MH + r0_ + 63); } while (0)
#define G3_WRU(P, nb_) do { asm volatile("s_waitcnt vmcnt(6)" : "+v"(P.U[0]), "+v"(P.U[1]), "+v"(P.U[2]), "+v"(P.U[3]), "+v"(P.g0), "+v"(P.g1) :: "memory"); \
                _Pragma("unroll") for (int j = 0; j < 4; ++j) *(LAS u32x4*)((nb_) + G3_UT + (2 * (rr0 + 4 * j) + (ch16 >> 3)) * 144 + (ch16 & 7) * 16) = P.U[j]; \
                    *(LAS float*)((nb_) + G3_GCB + l1 * 4) = __expf(P.g0); *(LAS float*)((nb_) + G3_GCB + 256 + l1 * 4) = __expf(P.g1 - P.g0); } while (0)
                G3_LOOP2(G3_LDU, G3_WRU);
#undef G3_LDU
#undef G3_WRU
            }
#undef G3_LOOP2
#undef G3_CLAMP
        } else {
            const int p = c.wave;
            f32x4 Sacc[8];
#pragma unroll
            for (int T8 = 0; T8 < 8; ++T8) Sacc[T8] = (f32x4){0.f, 0.f, 0.f, 0.f};
            bf16x8 Sb[4];
#pragma unroll
            for (int s4 = 0; s4 < 4; ++s4) Sb[s4] = pack44(Sacc[2 * s4], Sacc[2 * s4 + 1]);
            for (int ch = 0; ch < NCH; ++ch) {
                int ln = c.tid & 63; asm volatile("" : "+v"(ln));
                const int fr = ln & 15, fq = ln >> 4;
                LAS unsigned char* buf = lds + (ch & 1) * G3_BUF;
                const LAS float* gcb = (const LAS float*)(buf + G3_GCB);
                bf16x8 fA[16], fB[16];
#pragma unroll
                for (int t = 0; t < 4; ++t)
#pragma unroll
                    for (int s4 = 0; s4 < 4; ++s4) { fA[t * 4 + s4] = ldfrag(buf + G3_W + (16 * t + fr) * 272, s4, fq); fB[t * 4 + s4] = ldfrag(buf + G3_Q + (16 * t + fr) * 272, s4, fq); }
                f32x4 vn[4], oa[4];
#pragma unroll
                for (int t = 0; t < 4; ++t) { vn[t] = (f32x4){0.f, 0.f, 0.f, 0.f}; oa[t] = vn[t]; }
                __builtin_amdgcn_sched_barrier(0);
#pragma unroll
                for (int s4 = 0; s4 < 4; ++s4)
#pragma unroll
                    for (int t = 0; t < 4; ++t) vn[t] = __builtin_amdgcn_mfma_f32_16x16x32_bf16(fA[t * 4 + s4], Sb[s4], vn[t], 0, 0, 0);
                __builtin_amdgcn_sched_barrier(0);
#pragma unroll
                for (int T8 = 0; T8 < 8; ++T8)
#pragma unroll
                    for (int s2 = 0; s2 < 2; ++s2) fA[T8 * 2 + s2] = ldfrag(buf + G3_KT + (16 * T8 + fr) * 144, s2, fq);
                u32x2 uur[4]; f32x4 e2r[4];
#pragma unroll
                for (int t = 0; t < 4; ++t) { uur[t] = *(const LAS u32x2*)(buf + G3_UT + (16 * p + fr) * 144 + (16 * t + 4 * fq) * 2); e2r[t] = *(const LAS f32x4*)(gcb + 64 + 16 * t + 4 * fq); }
                const float dec = gcb[63];
                __builtin_amdgcn_sched_barrier(0);
#pragma unroll
                for (int s4 = 0; s4 < 4; ++s4)
#pragma unroll
                    for (int t = 0; t < 4; ++t) oa[t] = __builtin_amdgcn_mfma_f32_16x16x32_bf16(fB[t * 4 + s4], Sb[s4], oa[t], 0, 0, 0);
                __builtin_amdgcn_sched_barrier(0);
                bf16x8 af[6]; f32x4 e1v[4];
                af[0] = ldfrag(buf + G3_A + (0 + fr) * 144, 0, fq); af[1] = ldfrag(buf + G3_A + (16 + fr) * 144, 0, fq);
                af[2] = ldfrag(buf + G3_A + (32 + fr) * 144, 0, fq); af[3] = ldfrag(buf + G3_A + (32 + fr) * 144, 1, fq);
                af[4] = ldfrag(buf + G3_A + (48 + fr) * 144, 0, fq); af[5] = ldfrag(buf + G3_A + (48 + fr) * 144, 1, fq);
#pragma unroll
                for (int t = 0; t < 4; ++t) e1v[t] = *(const LAS f32x4*)(gcb + 16 * t + 4 * fq);
                MFMA_SETTLE();
                f32x4 vw[4], vs[4];
#pragma unroll
                for (int t = 0; t < 4; ++t) { const float u4[4] = {bflo(uur[t].x), bfhi(uur[t].x), bflo(uur[t].y), bfhi(uur[t].y)};
#pragma unroll
                    for (int q = 0; q < 4; ++q) { const float v = u4[q] - vn[t][q]; vw[t][q] = v; vs[t][q] = v * e2r[t][q]; oa[t][q] *= e1v[t][q]; } }
                bf16x8 Vb[2], Vsb[2];
#pragma unroll
                for (int s2 = 0; s2 < 2; ++s2) { Vb[s2] = pack44(vw[2 * s2], vw[2 * s2 + 1]); Vsb[s2] = pack44(vs[2 * s2], vs[2 * s2 + 1]); }
#pragma unroll
                for (int T8 = 0; T8 < 8; ++T8)
#pragma unroll
                    for (int q = 0; q < 4; ++q) Sacc[T8][q] *= dec;
                __builtin_amdgcn_sched_barrier(0);
                oa[0] = __builtin_amdgcn_mfma_f32_16x16x32_bf16(af[0], Vb[0], oa[0], 0, 0, 0);
                oa[1] = __builtin_amdgcn_mfma_f32_16x16x32_bf16(af[1], Vb[0], oa[1], 0, 0, 0);
                oa[2] = __builtin_amdgcn_mfma_f32_16x16x32_bf16(af[2], Vb[0], oa[2], 0, 0, 0);
                oa[3] = __builtin_amdgcn_mfma_f32_16x16x32_bf16(af[4], Vb[0], oa[3], 0, 0, 0);
                oa[2] = __builtin_amdgcn_mfma_f32_16x16x32_bf16(af[3], Vb[1], oa[2], 0, 0, 0);
                oa[3] = __builtin_amdgcn_mfma_f32_16x16x32_bf16(af[5], Vb[1], oa[3], 0, 0, 0);
#pragma unroll
                for (int s2 = 0; s2 < 2; ++s2)
#pragma unroll
                    for (int T8 = 0; T8 < 8; ++T8) Sacc[T8] = __builtin_amdgcn_mfma_f32_16x16x32_bf16(fA[T8 * 2 + s2], Vsb[s2], Sacc[T8], 0, 0, 0);
                MFMA_SETTLE();
                { bf16_t* op = OUT + ((size_t)(bl * NCH + ch) * CH) * 4096 + hv * 128 + 32 * dq + 16 * p + fr;
#pragma unroll
                  for (int t = 0; t < 4; ++t)
#pragma unroll
                    for (int q = 0; q < 4; ++q) op[(size_t)(16 * t + 4 * fq + q) * 4096] = (bf16_t)(cvt_pk_bf16(oa[t][q], oa[t][q]) & 0xffffu); }
#pragma unroll
                for (int s4 = 0; s4 < 4; ++s4) Sb[s4] = pack44(Sacc[2 * s4], Sacc[2 * s4 + 1]);
                __builtin_amdgcn_sched_barrier(0);
                G3_BAR();
            }
        }
        __syncthreads();
    }
}
#undef G3_BAR

__device__ __forceinline__ void phase_gdn_onorm(const Ctx& c, bf16_t* OUT, const bf16_t* GATE, const float* o_gain) {
    const int gw = c.bid * NWAVES + c.wave, NGW = c.G * NWAVES, sub = c.lane >> 4, ch = c.lane & 15;
    float og[8];
    { const f32x4 a = *(const f32x4*)(o_gain + ch * 8), b = *(const f32x4*)(o_gain + ch * 8 + 4);
#pragma unroll
      for (int k = 0; k < 4; ++k) { og[k] = a[k]; og[4 + k] = b[k]; } }
    const int npairs = MH * GVH / 4;
    for (int it0 = gw; it0 < npairs; it0 += 4 * NGW) {
        u32x4 ovr[4], gvr[4];
#pragma unroll
        for (int q = 0; q < 4; ++q) { const int it = it0 + q * NGW;
            if (it < npairs) { const int pr = it * 4 + sub, row = pr >> 5, hv = pr & 31;
                ovr[q] = *(const u32x4*)(OUT + (size_t)row * 4096 + hv * 128 + ch * 8); gvr[q] = *(const u32x4*)(GATE + (size_t)row * 4096 + hv * 128 + ch * 8); } }
#pragma unroll
        for (int q = 0; q < 4; ++q) { const int it = it0 + q * NGW;
            if (it < npairs) { const int pr = it * 4 + sub, row = pr >> 5, hv = pr & 31;
                bf16_t* op = OUT + (size_t)row * 4096 + hv * 128 + ch * 8;
                const u32x4 ov = ovr[q], gv = gvr[q];
                float o[8], g[8]; float ss = 0.f;
#pragma unroll
                for (int k = 0; k < 4; ++k) { o[2 * k] = bflo(ov[k]); o[2 * k + 1] = bfhi(ov[k]); g[2 * k] = bflo(gv[k]); g[2 * k + 1] = bfhi(gv[k]); }
#pragma unroll
                for (int k = 0; k < 8; ++k) ss += o[k] * o[k];
                ss += __shfl_xor(ss, 1); ss += __shfl_xor(ss, 2); ss += __shfl_xor(ss, 4); ss += __shfl_xor(ss, 8);
                const float rs = 1.0f / sqrtf(ss * (1.0f / 128.f) + EPS);
                float y[8];
#pragma unroll
                for (int k = 0; k < 8; ++k) y[k] = o[k] * rs * og[k] * siluf(g[k]);
                u32x4 w; w.x = cvt_pk_bf16(y[0], y[1]); w.y = cvt_pk_bf16(y[2], y[3]); w.z = cvt_pk_bf16(y[4], y[5]); w.w = cvt_pk_bf16(y[6], y[7]);
                *(u32x4*)op = w; } }
    }
}

typedef const __attribute__((address_space(4))) Args* KArgsP;
__device__ __forceinline__ KArgsP kargs() { const unsigned long long p0 = (unsigned long long)__builtin_amdgcn_kernarg_segment_ptr(); unsigned lo32 = (unsigned)p0, hi32 = (unsigned)(p0 >> 32);
    asm volatile("" : "+v"(lo32), "+v"(hi32)); lo32 = __builtin_amdgcn_readfirstlane(lo32); hi32 = __builtin_amdgcn_readfirstlane(hi32); return (KArgsP)(((unsigned long long)hi32 << 32) | lo32); }
__device__ __forceinline__ Ctx mkctx(LAS unsigned char* lds, int wv0) { Ctx c; int tid = wv0 * 64 + lane_id(); asm volatile("" : "+v"(tid)); c.lds = lds; c.tid = tid; c.lane = tid & 63; c.wave = __builtin_amdgcn_readfirstlane(tid >> 6); c.G = gridDim.x; c.bid = blockIdx.x; return c; }
#ifndef PHASE_EN
#define PHASE_EN 0xFFFFFFFFu
#endif
#define EN(id) (((PHASE_EN) >> (id)) & 1u)
#ifndef DUP_MASK
#define DUP_MASK 0u
#endif
#define DUP(id) (((DUP_MASK) >> (id)) & 1u)
#ifndef STAMP_ID
#define STAMP_ID (-1)
#endif
#define ST0(id) do { if (STAMP_ID == (id)) st_t0 = __builtin_amdgcn_s_memrealtime(); } while (0)
#define ST1(id) do { if (STAMP_ID == (id)) st_acc += __builtin_amdgcn_s_memrealtime() - st_t0; } while (0)

__global__ void __launch_bounds__(NTHREADS, 2) fwd_kernel(Args args) {
    extern __shared__ __attribute__((aligned(16))) unsigned char lds_raw[];
    LAS unsigned char* const lds = (LAS unsigned char*)lds_raw;
    volatile LAS unsigned* MISC = (volatile LAS unsigned*)(lds + MISC_OFF);
    const int wv0 = __builtin_amdgcn_readfirstlane((int)threadIdx.x >> 6);
    if (wv0 == 0) MISC[lane_id()] = 0u;
    __syncthreads();
    XcdBarrier bar; bar.bar = nullptr; bar.x = 0; bar.st = nullptr; bar.wv = wv0;
    if (N_LAUNCH_MODE == 1) { KArgsP ap = kargs(); bar = xcd_barrier_post((unsigned*)(ap->ws + WS_CTL) + CW_BAR, MISC + 8, wv0); }
    const int lo = args.ph_lo, hi = args.ph_hi;
    int ph = 0;
    unsigned long long st_t0 = 0ull, st_acc = 0ull;
#define PH_IN (ph >= lo && ph < hi)
#define PH_END do { if (PH_IN && ph + 1 < hi) { if (N_LAUNCH_MODE == 1) xcd_barrier(bar); } ++ph; } while (0)

    ST0(0);
    if (EN(0) && PH_IN) { const Ctx c = mkctx(lds, wv0); phase_weights(c, kargs()); if (DUP(0)) { __syncthreads(); phase_weights(c, kargs()); } }
    PH_END;
    ST1(0);

    for (int layer = 0; layer < 4; ++layer) {
        const int kind = layer % 3, j = layer / 3;
        ST0(1);
        if (EN(1) && PH_IN) { const Ctx c = mkctx(lds, wv0); KArgsP ap = kargs(); unsigned char* ws = ap->ws;
            phase_rmsnorm(c, (layer == 0) ? ap->x : (const float*)ap->out, ap->mix_norm + layer * D, (bf16_t*)(ws + WS_H));
            if (DUP(1)) phase_rmsnorm(c, (layer == 0) ? ap->x : (const float*)ap->out, ap->mix_norm + layer * D, (bf16_t*)(ws + WS_H)); }
        PH_END;
        ST1(1);
        if (kind == 0) {
            ST0(2);
            if (EN(2) && PH_IN) { const Ctx c = mkctx(lds, wv0); KArgsP ap = kargs(); unsigned char* ws = ap->ws;
                pg8::Gemm g{(const bf16_t*)(ws + WS_H), (const bf16_t*)(ws + WS_WQKV) + (size_t)j * 6144 * D, T, 6144, D, D, D, 0}; pg8::StaticOrder S; S.init(T, 6144, c.G, c.bid);
                pg8::EpiQkv E{(bf16_t*)(ws + WS_QKV), 6144, (float*)(ws + WS_PART)}; pg8::gemm_phase(c.lds, c.tid, g, S, E); if (DUP(2)) pg8::gemm_phase(c.lds, c.tid, g, S, E); }
            PH_END;
            ST1(2);
            ST0(3);
            if (EN(3) && PH_IN) { const Ctx c = mkctx(lds, wv0); KArgsP ap = kargs(); unsigned char* ws = ap->ws;
                phase_attention3(c, (const bf16_t*)(ws + WS_QKV), (bf16_t*)(ws + WS_AO), (const float*)(ws + WS_PART), ap->att_q_gain + j * AHD, ap->att_k_gain + j * AHD, ap->att_rel_bias + (size_t)j * AH * NREL);
                if (DUP(3)) phase_attention3(c, (const bf16_t*)(ws + WS_QKV), (bf16_t*)(ws + WS_AO), (const float*)(ws + WS_PART), ap->att_q_gain + j * AHD, ap->att_k_gain + j * AHD, ap->att_rel_bias + (size_t)j * AH * NREL); }
            PH_END;
            ST1(3);
            ST0(4);
            if (EN(4) && PH_IN) { const Ctx c = mkctx(lds, wv0); KArgsP ap = kargs(); unsigned char* ws = ap->ws;
                pg8::Gemm g{(const bf16_t*)(ws + WS_AO), (const bf16_t*)(ws + WS_WO) + (size_t)j * D * D, T, D, D, D, D, 0}; pg8::StaticOrder S; S.init(T, D, c.G, c.bid);
                pg8::EpiRes E{(layer == 0) ? ap->x : (const float*)ap->out, ap->out, D, nullptr}; pg8::gemm_phase(c.lds, c.tid, g, S, E);
                if (DUP(4)) { pg8::EpiBf16 E2{(bf16_t*)(ws + WS_H), D}; pg8::gemm_phase(c.lds, c.tid, g, S, E2); } }
            PH_END;
            ST1(4);
        } else if (kind == 1) {
            ST0(5);
            if (EN(5) && PH_IN) { const Ctx c = mkctx(lds, wv0); KArgsP ap = kargs(); unsigned char* ws = ap->ws;
                phase_pool_prep(c, (const bf16_t*)(ws + WS_H), (bf16_t*)(ws + WS_POOLED)); if (DUP(5)) phase_pool_prep(c, (const bf16_t*)(ws + WS_H), (bf16_t*)(ws + WS_POOLED)); }
            PH_END;
            ST1(5);
            ST0(6);
            if (EN(6) && PH_IN) { const Ctx c = mkctx(lds, wv0); KArgsP ap = kargs(); unsigned char* ws = ap->ws;
                pg8::Gemm g{(const bf16_t*)(ws + WS_POOLED), (const bf16_t*)(ws + WS_WPOOL), T, D, 512, D, 512, 2}; pg8::StaticOrder S; S.init(T, D, c.G, c.bid);
                pg8::EpiRes E{ap->out, ap->out, D, ap->pool_scale + j * D}; pg8::gemm_phase(c.lds, c.tid, g, S, E); }
            PH_END;
            ST1(6);
        } else {
            for (int half = 0; half < 2; ++half) {
                ST0(7);
                if (EN(7) && PH_IN) { const Ctx c = mkctx(lds, wv0); KArgsP ap = kargs(); unsigned char* ws = ap->ws;
                    pg8::Gemm g{(const bf16_t*)(ws + WS_H) + (size_t)half * MH * D, (const bf16_t*)(ws + WS_WGIN), MH, GINP, D, D, D, 0}; pg8::StaticOrder S; S.init(MH, GINP, c.G, c.bid);
                    pg8::EpiGdn E{(bf16_t*)(ws + WS_C), (bf16_t*)(ws + WS_GATE), (float*)(ws + WS_AB), ap->gdn_conv, (bf16_t*)(ws + WS_HEAD3), (bf16_t*)(ws + WS_TAIL3)};
                    pg8::gemm_phase(c.lds, c.tid, g, S, E); if (DUP(7)) pg8::gemm_phase(c.lds, c.tid, g, S, E); }
                PH_END;
                ST1(7);
                ST0(9);
                if (EN(9) && PH_IN) { const Ctx c = mkctx(lds, wv0); KArgsP ap = kargs(); unsigned char* ws = ap->ws;
                    phase_gdn_local(c, (bf16_t*)(ws + WS_C), (bf16_t*)(ws + WS_W), (bf16_t*)(ws + WS_ATT), (const float*)(ws + WS_AB), (float*)(ws + WS_GC), (const bf16_t*)(ws + WS_HEAD3), (const bf16_t*)(ws + WS_TAIL3),
                                    ap->gdn_conv, ap->gdn_a_log, ap->gdn_dt_bias); }
                PH_END;
                ST1(9);
                ST0(10);
                if (EN(10) && PH_IN) { const Ctx c = mkctx(lds, wv0); KArgsP ap = kargs(); unsigned char* ws = ap->ws;
                    phase_gdn_scan(c, (const bf16_t*)(ws + WS_W), (bf16_t*)(ws + WS_O), (const bf16_t*)(ws + WS_C), (const bf16_t*)(ws + WS_ATT), (const float*)(ws + WS_GC));
                    if (DUP(10)) phase_gdn_scan(c, (const bf16_t*)(ws + WS_W), (bf16_t*)(ws + WS_O), (const bf16_t*)(ws + WS_C), (const bf16_t*)(ws + WS_ATT), (const float*)(ws + WS_GC)); }
                PH_END;
                ST1(10);
                ST0(11);
                if (EN(11) && PH_IN) { const Ctx c = mkctx(lds, wv0); KArgsP ap = kargs(); unsigned char* ws = ap->ws;
                    phase_gdn_onorm(c, (bf16_t*)(ws + WS_O), (const bf16_t*)(ws + WS_GATE), ap->gdn_o_gain); }
                PH_END;
                ST1(11);
                ST0(12);
                if (EN(12) && PH_IN) { const Ctx c = mkctx(lds, wv0); KArgsP ap = kargs(); unsigned char* ws = ap->ws;
                    pg8::Gemm g{(const bf16_t*)(ws + WS_O), (const bf16_t*)(ws + WS_WGO), MH, D, 4096, 4096, 4096, 0}; pg8::StaticOrder S; S.init(MH, D, c.G, c.bid);
                    pg8::EpiRes E{(const float*)ap->out + (size_t)half * MH * D, ap->out + (size_t)half * MH * D, D, nullptr}; pg8::gemm_phase(c.lds, c.tid, g, S, E); }
                PH_END;
                ST1(12);
            }
        }
        ST0(13);
        if (EN(13) && PH_IN) { const Ctx c = mkctx(lds, wv0); KArgsP ap = kargs(); unsigned char* ws = ap->ws;
            phase_rmsnorm(c, ap->out, ap->ffn_norm + layer * D, (bf16_t*)(ws + WS_H)); if (DUP(13)) phase_rmsnorm(c, ap->out, ap->ffn_norm + layer * D, (bf16_t*)(ws + WS_H)); }
        PH_END;
        ST1(13);
        ST0(14);
        if (EN(14) && PH_IN) { const Ctx c = mkctx(lds, wv0); KArgsP ap = kargs(); unsigned char* ws = ap->ws;
            pg8::Gemm g{(const bf16_t*)(ws + WS_H), (const bf16_t*)(ws + WS_WUP) + (size_t)layer * FF2 * D, T, FF2, D, D, D, 0}; pg8::StaticOrder S; S.init(T, FF2, c.G, c.bid);
            pg8::EpiFfn E{(bf16_t*)(ws + WS_ACT), ap->ffn_conv + (size_t)layer * 3 * FF, (bf16_t*)(ws + WS_TAILU), (bf16_t*)(ws + WS_HEADU), (bf16_t*)(ws + WS_HEADG)};
            pg8::gemm_phase(c.lds, c.tid, g, S, E); if (DUP(14)) pg8::gemm_phase(c.lds, c.tid, g, S, E); }
        PH_END;
        ST1(14);
        ST0(15);
        if (EN(15) && PH_IN) { const Ctx c = mkctx(lds, wv0); KArgsP ap = kargs(); unsigned char* ws = ap->ws;
            phase_ffn_fix(c, (bf16_t*)(ws + WS_ACT), ap->ffn_conv + (size_t)layer * 3 * FF, (const bf16_t*)(ws + WS_TAILU), (const bf16_t*)(ws + WS_HEADU), (const bf16_t*)(ws + WS_HEADG)); }
        PH_END;
        ST1(15);
        ST0(16);
        if (EN(16) && PH_IN) { const Ctx c = mkctx(lds, wv0); KArgsP ap = kargs(); unsigned char* ws = ap->ws;
            pg8::Gemm g{(const bf16_t*)(ws + WS_ACT), (const bf16_t*)(ws + WS_WDN) + (size_t)layer * D * FF, T, D, FF, FF, FF, 0}; pg8::StaticOrder S; S.init(T, D, c.G, c.bid);
            pg8::EpiRes E{ap->out, ap->out, D, nullptr}; pg8::gemm_phase(c.lds, c.tid, g, S, E);
            if (DUP(16)) { pg8::EpiBf16 E2{(bf16_t*)(ws + WS_H), D}; pg8::gemm_phase(c.lds, c.tid, g, S, E2); } }
        PH_END;
        ST1(16);
    }
#undef PH_IN
#undef PH_END
    if (STAMP_ID >= 0 && blockIdx.x == 0 && wv0 == 0 && lane_id() == 0) kargs()->out[0] = (float)st_acc * 0.01f;
}

constexpr int N_PHASES = 1 + 8 + 7 + 15 + 8;

extern "C" void kernel_launch(void* const* d_in, const int* in_sizes, int n_in, void* d_out, int out_size, void* d_ws, size_t ws_size, hipStream_t stream) {
    static int grid = 0;
    if (grid == 0) {
        if (n_in != 19 || out_size != T * D || ws_size < WS_NEED) { fprintf(stderr, "kernel_launch: unexpected problem (n_in %d, out %d, ws %zu, need %zu)\n", n_in, out_size, ws_size, (size_t)WS_NEED); grid = -1; return; }
        int dev = 0, cus = 0, per_cu = 0;
        if (hipGetDevice(&dev) != hipSuccess || hipDeviceGetAttribute(&cus, hipDeviceAttributeMultiprocessorCount, dev) != hipSuccess) { grid = -1; return; }
        if (hipFuncSetAttribute((const void*)fwd_kernel, hipFuncAttributeMaxDynamicSharedMemorySize, LDS_BYTES) != hipSuccess) { fprintf(stderr, "kernel_launch: hipFuncSetAttribute failed\n"); grid = -1; return; }
        if (hipOccupancyMaxActiveBlocksPerMultiprocessor(&per_cu, (const void*)fwd_kernel, NTHREADS, LDS_BYTES) != hipSuccess || per_cu < 1) fprintf(stderr, "kernel_launch: occupancy query says %d\n", per_cu);
        (void)hipGetLastError();
        grid = cus;
    }
    if (grid < 0) return;
    unsigned char* ws = (unsigned char*)d_ws;
    (void)hipMemsetAsync(ws + WS_CTL, 0, CTL_ZERO_BYTES, stream);
    Args a{};
    a.x = (const float*)d_in[0]; a.mix_norm = (const float*)d_in[1]; a.ffn_norm = (const float*)d_in[2];
    a.att_q_gain = (const float*)d_in[4]; a.att_k_gain = (const float*)d_in[5]; a.att_rel_bias = (const float*)d_in[6];
    a.pool_scale = (const float*)d_in[9]; a.gdn_conv = (const float*)d_in[11]; a.gdn_a_log = (const float*)d_in[12]; a.gdn_dt_bias = (const float*)d_in[13];
    a.gdn_o_gain = (const float*)d_in[14]; a.ffn_conv = (const float*)d_in[17];
    a.out = (float*)d_out; a.ws = ws;
    a.wd[0] = WDesc{(const float*)d_in[3],  (bf16_t*)(ws + WS_WQKV), D, 6144, 2, 0};
    a.wd[1] = WDesc{(const float*)d_in[7],  (bf16_t*)(ws + WS_WO),   D, D, 2, 0};
    a.wd[2] = WDesc{(const float*)d_in[8],  (bf16_t*)(ws + WS_WPOOL), 512, 512, 4, 0};
    a.wd[3] = WDesc{(const float*)d_in[10], (bf16_t*)(ws + WS_WGIN), D, GIN, 1, 0};
    a.wd[4] = WDesc{(const float*)d_in[15], (bf16_t*)(ws + WS_WGO),  4096, D, 1, 0};
    a.wd[5] = WDesc{(const float*)d_in[16], (bf16_t*)(ws + WS_WUP),  D, FF2, 4, 1};
    a.wd[6] = WDesc{(const float*)d_in[18], (bf16_t*)(ws + WS_WDN),  FF, D, 4, 0};
    if (N_LAUNCH_MODE == 1) {
        a.ph_lo = 0; a.ph_hi = N_PHASES;
        hipLaunchKernelGGL(fwd_kernel, dim3(grid), dim3(NTHREADS), LDS_BYTES, stream, a);
    } else {
        for (int p = 0; p < N_PHASES; ++p) { a.ph_lo = p; a.ph_hi = p + 1; hipLaunchKernelGGL(fwd_kernel, dim3(grid), dim3(NTHREADS), LDS_BYTES, stream, a); }
    }
}
```

```cpp
#include <hip/hip_runtime.h>
#include <cstdio>
#include <cstdint>

#ifndef N_LAUNCH_MODE
#define N_LAUNCH_MODE 1
#endif

#define LAS __attribute__((address_space(3)))
#define GAS __attribute__((address_space(1)))
typedef unsigned short bf16_t;
typedef short bf16x8 __attribute__((ext_vector_type(8)));
typedef short s16x4 __attribute__((ext_vector_type(4)));
typedef float f32x4 __attribute__((ext_vector_type(4)));
typedef float f32x2 __attribute__((ext_vector_type(2)));
typedef float f32x16 __attribute__((ext_vector_type(16)));
typedef unsigned u32x4 __attribute__((ext_vector_type(4)));
typedef unsigned u32x2 __attribute__((ext_vector_type(2)));

constexpr int D = 2048, BATCH = 4, SEQ = 8192, T = BATCH * SEQ;
constexpr int CH = 64, NCH = SEQ / CH;
constexpr int AH = 16, AHD = 128, NREL = 320;
constexpr int GKH = 16, GVH = 32, GIN = 12352, GINP = 12544;
constexpr int FF = 5504, FF2 = 11008;
constexpr int MH = T / 2;
constexpr float EPS = 1e-6f;
constexpr int NTHREADS = 512, NWAVES = 8;

constexpr size_t MiB = 1u << 20;
constexpr size_t WS_CTL = 0, CTL_ZERO_BYTES = 1 * MiB;
constexpr size_t WS_WQKV = 1 * MiB;
constexpr size_t WS_WO   = WS_WQKV + 48 * MiB;
constexpr size_t WS_WPOOL= WS_WO + 16 * MiB;
constexpr size_t WS_WGIN = WS_WPOOL + 2 * MiB;
constexpr size_t WS_WGO  = WS_WGIN + 49 * MiB;
constexpr size_t WS_WUP  = WS_WGO + 16 * MiB;
constexpr size_t WS_WDN  = WS_WUP + 172 * MiB;
constexpr size_t WS_H    = WS_WDN + 86 * MiB;
constexpr size_t WS_BIG  = WS_H + 128 * MiB;
constexpr size_t WS_QKV  = WS_BIG;
constexpr size_t WS_AO   = WS_QKV + 384 * MiB;
constexpr size_t WS_PART = WS_AO + 128 * MiB;
constexpr size_t WS_ACT  = WS_BIG;
constexpr size_t WS_TAILU = WS_ACT + 344 * MiB;
constexpr size_t WS_HEADU = WS_TAILU + 11 * MiB;
constexpr size_t WS_HEADG = WS_HEADU + 11 * MiB;
constexpr size_t WS_POOLED = WS_BIG;
constexpr size_t WS_C    = WS_BIG;
constexpr size_t WS_GATE = WS_C + 256 * MiB;
constexpr size_t WS_W    = WS_GATE + 128 * MiB;
constexpr size_t WS_O    = WS_W + 128 * MiB;
constexpr size_t WS_ATT  = WS_O + 128 * MiB;
constexpr size_t WS_AB   = WS_ATT + 64 * MiB;
constexpr size_t WS_GC   = WS_AB + 4 * MiB;
constexpr size_t WS_HEAD3 = WS_GC + 2 * MiB;
constexpr size_t WS_TAIL3 = WS_HEAD3 + 13 * MiB;
constexpr size_t WS_END  = WS_TAIL3 + 13 * MiB;
constexpr size_t WS_NEED = WS_BIG + 736 * MiB;
static_assert(WS_END <= WS_NEED && WS_HEADG + 11 * MiB <= WS_NEED && WS_AO + (size_t)T * D * 2 <= WS_NEED, "map");

constexpr int CW_BAR = 4096;

__device__ __forceinline__ float bf2f(unsigned b) { return __uint_as_float(b << 16); }
__device__ __forceinline__ float bflo(unsigned w) { return __uint_as_float(w << 16); }
__device__ __forceinline__ float bfhi(unsigned w) { return __uint_as_float(w & 0xffff0000u); }
__device__ __forceinline__ unsigned cvt_pk_bf16(float lo, float hi) { unsigned r; asm volatile("v_cvt_pk_bf16_f32 %0, %1, %2" : "=v"(r) : "v"(lo), "v"(hi)); return r; }
typedef float f32x2_cv __attribute__((ext_vector_type(2))); typedef __bf16 bf16x2_cv __attribute__((ext_vector_type(2)));
__device__ __forceinline__ unsigned cvt_pk_bf16_op(float lo, float hi) { const f32x2_cv v = {lo, hi}; const bf16x2_cv b = __builtin_convertvector(v, bf16x2_cv); return __builtin_bit_cast(unsigned, b); }
__device__ __forceinline__ unsigned f2bf(float f) { return cvt_pk_bf16(f, 0.f) & 0xffffu; }
__device__ __forceinline__ float wave_sum(float v) {
#pragma unroll
    for (int o = 1; o < 64; o <<= 1) v += __shfl_xor(v, o);
    return v;
}
__device__ __forceinline__ float siluf(float x) { return x * __builtin_amdgcn_rcpf(1.0f + __expf(-x)); }
#define LDS_WAIT() asm volatile("s_waitcnt lgkmcnt(0)" ::: "memory")
#define MFMA_SETTLE() do { __builtin_amdgcn_sched_barrier(0); asm volatile("s_nop 15\n\ts_nop 15\n\ts_nop 15\n\ts_nop 15\n\ts_nop 15" ::: "memory"); __builtin_amdgcn_sched_barrier(0); } while (0)
#define VM_WAIT() asm volatile("s_waitcnt vmcnt(0)" ::: "memory")

namespace pg8 {
constexpr int BM = 256, BK = 64, HALF = 128, HTB = HALF * BK * 2, STAGE_BYTES = 8 * HTB, NXCD = 8, WGM = 8;
__host__ __device__ __forceinline__ int lds_byte(int r, int c) { const int st = (r >> 4) * 2 + (c >> 5), rr = r & 15, cc = c & 31, ob = rr * 64 + cc * 2; return st * 1024 + (ob ^ (((ob >> 9) & 1) << 5)); }
__host__ __device__ __forceinline__ void stage_rc(int b, int& R, int& C) { const int st = b / 1024, sb = b % 1024, swz = sb ^ (((sb >> 9) & 1) << 5); R = (st >> 1) * 16 + swz / 64; C = (st & 1) * 32 + (swz % 64) / 2; }
__host__ __device__ __forceinline__ int perm32(int rho) { const int n = rho >> 4, i = rho & 15; return 8 * (i >> 2) + 4 * n + (i & 3); }

struct Unit { int pm, pn; };
struct Gemm { const bf16_t* A; const bf16_t* Bt; int M, N, K, lda, ldb, grp; };

struct StaticOrder {
    int nM, nN, nwg, G, c;
    __device__ void init(int M, int N, int G_, int c_) { nM = M / BM; nN = N / BM; nwg = nM * nN; G = G_; c = c_; }
    __device__ bool next(int i, Unit& u) const {
        const long L = (long)i * G + c; if (L >= nwg) return false;
        int wgid = (int)L; { const int q = nwg / NXCD, r = nwg % NXCD, xcd = wgid % NXCD, off = wgid / NXCD; wgid = (xcd < r ? xcd * (q + 1) : r * (q + 1) + (xcd - r) * q) + off; }
        const int nig = WGM * nN, gid = wgid / nig, fm = gid * WGM, gsz = (nM - fm) < WGM ? (nM - fm) : WGM;
        u.pm = fm + ((wgid % nig) % gsz); u.pn = (wgid % nig) / gsz; return true;
    }
};

struct EpiBf16 {
    static constexpr bool PERM = true;
    bf16_t* O; int ldc;
    __device__ __forceinline__ void operator()(const f32x4 (&acc)[2][2][4][2], const Unit& u, int wr, int wc, int fr, int fq) const {
        const int row0 = u.pm * BM + wr * 64 + fr, col0 = u.pn * BM + wc * 32 + 8 * fq;
#pragma unroll
        for (int ai = 0; ai < 2; ++ai)
#pragma unroll
            for (int m = 0; m < 4; ++m) { bf16_t* rowp = O + (size_t)(row0 + ai * HALF + m * 16) * ldc + col0;
#pragma unroll
                for (int bj = 0; bj < 2; ++bj) { const f32x4 v0 = acc[ai][bj][m][0], v1 = acc[ai][bj][m][1];
                    u32x4 w; w.x = cvt_pk_bf16(v0[0], v0[1]); w.y = cvt_pk_bf16(v0[2], v0[3]); w.z = cvt_pk_bf16(v1[0], v1[1]); w.w = cvt_pk_bf16(v1[2], v1[3]);
                    *(u32x4*)(rowp + bj * HALF) = w; } }
    }
};
struct EpiQkv {
    static constexpr bool PERM = true;
    bf16_t* O; int ldc; float* PART;
    __device__ __forceinline__ void operator()(const f32x4 (&acc)[2][2][4][2], const Unit& u, int wr, int wc, int fr, int fq) const {
        const int row0 = u.pm * BM + wr * 64 + fr, col0 = u.pn * BM + wc * 32 + 8 * fq;
#pragma unroll
        for (int ai = 0; ai < 2; ++ai)
#pragma unroll
            for (int m = 0; m < 4; ++m) { bf16_t* rowp = O + (size_t)(row0 + ai * HALF + m * 16) * ldc + col0;
#pragma unroll
                for (int bj = 0; bj < 2; ++bj) { const f32x4 v0 = acc[ai][bj][m][0], v1 = acc[ai][bj][m][1];
                    u32x4 w; w.x = cvt_pk_bf16(v0[0], v0[1]); w.y = cvt_pk_bf16(v0[2], v0[3]); w.z = cvt_pk_bf16(v1[0], v1[1]); w.w = cvt_pk_bf16(v1[2], v1[3]);
                    *(u32x4*)(rowp + bj * HALF) = w; } }
        if (u.pn < 16) {
#pragma unroll
            for (int ai = 0; ai < 2; ++ai)
#pragma unroll
                for (int m = 0; m < 4; ++m)
#pragma unroll
                    for (int bj = 0; bj < 2; ++bj) { const f32x4 v0 = acc[ai][bj][m][0], v1 = acc[ai][bj][m][1];
                        float ss = (v0[0] * v0[0] + v0[1] * v0[1]) + (v0[2] * v0[2] + v0[3] * v0[3]) + (v1[0] * v1[0] + v1[1] * v1[1]) + (v1[2] * v1[2] + v1[3] * v1[3]);
                        ss += __shfl_xor(ss, 16); ss += __shfl_xor(ss, 32);
                        if (fq == 0) PART[(((size_t)u.pn * T + (row0 + ai * HALF + m * 16)) * 2 + bj) * 4 + wc] = ss; }
        }
    }
};
template <int CTRL> __device__ __forceinline__ float dpp0(float v) {
    return __builtin_bit_cast(float, __builtin_amdgcn_update_dpp(0, __builtin_bit_cast(int, v), CTRL, 0xf, 0xf, true)); }
#define DEF_FMAC_DPP(NAME, CTRL) __device__ __forceinline__ void NAME(float& a, float src, float w) { asm("v_fmac_f32_dpp %0, %1, %2 " CTRL " row_mask:0xf bank_mask:0xf bound_ctrl:1" : "+v"(a) : "v"(src), "v"(w)); }
DEF_FMAC_DPP(fmac_shr1, "row_shr:1")
DEF_FMAC_DPP(fmac_shr2, "row_shr:2")
DEF_FMAC_DPP(fmac_ror1, "row_ror:1")
DEF_FMAC_DPP(fmac_ror2, "row_ror:2")
DEF_FMAC_DPP(fmac_shr3, "row_shr:3")
DEF_FMAC_DPP(fmac_ror3, "row_ror:3")
#undef DEF_FMAC_DPP
template <int N> __device__ __forceinline__ float dpp_rowprev(float cur, float prevm) {
    const int t = __builtin_amdgcn_update_dpp(0, __builtin_bit_cast(int, prevm), 0x120 + N, 0xf, 0xf, false);
    return __builtin_bit_cast(float, __builtin_amdgcn_update_dpp(t, __builtin_bit_cast(int, cur), 0x110 + N, 0xf, 0xf, false));
}
struct EpiGdn {
    static constexpr bool PERM = true;
    bf16_t* C; bf16_t* GATE; float* AB; const float* cw; bf16_t* HEAD3; bf16_t* TAIL3;
    __device__ __forceinline__ void operator()(const f32x4 (&acc)[2][2][4][2], const Unit& u, int wr, int wc, int fr, int fq) const {
        const int row0 = u.pm * BM + wr * 64 + fr;
        if (u.pn == 48) {
            if (wc < 2) {
#pragma unroll
                for (int ai = 0; ai < 2; ++ai)
#pragma unroll
                    for (int m = 0; m < 4; ++m) { float* rp = AB + (size_t)(row0 + ai * HALF + m * 16) * 64 + wc * 32 + 8 * fq;
                        *(f32x4*)(rp) = acc[ai][0][m][0]; *(f32x4*)(rp + 4) = acc[ai][0][m][1]; }
            }
            return;
        }
        if (u.pn >= 32) {
            const int col0 = (u.pn - 32) * BM + wc * 32 + 8 * fq;
#pragma unroll
            for (int ai = 0; ai < 2; ++ai)
#pragma unroll
                for (int m = 0; m < 4; ++m) { bf16_t* rowp = GATE + (size_t)(row0 + ai * HALF + m * 16) * 4096 + col0;
#pragma unroll
                    for (int bj = 0; bj < 2; ++bj) { const f32x4 v0 = acc[ai][bj][m][0], v1 = acc[ai][bj][m][1];
                        u32x4 w; w.x = cvt_pk_bf16(v0[0], v0[1]); w.y = cvt_pk_bf16(v0[2], v0[3]); w.z = cvt_pk_bf16(v1[0], v1[1]); w.w = cvt_pk_bf16(v1[2], v1[3]);
                        *(u32x4*)(rowp + bj * HALF) = w; } }
            return;
        }
#pragma unroll
        for (int bj = 0; bj < 2; ++bj)
#pragma unroll
            for (int n = 0; n < 2; ++n) {
                const int colc = u.pn * BM + bj * HALF + wc * 32 + 8 * fq + 4 * n;
                const f32x4 w0 = *(const f32x4*)(cw + colc), w1 = *(const f32x4*)(cw + 8192 + colc), w2 = *(const f32x4*)(cw + 2 * 8192 + colc), w3 = *(const f32x4*)(cw + 3 * 8192 + colc);
                f32x4 w0m, w1m, w2m;
#pragma unroll
                for (int k = 0; k < 4; ++k) { w0m[k] = (fr < 3) ? w0[k] : 0.f; w1m[k] = (fr < 2) ? w1[k] : 0.f; w2m[k] = (fr < 1) ? w2[k] : 0.f; }
#pragma unroll
                for (int ai = 0; ai < 2; ++ai) {
                    const int sg = u.pm * 4 + ai * 2 + wr, rowbase = u.pm * BM + ai * HALF + wr * 64;
#pragma unroll
                    for (int m = 0; m < 4; ++m) {
                        float y[4];
#pragma unroll
                        for (int k = 0; k < 4; ++k) {
                            const float cur = acc[ai][bj][m][n][k];
                            float sv = w3[k] * cur;
                            fmac_shr1(sv, cur, w2[k]); fmac_shr2(sv, cur, w1[k]); fmac_shr3(sv, cur, w0[k]);
                            if (m > 0) { const float pv = acc[ai][bj][m > 0 ? m - 1 : 0][n][k];
                                fmac_ror1(sv, pv, w2m[k]); fmac_ror2(sv, pv, w1m[k]); fmac_ror3(sv, pv, w0m[k]); }
                            y[k] = siluf(sv);
                        }
                        if (!(m == 0 && fr < 3)) { u32x2 w; w.x = cvt_pk_bf16(y[0], y[1]); w.y = cvt_pk_bf16(y[2], y[3]);
                            *(u32x2*)(C + (size_t)(rowbase + 16 * m + fr) * 8192 + colc) = w; }
                        if (m == 0 && fr < 3) { const f32x4 u0 = acc[ai][bj][0][n];
                            u32x2 w; w.x = cvt_pk_bf16(u0[0], u0[1]); w.y = cvt_pk_bf16(u0[2], u0[3]);
                            *(u32x2*)(HEAD3 + (size_t)(sg * 3 + fr) * 8192 + colc) = w; }
                        if (m == 3 && fr >= 13) { const f32x4 u0 = acc[ai][bj][3][n];
                            u32x2 w; w.x = cvt_pk_bf16(u0[0], u0[1]); w.y = cvt_pk_bf16(u0[2], u0[3]);
                            *(u32x2*)(TAIL3 + (size_t)(sg * 3 + fr - 13) * 8192 + colc) = w; }
                    }
                }
            }
    }
};
struct EpiRes {
    static constexpr bool PERM = false;
    const float* base; float* out; int ldc; const float* scale;
    __device__ __forceinline__ void operator()(const f32x4 (&acc)[2][2][4][2], const Unit& u, int wr, int wc, int fr, int fq) const {
        const int row0 = u.pm * BM + wr * 64 + fr, col0 = u.pn * BM + wc * 32 + 4 * fq;
        f32x4 sv[2][2];
#pragma unroll
        for (int bj = 0; bj < 2; ++bj)
#pragma unroll
            for (int n = 0; n < 2; ++n) sv[bj][n] = scale ? *(const f32x4*)(scale + col0 + bj * HALF + n * 16) : (f32x4){1.f, 1.f, 1.f, 1.f};
#pragma unroll
        for (int ai = 0; ai < 2; ++ai) {
            f32x4 bs[4][2][2];
#pragma unroll
            for (int m = 0; m < 4; ++m) { const size_t off = (size_t)(row0 + ai * HALF + m * 16) * ldc + col0;
#pragma unroll
                for (int bj = 0; bj < 2; ++bj)
#pragma unroll
                    for (int n = 0; n < 2; ++n) bs[m][bj][n] = *(const f32x4*)(base + off + bj * HALF + n * 16); }
#pragma unroll
            for (int m = 0; m < 4; ++m) { const size_t off = (size_t)(row0 + ai * HALF + m * 16) * ldc + col0;
#pragma unroll
                for (int bj = 0; bj < 2; ++bj)
#pragma unroll
                    for (int n = 0; n < 2; ++n) *(f32x4*)(out + off + bj * HALF + n * 16) = bs[m][bj][n] + acc[ai][bj][m][n] * sv[bj][n]; }
        }
    }
};


struct EpiFfn {
    static constexpr bool PERM = true;
    bf16_t* ACT; const float* cw; bf16_t* TAILU; bf16_t* HEADU; bf16_t* HEADG;
    __device__ __forceinline__ void operator()(const f32x4 (&acc)[2][2][4][2], const Unit& u, int wr, int wc, int fr, int fq) const {
        const int colu = u.pn * 128 + wc * 32 + 8 * fq;
        float w0[8], w1[8], w2[8];
#pragma unroll
        for (int h = 0; h < 2; ++h) { const f32x4 a0 = *(const f32x4*)(cw + colu + 4 * h), a1 = *(const f32x4*)(cw + FF + colu + 4 * h), a2 = *(const f32x4*)(cw + 2 * FF + colu + 4 * h);
#pragma unroll
            for (int k = 0; k < 4; ++k) { w0[4 * h + k] = a0[k]; w1[4 * h + k] = a1[k]; w2[4 * h + k] = a2[k]; } }
        float w1m[8], w0m[8];
#pragma unroll
        for (int k = 0; k < 8; ++k) { w1m[k] = (fr < 1) ? w1[k] : 0.f; w0m[k] = (fr < 2) ? w0[k] : 0.f; }
#pragma unroll
        for (int ai = 0; ai < 2; ++ai) {
            const int sg = u.pm * 4 + ai * 2 + wr, rowbase = u.pm * BM + ai * HALF + wr * 64;
#pragma unroll
            for (int m = 0; m < 4; ++m) {
                float y[8];
#pragma unroll
                for (int n = 0; n < 2; ++n)
#pragma unroll
                    for (int k = 0; k < 4; ++k) {
                        const int ci = 4 * n + k;
                        const float cur = acc[ai][0][m][n][k];
                        float sv = w2[ci] * cur;
                        fmac_shr1(sv, cur, w1[ci]);
                        fmac_shr2(sv, cur, w0[ci]);
                        if (m > 0) { const float pv = acc[ai][0][m > 0 ? m - 1 : 0][n][k];
                            fmac_ror1(sv, pv, w1m[ci]);
                            fmac_ror2(sv, pv, w0m[ci]); }
                        y[ci] = siluf(sv) * acc[ai][1][m][n][k];
                    }
                if (!(m == 0 && fr < 2)) { u32x4 w; w.x = cvt_pk_bf16(y[0], y[1]); w.y = cvt_pk_bf16(y[2], y[3]); w.z = cvt_pk_bf16(y[4], y[5]); w.w = cvt_pk_bf16(y[6], y[7]);
                    *(u32x4*)(ACT + (size_t)(rowbase + 16 * m + fr) * FF + colu) = w; }
                if (m == 0 && fr < 2) {
                    const f32x4 u0 = acc[ai][0][0][0], u1 = acc[ai][0][0][1], g0 = acc[ai][1][0][0], g1 = acc[ai][1][0][1];
                    u32x4 w; w.x = cvt_pk_bf16(u0[0], u0[1]); w.y = cvt_pk_bf16(u0[2], u0[3]); w.z = cvt_pk_bf16(u1[0], u1[1]); w.w = cvt_pk_bf16(u1[2], u1[3]);
                    *(u32x4*)(HEADU + (size_t)(sg * 2 + fr) * FF + colu) = w;
                    w.x = cvt_pk_bf16(g0[0], g0[1]); w.y = cvt_pk_bf16(g0[2], g0[3]); w.z = cvt_pk_bf16(g1[0], g1[1]); w.w = cvt_pk_bf16(g1[2], g1[3]);
                    *(u32x4*)(HEADG + (size_t)(sg * 2 + fr) * FF + colu) = w;
                }
                if (m == 3 && fr >= 14) {
                    const f32x4 u0 = acc[ai][0][3][0], u1 = acc[ai][0][3][1];
                    u32x4 w; w.x = cvt_pk_bf16(u0[0], u0[1]); w.y = cvt_pk_bf16(u0[2], u0[3]); w.z = cvt_pk_bf16(u1[0], u1[1]); w.w = cvt_pk_bf16(u1[2], u1[3]);
                    *(u32x4*)(TAILU + (size_t)(sg * 2 + fr - 14) * FF + colu) = w;
                }
            }
        }
    }
};
template <class Epi, class Sched>
__device__ __forceinline__ void gemm_phase(LAS unsigned char* lds, const int tid, const Gemm g, const Sched& S, const Epi& E) {
    const int wid = __builtin_amdgcn_readfirstlane(tid >> 6), lane = tid & 63, wr = wid >> 2, wc = wid & 3, fr = lane & 15, fq = lane >> 4;
    const int K = g.K, nt = K / BK;
    unsigned voffA[2], voffB[2];
#pragma unroll
    for (int i = 0; i < 2; ++i) { int R, C; stage_rc(tid * 16 + i * 8192, R, C); const int Rb = Epi::PERM ? ((R & ~31) + perm32(R & 31)) : R;
        voffA[i] = (unsigned)(R * g.lda + C) * 2u; voffB[i] = (unsigned)(Rb * g.ldb + C) * 2u; }
    const size_t kstep = (size_t)(BK * 2);
    const size_t hstepA = (size_t)HALF * g.lda * 2, hstepB = (size_t)HALF * g.ldb * 2;
    const size_t tstepA = 2 * hstepA, tstepB = 2 * hstepB;
    const unsigned ldsw = (unsigned)wid * 1024u;
    const int aoff = lds_byte(wr * 64 + fr, fq * 8), boff = lds_byte(wc * 32 + fr, fq * 8);
#define PG8_SA(b, h) (((b) * 2 + (h)) * HTB)
#define PG8_SB(b, h) ((4 + (b) * 2 + (h)) * HTB)
#define PG8_STAGE(bufoff, gbase, voff) do { _Pragma("unroll") for (int _i = 0; _i < 2; ++_i) \
        __builtin_amdgcn_global_load_lds((const unsigned*)((const char*)(gbase) + (voff)[_i]), (LAS unsigned*)(lds + (bufoff) + ldsw + _i * 8192), 16, 0, 0); } while (0)
#define PG8_LDA(dst, b, h) do { _Pragma("unroll") for (int m = 0; m < 4; ++m) _Pragma("unroll") for (int k = 0; k < 2; ++k) dst[m][k] = *(const LAS bf16x8*)(lds + PG8_SA(b, h) + aoff + m * 2048 + k * 1024); } while (0)
#define PG8_LDB(dst, b, h) do { _Pragma("unroll") for (int n = 0; n < 2; ++n) _Pragma("unroll") for (int k = 0; k < 2; ++k) dst[n][k] = *(const LAS bf16x8*)(lds + PG8_SB(b, h) + boff + n * 2048 + k * 1024); } while (0)
#define PG8_MMA(ai, bj, At, Bt) do { __builtin_amdgcn_s_setprio(1); _Pragma("unroll") for (int m = 0; m < 4; ++m) _Pragma("unroll") for (int n = 0; n < 2; ++n) _Pragma("unroll") for (int k = 0; k < 2; ++k) \
        acc[ai][bj][m][n] = __builtin_amdgcn_mfma_f32_16x16x32_bf16(Bt[n][k], At[m][k], acc[ai][bj][m][n], 0, 0, 0); __builtin_amdgcn_s_setprio(0); } while (0)
#define PG8_WAIT_V(n) asm volatile("s_waitcnt vmcnt(" #n ")" ::: "memory")
#define PG8_WAIT_L(n) asm volatile("s_waitcnt lgkmcnt(" #n ")" ::: "memory")
#define PG8_BAR __builtin_amdgcn_s_barrier()
#define PG8_SCHED __builtin_amdgcn_sched_barrier(0)
#define PG8_AOFF(u) ((size_t)(u).pm * tstepA + (g.grp ? (size_t)((u).pn / g.grp) * (size_t)K * 2 : (size_t)0))
    Unit cur, nxt; int ui = 0;
    if (!S.next(0, cur)) return;
    f32x4 acc[2][2][4][2];
#pragma unroll
    for (int a = 0; a < 2; ++a)
#pragma unroll
        for (int b = 0; b < 2; ++b)
#pragma unroll
            for (int m = 0; m < 4; ++m)
#pragma unroll
                for (int n = 0; n < 2; ++n) acc[a][b][m][n] = (f32x4){0.f, 0.f, 0.f, 0.f};
    bf16x8 At[4][2], B0[2][2], B1[2][2];
    const char* cA = (const char*)g.A + PG8_AOFF(cur); const char* cB = (const char*)g.Bt + (size_t)cur.pn * tstepB;
    PG8_STAGE(PG8_SB(0, 0), cB, voffB); PG8_STAGE(PG8_SB(0, 1), cB + hstepB, voffB); PG8_STAGE(PG8_SA(0, 0), cA, voffA); PG8_STAGE(PG8_SA(0, 1), cA + hstepA, voffA);
    if (wr == 1) PG8_BAR;
    PG8_WAIT_V(2); PG8_BAR;
    PG8_STAGE(PG8_SB(1, 0), cB + kstep, voffB); PG8_STAGE(PG8_SA(1, 0), cA + kstep, voffA); PG8_STAGE(PG8_SB(1, 1), cB + hstepB + kstep, voffB);
    PG8_WAIT_V(6); PG8_BAR;
    for (;;) {
        const bool has_next = S.next(ui + 1, nxt);
        const char* nA = has_next ? (const char*)g.A + PG8_AOFF(nxt) : cA; const char* nB = has_next ? (const char*)g.Bt + (size_t)nxt.pn * tstepB : cB;
        for (int t = 0; t < nt; t += 2) {
            const bool last = (t == nt - 2);
            const char* a1 = cA + (size_t)(t + 1) * kstep;
            const char* a2 = last ? nA : cA + (size_t)(t + 2) * kstep; const char* b2 = last ? nB : cB + (size_t)(t + 2) * kstep;
            const char* a3 = a2 + kstep; const char* b3 = b2 + kstep;
            PG8_LDB(B0, 0, 0); PG8_LDB(B1, 0, 1); PG8_SCHED; PG8_LDA(At, 0, 0); PG8_STAGE(PG8_SA(1, 1), a1 + hstepA, voffA);
            PG8_WAIT_V(8); PG8_WAIT_L(0); PG8_BAR; PG8_MMA(0, 0, At, B0); PG8_MMA(0, 1, At, B1); PG8_BAR; PG8_SCHED;
            PG8_LDA(At, 0, 1); PG8_STAGE(PG8_SB(0, 0), b2, voffB); PG8_STAGE(PG8_SB(0, 1), b2 + hstepB, voffB); PG8_STAGE(PG8_SA(0, 0), a2, voffA);
            PG8_WAIT_V(8); PG8_WAIT_L(0); PG8_BAR; PG8_MMA(1, 0, At, B0); PG8_MMA(1, 1, At, B1); PG8_BAR; PG8_SCHED;
            PG8_LDB(B0, 1, 0); PG8_LDB(B1, 1, 1); PG8_SCHED; PG8_LDA(At, 1, 0); PG8_STAGE(PG8_SA(0, 1), a2 + hstepA, voffA);
            PG8_WAIT_V(8); PG8_WAIT_L(0); PG8_BAR; PG8_MMA(0, 0, At, B0); PG8_MMA(0, 1, At, B1); PG8_BAR; PG8_SCHED;
            PG8_LDA(At, 1, 1); PG8_STAGE(PG8_SB(1, 0), b3, voffB); PG8_STAGE(PG8_SB(1, 1), b3 + hstepB, voffB); PG8_STAGE(PG8_SA(1, 0), a3, voffA);
            PG8_WAIT_V(8); PG8_WAIT_L(0); PG8_BAR; PG8_MMA(1, 0, At, B0); PG8_MMA(1, 1, At, B1); PG8_BAR; PG8_SCHED;
        }
        if (wr == 0) PG8_BAR;
        asm volatile("s_nop 15\n\ts_nop 15\n\ts_nop 15" ::: "memory");
        E(acc, cur, wr, wc, fr, fq);
        if (!has_next) break;
#pragma unroll
        for (int a = 0; a < 2; ++a)
#pragma unroll
            for (int b = 0; b < 2; ++b)
#pragma unroll
                for (int m = 0; m < 4; ++m)
#pragma unroll
                    for (int n = 0; n < 2; ++n) acc[a][b][m][n] = (f32x4){0.f, 0.f, 0.f, 0.f};
        cur = nxt; cA = nA; cB = nB; ++ui;
        if (wr == 1) PG8_BAR;
    }
    PG8_WAIT_V(0);
    PG8_BAR;
#undef PG8_SA
#undef PG8_SB
#undef PG8_STAGE
#undef PG8_LDA
#undef PG8_LDB
#undef PG8_MMA
#undef PG8_WAIT_V
#undef PG8_WAIT_L
#undef PG8_BAR
#undef PG8_SCHED
#undef PG8_AOFF
}
}

#define XB_TMO      128
#define XB_XCNT(j)  (256  + 64 * (j))
#define XB_XSUB(j)  (1280 + 64 * (j))
#define XB_XGEN(j)  (2304 + 64 * (j))
#define XB_TOP      3328
#define XB_TOPGEN   3392
#define XCD_BAR_WORDS 3456
#define XB_SPIN_CAP (1u << 18)
__device__ __forceinline__ unsigned xb_ld(unsigned* p)              { return __hip_atomic_load(p, __ATOMIC_RELAXED, __HIP_MEMORY_SCOPE_AGENT); }
__device__ __forceinline__ unsigned xb_add(unsigned* p, unsigned v) { return __hip_atomic_fetch_add(p, v, __ATOMIC_RELAXED, __HIP_MEMORY_SCOPE_AGENT); }
__device__ __forceinline__ unsigned xb_xcc_id() { return (unsigned)__builtin_amdgcn_s_getreg((3 << 11) | 20) & 0xFu; }
#define XB_SPIN(cond, bar) do { unsigned _sp = 0; while (cond) { __builtin_amdgcn_s_sleep(1); \
    if ((++_sp & 255u) == 0u) { if (xb_ld(&(bar)[XB_TMO])) break; if (_sp > XB_SPIN_CAP) { atomicAdd(&(bar)[XB_TMO], 1u); break; } } } } while (0)
__device__ __forceinline__ int lane_id() { return (int)__builtin_amdgcn_mbcnt_hi(~0u, __builtin_amdgcn_mbcnt_lo(~0u, 0u)); }
struct XcdBarrier { unsigned* bar; unsigned x; volatile LAS unsigned* st; int wv; };
__device__ __forceinline__ XcdBarrier xcd_barrier_post(unsigned* bar, volatile LAS unsigned* st, int wv) {
    XcdBarrier b; b.bar = bar; b.x = xb_xcc_id(); b.st = st; b.wv = wv;
    if (b.wv == 0 && lane_id() == 0) (void)xb_add(&bar[XB_XCNT(b.x)], 1u);
    return b;
}
__device__ __forceinline__ void xcd_barrier_complete(unsigned* bar, unsigned x, unsigned& nloc, unsigned& nx) {
    const unsigned G = gridDim.x * gridDim.y * gridDim.z;
    unsigned sum, cnt, mine, sp = 0u;
    for (;;) {
        sum = 0u; cnt = 0u; mine = 0u;
#pragma unroll
        for (unsigned j = 0; j < 16; ++j) { const unsigned c = xb_ld(&bar[XB_XCNT(j)]); sum += c; cnt += (c > 0u) ? 1u : 0u; mine = (j == x) ? c : mine; }
        if (sum == G) break;
        __builtin_amdgcn_s_sleep(1);
        if ((++sp & 255u) == 0u) { if (xb_ld(&bar[XB_TMO])) break; if (sp > XB_SPIN_CAP) { atomicAdd(&bar[XB_TMO], 1u); break; } }
    }
    nloc = mine > 0u ? mine : 1u; nx = cnt > 0u ? cnt : 1u;
}
__device__ __forceinline__ void xcd_barrier(const XcdBarrier& b) {
    asm volatile("s_waitcnt vmcnt(0)" ::: "memory");
    __syncthreads();
    if (b.wv == 0 && lane_id() == 0) {
        unsigned* bar = b.bar;
        __builtin_amdgcn_s_waitcnt(0);
        unsigned nloc = b.st[0], nx = b.st[1];
        if (nloc == 0u) { xcd_barrier_complete(bar, b.x, nloc, nx); b.st[0] = nloc; b.st[1] = nx; }
        const unsigned old = xb_add(&bar[XB_XSUB(b.x)], 1u);
        const unsigned gen = old / nloc;
        if (old + 1u == (gen + 1u) * nloc) {
            __builtin_amdgcn_fence(__ATOMIC_RELEASE, "agent");
            asm volatile("s_waitcnt vmcnt(0)" ::: "memory");
            const unsigned og = xb_add(&bar[XB_TOP], 1u);
            const unsigned tg = og / nx;
            if (og + 1u == (tg + 1u) * nx) xb_add(&bar[XB_TOPGEN], 1u);
            else XB_SPIN(xb_ld(&bar[XB_TOPGEN]) == tg, bar);
            __builtin_amdgcn_fence(__ATOMIC_ACQUIRE, "agent");
            xb_add(&bar[XB_XGEN(b.x)], 1u);
            asm volatile("s_waitcnt vmcnt(0)" ::: "memory");
        } else {
            XB_SPIN(xb_ld(&bar[XB_XGEN(b.x)]) == gen, bar);
            __builtin_amdgcn_fence(__ATOMIC_ACQUIRE, "agent");
            asm volatile("s_waitcnt vmcnt(0)" ::: "memory");
        }
    }
    __syncthreads();
}

constexpr int LDS_BYTES = 163840;
constexpr int MISC_OFF = LDS_BYTES - 256;

struct WDesc { const float* W; bf16_t* WT; int K, N, nmat, pad; };
struct Args {
    const float* x; const float* mix_norm; const float* ffn_norm;
    const float* att_q_gain; const float* att_k_gain; const float* att_rel_bias;
    const float* pool_scale; const float* gdn_conv; const float* gdn_a_log; const float* gdn_dt_bias; const float* gdn_o_gain; const float* ffn_conv;
    float* out; unsigned char* ws;
    WDesc wd[7];
    int ph_lo, ph_hi;
};

struct Ctx { LAS unsigned char* lds; int tid, lane, wave, G, bid; };

__device__ __forceinline__ void transpose_item(const float* W, int K, int N, bf16_t* WT, LAS float* scr, int item, int lane, int mode) {
    const int nblk = N / 64, kb = item / nblk, nb = item % nblk, k0 = 64 * kb, n0 = 64 * nb;
    const int r0 = (mode == 0) ? n0 : ((n0 < FF) ? 256 * (n0 >> 7) + (n0 & 127) : 256 * ((n0 - FF) >> 7) + 128 + ((n0 - FF) & 127));
    f32x4 v[16];
#pragma unroll
    for (int i = 0; i < 16; ++i) v[i] = *(const f32x4*)(W + (size_t)(k0 + 4 * i + (lane >> 4)) * N + n0 + 4 * (lane & 15));
#pragma unroll
    for (int i = 0; i < 16; ++i) *(LAS f32x4*)(scr + (4 * i + (lane >> 4)) * 68 + 4 * (lane & 15)) = v[i];
    LDS_WAIT();
    const int c = lane & 7;
#pragma unroll
    for (int j = 0; j < 8; ++j) { const int n = (lane >> 3) + 8 * j; const LAS float* sp = scr + (8 * c) * 68 + n;
        u32x4 o; o.x = cvt_pk_bf16(sp[0 * 68], sp[1 * 68]); o.y = cvt_pk_bf16(sp[2 * 68], sp[3 * 68]); o.z = cvt_pk_bf16(sp[4 * 68], sp[5 * 68]); o.w = cvt_pk_bf16(sp[6 * 68], sp[7 * 68]);
        *(u32x4*)(WT + (size_t)(r0 + n) * K + k0 + 8 * c) = o; }
    LDS_WAIT();
}
typedef const __attribute__((address_space(4))) struct Args* KArgsP0;
__device__ __forceinline__ void phase_weights(const Ctx& c, KArgsP0 a) {
    LAS float* scr = (LAS float*)(c.lds + c.wave * 17408);
    const int gw = c.bid * NWAVES + c.wave, NGW = c.G * NWAVES;
#pragma unroll
    for (int d = 0; d < 7; ++d) {
        const float* W = a->wd[d].W; bf16_t* WT = a->wd[d].WT; const int K = a->wd[d].K, N = a->wd[d].N, nmat = a->wd[d].nmat, mode = a->wd[d].pad;
        const int per = (K / 64) * (N / 64), tot = per * nmat;
        for (int it = gw; it < tot; it += NGW) { const int mat = it / per, r = it - mat * per;
            transpose_item(W + (size_t)mat * K * N, K, N, WT + (size_t)mat * K * N, scr, r, c.lane, mode); }
    }
    { u32x4* z = (u32x4*)(a->ws + WS_WGIN + (size_t)GIN * D * 2); const int n16 = (GINP - GIN) * D * 2 / 16;
      for (int i = c.bid * NTHREADS + c.tid; i < n16; i += c.G * NTHREADS) z[i] = (u32x4){0u, 0u, 0u, 0u}; }
}

__device__ __forceinline__ void phase_rmsnorm(const Ctx& c, const float* x, const float* gain, bf16_t* out) {
    const int gw = c.bid * NWAVES + c.wave, NGW = c.G * NWAVES;
    f32x4 gv[8];
#pragma unroll
    for (int j = 0; j < 8; ++j) gv[j] = *(const f32x4*)(gain + 4 * c.lane + 256 * j);
    f32x4 v[8], vn[8];
    if (gw < T) {
#pragma unroll
        for (int j = 0; j < 8; ++j) v[j] = ((const f32x4*)(x + (size_t)gw * D) + c.lane)[64 * j];
    }
    for (int m = gw; m < T; m += NGW) {
        const int mn = (m + NGW < T) ? m + NGW : m;
        const f32x4* xn = (const f32x4*)(x + (size_t)mn * D) + c.lane;
#pragma unroll
        for (int j = 0; j < 8; ++j) vn[j] = xn[64 * j];
        float s = 0.f;
#pragma unroll
        for (int j = 0; j < 8; ++j) s += (v[j].x * v[j].x + v[j].y * v[j].y) + (v[j].z * v[j].z + v[j].w * v[j].w);
        const float rstd = 1.0f / sqrtf(wave_sum(s) * (1.0f / D) + EPS);
        u32x2* o8 = (u32x2*)(out + (size_t)m * D) + c.lane;
#pragma unroll
        for (int j = 0; j < 8; ++j) { u32x2 w; w.x = cvt_pk_bf16(v[j].x * rstd * gv[j].x, v[j].y * rstd * gv[j].y); w.y = cvt_pk_bf16(v[j].z * rstd * gv[j].z, v[j].w * rstd * gv[j].w); o8[64 * j] = w; }
#pragma unroll
        for (int j = 0; j < 8; ++j) v[j] = vn[j];
    }
}
__device__ __forceinline__ void phase_ffn_fix(const Ctx& c, bf16_t* ACT, const float* cw, const bf16_t* TAILU, const bf16_t* HEADU, const bf16_t* HEADG) {
    constexpr int NCG = FF / 8, NS = T / 64;
    for (int it = c.bid * NTHREADS + c.tid; it < NS * NCG; it += c.G * NTHREADS) {
        const int sg = it / NCG, cg = it - sg * NCG, col = cg * 8; const bool first = ((sg * 64) % SEQ) == 0;
        float w0[8], w1[8], w2[8], um2[8], um1[8], u0[8], u1[8], g0[8], g1[8];
#pragma unroll
        for (int h = 0; h < 2; ++h) { const f32x4 a0 = *(const f32x4*)(cw + col + 4 * h), a1 = *(const f32x4*)(cw + FF + col + 4 * h), a2 = *(const f32x4*)(cw + 2 * FF + col + 4 * h);
#pragma unroll
            for (int k = 0; k < 4; ++k) { w0[4 * h + k] = a0[k]; w1[4 * h + k] = a1[k]; w2[4 * h + k] = a2[k]; } }
        const u32x4 hu0 = *(const u32x4*)(HEADU + (size_t)(sg * 2) * FF + col), hu1 = *(const u32x4*)(HEADU + (size_t)(sg * 2 + 1) * FF + col);
        const u32x4 hg0 = *(const u32x4*)(HEADG + (size_t)(sg * 2) * FF + col), hg1 = *(const u32x4*)(HEADG + (size_t)(sg * 2 + 1) * FF + col);
        u32x4 t0 = (u32x4){0u, 0u, 0u, 0u}, t1 = t0;
        if (!first) { t0 = *(const u32x4*)(TAILU + (size_t)(sg * 2 - 2) * FF + col); t1 = *(const u32x4*)(TAILU + (size_t)(sg * 2 - 1) * FF + col); }
#pragma unroll
        for (int k = 0; k < 4; ++k) { um2[2 * k] = bflo(t0[k]); um2[2 * k + 1] = bfhi(t0[k]); um1[2 * k] = bflo(t1[k]); um1[2 * k + 1] = bfhi(t1[k]);
            u0[2 * k] = bflo(hu0[k]); u0[2 * k + 1] = bfhi(hu0[k]); u1[2 * k] = bflo(hu1[k]); u1[2 * k + 1] = bfhi(hu1[k]);
            g0[2 * k] = bflo(hg0[k]); g0[2 * k + 1] = bfhi(hg0[k]); g1[2 * k] = bflo(hg1[k]); g1[2 * k + 1] = bfhi(hg1[k]); }
        float y0[8], y1[8];
#pragma unroll
        for (int k = 0; k < 8; ++k) { y0[k] = siluf(w0[k] * um2[k] + w1[k] * um1[k] + w2[k] * u0[k]) * g0[k]; y1[k] = siluf(w0[k] * um1[k] + w1[k] * u0[k] + w2[k] * u1[k]) * g1[k]; }
        u32x4 o; o.x = cvt_pk_bf16(y0[0], y0[1]); o.y = cvt_pk_bf16(y0[2], y0[3]); o.z = cvt_pk_bf16(y0[4], y0[5]); o.w = cvt_pk_bf16(y0[6], y0[7]);
        *(u32x4*)(ACT + (size_t)(sg * 64) * FF + col) = o;
        o.x = cvt_pk_bf16(y1[0], y1[1]); o.y = cvt_pk_bf16(y1[2], y1[3]); o.z = cvt_pk_bf16(y1[4], y1[5]); o.w = cvt_pk_bf16(y1[6], y1[7]);
        *(u32x4*)(ACT + (size_t)(sg * 64 + 1) * FF + col) = o;
    }
}

__device__ __forceinline__ void phase_pool_prep(const Ctx& c, const bf16_t* H, bf16_t* P) {
    constexpr int NCG = D / 8, RB = 64;
    const int nitems = (T / RB) * NCG;
    for (int it = c.bid * NTHREADS + c.tid; it < nitems; it += c.G * NTHREADS) {
        const int rb = it / NCG, cg = it - rb * NCG, t0 = rb * RB, col = cg * 8, w = 2 << (col >> 9), tp0 = t0 % SEQ;
        float s[8];
#pragma unroll
        for (int k = 0; k < 8; ++k) s[k] = 0.f;
        for (int i = 1; i <= w; ++i) if (tp0 - i >= 0) {   const u32x4 a = *(const u32x4*)(H + (size_t)(t0 - i) * D + col);
#pragma unroll
            for (int k = 0; k < 4; ++k) { s[2 * k] += bflo(a[k]); s[2 * k + 1] += bfhi(a[k]); } }
        for (int tb = t0; tb < t0 + RB; tb += 8) {
            u32x4 ar[8], br[8];
#pragma unroll
            for (int q = 0; q < 8; ++q) { const int t = tb + q, tp = tp0 + (t - t0);
                ar[q] = *(const u32x4*)(H + (size_t)t * D + col);
                br[q] = (tp >= w) ? *(const u32x4*)(H + (size_t)(t - w) * D + col) : (u32x4){0u, 0u, 0u, 0u}; }
#pragma unroll
            for (int q = 0; q < 8; ++q) { const int t = tb + q, tp = tp0 + (t - t0);
                const u32x4 a = ar[q], b = br[q];
                float cu[8];
#pragma unroll
                for (int k = 0; k < 4; ++k) { cu[2 * k] = bflo(a[k]); cu[2 * k + 1] = bfhi(a[k]); }
#pragma unroll
                for (int k = 0; k < 8; ++k) s[k] += cu[k];
#pragma unroll
                for (int k = 0; k < 4; ++k) { s[2 * k] -= bflo(b[k]); s[2 * k + 1] -= bfhi(b[k]); }
                const float inv = 1.0f / (float)(tp + 1 < w ? tp + 1 : w);
                u32x4 o; o.x = cvt_pk_bf16(s[0] * inv - cu[0], s[1] * inv - cu[1]); o.y = cvt_pk_bf16(s[2] * inv - cu[2], s[3] * inv - cu[3]);
                o.z = cvt_pk_bf16(s[4] * inv - cu[4], s[5] * inv - cu[5]); o.w = cvt_pk_bf16(s[6] * inv - cu[6], s[7] * inv - cu[7]);
                *(u32x4*)(P + (size_t)t * D + col) = o;
            }
        }
    }
}

constexpr int ATT_ROWB = 272;
constexpr int ATT_WAVE_BYTES = 2 * 32 * ATT_ROWB + NREL * 4;
static_assert(ATT_WAVE_BYTES * NWAVES <= MISC_OFF, "attention LDS");
__device__ __forceinline__ void phase_attention(const Ctx& c, const bf16_t* QKV, bf16_t* O, const float* q_gain, const float* k_gain, const float* rel_bias) {
    LAS unsigned char* Kt = c.lds + c.wave * ATT_WAVE_BYTES;
    LAS unsigned char* Vt = Kt + 32 * ATT_ROWB;
    LAS float* bias = (LAS float*)(Vt + 32 * ATT_ROWB);
    const int lane = c.lane, l31 = lane & 31, hh = lane >> 5;
    const int gw = c.bid * NWAVES + c.wave, NGW = c.G * NWAVES;
    constexpr int NU = BATCH * NCH * AH * 2;
    const float scale = 0.08838834764831845f;
    float kg[8];
    { const int ch = lane & 15; const f32x4 a = *(const f32x4*)(k_gain + ch * 8), b = *(const f32x4*)(k_gain + ch * 8 + 4);
#pragma unroll
      for (int k = 0; k < 4; ++k) { kg[k] = a[k]; kg[4 + k] = b[k]; } }
    for (int u = gw; u < NU; u += NGW) {
        const int qh = u & 1, h = (u >> 1) & 15, ck = (u >> 5) & 127, b = u >> 12;
        const size_t row_q0 = (size_t)b * SEQ + (size_t)ck * CH + qh * 32;
        for (int i = lane; i < NREL; i += 64) bias[i] = rel_bias[h * NREL + i];
        bf16x8 qf[8];
        {
            float qv[8][8]; float ss = 0.f;
            const bf16_t* qp = QKV + (row_q0 + l31) * 6144 + h * AHD + hh * 8;
#pragma unroll
            for (int ks = 0; ks < 8; ++ks) { const u32x4 a = *(const u32x4*)(qp + ks * 16);
#pragma unroll
                for (int k = 0; k < 4; ++k) { qv[ks][2 * k] = bflo(a[k]); qv[ks][2 * k + 1] = bfhi(a[k]); }
#pragma unroll
                for (int k = 0; k < 8; ++k) ss += qv[ks][k] * qv[ks][k]; }
            ss += __shfl_xor(ss, 32);
            const float rq = scale / sqrtf(ss * (1.0f / AHD) + EPS);
#pragma unroll
            for (int ks = 0; ks < 8; ++ks) { const f32x4 g0 = *(const f32x4*)(q_gain + ks * 16 + hh * 8), g1 = *(const f32x4*)(q_gain + ks * 16 + hh * 8 + 4);
                u32x4 w; w.x = cvt_pk_bf16(qv[ks][0] * rq * g0[0], qv[ks][1] * rq * g0[1]); w.y = cvt_pk_bf16(qv[ks][2] * rq * g0[2], qv[ks][3] * rq * g0[3]);
                w.z = cvt_pk_bf16(qv[ks][4] * rq * g1[0], qv[ks][5] * rq * g1[1]); w.w = cvt_pk_bf16(qv[ks][6] * rq * g1[2], qv[ks][7] * rq * g1[3]);
                qf[ks] = __builtin_bit_cast(bf16x8, w); }
        }
        float mrun = -1e30f, lsum = 0.f;
        f32x16 oacc[4];
#pragma unroll
        for (int dt = 0; dt < 4; ++dt)
#pragma unroll
            for (int r = 0; r < 16; ++r) oacc[dt][r] = 0.f;
        const int qi = qh * 32 + l31;
        const int kt_first = (ck >= 8) ? 0 : 2 * (8 - ck);
        for (int kt = kt_first; kt < 18; ++kt) {
            const int kj0 = kt * 32;
            const size_t krow0 = (size_t)b * SEQ + (size_t)((ck - 8) * CH + kj0);
            {
                const int ch = lane & 15, rr = lane >> 4;
#pragma unroll
                for (int i = 0; i < 8; ++i) {
                    const int row = rr + 4 * i;
                    const bf16_t* kp = QKV + (krow0 + row) * 6144 + 2048 + h * AHD + ch * 8;
                    const u32x4 a = *(const u32x4*)kp, vv = *(const u32x4*)(kp + 2048);
                    float kv[8]; float ss = 0.f;
#pragma unroll
                    for (int k = 0; k < 4; ++k) { kv[2 * k] = bflo(a[k]); kv[2 * k + 1] = bfhi(a[k]); }
#pragma unroll
                    for (int k = 0; k < 8; ++k) ss += kv[k] * kv[k];
                    ss += __shfl_xor(ss, 1); ss += __shfl_xor(ss, 2); ss += __shfl_xor(ss, 4); ss += __shfl_xor(ss, 8);
                    const float rk = 1.0f / sqrtf(ss * (1.0f / AHD) + EPS);
                    u32x4 w; w.x = cvt_pk_bf16(kv[0] * rk * kg[0], kv[1] * rk * kg[1]); w.y = cvt_pk_bf16(kv[2] * rk * kg[2], kv[3] * rk * kg[3]);
                    w.z = cvt_pk_bf16(kv[4] * rk * kg[4], kv[5] * rk * kg[5]); w.w = cvt_pk_bf16(kv[6] * rk * kg[6], kv[7] * rk * kg[7]);
                    *(LAS u32x4*)(Kt + row * ATT_ROWB + ch * 16) = w;
                    *(LAS u32x4*)(Vt + row * ATT_ROWB + ch * 16) = vv;
                }
            }
            LDS_WAIT();
            f32x16 st;
#pragma unroll
            for (int r = 0; r < 16; ++r) st[r] = 0.f;
#pragma unroll
            for (int ks = 0; ks < 8; ++ks) { const bf16x8 kf = *(const LAS bf16x8*)(Kt + l31 * ATT_ROWB + ks * 32 + hh * 16);
                st = __builtin_amdgcn_mfma_f32_32x32x16_bf16(kf, qf[ks], st, 0, 0, 0); }
            float mt = -1e30f;
#pragma unroll
            for (int r = 0; r < 16; ++r) { const int kj = kj0 + (r & 3) + 8 * (r >> 2) + 4 * hh; int idx = 575 + qi - kj; idx = idx > 319 ? 319 : idx; st[r] += bias[idx]; mt = fmaxf(mt, st[r]); }
            mt = fmaxf(mt, __shfl_xor(mt, 32));
            const float mnew = fmaxf(mrun, mt), alpha = __expf(mrun - mnew);
            mrun = mnew;
            float ps = 0.f;
#pragma unroll
            for (int r = 0; r < 16; ++r) { st[r] = __expf(st[r] - mnew); ps += st[r]; }
            lsum = lsum * alpha + ps;
#pragma unroll
            for (int dt = 0; dt < 4; ++dt)
#pragma unroll
                for (int r = 0; r < 16; ++r) oacc[dt][r] *= alpha;
            bf16x8 pf[2];
#pragma unroll
            for (int s = 0; s < 2; ++s) { u32x4 w; w.x = cvt_pk_bf16(st[8 * s + 0], st[8 * s + 1]); w.y = cvt_pk_bf16(st[8 * s + 2], st[8 * s + 3]); w.z = cvt_pk_bf16(st[8 * s + 4], st[8 * s + 5]); w.w = cvt_pk_bf16(st[8 * s + 6], st[8 * s + 7]);
                pf[s] = __builtin_bit_cast(bf16x8, w); }
            {
                const int i16 = lane & 15, g1 = (lane >> 4) & 1;
                LAS unsigned char* vb = Vt + (4 * hh + (i16 >> 2)) * ATT_ROWB + (16 * g1 + 4 * (i16 & 3)) * 2;
#pragma unroll
                for (int dt = 0; dt < 4; ++dt)
#pragma unroll
                    for (int s = 0; s < 2; ++s) {
                        const s16x4 lo = __builtin_bit_cast(s16x4, __builtin_amdgcn_ds_read_tr16_b64_v4i16((LAS s16x4*)(vb + (16 * s) * ATT_ROWB + dt * 64)));
                        const s16x4 hi = __builtin_bit_cast(s16x4, __builtin_amdgcn_ds_read_tr16_b64_v4i16((LAS s16x4*)(vb + (16 * s + 8) * ATT_ROWB + dt * 64)));
                        const bf16x8 vf = (bf16x8){lo[0], lo[1], lo[2], lo[3], hi[0], hi[1], hi[2], hi[3]};
                        oacc[dt] = __builtin_amdgcn_mfma_f32_32x32x16_bf16(vf, pf[s], oacc[dt], 0, 0, 0);
                    }
            }
            LDS_WAIT();
        }
        lsum += __shfl_xor(lsum, 32);
        const float inv = 1.0f / lsum;
        bf16_t* op = O + (row_q0 + l31) * D + h * AHD + 4 * hh;
#pragma unroll
        for (int dt = 0; dt < 4; ++dt)
#pragma unroll
            for (int g = 0; g < 4; ++g) { u32x2 w; w.x = cvt_pk_bf16(oacc[dt][4 * g] * inv, oacc[dt][4 * g + 1] * inv); w.y = cvt_pk_bf16(oacc[dt][4 * g + 2] * inv, oacc[dt][4 * g + 3] * inv);
                *(u32x2*)(op + dt * 32 + g * 8) = w; }
        LDS_WAIT();
    }
}

constexpr int AT_SLOT = 32768, AT_BIAS = 4 * AT_SLOT, AT_NB = 640, AT_RK = AT_BIAS + AT_NB * 4, AT_END = AT_RK + 768 * 4;
static_assert(AT_END <= MISC_OFF, "attention LDS");
__device__ __forceinline__ void glds16(const void* gsrc, unsigned lds_dst) { unsigned keep;
    asm volatile("s_mov_b32 %0, m0\n\ts_mov_b32 m0, %2\n\ts_nop 0\n\tglobal_load_lds_dwordx4 %1, off\n\ts_mov_b32 m0, %0" : "=&s"(keep) : "v"(gsrc), "s"(lds_dst) : "memory"); }
__device__ __forceinline__ void phase_attention3(const Ctx& c, const bf16_t* QKV, bf16_t* O, const float* PART, const float* q_gain, const float* k_gain, const float* rel_bias) {
    LAS unsigned char* lds = c.lds;
    const unsigned lds0 = (unsigned)(size_t)lds;
    LAS float* bias = (LAS float*)(lds + AT_BIAS);
    LAS float* rkt = (LAS float*)(lds + AT_RK);
    const int lane = c.lane, w = c.wave, l31 = lane & 31, hh = lane >> 5, i16 = lane & 15, g1 = (lane >> 4) & 1;
    const int wo = w >> 1, qi = 32 * (w & 1) + l31;
    const int fr = ((l31 & 3) << 2) | ((l31 >> 2) & 3);
    constexpr float LOG2E = 1.4426950408889634f;
    constexpr int NU = BATCH * 32 * AH;
    for (int u = c.bid; u < NU; u += c.G) {
        const int h = u & 15, cq = (u >> 4) & 31, b = u >> 9;
        const int jf = (cq >= 2) ? 0 : 8 - 4 * cq;
        const bf16_t* ksrc[2];
#pragma unroll
        for (int pp = 0; pp < 2; ++pp) { const int row = 8 * w + 4 * pp + (lane >> 4), chl = (lane & 15) ^ (((row & 3) << 2) | ((row >> 2) & 3));
            ksrc[pp] = QKV + ((size_t)b * SEQ + (size_t)((4 * cq - 8) * CH + row)) * 6144 + 2048 + h * AHD + chl * 8; }
#define AT_DMA(j) do { const unsigned sl_ = lds0 + (unsigned)(((j) & 3) * AT_SLOT) + (unsigned)(2 * w) * 1024u; const size_t to_ = (size_t)(j) * CH * 6144; \
            glds16(ksrc[0] + to_, sl_); glds16(ksrc[1] + to_, sl_ + 1024u); glds16(ksrc[0] + to_ + 2048, sl_ + 16384u); glds16(ksrc[1] + to_ + 2048, sl_ + 16384u + 1024u); } while (0)
        AT_DMA(jf); AT_DMA(jf + 1); AT_DMA(jf + 2);
        for (int i = c.tid; i < AT_NB; i += NTHREADS) bias[i] = rel_bias[h * NREL + (i < NREL - 1 ? i : NREL - 1)] * LOG2E;
        for (int i = c.tid; i < 768; i += NTHREADS) { const int kr = (4 * cq - 8) * CH + i;
            if (kr >= 0) { const f32x4 p = *(const f32x4*)(PART + (((size_t)(8 + (h >> 1)) * T + ((size_t)b * SEQ + kr)) * 2 + (h & 1)) * 4); rkt[i] = 1.0f / sqrtf(((p[0] + p[1]) + (p[2] + p[3])) * (1.0f / AHD) + EPS); } }
        bf16x8 qf[8];
        { const size_t qrow = (size_t)b * SEQ + 256 * cq + 32 * w + l31;
          const f32x4 pq = *(const f32x4*)(PART + (((size_t)(h >> 1) * T + qrow) * 2 + (h & 1)) * 4);
          const float rq = 0.08838834764831845f * LOG2E / sqrtf(((pq[0] + pq[1]) + (pq[2] + pq[3])) * (1.0f / AHD) + EPS);
          const bf16_t* qp = QKV + qrow * 6144 + h * AHD + hh * 8;
#pragma unroll
          for (int ks = 0; ks < 8; ++ks) { const u32x4 a = *(const u32x4*)(qp + ks * 16);
              const f32x4 gq0 = *(const f32x4*)(q_gain + ks * 16 + hh * 8), gq1 = *(const f32x4*)(q_gain + ks * 16 + hh * 8 + 4), gk0 = *(const f32x4*)(k_gain + ks * 16 + hh * 8), gk1 = *(const f32x4*)(k_gain + ks * 16 + hh * 8 + 4);
              u32x4 wv; wv.x = cvt_pk_bf16_op(bflo(a.x) * rq * gq0[0] * gk0[0], bfhi(a.x) * rq * gq0[1] * gk0[1]); wv.y = cvt_pk_bf16_op(bflo(a.y) * rq * gq0[2] * gk0[2], bfhi(a.y) * rq * gq0[3] * gk0[3]);
              wv.z = cvt_pk_bf16_op(bflo(a.z) * rq * gq1[0] * gk1[0], bfhi(a.z) * rq * gq1[1] * gk1[1]); wv.w = cvt_pk_bf16_op(bflo(a.w) * rq * gq1[2] * gk1[2], bfhi(a.w) * rq * gq1[3] * gk1[3]);
              qf[ks] = __builtin_bit_cast(bf16x8, wv); } }
        __builtin_amdgcn_s_waitcnt(0);
#pragma unroll
        for (int ks = 0; ks < 8; ++ks) asm volatile("" : "+v"(qf[ks]));
        __syncthreads();
        float mrun = -1e30f, lsum = 0.f;
        f32x16 oacc[4];
#pragma unroll
        for (int dt = 0; dt < 4; ++dt)
#pragma unroll
            for (int r = 0; r < 16; ++r) oacc[dt][r] = 0.f;
        for (int j = jf; j < 12; ++j) {
            if (j <= 9) asm volatile("s_waitcnt vmcnt(8)\n\ts_barrier" ::: "memory");
            else if (j == 10) asm volatile("s_waitcnt vmcnt(4)\n\ts_barrier" ::: "memory");
            else asm volatile("s_waitcnt vmcnt(0)\n\ts_barrier" ::: "memory");
            if (j + 3 < 12) AT_DMA(j + 3);
            if (j >= wo && j <= wo + 8) {
                const LAS unsigned char* Kt = lds + (j & 3) * AT_SLOT; const LAS unsigned char* Vt = Kt + 16384;
                const int bp = j - wo;
                f32x16 st[2];
#pragma unroll
                for (int k2 = 0; k2 < 2; ++k2)
#pragma unroll
                    for (int r = 0; r < 16; ++r) st[k2][r] = 0.f;
                {
                    bf16x8 kfa[8], kfb[8];
#pragma unroll
                    for (int ks = 0; ks < 8; ++ks) { kfa[ks] = *(const LAS bf16x8*)(Kt + 256 * l31 + 16 * ((2 * ks + hh) ^ fr)); kfb[ks] = *(const LAS bf16x8*)(Kt + 256 * (32 + l31) + 16 * ((2 * ks + hh) ^ fr)); }
                    __builtin_amdgcn_sched_barrier(0);
#pragma unroll
                    for (int ks = 0; ks < 8; ++ks) { st[0] = __builtin_amdgcn_mfma_f32_32x32x16_bf16(kfa[ks], qf[ks], st[0], 0, 0, 0); st[1] = __builtin_amdgcn_mfma_f32_32x32x16_bf16(kfb[ks], qf[ks], st[1], 0, 0, 0); }
                }
                float mt = -1e30f;
                {
                    const LAS float* rkp = rkt + 64 * j + 4 * hh;
                    const LAS float* bp_ = bias + (575 + qi - 64 * bp - 4 * hh - 59);
#pragma unroll
                    for (int k2 = 0; k2 < 2; ++k2) {
                        f32x4 rkv[4]; float bv[16];
#pragma unroll
                        for (int g = 0; g < 4; ++g) rkv[g] = *(const LAS f32x4*)(rkp + 32 * k2 + 8 * g);
#pragma unroll
                        for (int r = 0; r < 16; ++r) bv[r] = bp_[59 - (32 * k2 + (r & 3) + 8 * (r >> 2))];
                        __builtin_amdgcn_sched_barrier(0);
                        if (k2 == 0) asm volatile("s_nop 15\n\ts_nop 15\n\ts_nop 15" ::: "memory");
#pragma unroll
                        for (int r = 0; r < 16; ++r) { st[k2][r] = st[k2][r] * rkv[r >> 2][r & 3] + bv[r]; mt = fmaxf(mt, st[k2][r]); }
                        __builtin_amdgcn_sched_barrier(0);
                    }
                }
                mt = fmaxf(mt, __shfl_xor(mt, 32));
                if (__builtin_amdgcn_ballot_w64(mt > mrun + 8.0f) != 0ull) {
                    const float mnew = (mt > mrun + 8.0f) ? mt : mrun, alpha = __builtin_amdgcn_exp2f(mrun - mnew);
                    mrun = mnew; lsum *= alpha;
#pragma unroll
                    for (int dt = 0; dt < 4; ++dt)
#pragma unroll
                        for (int r = 0; r < 16; ++r) oacc[dt][r] *= alpha;
                }
                float ps = 0.f;
#pragma unroll
                for (int k2 = 0; k2 < 2; ++k2)
#pragma unroll
                    for (int r = 0; r < 16; ++r) { st[k2][r] = __builtin_amdgcn_exp2f(st[k2][r] - mrun); ps += st[k2][r]; }
                lsum += ps;
                bf16x8 pf[4];
#pragma unroll
                for (int s = 0; s < 4; ++s) { const f32x16& sv = st[s >> 1]; const int o8 = 8 * (s & 1);
                    u32x4 wv; wv.x = cvt_pk_bf16_op(sv[o8 + 0], sv[o8 + 1]); wv.y = cvt_pk_bf16_op(sv[o8 + 2], sv[o8 + 3]); wv.z = cvt_pk_bf16_op(sv[o8 + 4], sv[o8 + 5]); wv.w = cvt_pk_bf16_op(sv[o8 + 6], sv[o8 + 7]);
                    pf[s] = __builtin_bit_cast(bf16x8, wv); }
                const int q4 = i16 >> 2, p4 = i16 & 3;
#pragma unroll
                for (int sp = 0; sp < 2; ++sp) {
                    s16x4 lo[2][4], hi[2][4];
#pragma unroll
                    for (int s2 = 0; s2 < 2; ++s2) { const int s = 2 * sp + s2, rlo = 16 * s + 4 * hh + q4, flo = (q4 << 2) | hh, fhi = (q4 << 2) | (hh + 2);
#pragma unroll
                        for (int dt = 0; dt < 4; ++dt) { const int chl = 4 * dt + 2 * g1 + (p4 >> 1);
                            lo[s2][dt] = __builtin_bit_cast(s16x4, __builtin_amdgcn_ds_read_tr16_b64_v4i16((LAS s16x4*)(Vt + 256 * rlo + 16 * (chl ^ flo) + 8 * (p4 & 1))));
                            hi[s2][dt] = __builtin_bit_cast(s16x4, __builtin_amdgcn_ds_read_tr16_b64_v4i16((LAS s16x4*)(Vt + 256 * (rlo + 8) + 16 * (chl ^ fhi) + 8 * (p4 & 1)))); } }
                    __builtin_amdgcn_sched_barrier(0);
#pragma unroll
                    for (int s2 = 0; s2 < 2; ++s2)
#pragma unroll
                        for (int dt = 0; dt < 4; ++dt) { const bf16x8 vf = (bf16x8){lo[s2][dt][0], lo[s2][dt][1], lo[s2][dt][2], lo[s2][dt][3], hi[s2][dt][0], hi[s2][dt][1], hi[s2][dt][2], hi[s2][dt][3]};
                            oacc[dt] = __builtin_amdgcn_mfma_f32_32x32x16_bf16(vf, pf[2 * sp + s2], oacc[dt], 0, 0, 0); }
                    __builtin_amdgcn_sched_barrier(0);
                }
            }
        }
#undef AT_DMA
        MFMA_SETTLE();
        lsum += __shfl_xor(lsum, 32);
        const float inv = 1.0f / lsum;
        bf16_t* op = O + ((size_t)b * SEQ + 256 * cq + 32 * w + l31) * D + h * AHD + 4 * hh;
#pragma unroll
        for (int dt = 0; dt < 4; ++dt)
#pragma unroll
            for (int g = 0; g < 4; ++g) { u32x2 wv; wv.x = cvt_pk_bf16(oacc[dt][4 * g] * inv, oacc[dt][4 * g + 1] * inv); wv.y = cvt_pk_bf16(oacc[dt][4 * g + 2] * inv, oacc[dt][4 * g + 3] * inv);
                *(u32x2*)(op + dt * 32 + g * 8) = wv; }
        asm volatile("s_waitcnt vmcnt(0) lgkmcnt(0)" ::: "memory");
        __syncthreads();
    }
}

constexpr int G2_QS = 0, G2_KS = 17408, G2_VS = 34816, G2_KK = G2_VS + 64 * 528, G2_QK = G2_KK + 64 * 65 * 4, G2_AT = G2_QK + 64 * 65 * 4, G2_GC = G2_AT + 2 * 64 * 64 * 4, G2_BETA = G2_GC + 512, G2_END = G2_BETA + 512;
constexpr int G2_TI = G2_END, G2_FBW = G2_TI + 8192, G2_END2 = G2_FBW + 512;
static_assert(G2_END2 <= MISC_OFF && (G2_AT % 16) == 0 && (G2_TI % 16) == 0, "G2 LDS");
#define G2_CL16(x) ((x) < 0 ? 0 : ((x) > 16 ? 16 : (x)))
#define G2_ORD(j) (4 * ((j) < 15 ? (j) : 15) + 3 * G2_CL16((j) - 15) + 2 * G2_CL16((j) - 31) + G2_CL16((j) - 47))
#define G2_SUBST_LOOP(SG_LO, SG_HI) \
_Pragma("unroll") \
            for (int sg = SG_LO; sg < SG_HI; ++sg) { \
                const int j = sg >> 2, cq = sg & 3, lo = ((j + 1) >> 2) + 4 * cq; \
                if (lo < 16) { \
                    const int ord = G2_ORD(j) + cq; \
                    const bool m1 = (lo + 4 < 16);  const int j1 = m1 ? j : j + 1,   l1 = m1 ? lo + 4 : ((j + 2) >> 2); \
                    const bool m2 = (l1 + 4 < 16);  const int j2 = m2 ? j1 : j1 + 1, l2 = m2 ? l1 + 4 : ((j1 + 2) >> 2); \
                    if (j2 < 63) { \
_Pragma("unroll") \
                        for (int g = 0; g < 4; ++g) if (l2 + g < 16) cb[(ord + 2) % 3][g] = *(const LAS f32x4*)(Ae + j2 * 64 + 4 * (l2 + g)); \
                    } \
                    __builtin_amdgcn_sched_barrier(0); \
                    const float xu = ru[j], xw = rw[j]; \
_Pragma("unroll") \
                    for (int g = 0; g < 4; ++g) if (lo + g < 16) { const f32x4 a = cb[ord % 3][g]; const int r_ = 4 * (lo + g); \
                        ru[r_ + 0] -= a[0] * xu; ru[r_ + 1] -= a[1] * xu; ru[r_ + 2] -= a[2] * xu; ru[r_ + 3] -= a[3] * xu; \
                        rw[r_ + 0] -= a[0] * xw; rw[r_ + 1] -= a[1] * xw; rw[r_ + 2] -= a[2] * xw; rw[r_ + 3] -= a[3] * xw; } \
                    __builtin_amdgcn_sched_barrier(0); \
                } \
            }

__device__ __forceinline__ void phase_gdn_local(const Ctx& c, bf16_t* C, bf16_t* W, bf16_t* ATT, const float* AB, float* GC, const bf16_t* HEAD3, const bf16_t* TAIL3, const float* cw, const float* a_log, const float* dt_bias) {
    LAS unsigned char* lds = c.lds;
    LAS float* KKs = (LAS float*)(lds + G2_KK); LAS float* QKs = (LAS float*)(lds + G2_QK); LAS float* At = (LAS float*)(lds + G2_AT);
    LAS float* gcs = (LAS float*)(lds + G2_GC); LAS float* betas = (LAS float*)(lds + G2_BETA);
    LAS float* TI = (LAS float*)(lds + G2_TI); LAS float* fbw = (LAS float*)(lds + G2_FBW);
    const int wave = c.wave;
    constexpr int NUNITS = (MH / CH) * GKH;
    u32x4 pQ[2], pK[2], pV[4]; float pcw[4]; unsigned short ph3[3], pt3[3]; float pav = 0.f, pbv = 0.f;
#define G2_PREFETCH(un_) do { int tp_ = c.tid; asm volatile("" : "+v"(tp_)); const int hk_ = (un_) & 15, cg_ = (un_) >> 4, r0_ = cg_ * CH; \
        _Pragma("unroll") for (int i = 0; i < 2; ++i) { const int idx = tp_ + i * 512, row = idx >> 4, ch = idx & 15; \
            pQ[i] = *(const u32x4*)(C + (size_t)(r0_ + row) * 8192 + hk_ * 128 + ch * 8); pK[i] = *(const u32x4*)(C + (size_t)(r0_ + row) * 8192 + 2048 + hk_ * 128 + ch * 8); } \
        _Pragma("unroll") for (int i = 0; i < 4; ++i) { const int idx = tp_ + i * 512, row = idx >> 5, ch = idx & 31; \
            pV[i] = *(const u32x4*)(C + (size_t)(r0_ + row) * 8192 + 4096 + hk_ * 256 + ch * 8); } \
        { const int chg = (tp_ < 128) ? hk_ * 128 + tp_ : (tp_ < 256) ? 2048 + hk_ * 128 + (tp_ - 128) : 4096 + hk_ * 256 + (tp_ - 256); \
          _Pragma("unroll") for (int q = 0; q < 4; ++q) pcw[q] = cw[q * 8192 + chg]; \
          _Pragma("unroll") for (int q = 0; q < 3; ++q) { ph3[q] = HEAD3[(size_t)(cg_ * 3 + q) * 8192 + chg]; pt3[q] = ((r0_ % SEQ) != 0) ? TAIL3[(size_t)(cg_ * 3 - 3 + q) * 8192 + chg] : (unsigned short)0; } } \
        if (tp_ < 128) { const int hv_ = 2 * hk_ + (tp_ >> 6), ln_ = tp_ & 63; pav = AB[(size_t)(r0_ + ln_) * 64 + hv_]; pbv = AB[(size_t)(r0_ + ln_) * 64 + 32 + hv_]; } } while (0)
    if (c.bid < NUNITS) G2_PREFETCH(c.bid);
    for (int u = c.bid; u < NUNITS; u += c.G) {
        int tid = c.tid; asm volatile("" : "+v"(tid));
        const int lane = tid & 63, l31 = lane & 31, hh = lane >> 5;
        const int hk = u & 15, cg = u >> 4, r0 = cg * CH;
#pragma unroll
        for (int i = 0; i < 2; ++i) { const int idx = tid + i * 512, row = idx >> 4, ch = idx & 15;
            if (row >= 3) { *(LAS u32x4*)(lds + G2_QS + row * 272 + ch * 16) = pQ[i]; *(LAS u32x4*)(lds + G2_KS + row * 272 + ch * 16) = pK[i]; } }
#pragma unroll
        for (int i = 0; i < 4; ++i) { const int idx = tid + i * 512, row = idx >> 5, ch = idx & 31;
            if (row >= 3) *(LAS u32x4*)(lds + G2_VS + row * 528 + ch * 16) = pV[i]; }
        {
            const float w0 = pcw[0], w1 = pcw[1], w2 = pcw[2], w3 = pcw[3];
            const float h0 = bf2f(ph3[0]), h1 = bf2f(ph3[1]), h2 = bf2f(ph3[2]), t0 = bf2f(pt3[0]), t1 = bf2f(pt3[1]), t2 = bf2f(pt3[2]);
            const float y0 = siluf(w0 * t0 + w1 * t1 + w2 * t2 + w3 * h0), y1 = siluf(w0 * t1 + w1 * t2 + w2 * h0 + w3 * h1), y2 = siluf(w0 * t2 + w1 * h0 + w2 * h1 + w3 * h2);
            LAS unsigned char* dst = (tid < 128) ? lds + G2_QS + tid * 2 : (tid < 256) ? lds + G2_KS + (tid - 128) * 2 : lds + G2_VS + (tid - 256) * 2;
            const int rs = (tid < 256) ? 272 : 528;
            *(LAS bf16_t*)(dst) = (bf16_t)f2bf(y0); *(LAS bf16_t*)(dst + rs) = (bf16_t)f2bf(y1); *(LAS bf16_t*)(dst + 2 * rs) = (bf16_t)f2bf(y2);
        }
        if (wave < 2) {
            const int hv = 2 * hk + wave;
            const float z = pav + dt_bias[hv];
            const float sp = z > 20.f ? z : log1pf(__expf(z));
            float g = -__expf(a_log[hv]) * sp;
#pragma unroll
            for (int o = 1; o < 64; o <<= 1) { const float t = __shfl_up(g, o); if (lane >= o) g += t; }
            gcs[wave * 64 + lane] = g; betas[wave * 64 + lane] = 1.0f / (1.0f + __expf(-pbv));
            GC[(size_t)hv * MH + r0 + lane] = g;
        }
        __syncthreads();
#pragma unroll
        for (int it = 0; it < 4; ++it) {
            const int rt = it * 32 + wave * 4 + (lane >> 4), tile = rt >> 6, row = rt & 63, ch = lane & 15;
            LAS unsigned char* p = lds + (tile ? G2_KS : G2_QS) + row * 272 + ch * 16;
            const u32x4 a = *(const LAS u32x4*)p;
            float x[8]; float ss = 0.f;
#pragma unroll
            for (int k = 0; k < 4; ++k) { x[2 * k] = bflo(a[k]); x[2 * k + 1] = bfhi(a[k]); }
#pragma unroll
            for (int k = 0; k < 8; ++k) ss += x[k] * x[k];
            ss += __shfl_xor(ss, 1); ss += __shfl_xor(ss, 2); ss += __shfl_xor(ss, 4); ss += __shfl_xor(ss, 8);
            const float rr = (tile ? 1.0f : 0.08838834764831845f) / sqrtf(ss + EPS);
            u32x4 w; w.x = cvt_pk_bf16(x[0] * rr, x[1] * rr); w.y = cvt_pk_bf16(x[2] * rr, x[3] * rr); w.z = cvt_pk_bf16(x[4] * rr, x[5] * rr); w.w = cvt_pk_bf16(x[6] * rr, x[7] * rr);
            *(LAS u32x4*)p = w;
            if (tile == 0) *(u32x4*)(C + (size_t)(r0 + row) * 8192 + hk * 128 + ch * 8) = w;
        }
        __syncthreads();
        {
            const int mat = wave >> 2, ti = (wave >> 1) & 1, tj = wave & 1;
            LAS unsigned char* xa = lds + (mat ? G2_QS : G2_KS) + (32 * ti + l31) * 272 + hh * 16;
            LAS unsigned char* xb = lds + G2_KS + (32 * tj + l31) * 272 + hh * 16;
            f32x16 acc;
#pragma unroll
            for (int r = 0; r < 16; ++r) acc[r] = 0.f;
#pragma unroll
            for (int ks = 0; ks < 8; ++ks) acc = __builtin_amdgcn_mfma_f32_32x32x16_bf16(*(const LAS bf16x8*)(xa + ks * 32), *(const LAS bf16x8*)(xb + ks * 32), acc, 0, 0, 0);
            MFMA_SETTLE();
            const int j = 32 * tj + l31;
            if (mat == 0) {
                if (ti >= tj) {
#pragma unroll
                    for (int e = 0; e < 2; ++e) { const float gj = gcs[e * 64 + j];
#pragma unroll
                        for (int g = 0; g < 4; ++g) { const int i0 = 32 * ti + 8 * g + 4 * hh;
                            const f32x4 gi = *(const LAS f32x4*)(gcs + e * 64 + i0), bi = *(const LAS f32x4*)(betas + e * 64 + i0);
#pragma unroll
                            for (int q = 0; q < 4; ++q) { const int i = i0 + q;
                                At[e * 4096 + i * 64 + j] = (i > j) ? -bi[q] * acc[4 * g + q] * __expf(gi[q] - gj) : 0.f; } } }
                } else {
                    fbw[lane] = betas[lane] * __expf(gcs[lane]); fbw[64 + lane] = betas[64 + lane] * __expf(gcs[64 + lane]);
                }
            } else {
#pragma unroll
                for (int e = 0; e < 2; ++e) { const float gj = gcs[e * 64 + j];
                    bf16_t* ap = ATT + ((size_t)(cg * 32 + 2 * hk + e) * 64) * 64 + j;
#pragma unroll
                    for (int g = 0; g < 4; ++g) { const int i0 = 32 * ti + 8 * g + 4 * hh;
                        const f32x4 gi = *(const LAS f32x4*)(gcs + e * 64 + i0);
#pragma unroll
                        for (int q = 0; q < 4; ++q) { const int i = i0 + q;
                            const float v = (i >= j) ? acc[4 * g + q] * __expf(gi[q] - gj) : 0.f;
                            ap[(size_t)i * 64] = (bf16_t)f2bf(v); } } }
            }
        }
        __syncthreads();
        { const int un = (u + c.G < NUNITS) ? u + c.G : u; G2_PREFETCH(un); }
        if (wave < 2) {
            const int e = tid >> 6, b = (tid >> 4) & 3, cc = tid & 15;
            const LAS float* An = At + e * 4096 + (16 * b) * 64 + 16 * b;
            float x[16];
#pragma unroll
            for (int r = 0; r < 16; ++r) x[r] = (r == cc) ? 1.f : 0.f;
#pragma unroll
            for (int r = 1; r < 16; ++r) {
                float acc = x[r];
#pragma unroll
                for (int k4 = 0; k4 < (r + 3) / 4; ++k4) { const f32x4 a = *(const LAS f32x4*)(An + r * 64 + 4 * k4);
#pragma unroll
                    for (int q = 0; q < 4; ++q) if (4 * k4 + q < r) acc += a[q] * x[4 * k4 + q]; }
                x[r] = acc;
            }
#pragma unroll
            for (int r = 0; r < 16; ++r) TI[((e * 4 + b) * 16 + r) * 16 + cc] = x[r];
        } else if (wave >= 4) {
            const int t2 = tid - 256;
#pragma unroll
            for (int p = 0; p < 2; ++p) {
                const int t3 = t2 + 256 * p, dk = t3 >> 2, ib = (t3 & 3) * 16;
                unsigned wv[8];
#pragma unroll
                for (int q = 0; q < 8; ++q) { const unsigned lo = *(const LAS bf16_t*)(lds + G2_KS + (ib + 2 * q) * 272 + dk * 2), hi = *(const LAS bf16_t*)(lds + G2_KS + (ib + 2 * q + 1) * 272 + dk * 2); wv[q] = lo | (hi << 16); }
                bf16_t* kp = C + (size_t)(r0 + (dk >> 1)) * 8192 + 2048 + hk * 128 + (dk & 1) * 64 + ib;
                *(u32x4*)(kp) = (u32x4){wv[0], wv[1], wv[2], wv[3]}; *(u32x4*)(kp + 8) = (u32x4){wv[4], wv[5], wv[6], wv[7]};
            }
        }
        __syncthreads();
        {
            const int e = wave >> 2, fr = lane & 15, fq = lane >> 4, hv = 2 * hk + e, ct0 = (wave & 1) * 4;
            const bool isw = (wave & 2) != 0;
            f32x4 ti[4], an[6];
#pragma unroll
            for (int b = 0; b < 4; ++b) ti[b] = *(const LAS f32x4*)(TI + ((e * 4 + b) * 16 + fr) * 16 + 4 * fq);
            an[0] = *(const LAS f32x4*)(At + e * 4096 + (16 + fr) * 64 + 0 + 4 * fq);
            an[1] = *(const LAS f32x4*)(At + e * 4096 + (32 + fr) * 64 + 0 + 4 * fq);  an[2] = *(const LAS f32x4*)(At + e * 4096 + (32 + fr) * 64 + 16 + 4 * fq);
            an[3] = *(const LAS f32x4*)(At + e * 4096 + (48 + fr) * 64 + 0 + 4 * fq);  an[4] = *(const LAS f32x4*)(At + e * 4096 + (48 + fr) * 64 + 16 + 4 * fq);
            an[5] = *(const LAS f32x4*)(At + e * 4096 + (48 + fr) * 64 + 32 + 4 * fq);
            f32x4 R[4][4], X[4][4];
#pragma unroll
            for (int b = 0; b < 4; ++b) { const f32x4 fac = *(const LAS f32x4*)((isw ? fbw : betas) + e * 64 + 16 * b + 4 * fq);
#pragma unroll
                for (int t = 0; t < 4; ++t) { const int col = 16 * (ct0 + t) + fr;
#pragma unroll
                    for (int q = 0; q < 4; ++q) { const int i = 16 * b + 4 * fq + q;
                        const unsigned short raw = isw ? *(const LAS bf16_t*)(lds + G2_KS + i * 272 + col * 2) : *(const LAS bf16_t*)(lds + G2_VS + i * 528 + (e * 128 + col) * 2);
                        R[t][b][q] = fac[q] * bf2f(raw); } } }
#define G2_MM(dst, av, bv) do { _Pragma("unroll") for (int q = 0; q < 4; ++q) dst = __builtin_amdgcn_mfma_f32_16x16x4f32(av[q], bv[q], dst, 0, 0, 0); } while (0)
#pragma unroll
            for (int t = 0; t < 4; ++t) { X[t][0] = (f32x4){0.f, 0.f, 0.f, 0.f}; G2_MM(X[t][0], ti[0], R[t][0]); }
#pragma unroll
            for (int t = 0; t < 4; ++t) G2_MM(R[t][1], an[0], X[t][0]);
#pragma unroll
            for (int t = 0; t < 4; ++t) { X[t][1] = (f32x4){0.f, 0.f, 0.f, 0.f}; G2_MM(X[t][1], ti[1], R[t][1]); }
#pragma unroll
            for (int t = 0; t < 4; ++t) { G2_MM(R[t][2], an[1], X[t][0]); G2_MM(R[t][2], an[2], X[t][1]); }
#pragma unroll
            for (int t = 0; t < 4; ++t) { X[t][2] = (f32x4){0.f, 0.f, 0.f, 0.f}; G2_MM(X[t][2], ti[2], R[t][2]); }
#pragma unroll
            for (int t = 0; t < 4; ++t) { G2_MM(R[t][3], an[3], X[t][0]); G2_MM(R[t][3], an[4], X[t][1]); G2_MM(R[t][3], an[5], X[t][2]); }
#pragma unroll
            for (int t = 0; t < 4; ++t) { X[t][3] = (f32x4){0.f, 0.f, 0.f, 0.f}; G2_MM(X[t][3], ti[3], R[t][3]); }
#undef G2_MM
            MFMA_SETTLE();
            if (!isw) {
#pragma unroll
                for (int t = 0; t < 4; ++t) { const int dv = 16 * (ct0 + t) + fr;
                    bf16_t* up = C + (size_t)(r0 + (dv >> 1)) * 8192 + 4096 + hv * 128 + (dv & 1) * 64 + 4 * fq;
#pragma unroll
                    for (int b = 0; b < 4; ++b) { u32x2 w; w.x = cvt_pk_bf16(X[t][b][0], X[t][b][1]); w.y = cvt_pk_bf16(X[t][b][2], X[t][b][3]); *(u32x2*)(up + 16 * b) = w; } }
            } else {
#pragma unroll
                for (int t = 0; t < 4; ++t) { bf16_t* wp = W + (size_t)(r0 + 4 * fq) * 4096 + hv * 128 + 16 * (ct0 + t) + fr;
#pragma unroll
                    for (int b = 0; b < 4; ++b)
#pragma unroll
                        for (int q = 0; q < 4; ++q) wp[(size_t)(16 * b + q) * 4096] = (bf16_t)f2bf(X[t][b][q]); }
            }
        }
        __syncthreads();
    }
}

#undef G2_PREFETCH
constexpr int G3_W = 0, G3_Q = 17408, G3_KT = 34816, G3_A = G3_KT + 128 * 144, G3_UT = G3_A + 64 * 144, G3_GCB = G3_UT + 32 * 144, G3_BUF = G3_GCB + 512;
static_assert(2 * G3_BUF <= MISC_OFF, "G3 LDS");
__device__ __forceinline__ void g3_wperm(LAS unsigned char* rowp, int cidx, u32x4 v) {
    LAS unsigned char* p = rowp + (cidx >> 2) * 64 + (((cidx & 1) << 2) + ((cidx >> 1) & 1)) * 8;
    *(LAS u32x2*)p = (u32x2){v.x, v.y}; *(LAS u32x2*)(p + 16) = (u32x2){v.z, v.w};
}
__device__ __forceinline__ void g3_stage(LAS unsigned char* buf, const bf16_t* PROJ, const bf16_t* C, const bf16_t* ATT, const float* GC, int cgl, int hv, int dq, int t, int nt) {
    const size_t r0 = (size_t)cgl * CH; const int hk = hv >> 1;
    for (int i = t; i < 1024; i += nt) { const int row = i >> 4, ch = i & 15;
        g3_wperm(buf + G3_W + row * 272, ch, *(const u32x4*)(PROJ + (r0 + row) * 4096 + hv * 128 + ch * 8));
        g3_wperm(buf + G3_Q + row * 272, ch, *(const u32x4*)(C + (r0 + row) * 8192 + hk * 128 + ch * 8)); }
    for (int i = t; i < 1024; i += nt) { const int rr = i >> 4, ch = i & 15, dk = 2 * rr + (ch >> 3);
        g3_wperm(buf + G3_KT + dk * 144, ch & 7, *(const u32x4*)(C + (r0 + rr) * 8192 + 2048 + hk * 128 + ch * 8)); }
    for (int i = t; i < 512; i += nt) { const int row = i >> 3, ch = i & 7;
        g3_wperm(buf + G3_A + row * 144, ch, *(const u32x4*)(ATT + ((size_t)(cgl * 32 + hv) * 64 + row) * 64 + ch * 8)); }
    for (int i = t; i < 256; i += nt) { const int rr = i >> 4, ch = i & 15, dvl = 2 * rr + (ch >> 3);
        *(LAS u32x4*)(buf + G3_UT + dvl * 144 + (ch & 7) * 16) = *(const u32x4*)(C + (r0 + 16 * dq + rr) * 8192 + 4096 + hv * 128 + ch * 8); }
    if (t < 64) { const float gct = GC[(size_t)hv * MH + r0 + t], gl = GC[(size_t)hv * MH + r0 + 63];
        *(LAS float*)(buf + G3_GCB + t * 4) = __expf(gct); *(LAS float*)(buf + G3_GCB + 256 + t * 4) = __expf(gl - gct); }
}
__device__ __forceinline__ bf16x8 pack8(const f32x16& v, int s) {
    u32x4 w; w.x = cvt_pk_bf16_op(v[8 * s + 0], v[8 * s + 1]); w.y = cvt_pk_bf16_op(v[8 * s + 2], v[8 * s + 3]); w.z = cvt_pk_bf16_op(v[8 * s + 4], v[8 * s + 5]); w.w = cvt_pk_bf16_op(v[8 * s + 6], v[8 * s + 7]);
    return __builtin_bit_cast(bf16x8, w);
}
__device__ __forceinline__ bf16x8 ld2x8(const LAS unsigned char* p) {
    const u32x2 a = *(const LAS u32x2*)p, b = *(const LAS u32x2*)(p + 16);
    return __builtin_bit_cast(bf16x8, (u32x4){a.x, a.y, b.x, b.y});
}
__device__ __forceinline__ u32x4 gld16(const void* p) { u32x4 r; asm volatile("global_load_dwordx4 %0, %1, off" : "=v"(r) : "v"(p) : "memory"); return r; }
__device__ __forceinline__ float gld4(const void* p) { float r; asm volatile("global_load_dword %0, %1, off" : "=v"(r) : "v"(p) : "memory"); return r; }
#define G3_BAR() asm volatile("s_waitcnt lgkmcnt(0)\n\ts_barrier" ::: "memory")
__device__ __forceinline__ bf16x8 ldfrag(const LAS unsigned char* rowp, int s32, int fq) {
    return *(const LAS bf16x8*)(rowp + s32 * 64 + fq * 16);
}
__device__ __forceinline__ bf16x8 pack44(const f32x4& lo, const f32x4& hi) {
    u32x4 w; w.x = cvt_pk_bf16_op(lo[0], lo[1]); w.y = cvt_pk_bf16_op(lo[2], lo[3]); w.z = cvt_pk_bf16_op(hi[0], hi[1]); w.w = cvt_pk_bf16_op(hi[2], hi[3]);
    return __builtin_bit_cast(bf16x8, w);
}
__device__ __forceinline__ void phase_gdn_scan(const Ctx& c, const bf16_t* PROJ  , bf16_t* OUT, const bf16_t* C, const bf16_t* ATT, const float* GC) {
    LAS unsigned char* lds = c.lds;
    constexpr int NITEMS = 2 * GVH * 4;
    for (int wi = c.bid; wi < NITEMS; wi += c.G) {
        int tid = c.tid; asm volatile("" : "+v"(tid));
        const int xslot = wi >> 3, grp = (wi & 7) * 8 + (xslot >> 2), bl = grp >> 5, hv = grp & 31, dq = xslot & 3;
        g3_stage(lds, PROJ, C, ATT, GC, bl * NCH, hv, dq, tid, NTHREADS);
        __syncthreads();
        if (c.wave >= 2) {
            int t2 = c.tid; asm volatile("" : "+v"(t2));
            const int hk = hv >> 1;
#define G3_CLAMP(x) ((x) < NCH ? (x) : NCH - 1)
#define G3_LOOP2(LD_, WR_) do { LD_(sa, bl * NCH + 1); LD_(sb, bl * NCH + 2); \
                for (int ch = 0; ch < NCH; ch += 2) { \
                    asm volatile("s_sleep 3" ::: "memory"); WR_(sa, lds + G3_BUF); LD_(sa, bl * NCH + G3_CLAMP(ch + 3)); G3_BAR(); \
                    asm volatile("s_sleep 3" ::: "memory"); WR_(sb, lds); LD_(sb, bl * NCH + G3_CLAMP(ch + 4)); G3_BAR(); } \
                asm volatile("s_waitcnt vmcnt(0)" ::: "memory"); } while (0)
            if (c.wave <= 5) {
                const int l4 = t2 - 128, row0 = l4 >> 4, ch16 = l4 & 15;
                struct S3 { u32x4 W[4], Q[4], K[4]; }; S3 sa, sb;
#define G3_LD3(P, cgl_) do { const size_t r0_ = (size_t)(cgl_) * CH; _Pragma("unroll") for (int j = 0; j < 4; ++j) { const int row = row0 + 16 * j; \
                    P.W[j] = gld16(PROJ + (r0_ + row) * 4096 + hv * 128 + ch16 * 8); \
                    P.Q[j] = gld16(C + (r0_ + row) * 8192 + hk * 128 + ch16 * 8); \
                    P.K[j] = gld16(C + (r0_ + row) * 8192 + 2048 + hk * 128 + ch16 * 8); } } while (0)
#define G3_WR3(P, nb_) do { asm volatile("s_waitcnt vmcnt(12)" : "+v"(P.W[0]), "+v"(P.W[1]), "+v"(P.W[2]), "+v"(P.W[3]), "+v"(P.Q[0]), "+v"(P.Q[1]), "+v"(P.Q[2]), "+v"(P.Q[3]), \
                                                                  "+v"(P.K[0]), "+v"(P.K[1]), "+v"(P.K[2]), "+v"(P.K[3]) :: "memory"); \
                _Pragma("unroll") for (int j = 0; j < 4; ++j) { const int row = row0 + 16 * j; \
                    g3_wperm((nb_) + G3_W + row * 272, ch16, P.W[j]); \
                    g3_wperm((nb_) + G3_Q + row * 272, ch16, P.Q[j]); \
                    g3_wperm((nb_) + G3_KT + (2 * row + (ch16 >> 3)) * 144, ch16 & 7, P.K[j]); } } while (0)
                G3_LOOP2(G3_LD3, G3_WR3);
#undef G3_LD3
#undef G3_WR3
            } else if (c.wave == 6) {
                const int l2 = t2 - 384, row0 = l2 >> 3, ch8 = l2 & 7;
                struct S1 { u32x4 A[8]; }; S1 sa, sb;
#define G3_LD1(P, cgl_) do { _Pragma("unroll") for (int j = 0; j < 8; ++j) P.A[j] = gld16(ATT + ((size_t)((cgl_) * 32 + hv) * 64 + row0 + 8 * j) * 64 + ch8 * 8); } while (0)
#define G3_WR1(P, nb_) do { asm volatile("s_waitcnt vmcnt(8)" : "+v"(P.A[0]), "+v"(P.A[1]), "+v"(P.A[2]), "+v"(P.A[3]), "+v"(P.A[4]), "+v"(P.A[5]), "+v"(P.A[6]), "+v"(P.A[7]) :: "memory"); \
                _Pragma("unroll") for (int j = 0; j < 8; ++j) g3_wperm((nb_) + G3_A + (row0 + 8 * j) * 144, ch8, P.A[j]); } while (0)
                G3_LOOP2(G3_LD1, G3_WR1);
#undef G3_LD1
#undef G3_WR1
            } else {
                const int l1 = t2 - 448, rr0 = l1 >> 4, ch16 = l1 & 15;
                struct SU { u32x4 U[4]; float g0, g1; }; SU sa, sb;
#define G3_LDU(P, cgl_) do { const size_t r0_ = (size_t)(cgl_) * CH; _Pragma("unroll") for (int j = 0; j < 4; ++j) P.U[j] = gld16(C + (r0_ + 16 * dq + rr0 + 4 * j) * 8192 + 4096 + hv * 128 + ch16 * 8); \
                    P.g0 = gld4(GC + (size_t)hv * MH + r0_ + l1); P.g1 = gld4(GC + (size_t)hv * MH + r0_ + 63); } while (0)
#define G3_WRU(P, nb_) do { asm volatile("s_waitcnt vmcnt(6)" : "+v"(P.U[0]), "+v"(P.U[1]), "+v"(P.U[2]), "+v"(P.U[3]), "+v"(P.g0), "+v"(P.g1) :: "memory"); \
                _Pragma("unroll") for (int j = 0; j < 4; ++j) *(LAS u32x4*)((nb_) + G3_UT + (2 * (rr0 + 4 * j) + (ch16 >> 3)) * 144 + (ch16 & 7) * 16) = P.U[j]; \
                    *(LAS float*)((nb_) + G3_GCB + l1 * 4) = __expf(P.g0); *(LAS float*)((nb_) + G3_GCB + 256 + l1 * 4) = __expf(P.g1 - P.g0); } while (0)
                G3_LOOP2(G3_LDU, G3_WRU);
#undef G3_LDU
#undef G3_WRU
            }
#undef G3_LOOP2
#undef G3_CLAMP
        } else {
            const int p = c.wave;
            f32x4 Sacc[8];
#pragma unroll
            for (int T8 = 0; T8 < 8; ++T8) Sacc[T8] = (f32x4){0.f, 0.f, 0.f, 0.f};
            bf16x8 Sb[4];
#pragma unroll
            for (int s4 = 0; s4 < 4; ++s4) Sb[s4] = pack44(Sacc[2 * s4], Sacc[2 * s4 + 1]);
            for (int ch = 0; ch < NCH; ++ch) {
                int ln = c.tid & 63; asm volatile("" : "+v"(ln));
                const int fr = ln & 15, fq = ln >> 4;
                LAS unsigned char* buf = lds + (ch & 1) * G3_BUF;
                const LAS float* gcb = (const LAS float*)(buf + G3_GCB);
                bf16x8 fA[16], fB[16];
#pragma unroll
                for (int t = 0; t < 4; ++t)
#pragma unroll
                    for (int s4 = 0; s4 < 4; ++s4) { fA[t * 4 + s4] = ldfrag(buf + G3_W + (16 * t + fr) * 272, s4, fq); fB[t * 4 + s4] = ldfrag(buf + G3_Q + (16 * t + fr) * 272, s4, fq); }
                f32x4 vn[4], oa[4];
#pragma unroll
                for (int t = 0; t < 4; ++t) { vn[t] = (f32x4){0.f, 0.f, 0.f, 0.f}; oa[t] = vn[t]; }
                __builtin_amdgcn_sched_barrier(0);
#pragma unroll
                for (int s4 = 0; s4 < 4; ++s4)
#pragma unroll
                    for (int t = 0; t < 4; ++t) vn[t] = __builtin_amdgcn_mfma_f32_16x16x32_bf16(fA[t * 4 + s4], Sb[s4], vn[t], 0, 0, 0);
                __builtin_amdgcn_sched_barrier(0);
#pragma unroll
                for (int T8 = 0; T8 < 8; ++T8)
#pragma unroll
                    for (int s2 = 0; s2 < 2; ++s2) fA[T8 * 2 + s2] = ldfrag(buf + G3_KT + (16 * T8 + fr) * 144, s2, fq);
                u32x2 uur[4]; f32x4 e2r[4];
#pragma unroll
                for (int t = 0; t < 4; ++t) { uur[t] = *(const LAS u32x2*)(buf + G3_UT + (16 * p + fr) * 144 + (16 * t + 4 * fq) * 2); e2r[t] = *(const LAS f32x4*)(gcb + 64 + 16 * t + 4 * fq); }
                const float dec = gcb[63];
                __builtin_amdgcn_sched_barrier(0);
#pragma unroll
                for (int s4 = 0; s4 < 4; ++s4)
#pragma unroll
                    for (int t = 0; t < 4; ++t) oa[t] = __builtin_amdgcn_mfma_f32_16x16x32_bf16(fB[t * 4 + s4], Sb[s4], oa[t], 0, 0, 0);
                __builtin_amdgcn_sched_barrier(0);
                bf16x8 af[6]; f32x4 e1v[4];
                af[0] = ldfrag(buf + G3_A + (0 + fr) * 144, 0, fq); af[1] = ldfrag(buf + G3_A + (16 + fr) * 144, 0, fq);
                af[2] = ldfrag(buf + G3_A + (32 + fr) * 144, 0, fq); af[3] = ldfrag(buf + G3_A + (32 + fr) * 144, 1, fq);
                af[4] = ldfrag(buf + G3_A + (48 + fr) * 144, 0, fq); af[5] = ldfrag(buf + G3_A + (48 + fr) * 144, 1, fq);
#pragma unroll
                for (int t = 0; t < 4; ++t) e1v[t] = *(const LAS f32x4*)(gcb + 16 * t + 4 * fq);
                MFMA_SETTLE();
                f32x4 vw[4], vs[4];
#pragma unroll
                for (int t = 0; t < 4; ++t) { const float u4[4] = {bflo(uur[t].x), bfhi(uur[t].x), bflo(uur[t].y), bfhi(uur[t].y)};
#pragma unroll
                    for (int q = 0; q < 4; ++q) { const float v = u4[q] - vn[t][q]; vw[t][q] = v; vs[t][q] = v * e2r[t][q]; oa[t][q] *= e1v[t][q]; } }
                bf16x8 Vb[2], Vsb[2];
#pragma unroll
                for (int s2 = 0; s2 < 2; ++s2) { Vb[s2] = pack44(vw[2 * s2], vw[2 * s2 + 1]); Vsb[s2] = pack44(vs[2 * s2], vs[2 * s2 + 1]); }
#pragma unroll
                for (int T8 = 0; T8 < 8; ++T8)
#pragma unroll
                    for (int q = 0; q < 4; ++q) Sacc[T8][q] *= dec;
                __builtin_amdgcn_sched_barrier(0);
                oa[0] = __builtin_amdgcn_mfma_f32_16x16x32_bf16(af[0], Vb[0], oa[0], 0, 0, 0);
                oa[1] = __builtin_amdgcn_mfma_f32_16x16x32_bf16(af[1], Vb[0], oa[1], 0, 0, 0);
                oa[2] = __builtin_amdgcn_mfma_f32_16x16x32_bf16(af[2], Vb[0], oa[2], 0, 0, 0);
                oa[3] = __builtin_amdgcn_mfma_f32_16x16x32_bf16(af[4], Vb[0], oa[3], 0, 0, 0);
                oa[2] = __builtin_amdgcn_mfma_f32_16x16x32_bf16(af[3], Vb[1], oa[2], 0, 0, 0);
                oa[3] = __builtin_amdgcn_mfma_f32_16x16x32_bf16(af[5], Vb[1], oa[3], 0, 0, 0);
#pragma unroll
                for (int s2 = 0; s2 < 2; ++s2)
#pragma unroll
                    for (int T8 = 0; T8 < 8; ++T8) Sacc[T8] = __builtin_amdgcn_mfma_f32_16x16x32_bf16(fA[T8 * 2 + s2], Vsb[s2], Sacc[T8], 0, 0, 0);
                MFMA_SETTLE();
                { bf16_t* op = OUT + ((size_t)(bl * NCH + ch) * CH) * 4096 + hv * 128 + 32 * dq + 16 * p + fr;
#pragma unroll
                  for (int t = 0; t < 4; ++t)
#pragma unroll
                    for (int q = 0; q < 4; ++q) op[(size_t)(16 * t + 4 * fq + q) * 4096] = (bf16_t)(cvt_pk_bf16(oa[t][q], oa[t][q]) & 0xffffu); }
#pragma unroll
                for (int s4 = 0; s4 < 4; ++s4) Sb[s4] = pack44(Sacc[2 * s4], Sacc[2 * s4 + 1]);
                __builtin_amdgcn_sched_barrier(0);
                G3_BAR();
            }
        }
        __syncthreads();
    }
}
#undef G3_BAR

__device__ __forceinline__ void phase_gdn_onorm(const Ctx& c, bf16_t* OUT, const bf16_t* GATE, const float* o_gain) {
    const int gw = c.bid * NWAVES + c.wave, NGW = c.G * NWAVES, sub = c.lane >> 4, ch = c.lane & 15;
    float og[8];
    { const f32x4 a = *(const f32x4*)(o_gain + ch * 8), b = *(const f32x4*)(o_gain + ch * 8 + 4);
#pragma unroll
      for (int k = 0; k < 4; ++k) { og[k] = a[k]; og[4 + k] = b[k]; } }
    const int npairs = MH * GVH / 4;
    for (int it0 = gw; it0 < npairs; it0 += 4 * NGW) {
        u32x4 ovr[4], gvr[4];
#pragma unroll
        for (int q = 0; q < 4; ++q) { const int it = it0 + q * NGW;
            if (it < npairs) { const int pr = it * 4 + sub, row = pr >> 5, hv = pr & 31;
                ovr[q] = *(const u32x4*)(OUT + (size_t)row * 4096 + hv * 128 + ch * 8); gvr[q] = *(const u32x4*)(GATE + (size_t)row * 4096 + hv * 128 + ch * 8); } }
#pragma unroll
        for (int q = 0; q < 4; ++q) { const int it = it0 + q * NGW;
            if (it < npairs) { const int pr = it * 4 + sub, row = pr >> 5, hv = pr & 31;
                bf16_t* op = OUT + (size_t)row * 4096 + hv * 128 + ch * 8;
                const u32x4 ov = ovr[q], gv = gvr[q];
                float o[8], g[8]; float ss = 0.f;
#pragma unroll
                for (int k = 0; k < 4; ++k) { o[2 * k] = bflo(ov[k]); o[2 * k + 1] = bfhi(ov[k]); g[2 * k] = bflo(gv[k]); g[2 * k + 1] = bfhi(gv[k]); }
#pragma unroll
                for (int k = 0; k < 8; ++k) ss += o[k] * o[k];
                ss += __shfl_xor(ss, 1); ss += __shfl_xor(ss, 2); ss += __shfl_xor(ss, 4); ss += __shfl_xor(ss, 8);
                const float rs = 1.0f / sqrtf(ss * (1.0f / 128.f) + EPS);
                float y[8];
#pragma unroll
                for (int k = 0; k < 8; ++k) y[k] = o[k] * rs * og[k] * siluf(g[k]);
                u32x4 w; w.x = cvt_pk_bf16(y[0], y[1]); w.y = cvt_pk_bf16(y[2], y[3]); w.z = cvt_pk_bf16(y[4], y[5]); w.w = cvt_pk_bf16(y[6], y[7]);
                *(u32x4*)op = w; } }
    }
}

typedef const __attribute__((address_space(4))) Args* KArgsP;
__device__ __forceinline__ KArgsP kargs() { const unsigned long long p0 = (unsigned long long)__builtin_amdgcn_kernarg_segment_ptr(); unsigned lo32 = (unsigned)p0, hi32 = (unsigned)(p0 >> 32);
    asm volatile("" : "+v"(lo32), "+v"(hi32)); lo32 = __builtin_amdgcn_readfirstlane(lo32); hi32 = __builtin_amdgcn_readfirstlane(hi32); return (KArgsP)(((unsigned long long)hi32 << 32) | lo32); }
__device__ __forceinline__ Ctx mkctx(LAS unsigned char* lds, int wv0) { Ctx c; int tid = wv0 * 64 + lane_id(); asm volatile("" : "+v"(tid)); c.lds = lds; c.tid = tid; c.lane = tid & 63; c.wave = __builtin_amdgcn_readfirstlane(tid >> 6); c.G = gridDim.x; c.bid = blockIdx.x; return c; }
#ifndef PHASE_EN
#define PHASE_EN 0xFFFFFFFFu
#endif
#define EN(id) (((PHASE_EN) >> (id)) & 1u)
#ifndef DUP_MASK
#define DUP_MASK 0u
#endif
#define DUP(id) (((DUP_MASK) >> (id)) & 1u)
#ifndef STAMP_ID
#define STAMP_ID (-1)
#endif
#define ST0(id) do { if (STAMP_ID == (id)) st_t0 = __builtin_amdgcn_s_memrealtime(); } while (0)
#define ST1(id) do { if (STAMP_ID == (id)) st_acc += __builtin_amdgcn_s_memrealtime() - st_t0; } while (0)

__global__ void __launch_bounds__(NTHREADS, 2) fwd_kernel(Args args) {
    extern __shared__ __attribute__((aligned(16))) unsigned char lds_raw[];
    LAS unsigned char* const lds = (LAS unsigned char*)lds_raw;
    volatile LAS unsigned* MISC = (volatile LAS unsigned*)(lds + MISC_OFF);
    const int wv0 = __builtin_amdgcn_readfirstlane((int)threadIdx.x >> 6);
    if (wv0 == 0) MISC[lane_id()] = 0u;
    __syncthreads();
    XcdBarrier bar; bar.bar = nullptr; bar.x = 0; bar.st = nullptr; bar.wv = wv0;
    if (N_LAUNCH_MODE == 1) { KArgsP ap = kargs(); bar = xcd_barrier_post((unsigned*)(ap->ws + WS_CTL) + CW_BAR, MISC + 8, wv0); }
    const int lo = args.ph_lo, hi = args.ph_hi;
    int ph = 0;
    unsigned long long st_t0 = 0ull, st_acc = 0ull;
#define PH_IN (ph >= lo && ph < hi)
#define PH_END do { if (PH_IN && ph + 1 < hi) { if (N_LAUNCH_MODE == 1) xcd_barrier(bar); } ++ph; } while (0)

    ST0(0);
    if (EN(0) && PH_IN) { const Ctx c = mkctx(lds, wv0); phase_weights(c, kargs()); if (DUP(0)) { __syncthreads(); phase_weights(c, kargs()); } }
    PH_END;
    ST1(0);

    for (int layer = 0; layer < 4; ++layer) {
        const int kind = layer % 3, j = layer / 3;
        ST0(1);
        if (EN(1) && PH_IN) { const Ctx c = mkctx(lds, wv0); KArgsP ap = kargs(); unsigned char* ws = ap->ws;
            phase_rmsnorm(c, (layer == 0) ? ap->x : (const float*)ap->out, ap->mix_norm + layer * D, (bf16_t*)(ws + WS_H));
            if (DUP(1)) phase_rmsnorm(c, (layer == 0) ? ap->x : (const float*)ap->out, ap->mix_norm + layer * D, (bf16_t*)(ws + WS_H)); }
        PH_END;
        ST1(1);
        if (kind == 0) {
            ST0(2);
            if (EN(2) && PH_IN) { const Ctx c = mkctx(lds, wv0); KArgsP ap = kargs(); unsigned char* ws = ap->ws;
                pg8::Gemm g{(const bf16_t*)(ws + WS_H), (const bf16_t*)(ws + WS_WQKV) + (size_t)j * 6144 * D, T, 6144, D, D, D, 0}; pg8::StaticOrder S; S.init(T, 6144, c.G, c.bid);
                pg8::EpiQkv E{(bf16_t*)(ws + WS_QKV), 6144, (float*)(ws + WS_PART)}; pg8::gemm_phase(c.lds, c.tid, g, S, E); if (DUP(2)) pg8::gemm_phase(c.lds, c.tid, g, S, E); }
            PH_END;
            ST1(2);
            ST0(3);
            if (EN(3) && PH_IN) { const Ctx c = mkctx(lds, wv0); KArgsP ap = kargs(); unsigned char* ws = ap->ws;
                phase_attention3(c, (const bf16_t*)(ws + WS_QKV), (bf16_t*)(ws + WS_AO), (const float*)(ws + WS_PART), ap->att_q_gain + j * AHD, ap->att_k_gain + j * AHD, ap->att_rel_bias + (size_t)j * AH * NREL);
                if (DUP(3)) phase_attention3(c, (const bf16_t*)(ws + WS_QKV), (bf16_t*)(ws + WS_AO), (const float*)(ws + WS_PART), ap->att_q_gain + j * AHD, ap->att_k_gain + j * AHD, ap->att_rel_bias + (size_t)j * AH * NREL); }
            PH_END;
            ST1(3);
            ST0(4);
            if (EN(4) && PH_IN) { const Ctx c = mkctx(lds, wv0); KArgsP ap = kargs(); unsigned char* ws = ap->ws;
                pg8::Gemm g{(const bf16_t*)(ws + WS_AO), (const bf16_t*)(ws + WS_WO) + (size_t)j * D * D, T, D, D, D, D, 0}; pg8::StaticOrder S; S.init(T, D, c.G, c.bid);
                pg8::EpiRes E{(layer == 0) ? ap->x : (const float*)ap->out, ap->out, D, nullptr}; pg8::gemm_phase(c.lds, c.tid, g, S, E);
                if (DUP(4)) { pg8::EpiBf16 E2{(bf16_t*)(ws + WS_H), D}; pg8::gemm_phase(c.lds, c.tid, g, S, E2); } }
            PH_END;
            ST1(4);
        } else if (kind == 1) {
            ST0(5);
            if (EN(5) && PH_IN) { const Ctx c = mkctx(lds, wv0); KArgsP ap = kargs(); unsigned char* ws = ap->ws;
                phase_pool_prep(c, (const bf16_t*)(ws + WS_H), (bf16_t*)(ws + WS_POOLED)); if (DUP(5)) phase_pool_prep(c, (const bf16_t*)(ws + WS_H), (bf16_t*)(ws + WS_POOLED)); }
            PH_END;
            ST1(5);
            ST0(6);
            if (EN(6) && PH_IN) { const Ctx c = mkctx(lds, wv0); KArgsP ap = kargs(); unsigned char* ws = ap->ws;
                pg8::Gemm g{(const bf16_t*)(ws + WS_POOLED), (const bf16_t*)(ws + WS_WPOOL), T, D, 512, D, 512, 2}; pg8::StaticOrder S; S.init(T, D, c.G, c.bid);
                pg8::EpiRes E{ap->out, ap->out, D, ap->pool_scale + j * D}; pg8::gemm_phase(c.lds, c.tid, g, S, E); }
            PH_END;
            ST1(6);
        } else {
            for (int half = 0; half < 2; ++half) {
                ST0(7);
                if (EN(7) && PH_IN) { const Ctx c = mkctx(lds, wv0); KArgsP ap = kargs(); unsigned char* ws = ap->ws;
                    pg8::Gemm g{(const bf16_t*)(ws + WS_H) + (size_t)half * MH * D, (const bf16_t*)(ws + WS_WGIN), MH, GINP, D, D, D, 0}; pg8::StaticOrder S; S.init(MH, GINP, c.G, c.bid);
                    pg8::EpiGdn E{(bf16_t*)(ws + WS_C), (bf16_t*)(ws + WS_GATE), (float*)(ws + WS_AB), ap->gdn_conv, (bf16_t*)(ws + WS_HEAD3), (bf16_t*)(ws + WS_TAIL3)};
                    pg8::gemm_phase(c.lds, c.tid, g, S, E); if (DUP(7)) pg8::gemm_phase(c.lds, c.tid, g, S, E); }
                PH_END;
                ST1(7);
                ST0(9);
                if (EN(9) && PH_IN) { const Ctx c = mkctx(lds, wv0); KArgsP ap = kargs(); unsigned char* ws = ap->ws;
                    phase_gdn_local(c, (bf16_t*)(ws + WS_C), (bf16_t*)(ws + WS_W), (bf16_t*)(ws + WS_ATT), (const float*)(ws + WS_AB), (float*)(ws + WS_GC), (const bf16_t*)(ws + WS_HEAD3), (const bf16_t*)(ws + WS_TAIL3),
                                    ap->gdn_conv, ap->gdn_a_log, ap->gdn_dt_bias); }
                PH_END;
                ST1(9);
                ST0(10);
                if (EN(10) && PH_IN) { const Ctx c = mkctx(lds, wv0); KArgsP ap = kargs(); unsigned char* ws = ap->ws;
                    phase_gdn_scan(c, (const bf16_t*)(ws + WS_W), (bf16_t*)(ws + WS_O), (const bf16_t*)(ws + WS_C), (const bf16_t*)(ws + WS_ATT), (const float*)(ws + WS_GC));
                    if (DUP(10)) phase_gdn_scan(c, (const bf16_t*)(ws + WS_W), (bf16_t*)(ws + WS_O), (const bf16_t*)(ws + WS_C), (const bf16_t*)(ws + WS_ATT), (const float*)(ws + WS_GC)); }
                PH_END;
                ST1(10);
                ST0(11);
                if (EN(11) && PH_IN) { const Ctx c = mkctx(lds, wv0); KArgsP ap = kargs(); unsigned char* ws = ap->ws;
                    phase_gdn_onorm(c, (bf16_t*)(ws + WS_O), (const bf16_t*)(ws + WS_GATE), ap->gdn_o_gain); }
                PH_END;
                ST1(11);
                ST0(12);
                if (EN(12) && PH_IN) { const Ctx c = mkctx(lds, wv0); KArgsP ap = kargs(); unsigned char* ws = ap->ws;
                    pg8::Gemm g{(const bf16_t*)(ws + WS_O), (const bf16_t*)(ws + WS_WGO), MH, D, 4096, 4096, 4096, 0}; pg8::StaticOrder S; S.init(MH, D, c.G, c.bid);
                    pg8::EpiRes E{(const float*)ap->out + (size_t)half * MH * D, ap->out + (size_t)half * MH * D, D, nullptr}; pg8::gemm_phase(c.lds, c.tid, g, S, E); }
                PH_END;
                ST1(12);
            }
        }
        ST0(13);
        if (EN(13) && PH_IN) { const Ctx c = mkctx(lds, wv0); KArgsP ap = kargs(); unsigned char* ws = ap->ws;
            phase_rmsnorm(c, ap->out, ap->ffn_norm + layer * D, (bf16_t*)(ws + WS_H)); if (DUP(13)) phase_rmsnorm(c, ap->out, ap->ffn_norm + layer * D, (bf16_t*)(ws + WS_H)); }
        PH_END;
        ST1(13);
        ST0(14);
        if (EN(14) && PH_IN) { const Ctx c = mkctx(lds, wv0); KArgsP ap = kargs(); unsigned char* ws = ap->ws;
            pg8::Gemm g{(const bf16_t*)(ws + WS_H), (const bf16_t*)(ws + WS_WUP) + (size_t)layer * FF2 * D, T, FF2, D, D, D, 0}; pg8::StaticOrder S; S.init(T, FF2, c.G, c.bid);
            pg8::EpiFfn E{(bf16_t*)(ws + WS_ACT), ap->ffn_conv + (size_t)layer * 3 * FF, (bf16_t*)(ws + WS_TAILU), (bf16_t*)(ws + WS_HEADU), (bf16_t*)(ws + WS_HEADG)};
            pg8::gemm_phase(c.lds, c.tid, g, S, E); if (DUP(14)) pg8::gemm_phase(c.lds, c.tid, g, S, E); }
        PH_END;
        ST1(14);
        ST0(15);
        if (EN(15) && PH_IN) { const Ctx c = mkctx(lds, wv0); KArgsP ap = kargs(); unsigned char* ws = ap->ws;
            phase_ffn_fix(c, (bf16_t*)(ws + WS_ACT), ap->ffn_conv + (size_t)layer * 3 * FF, (const bf16_t*)(ws + WS_TAILU), (const bf16_t*)(ws + WS_HEADU), (const bf16_t*)(ws + WS_HEADG)); }
        PH_END;
        ST1(15);
        ST0(16);
        if (EN(16) && PH_IN) { const Ctx c = mkctx(lds, wv0); KArgsP ap = kargs(); unsigned char* ws = ap->ws;
            pg8::Gemm g{(const bf16_t*)(ws + WS_ACT), (const bf16_t*)(ws + WS_WDN) + (size_t)layer * D * FF, T, D, FF, FF, FF, 0}; pg8::StaticOrder S; S.init(T, D, c.G, c.bid);
            pg8::EpiRes E{ap->out, ap->out, D, nullptr}; pg8::gemm_phase(c.lds, c.tid, g, S, E);
            if (DUP(16)) { pg8::EpiBf16 E2{(bf16_t*)(ws + WS_H), D}; pg8::gemm_phase(c.lds, c.tid, g, S, E2); } }
        PH_END;
        ST1(16);
    }
#undef PH_IN
#undef PH_END
    if (STAMP_ID >= 0 && blockIdx.x == 0 && wv0 == 0 && lane_id() == 0) kargs()->out[0] = (float)st_acc * 0.01f;
}

constexpr int N_PHASES = 1 + 8 + 7 + 15 + 8;

extern "C" void kernel_launch(void* const* d_in, const int* in_sizes, int n_in, void* d_out, int out_size, void* d_ws, size_t ws_size, hipStream_t stream) {
    static int grid = 0;
    if (grid == 0) {
        if (n_in != 19 || out_size != T * D || ws_size < WS_NEED) { fprintf(stderr, "kernel_launch: unexpected problem (n_in %d, out %d, ws %zu, need %zu)\n", n_in, out_size, ws_size, (size_t)WS_NEED); grid = -1; return; }
        int dev = 0, cus = 0, per_cu = 0;
        if (hipGetDevice(&dev) != hipSuccess || hipDeviceGetAttribute(&cus, hipDeviceAttributeMultiprocessorCount, dev) != hipSuccess) { grid = -1; return; }
        if (hipFuncSetAttribute((const void*)fwd_kernel, hipFuncAttributeMaxDynamicSharedMemorySize, LDS_BYTES) != hipSuccess) { fprintf(stderr, "kernel_launch: hipFuncSetAttribute failed\n"); grid = -1; return; }
        if (hipOccupancyMaxActiveBlocksPerMultiprocessor(&per_cu, (const void*)fwd_kernel, NTHREADS, LDS_BYTES) != hipSuccess || per_cu < 1) fprintf(stderr, "kernel_launch: occupancy query says %d\n", per_cu);
        (void)hipGetLastError();
        grid = cus;
    }
    if (grid < 0) return;
    unsigned char* ws = (unsigned char*)d_ws;
    (void)hipMemsetAsync(ws + WS_CTL, 0, CTL_ZERO_BYTES, stream);
    Args a{};
    a.x = (const float*)d_in[0]; a.mix_norm = (const float*)d_in[1]; a.ffn_norm = (const float*)d_in[2];
    a.att_q_gain = (const float*)d_in[4]; a.att_k_gain = (const float*)d_in[5]; a.att_rel_bias = (const float*)d_in[6];
    a.pool_scale = (const float*)d_in[9]; a.gdn_conv = (const float*)d_in[11]; a.gdn_a_log = (const float*)d_in[12]; a.gdn_dt_bias = (const float*)d_in[13];
    a.gdn_o_gain = (const float*)d_in[14]; a.ffn_conv = (const float*)d_in[17];
    a.out = (float*)d_out; a.ws = ws;
    a.wd[0] = WDesc{(const float*)d_in[3],  (bf16_t*)(ws + WS_WQKV), D, 6144, 2, 0};
    a.wd[1] = WDesc{(const float*)d_in[7],  (bf16_t*)(ws + WS_WO),   D, D, 2, 0};
    a.wd[2] = WDesc{(const float*)d_in[8],  (bf16_t*)(ws + WS_WPOOL), 512, 512, 4, 0};
    a.wd[3] = WDesc{(const float*)d_in[10], (bf16_t*)(ws + WS_WGIN), D, GIN, 1, 0};
    a.wd[4] = WDesc{(const float*)d_in[15], (bf16_t*)(ws + WS_WGO),  4096, D, 1, 0};
    a.wd[5] = WDesc{(const float*)d_in[16], (bf16_t*)(ws + WS_WUP),  D, FF2, 4, 1};
    a.wd[6] = WDesc{(const float*)d_in[18], (bf16_t*)(ws + WS_WDN),  FF, D, 4, 0};
    if (N_LAUNCH_MODE == 1) {
        a.ph_lo = 0; a.ph_hi = N_PHASES;
        hipLaunchKernelGGL(fwd_kernel, dim3(grid), dim3(NTHREADS), LDS_BYTES, stream, a);
    } else {
        for (int p = 0; p < N_PHASES; ++p) { a.ph_lo = p; a.ph_hi = p + 1; hipLaunchKernelGGL(fwd_kernel, dim3(grid), dim3(NTHREADS), LDS_BYTES, stream, a); }
    }
}
```

```cpp
#include <hip/hip_runtime.h>
#include <cstdio>
#include <cstdint>

#ifndef N_LAUNCH_MODE
#define N_LAUNCH_MODE 1
#endif

#define LAS __attribute__((address_space(3)))
#define GAS __attribute__((address_space(1)))
typedef unsigned short bf16_t;
typedef short bf16x8 __attribute__((ext_vector_type(8)));
typedef short s16x4 __attribute__((ext_vector_type(4)));
typedef float f32x4 __attribute__((ext_vector_type(4)));
typedef float f32x2 __attribute__((ext_vector_type(2)));
typedef float f32x16 __attribute__((ext_vector_type(16)));
typedef unsigned u32x4 __attribute__((ext_vector_type(4)));
typedef unsigned u32x2 __attribute__((ext_vector_type(2)));

constexpr int D = 2048, BATCH = 4, SEQ = 8192, T = BATCH * SEQ;
constexpr int CH = 64, NCH = SEQ / CH;
constexpr int AH = 16, AHD = 128, NREL = 320;
constexpr int GKH = 16, GVH = 32, GIN = 12352, GINP = 12544;
constexpr int FF = 5504, FF2 = 11008;
constexpr int MH = T / 2;
constexpr float EPS = 1e-6f;
constexpr int NTHREADS = 512, NWAVES = 8;

constexpr size_t MiB = 1u << 20;
constexpr size_t WS_CTL = 0, CTL_ZERO_BYTES = 1 * MiB;
constexpr size_t WS_WQKV = 1 * MiB;
constexpr size_t WS_WO   = WS_WQKV + 48 * MiB;
constexpr size_t WS_WPOOL= WS_WO + 16 * MiB;
constexpr size_t WS_WGIN = WS_WPOOL + 2 * MiB;
constexpr size_t WS_WGO  = WS_WGIN + 49 * MiB;
constexpr size_t WS_WUP  = WS_WGO + 16 * MiB;
constexpr size_t WS_WDN  = WS_WUP + 172 * MiB;
constexpr size_t WS_H    = WS_WDN + 86 * MiB;
constexpr size_t WS_BIG  = WS_H + 128 * MiB;
constexpr size_t WS_QKV  = WS_BIG;
constexpr size_t WS_AO   = WS_QKV + 384 * MiB;
constexpr size_t WS_PART = WS_AO + 128 * MiB;
constexpr size_t WS_ACT  = WS_BIG;
constexpr size_t WS_TAILU = WS_ACT + 344 * MiB;
constexpr size_t WS_HEADU = WS_TAILU + 11 * MiB;
constexpr size_t WS_HEADG = WS_HEADU + 11 * MiB;
constexpr size_t WS_POOLED = WS_BIG;
constexpr size_t WS_C    = WS_BIG;
constexpr size_t WS_GATE = WS_C + 256 * MiB;
constexpr size_t WS_W    = WS_GATE + 128 * MiB;
constexpr size_t WS_O    = WS_W + 128 * MiB;
constexpr size_t WS_ATT  = WS_O + 128 * MiB;
constexpr size_t WS_AB   = WS_ATT + 64 * MiB;
constexpr size_t WS_GC   = WS_AB + 4 * MiB;
constexpr size_t WS_HEAD3 = WS_GC + 2 * MiB;
constexpr size_t WS_TAIL3 = WS_HEAD3 + 13 * MiB;
constexpr size_t WS_END  = WS_TAIL3 + 13 * MiB;
constexpr size_t WS_NEED = WS_BIG + 736 * MiB;
static_assert(WS_END <= WS_NEED && WS_HEADG + 11 * MiB <= WS_NEED && WS_AO + (size_t)T * D * 2 <= WS_NEED, "map");

constexpr int CW_BAR = 4096;

__device__ __forceinline__ float bf2f(unsigned b) { return __uint_as_float(b << 16); }
__device__ __forceinline__ float bflo(unsigned w) { return __uint_as_float(w << 16); }
__device__ __forceinline__ float bfhi(unsigned w) { return __uint_as_float(w & 0xffff0000u); }
__device__ __forceinline__ unsigned cvt_pk_bf16(float lo, float hi) { unsigned r; asm volatile("v_cvt_pk_bf16_f32 %0, %1, %2" : "=v"(r) : "v"(lo), "v"(hi)); return r; }
typedef float f32x2_cv __attribute__((ext_vector_type(2))); typedef __bf16 bf16x2_cv __attribute__((ext_vector_type(2)));
__device__ __forceinline__ unsigned cvt_pk_bf16_op(float lo, float hi) { const f32x2_cv v = {lo, hi}; const bf16x2_cv b = __builtin_convertvector(v, bf16x2_cv); return __builtin_bit_cast(unsigned, b); }
__device__ __forceinline__ unsigned f2bf(float f) { return cvt_pk_bf16(f, 0.f) & 0xffffu; }
template <int CTRL, int RMASK, bool BC> __device__ __forceinline__ float dpp_get(float oldv, float v) { return __builtin_bit_cast(float, __builtin_amdgcn_update_dpp(__builtin_bit_cast(int, oldv), __builtin_bit_cast(int, v), CTRL, RMASK, 0xf, BC)); }
__device__ __forceinline__ float sum16(float v) {
    v += dpp_get<0xB1, 0xf, false>(v, v); v += dpp_get<0x4E, 0xf, false>(v, v); v += dpp_get<0x141, 0xf, false>(v, v); v += dpp_get<0x140, 0xf, false>(v, v); return v; }
__device__ __forceinline__ float scan64(float v) {
    v += dpp_get<0x111, 0xf, true>(0.f, v); v += dpp_get<0x112, 0xf, true>(0.f, v); v += dpp_get<0x114, 0xf, true>(0.f, v); v += dpp_get<0x118, 0xf, true>(0.f, v);
    v += dpp_get<0x142, 0xa, false>(0.f, v); v += dpp_get<0x143, 0xc, false>(0.f, v); return v; }
__device__ __forceinline__ float wave_sum(float v) {
#pragma unroll
    for (int o = 1; o < 64; o <<= 1) v += __shfl_xor(v, o);
    return v;
}
__device__ __forceinline__ float siluf(float x) { return x * __builtin_amdgcn_rcpf(1.0f + __expf(-x)); }
#define LDS_WAIT() asm volatile("s_waitcnt lgkmcnt(0)" ::: "memory")
#define MFMA_SETTLE() do { __builtin_amdgcn_sched_barrier(0); asm volatile("s_nop 15\n\ts_nop 15\n\ts_nop 15\n\ts_nop 15\n\ts_nop 15" ::: "memory"); __builtin_amdgcn_sched_barrier(0); } while (0)
#define VM_WAIT() asm volatile("s_waitcnt vmcnt(0)" ::: "memory")

namespace pg8 {
constexpr int BM = 256, BK = 64, HALF = 128, HTB = HALF * BK * 2, STAGE_BYTES = 8 * HTB, NXCD = 8, WGM = 8;
__host__ __device__ __forceinline__ int lds_byte(int r, int c) { const int st = (r >> 4) * 2 + (c >> 5), rr = r & 15, cc = c & 31, ob = rr * 64 + cc * 2; return st * 1024 + (ob ^ (((ob >> 9) & 1) << 5)); }
__host__ __device__ __forceinline__ void stage_rc(int b, int& R, int& C) { const int st = b / 1024, sb = b % 1024, swz = sb ^ (((sb >> 9) & 1) << 5); R = (st >> 1) * 16 + swz / 64; C = (st & 1) * 32 + (swz % 64) / 2; }
__host__ __device__ __forceinline__ int perm32(int rho) { const int n = rho >> 4, i = rho & 15; return 8 * (i >> 2) + 4 * n + (i & 3); }

struct Unit { int pm, pn; };
struct Gemm { const bf16_t* A; const bf16_t* Bt; int M, N, K, lda, ldb, grp; };

struct StaticOrder {
    int nM, nN, nwg, G, c;
    __device__ void init(int M, int N, int G_, int c_) { nM = M / BM; nN = N / BM; nwg = nM * nN; G = G_; c = c_; }
    __device__ bool next(int i, Unit& u) const {
        const long L = (long)i * G + c; if (L >= nwg) return false;
        int wgid = (int)L; { const int q = nwg / NXCD, r = nwg % NXCD, xcd = wgid % NXCD, off = wgid / NXCD; wgid = (xcd < r ? xcd * (q + 1) : r * (q + 1) + (xcd - r) * q) + off; }
        const int nig = WGM * nN, gid = wgid / nig, fm = gid * WGM, gsz = (nM - fm) < WGM ? (nM - fm) : WGM;
        u.pm = fm + ((wgid % nig) % gsz); u.pn = (wgid % nig) / gsz; return true;
    }
};

struct EpiBf16 {
    static constexpr bool PERM = true;
    bf16_t* O; int ldc;
    __device__ __forceinline__ void operator()(const f32x4 (&acc)[2][2][4][2], const Unit& u, int wr, int wc, int fr, int fq) const {
        const int row0 = u.pm * BM + wr * 64 + fr, col0 = u.pn * BM + wc * 32 + 8 * fq;
#pragma unroll
        for (int ai = 0; ai < 2; ++ai)
#pragma unroll
            for (int m = 0; m < 4; ++m) { bf16_t* rowp = O + (size_t)(row0 + ai * HALF + m * 16) * ldc + col0;
#pragma unroll
                for (int bj = 0; bj < 2; ++bj) { const f32x4 v0 = acc[ai][bj][m][0], v1 = acc[ai][bj][m][1];
                    u32x4 w; w.x = cvt_pk_bf16(v0[0], v0[1]); w.y = cvt_pk_bf16(v0[2], v0[3]); w.z = cvt_pk_bf16(v1[0], v1[1]); w.w = cvt_pk_bf16(v1[2], v1[3]);
                    *(u32x4*)(rowp + bj * HALF) = w; } }
    }
};
struct EpiQkv {
    static constexpr bool PERM = true;
    bf16_t* O; int ldc; float* PART;
    __device__ __forceinline__ void operator()(const f32x4 (&acc)[2][2][4][2], const Unit& u, int wr, int wc, int fr, int fq) const {
        const int row0 = u.pm * BM + wr * 64 + fr, col0 = u.pn * BM + wc * 32 + 8 * fq;
#pragma unroll
        for (int ai = 0; ai < 2; ++ai)
#pragma unroll
            for (int m = 0; m < 4; ++m) { bf16_t* rowp = O + (size_t)(row0 + ai * HALF + m * 16) * ldc + col0;
#pragma unroll
                for (int bj = 0; bj < 2; ++bj) { const f32x4 v0 = acc[ai][bj][m][0], v1 = acc[ai][bj][m][1];
                    u32x4 w; w.x = cvt_pk_bf16(v0[0], v0[1]); w.y = cvt_pk_bf16(v0[2], v0[3]); w.z = cvt_pk_bf16(v1[0], v1[1]); w.w = cvt_pk_bf16(v1[2], v1[3]);
                    *(u32x4*)(rowp + bj * HALF) = w; } }
        if (u.pn < 16) {
#pragma unroll
            for (int ai = 0; ai < 2; ++ai)
#pragma unroll
                for (int m = 0; m < 4; ++m)
#pragma unroll
                    for (int bj = 0; bj < 2; ++bj) { const f32x4 v0 = acc[ai][bj][m][0], v1 = acc[ai][bj][m][1];
                        float ss = (v0[0] * v0[0] + v0[1] * v0[1]) + (v0[2] * v0[2] + v0[3] * v0[3]) + (v1[0] * v1[0] + v1[1] * v1[1]) + (v1[2] * v1[2] + v1[3] * v1[3]);
                        ss += __shfl_xor(ss, 16); ss += __shfl_xor(ss, 32);
                        if (fq == 0) PART[(((size_t)u.pn * T + (row0 + ai * HALF + m * 16)) * 2 + bj) * 4 + wc] = ss; }
        }
    }
};
template <int CTRL> __device__ __forceinline__ float dpp0(float v) {
    return __builtin_bit_cast(float, __builtin_amdgcn_update_dpp(0, __builtin_bit_cast(int, v), CTRL, 0xf, 0xf, true)); }
#define DEF_FMAC_DPP(NAME, CTRL) __device__ __forceinline__ void NAME(float& a, float src, float w) { asm("v_fmac_f32_dpp %0, %1, %2 " CTRL " row_mask:0xf bank_mask:0xf bound_ctrl:1" : "+v"(a) : "v"(src), "v"(w)); }
DEF_FMAC_DPP(fmac_shr1, "row_shr:1")
DEF_FMAC_DPP(fmac_shr2, "row_shr:2")
DEF_FMAC_DPP(fmac_ror1, "row_ror:1")
DEF_FMAC_DPP(fmac_ror2, "row_ror:2")
DEF_FMAC_DPP(fmac_shr3, "row_shr:3")
DEF_FMAC_DPP(fmac_ror3, "row_ror:3")
#undef DEF_FMAC_DPP
template <int N> __device__ __forceinline__ float dpp_rowprev(float cur, float prevm) {
    const int t = __builtin_amdgcn_update_dpp(0, __builtin_bit_cast(int, prevm), 0x120 + N, 0xf, 0xf, false);
    return __builtin_bit_cast(float, __builtin_amdgcn_update_dpp(t, __builtin_bit_cast(int, cur), 0x110 + N, 0xf, 0xf, false));
}
struct EpiGdn {
    static constexpr bool PERM = true;
    bf16_t* C; bf16_t* GATE; float* AB; const float* cw; bf16_t* HEAD3; bf16_t* TAIL3;
    __device__ __forceinline__ void operator()(const f32x4 (&acc)[2][2][4][2], const Unit& u, int wr, int wc, int fr, int fq) const {
        const int row0 = u.pm * BM + wr * 64 + fr;
        if (u.pn == 48) {
            if (wc < 2) {
#pragma unroll
                for (int ai = 0; ai < 2; ++ai)
#pragma unroll
                    for (int m = 0; m < 4; ++m) { float* rp = AB + (size_t)(row0 + ai * HALF + m * 16) * 64 + wc * 32 + 8 * fq;
                        *(f32x4*)(rp) = acc[ai][0][m][0]; *(f32x4*)(rp + 4) = acc[ai][0][m][1]; }
            }
            return;
        }
        if (u.pn >= 32) {
            const int col0 = (u.pn - 32) * BM + wc * 32 + 8 * fq;
#pragma unroll
            for (int ai = 0; ai < 2; ++ai)
#pragma unroll
                for (int m = 0; m < 4; ++m) { bf16_t* rowp = GATE + (size_t)(row0 + ai * HALF + m * 16) * 4096 + col0;
#pragma unroll
                    for (int bj = 0; bj < 2; ++bj) { const f32x4 v0 = acc[ai][bj][m][0], v1 = acc[ai][bj][m][1];
                        u32x4 w; w.x = cvt_pk_bf16(v0[0], v0[1]); w.y = cvt_pk_bf16(v0[2], v0[3]); w.z = cvt_pk_bf16(v1[0], v1[1]); w.w = cvt_pk_bf16(v1[2], v1[3]);
                        *(u32x4*)(rowp + bj * HALF) = w; } }
            return;
        }
#pragma unroll
        for (int bj = 0; bj < 2; ++bj)
#pragma unroll
            for (int n = 0; n < 2; ++n) {
                const int colc = u.pn * BM + bj * HALF + wc * 32 + 8 * fq + 4 * n;
                const f32x4 w0 = *(const f32x4*)(cw + colc), w1 = *(const f32x4*)(cw + 8192 + colc), w2 = *(const f32x4*)(cw + 2 * 8192 + colc), w3 = *(const f32x4*)(cw + 3 * 8192 + colc);
                f32x4 w0m, w1m, w2m;
#pragma unroll
                for (int k = 0; k < 4; ++k) { w0m[k] = (fr < 3) ? w0[k] : 0.f; w1m[k] = (fr < 2) ? w1[k] : 0.f; w2m[k] = (fr < 1) ? w2[k] : 0.f; }
#pragma unroll
                for (int ai = 0; ai < 2; ++ai) {
                    const int sg = u.pm * 4 + ai * 2 + wr, rowbase = u.pm * BM + ai * HALF + wr * 64;
#pragma unroll
                    for (int m = 0; m < 4; ++m) {
                        float y[4];
#pragma unroll
                        for (int k = 0; k < 4; ++k) {
                            const float cur = acc[ai][bj][m][n][k];
                            float sv = w3[k] * cur;
                            fmac_shr1(sv, cur, w2[k]); fmac_shr2(sv, cur, w1[k]); fmac_shr3(sv, cur, w0[k]);
                            if (m > 0) { const float pv = acc[ai][bj][m > 0 ? m - 1 : 0][n][k];
                                fmac_ror1(sv, pv, w2m[k]); fmac_ror2(sv, pv, w1m[k]); fmac_ror3(sv, pv, w0m[k]); }
                            y[k] = siluf(sv);
                        }
                        if (!(m == 0 && fr < 3)) { u32x2 w; w.x = cvt_pk_bf16(y[0], y[1]); w.y = cvt_pk_bf16(y[2], y[3]);
                            *(u32x2*)(C + (size_t)(rowbase + 16 * m + fr) * 8192 + colc) = w; }
                        if (m == 0 && fr < 3) { const f32x4 u0 = acc[ai][bj][0][n];
                            u32x2 w; w.x = cvt_pk_bf16(u0[0], u0[1]); w.y = cvt_pk_bf16(u0[2], u0[3]);
                            *(u32x2*)(HEAD3 + (size_t)(sg * 3 + fr) * 8192 + colc) = w; }
                        if (m == 3 && fr >= 13) { const f32x4 u0 = acc[ai][bj][3][n];
                            u32x2 w; w.x = cvt_pk_bf16(u0[0], u0[1]); w.y = cvt_pk_bf16(u0[2], u0[3]);
                            *(u32x2*)(TAIL3 + (size_t)(sg * 3 + fr - 13) * 8192 + colc) = w; }
                    }
                }
            }
    }
};
struct EpiRes {
    static constexpr bool PERM = false;
    const float* base; float* out; int ldc; const float* scale;
    __device__ __forceinline__ void operator()(const f32x4 (&acc)[2][2][4][2], const Unit& u, int wr, int wc, int fr, int fq) const {
        const int row0 = u.pm * BM + wr * 64 + fr, col0 = u.pn * BM + wc * 32 + 4 * fq;
        f32x4 sv[2][2];
#pragma unroll
        for (int bj = 0; bj < 2; ++bj)
#pragma unroll
            for (int n = 0; n < 2; ++n) sv[bj][n] = scale ? *(const f32x4*)(scale + col0 + bj * HALF + n * 16) : (f32x4){1.f, 1.f, 1.f, 1.f};
#pragma unroll
        for (int ai = 0; ai < 2; ++ai) {
            f32x4 bs[4][2][2];
#pragma unroll
            for (int m = 0; m < 4; ++m) { const size_t off = (size_t)(row0 + ai * HALF + m * 16) * ldc + col0;
#pragma unroll
                for (int bj = 0; bj < 2; ++bj)
#pragma unroll
                    for (int n = 0; n < 2; ++n) bs[m][bj][n] = *(const f32x4*)(base + off + bj * HALF + n * 16); }
#pragma unroll
            for (int m = 0; m < 4; ++m) { const size_t off = (size_t)(row0 + ai * HALF + m * 16) * ldc + col0;
#pragma unroll
                for (int bj = 0; bj < 2; ++bj)
#pragma unroll
                    for (int n = 0; n < 2; ++n) *(f32x4*)(out + off + bj * HALF + n * 16) = bs[m][bj][n] + acc[ai][bj][m][n] * sv[bj][n]; }
        }
    }
};


struct EpiFfn {
    static constexpr bool PERM = true;
    bf16_t* ACT; const float* cw; bf16_t* TAILU; bf16_t* HEADU; bf16_t* HEADG;
    __device__ __forceinline__ void operator()(const f32x4 (&acc)[2][2][4][2], const Unit& u, int wr, int wc, int fr, int fq) const {
        const int colu = u.pn * 128 + wc * 32 + 8 * fq;
        float w0[8], w1[8], w2[8];
#pragma unroll
        for (int h = 0; h < 2; ++h) { const f32x4 a0 = *(const f32x4*)(cw + colu + 4 * h), a1 = *(const f32x4*)(cw + FF + colu + 4 * h), a2 = *(const f32x4*)(cw + 2 * FF + colu + 4 * h);
#pragma unroll
            for (int k = 0; k < 4; ++k) { w0[4 * h + k] = a0[k]; w1[4 * h + k] = a1[k]; w2[4 * h + k] = a2[k]; } }
        float w1m[8], w0m[8];
#pragma unroll
        for (int k = 0; k < 8; ++k) { w1m[k] = (fr < 1) ? w1[k] : 0.f; w0m[k] = (fr < 2) ? w0[k] : 0.f; }
#pragma unroll
        for (int ai = 0; ai < 2; ++ai) {
            const int sg = u.pm * 4 + ai * 2 + wr, rowbase = u.pm * BM + ai * HALF + wr * 64;
#pragma unroll
            for (int m = 0; m < 4; ++m) {
                float y[8];
#pragma unroll
                for (int n = 0; n < 2; ++n)
#pragma unroll
                    for (int k = 0; k < 4; ++k) {
                        const int ci = 4 * n + k;
                        const float cur = acc[ai][0][m][n][k];
                        float sv = w2[ci] * cur;
                        fmac_shr1(sv, cur, w1[ci]);
                        fmac_shr2(sv, cur, w0[ci]);
                        if (m > 0) { const float pv = acc[ai][0][m > 0 ? m - 1 : 0][n][k];
                            fmac_ror1(sv, pv, w1m[ci]);
                            fmac_ror2(sv, pv, w0m[ci]); }
                        y[ci] = siluf(sv) * acc[ai][1][m][n][k];
                    }
                if (!(m == 0 && fr < 2)) { u32x4 w; w.x = cvt_pk_bf16(y[0], y[1]); w.y = cvt_pk_bf16(y[2], y[3]); w.z = cvt_pk_bf16(y[4], y[5]); w.w = cvt_pk_bf16(y[6], y[7]);
                    *(u32x4*)(ACT + (size_t)(rowbase + 16 * m + fr) * FF + colu) = w; }
                if (m == 0 && fr < 2) {
                    const f32x4 u0 = acc[ai][0][0][0], u1 = acc[ai][0][0][1], g0 = acc[ai][1][0][0], g1 = acc[ai][1][0][1];
                    u32x4 w; w.x = cvt_pk_bf16(u0[0], u0[1]); w.y = cvt_pk_bf16(u0[2], u0[3]); w.z = cvt_pk_bf16(u1[0], u1[1]); w.w = cvt_pk_bf16(u1[2], u1[3]);
                    *(u32x4*)(HEADU + (size_t)(sg * 2 + fr) * FF + colu) = w;
                    w.x = cvt_pk_bf16(g0[0], g0[1]); w.y = cvt_pk_bf16(g0[2], g0[3]); w.z = cvt_pk_bf16(g1[0], g1[1]); w.w = cvt_pk_bf16(g1[2], g1[3]);
                    *(u32x4*)(HEADG + (size_t)(sg * 2 + fr) * FF + colu) = w;
                }
                if (m == 3 && fr >= 14) {
                    const f32x4 u0 = acc[ai][0][3][0], u1 = acc[ai][0][3][1];
                    u32x4 w; w.x = cvt_pk_bf16(u0[0], u0[1]); w.y = cvt_pk_bf16(u0[2], u0[3]); w.z = cvt_pk_bf16(u1[0], u1[1]); w.w = cvt_pk_bf16(u1[2], u1[3]);
                    *(u32x4*)(TAILU + (size_t)(sg * 2 + fr - 14) * FF + colu) = w;
                }
            }
        }
    }
};
template <class Epi, class Sched>
__device__ __forceinline__ void gemm_phase(LAS unsigned char* lds, const int tid, const Gemm g, const Sched& S, const Epi& E) {
    const int wid = __builtin_amdgcn_readfirstlane(tid >> 6), lane = tid & 63, wr = wid >> 2, wc = wid & 3, fr = lane & 15, fq = lane >> 4;
    const int K = g.K, nt = K / BK;
    unsigned voffA[2], voffB[2];
#pragma unroll
    for (int i = 0; i < 2; ++i) { int R, C; stage_rc(tid * 16 + i * 8192, R, C); const int Rb = Epi::PERM ? ((R & ~31) + perm32(R & 31)) : R;
        voffA[i] = (unsigned)(R * g.lda + C) * 2u; voffB[i] = (unsigned)(Rb * g.ldb + C) * 2u; }
    const size_t kstep = (size_t)(BK * 2);
    const size_t hstepA = (size_t)HALF * g.lda * 2, hstepB = (size_t)HALF * g.ldb * 2;
    const size_t tstepA = 2 * hstepA, tstepB = 2 * hstepB;
    const unsigned ldsw = (unsigned)wid * 1024u;
    const int aoff = lds_byte(wr * 64 + fr, fq * 8), boff = lds_byte(wc * 32 + fr, fq * 8);
#define PG8_SA(b, h) (((b) * 2 + (h)) * HTB)
#define PG8_SB(b, h) ((4 + (b) * 2 + (h)) * HTB)
#define PG8_STAGE(bufoff, gbase, voff) do { _Pragma("unroll") for (int _i = 0; _i < 2; ++_i) \
        __builtin_amdgcn_global_load_lds((const unsigned*)((const char*)(gbase) + (voff)[_i]), (LAS unsigned*)(lds + (bufoff) + ldsw + _i * 8192), 16, 0, 0); } while (0)
#define PG8_LDA(dst, b, h) do { _Pragma("unroll") for (int m = 0; m < 4; ++m) _Pragma("unroll") for (int k = 0; k < 2; ++k) dst[m][k] = *(const LAS bf16x8*)(lds + PG8_SA(b, h) + aoff + m * 2048 + k * 1024); } while (0)
#define PG8_LDB(dst, b, h) do { _Pragma("unroll") for (int n = 0; n < 2; ++n) _Pragma("unroll") for (int k = 0; k < 2; ++k) dst[n][k] = *(const LAS bf16x8*)(lds + PG8_SB(b, h) + boff + n * 2048 + k * 1024); } while (0)
#define PG8_MMA(ai, bj, At, Bt) do { __builtin_amdgcn_s_setprio(1); _Pragma("unroll") for (int m = 0; m < 4; ++m) _Pragma("unroll") for (int n = 0; n < 2; ++n) _Pragma("unroll") for (int k = 0; k < 2; ++k) \
        acc[ai][bj][m][n] = __builtin_amdgcn_mfma_f32_16x16x32_bf16(Bt[n][k], At[m][k], acc[ai][bj][m][n], 0, 0, 0); __builtin_amdgcn_s_setprio(0); } while (0)
#define PG8_WAIT_V(n) asm volatile("s_waitcnt vmcnt(" #n ")" ::: "memory")
#define PG8_WAIT_L(n) asm volatile("s_waitcnt lgkmcnt(" #n ")" ::: "memory")
#define PG8_BAR __builtin_amdgcn_s_barrier()
#define PG8_SCHED __builtin_amdgcn_sched_barrier(0)
#define PG8_AOFF(u) ((size_t)(u).pm * tstepA + (g.grp ? (size_t)((u).pn / g.grp) * (size_t)K * 2 : (size_t)0))
    Unit cur, nxt; int ui = 0;
    if (!S.next(0, cur)) return;
    f32x4 acc[2][2][4][2];
#pragma unroll
    for (int a = 0; a < 2; ++a)
#pragma unroll
        for (int b = 0; b < 2; ++b)
#pragma unroll
            for (int m = 0; m < 4; ++m)
#pragma unroll
                for (int n = 0; n < 2; ++n) acc[a][b][m][n] = (f32x4){0.f, 0.f, 0.f, 0.f};
    bf16x8 At[4][2], B0[2][2], B1[2][2];
    const char* cA = (const char*)g.A + PG8_AOFF(cur); const char* cB = (const char*)g.Bt + (size_t)cur.pn * tstepB;
    PG8_STAGE(PG8_SB(0, 0), cB, voffB); PG8_STAGE(PG8_SB(0, 1), cB + hstepB, voffB); PG8_STAGE(PG8_SA(0, 0), cA, voffA); PG8_STAGE(PG8_SA(0, 1), cA + hstepA, voffA);
    if (wr == 1) PG8_BAR;
    PG8_WAIT_V(2); PG8_BAR;
    PG8_STAGE(PG8_SB(1, 0), cB + kstep, voffB); PG8_STAGE(PG8_SA(1, 0), cA + kstep, voffA); PG8_STAGE(PG8_SB(1, 1), cB + hstepB + kstep, voffB);
    PG8_WAIT_V(6); PG8_BAR;
    for (;;) {
        const bool has_next = S.next(ui + 1, nxt);
        const char* nA = has_next ? (const char*)g.A + PG8_AOFF(nxt) : cA; const char* nB = has_next ? (const char*)g.Bt + (size_t)nxt.pn * tstepB : cB;
        for (int t = 0; t < nt; t += 2) {
            const bool last = (t == nt - 2);
            const char* a1 = cA + (size_t)(t + 1) * kstep;
            const char* a2 = last ? nA : cA + (size_t)(t + 2) * kstep; const char* b2 = last ? nB : cB + (size_t)(t + 2) * kstep;
            const char* a3 = a2 + kstep; const char* b3 = b2 + kstep;
            PG8_LDB(B0, 0, 0); PG8_LDB(B1, 0, 1); PG8_SCHED; PG8_LDA(At, 0, 0); PG8_STAGE(PG8_SA(1, 1), a1 + hstepA, voffA);
            PG8_WAIT_V(8); PG8_WAIT_L(0); PG8_BAR; PG8_MMA(0, 0, At, B0); PG8_MMA(0, 1, At, B1); PG8_BAR; PG8_SCHED;
            PG8_LDA(At, 0, 1); PG8_STAGE(PG8_SB(0, 0), b2, voffB); PG8_STAGE(PG8_SB(0, 1), b2 + hstepB, voffB); PG8_STAGE(PG8_SA(0, 0), a2, voffA);
            PG8_WAIT_V(8); PG8_WAIT_L(0); PG8_BAR; PG8_MMA(1, 0, At, B0); PG8_MMA(1, 1, At, B1); PG8_BAR; PG8_SCHED;
            PG8_LDB(B0, 1, 0); PG8_LDB(B1, 1, 1); PG8_SCHED; PG8_LDA(At, 1, 0); PG8_STAGE(PG8_SA(0, 1), a2 + hstepA, voffA);
            PG8_WAIT_V(8); PG8_WAIT_L(0); PG8_BAR; PG8_MMA(0, 0, At, B0); PG8_MMA(0, 1, At, B1); PG8_BAR; PG8_SCHED;
            PG8_LDA(At, 1, 1); PG8_STAGE(PG8_SB(1, 0), b3, voffB); PG8_STAGE(PG8_SB(1, 1), b3 + hstepB, voffB); PG8_STAGE(PG8_SA(1, 0), a3, voffA);
            PG8_WAIT_V(8); PG8_WAIT_L(0); PG8_BAR; PG8_MMA(1, 0, At, B0); PG8_MMA(1, 1, At, B1); PG8_BAR; PG8_SCHED;
        }
        if (wr == 0) PG8_BAR;
        asm volatile("s_nop 15\n\ts_nop 15\n\ts_nop 15" ::: "memory");
        E(acc, cur, wr, wc, fr, fq);
        if (!has_next) break;
#pragma unroll
        for (int a = 0; a < 2; ++a)
#pragma unroll
            for (int b = 0; b < 2; ++b)
#pragma unroll
                for (int m = 0; m < 4; ++m)
#pragma unroll
                    for (int n = 0; n < 2; ++n) acc[a][b][m][n] = (f32x4){0.f, 0.f, 0.f, 0.f};
        cur = nxt; cA = nA; cB = nB; ++ui;
        if (wr == 1) PG8_BAR;
    }
    PG8_WAIT_V(0);
    PG8_BAR;
#undef PG8_SA
#undef PG8_SB
#undef PG8_STAGE
#undef PG8_LDA
#undef PG8_LDB
#undef PG8_MMA
#undef PG8_WAIT_V
#undef PG8_WAIT_L
#undef PG8_BAR
#undef PG8_SCHED
#undef PG8_AOFF
}
}

#define XB_TMO      128
#define XB_XCNT(j)  (256  + 64 * (j))
#define XB_XSUB(j)  (1280 + 64 * (j))
#define XB_XGEN(j)  (2304 + 64 * (j))
#define XB_TOP      3328
#define XB_TOPGEN   3392
#define XCD_BAR_WORDS 3456
#define XB_SPIN_CAP (1u << 18)
__device__ __forceinline__ unsigned xb_ld(unsigned* p)              { return __hip_atomic_load(p, __ATOMIC_RELAXED, __HIP_MEMORY_SCOPE_AGENT); }
__device__ __forceinline__ unsigned xb_add(unsigned* p, unsigned v) { return __hip_atomic_fetch_add(p, v, __ATOMIC_RELAXED, __HIP_MEMORY_SCOPE_AGENT); }
__device__ __forceinline__ unsigned xb_xcc_id() { return (unsigned)__builtin_amdgcn_s_getreg((3 << 11) | 20) & 0xFu; }
#define XB_SPIN(cond, bar) do { unsigned _sp = 0; while (cond) { __builtin_amdgcn_s_sleep(1); \
    if ((++_sp & 255u) == 0u) { if (xb_ld(&(bar)[XB_TMO])) break; if (_sp > XB_SPIN_CAP) { atomicAdd(&(bar)[XB_TMO], 1u); break; } } } } while (0)
__device__ __forceinline__ int lane_id() { int l; asm volatile("v_mbcnt_lo_u32_b32 %0, -1, 0\n\tv_mbcnt_hi_u32_b32 %0, -1, %0" : "=v"(l)); return l; }
struct XcdBarrier { unsigned* bar; unsigned x; volatile LAS unsigned* st; int wv; };
__device__ __forceinline__ XcdBarrier xcd_barrier_post(unsigned* bar, volatile LAS unsigned* st, int wv) {
    XcdBarrier b; b.bar = bar; b.x = xb_xcc_id(); b.st = st; b.wv = wv;
    if (b.wv == 0 && lane_id() == 0) (void)xb_add(&bar[XB_XCNT(b.x)], 1u);
    return b;
}
__device__ __forceinline__ void xcd_barrier_complete(unsigned* bar, unsigned x, unsigned& nloc, unsigned& nx) {
    const unsigned G = gridDim.x * gridDim.y * gridDim.z;
    unsigned sum, cnt, mine, sp = 0u;
    for (;;) {
        sum = 0u; cnt = 0u; mine = 0u;
#pragma unroll
        for (unsigned j = 0; j < 16; ++j) { const unsigned c = xb_ld(&bar[XB_XCNT(j)]); sum += c; cnt += (c > 0u) ? 1u : 0u; mine = (j == x) ? c : mine; }
        if (sum == G) break;
        __builtin_amdgcn_s_sleep(1);
        if ((++sp & 255u) == 0u) { if (xb_ld(&bar[XB_TMO])) break; if (sp > XB_SPIN_CAP) { atomicAdd(&bar[XB_TMO], 1u); break; } }
    }
    nloc = mine > 0u ? mine : 1u; nx = cnt > 0u ? cnt : 1u;
}
__device__ __forceinline__ void xcd_barrier(const XcdBarrier& b) {
    asm volatile("s_waitcnt vmcnt(0)" ::: "memory");
    __syncthreads();
    if (b.wv == 0 && lane_id() == 0) {
        unsigned* bar = b.bar;
        __builtin_amdgcn_s_waitcnt(0);
        unsigned nloc = b.st[0], nx = b.st[1];
        if (nloc == 0u) { xcd_barrier_complete(bar, b.x, nloc, nx); b.st[0] = nloc; b.st[1] = nx; }
        const unsigned old = xb_add(&bar[XB_XSUB(b.x)], 1u);
        const unsigned gen = old / nloc;
        if (old + 1u == (gen + 1u) * nloc) {
            __builtin_amdgcn_fence(__ATOMIC_RELEASE, "agent");
            asm volatile("s_waitcnt vmcnt(0)" ::: "memory");
            const unsigned og = xb_add(&bar[XB_TOP], 1u);
            const unsigned tg = og / nx;
            if (og + 1u == (tg + 1u) * nx) xb_add(&bar[XB_TOPGEN], 1u);
            else XB_SPIN(xb_ld(&bar[XB_TOPGEN]) == tg, bar);
            __builtin_amdgcn_fence(__ATOMIC_ACQUIRE, "agent");
            xb_add(&bar[XB_XGEN(b.x)], 1u);
            asm volatile("s_waitcnt vmcnt(0)" ::: "memory");
        } else {
            XB_SPIN(xb_ld(&bar[XB_XGEN(b.x)]) == gen, bar);
            __builtin_amdgcn_fence(__ATOMIC_ACQUIRE, "agent");
            asm volatile("s_waitcnt vmcnt(0)" ::: "memory");
        }
    }
    __syncthreads();
}

constexpr int LDS_BYTES = 163840;
constexpr int MISC_OFF = LDS_BYTES - 256;

struct WDesc { const float* W; bf16_t* WT; int K, N, nmat, pad; };
struct Args {
    const float* x; const float* mix_norm; const float* ffn_norm;
    const float* att_q_gain; const float* att_k_gain; const float* att_rel_bias;
    const float* pool_scale; const float* gdn_conv; const float* gdn_a_log; const float* gdn_dt_bias; const float* gdn_o_gain; const float* ffn_conv;
    float* out; unsigned char* ws;
    WDesc wd[7];
    int ph_lo, ph_hi;
};

struct Ctx { LAS unsigned char* lds; int tid, lane, wave, G, bid; };

__device__ __forceinline__ void transpose_item(const float* W, int K, int N, bf16_t* WT, LAS float* scr, int item, int lane, int mode) {
    const int nblk = N / 64, kb = item / nblk, nb = item % nblk, k0 = 64 * kb, n0 = 64 * nb;
    const int r0 = (mode == 0) ? n0 : ((n0 < FF) ? 256 * (n0 >> 7) + (n0 & 127) : 256 * ((n0 - FF) >> 7) + 128 + ((n0 - FF) & 127));
    f32x4 v[16];
#pragma unroll
    for (int i = 0; i < 16; ++i) v[i] = *(const f32x4*)(W + (size_t)(k0 + 4 * i + (lane >> 4)) * N + n0 + 4 * (lane & 15));
#pragma unroll
    for (int i = 0; i < 16; ++i) *(LAS f32x4*)(scr + (4 * i + (lane >> 4)) * 68 + 4 * (lane & 15)) = v[i];
    LDS_WAIT();
    const int c = lane & 7;
#pragma unroll
    for (int j = 0; j < 8; ++j) { const int n = (lane >> 3) + 8 * j; const LAS float* sp = scr + (8 * c) * 68 + n;
        u32x4 o; o.x = cvt_pk_bf16(sp[0 * 68], sp[1 * 68]); o.y = cvt_pk_bf16(sp[2 * 68], sp[3 * 68]); o.z = cvt_pk_bf16(sp[4 * 68], sp[5 * 68]); o.w = cvt_pk_bf16(sp[6 * 68], sp[7 * 68]);
        *(u32x4*)(WT + (size_t)(r0 + n) * K + k0 + 8 * c) = o; }
    LDS_WAIT();
}
typedef const __attribute__((address_space(4))) struct Args* KArgsP0;
__device__ __forceinline__ void phase_weights(const Ctx& c, KArgsP0 a) {
    LAS float* scr = (LAS float*)(c.lds + c.wave * 17408);
    const int gw = c.bid * NWAVES + c.wave, NGW = c.G * NWAVES;
#pragma unroll
    for (int d = 0; d < 7; ++d) {
        const float* W = a->wd[d].W; bf16_t* WT = a->wd[d].WT; const int K = a->wd[d].K, N = a->wd[d].N, nmat = a->wd[d].nmat, mode = a->wd[d].pad;
        const int per = (K / 64) * (N / 64), tot = per * nmat;
        for (int it = gw; it < tot; it += NGW) { const int mat = it / per, r = it - mat * per;
            transpose_item(W + (size_t)mat * K * N, K, N, WT + (size_t)mat * K * N, scr, r, c.lane, mode); }
    }
    { u32x4* z = (u32x4*)(a->ws + WS_WGIN + (size_t)GIN * D * 2); const int n16 = (GINP - GIN) * D * 2 / 16;
      for (int i = c.bid * NTHREADS + c.tid; i < n16; i += c.G * NTHREADS) z[i] = (u32x4){0u, 0u, 0u, 0u}; }
}

__device__ __forceinline__ void phase_rmsnorm(const Ctx& c, const float* x, const float* gain, bf16_t* out) {
    const int gw = c.bid * NWAVES + c.wave, NGW = c.G * NWAVES;
    f32x4 gv[8];
#pragma unroll
    for (int j = 0; j < 8; ++j) gv[j] = *(const f32x4*)(gain + 4 * c.lane + 256 * j);
    f32x4 v[8], vn[8];
    if (gw < T) {
#pragma unroll
        for (int j = 0; j < 8; ++j) v[j] = ((const f32x4*)(x + (size_t)gw * D) + c.lane)[64 * j];
    }
    for (int m = gw; m < T; m += NGW) {
        const int mn = (m + NGW < T) ? m + NGW : m;
        const f32x4* xn = (const f32x4*)(x + (size_t)mn * D) + c.lane;
#pragma unroll
        for (int j = 0; j < 8; ++j) vn[j] = xn[64 * j];
        float s = 0.f;
#pragma unroll
        for (int j = 0; j < 8; ++j) s += (v[j].x * v[j].x + v[j].y * v[j].y) + (v[j].z * v[j].z + v[j].w * v[j].w);
        const float rstd = 1.0f / sqrtf(wave_sum(s) * (1.0f / D) + EPS);
        u32x2* o8 = (u32x2*)(out + (size_t)m * D) + c.lane;
#pragma unroll
        for (int j = 0; j < 8; ++j) { u32x2 w; w.x = cvt_pk_bf16(v[j].x * rstd * gv[j].x, v[j].y * rstd * gv[j].y); w.y = cvt_pk_bf16(v[j].z * rstd * gv[j].z, v[j].w * rstd * gv[j].w); o8[64 * j] = w; }
#pragma unroll
        for (int j = 0; j < 8; ++j) v[j] = vn[j];
    }
}
__device__ __forceinline__ void phase_ffn_fix(const Ctx& c, bf16_t* ACT, const float* cw, const bf16_t* TAILU, const bf16_t* HEADU, const bf16_t* HEADG) {
    constexpr int NCG = FF / 8, NS = T / 64;
    for (int it = c.bid * NTHREADS + c.tid; it < NS * NCG; it += c.G * NTHREADS) {
        const int sg = it / NCG, cg = it - sg * NCG, col = cg * 8; const bool first = ((sg * 64) % SEQ) == 0;
        float w0[8], w1[8], w2[8], um2[8], um1[8], u0[8], u1[8], g0[8], g1[8];
#pragma unroll
        for (int h = 0; h < 2; ++h) { const f32x4 a0 = *(const f32x4*)(cw + col + 4 * h), a1 = *(const f32x4*)(cw + FF + col + 4 * h), a2 = *(const f32x4*)(cw + 2 * FF + col + 4 * h);
#pragma unroll
            for (int k = 0; k < 4; ++k) { w0[4 * h + k] = a0[k]; w1[4 * h + k] = a1[k]; w2[4 * h + k] = a2[k]; } }
        const u32x4 hu0 = *(const u32x4*)(HEADU + (size_t)(sg * 2) * FF + col), hu1 = *(const u32x4*)(HEADU + (size_t)(sg * 2 + 1) * FF + col);
        const u32x4 hg0 = *(const u32x4*)(HEADG + (size_t)(sg * 2) * FF + col), hg1 = *(const u32x4*)(HEADG + (size_t)(sg * 2 + 1) * FF + col);
        u32x4 t0 = (u32x4){0u, 0u, 0u, 0u}, t1 = t0;
        if (!first) { t0 = *(const u32x4*)(TAILU + (size_t)(sg * 2 - 2) * FF + col); t1 = *(const u32x4*)(TAILU + (size_t)(sg * 2 - 1) * FF + col); }
#pragma unroll
        for (int k = 0; k < 4; ++k) { um2[2 * k] = bflo(t0[k]); um2[2 * k + 1] = bfhi(t0[k]); um1[2 * k] = bflo(t1[k]); um1[2 * k + 1] = bfhi(t1[k]);
            u0[2 * k] = bflo(hu0[k]); u0[2 * k + 1] = bfhi(hu0[k]); u1[2 * k] = bflo(hu1[k]); u1[2 * k + 1] = bfhi(hu1[k]);
            g0[2 * k] = bflo(hg0[k]); g0[2 * k + 1] = bfhi(hg0[k]); g1[2 * k] = bflo(hg1[k]); g1[2 * k + 1] = bfhi(hg1[k]); }
        float y0[8], y1[8];
#pragma unroll
        for (int k = 0; k < 8; ++k) { y0[k] = siluf(w0[k] * um2[k] + w1[k] * um1[k] + w2[k] * u0[k]) * g0[k]; y1[k] = siluf(w0[k] * um1[k] + w1[k] * u0[k] + w2[k] * u1[k]) * g1[k]; }
        u32x4 o; o.x = cvt_pk_bf16(y0[0], y0[1]); o.y = cvt_pk_bf16(y0[2], y0[3]); o.z = cvt_pk_bf16(y0[4], y0[5]); o.w = cvt_pk_bf16(y0[6], y0[7]);
        *(u32x4*)(ACT + (size_t)(sg * 64) * FF + col) = o;
        o.x = cvt_pk_bf16(y1[0], y1[1]); o.y = cvt_pk_bf16(y1[2], y1[3]); o.z = cvt_pk_bf16(y1[4], y1[5]); o.w = cvt_pk_bf16(y1[6], y1[7]);
        *(u32x4*)(ACT + (size_t)(sg * 64 + 1) * FF + col) = o;
    }
}

__device__ __forceinline__ void phase_pool_prep(const Ctx& c, const bf16_t* H, bf16_t* P) {
    constexpr int NCG = D / 8, RB = 64;
    const int nitems = (T / RB) * NCG;
    for (int it = c.bid * NTHREADS + c.tid; it < nitems; it += c.G * NTHREADS) {
        const int rb = it / NCG, cg = it - rb * NCG, t0 = rb * RB, col = cg * 8, w = 2 << (col >> 9), tp0 = t0 % SEQ;
        float s[8];
#pragma unroll
        for (int k = 0; k < 8; ++k) s[k] = 0.f;
        for (int i = 1; i <= w; ++i) if (tp0 - i >= 0) {   const u32x4 a = *(const u32x4*)(H + (size_t)(t0 - i) * D + col);
#pragma unroll
            for (int k = 0; k < 4; ++k) { s[2 * k] += bflo(a[k]); s[2 * k + 1] += bfhi(a[k]); } }
        for (int tb = t0; tb < t0 + RB; tb += 8) {
            u32x4 ar[8], br[8];
#pragma unroll
            for (int q = 0; q < 8; ++q) { const int t = tb + q, tp = tp0 + (t - t0);
                ar[q] = *(const u32x4*)(H + (size_t)t * D + col);
                br[q] = (tp >= w) ? *(const u32x4*)(H + (size_t)(t - w) * D + col) : (u32x4){0u, 0u, 0u, 0u}; }
#pragma unroll
            for (int q = 0; q < 8; ++q) { const int t = tb + q, tp = tp0 + (t - t0);
                const u32x4 a = ar[q], b = br[q];
                float cu[8];
#pragma unroll
                for (int k = 0; k < 4; ++k) { cu[2 * k] = bflo(a[k]); cu[2 * k + 1] = bfhi(a[k]); }
#pragma unroll
                for (int k = 0; k < 8; ++k) s[k] += cu[k];
#pragma unroll
                for (int k = 0; k < 4; ++k) { s[2 * k] -= bflo(b[k]); s[2 * k + 1] -= bfhi(b[k]); }
                const float inv = 1.0f / (float)(tp + 1 < w ? tp + 1 : w);
                u32x4 o; o.x = cvt_pk_bf16(s[0] * inv - cu[0], s[1] * inv - cu[1]); o.y = cvt_pk_bf16(s[2] * inv - cu[2], s[3] * inv - cu[3]);
                o.z = cvt_pk_bf16(s[4] * inv - cu[4], s[5] * inv - cu[5]); o.w = cvt_pk_bf16(s[6] * inv - cu[6], s[7] * inv - cu[7]);
                *(u32x4*)(P + (size_t)t * D + col) = o;
            }
        }
    }
}

constexpr int ATT_ROWB = 272;
constexpr int ATT_WAVE_BYTES = 2 * 32 * ATT_ROWB + NREL * 4;
static_assert(ATT_WAVE_BYTES * NWAVES <= MISC_OFF, "attention LDS");
__device__ __forceinline__ void phase_attention(const Ctx& c, const bf16_t* QKV, bf16_t* O, const float* q_gain, const float* k_gain, const float* rel_bias) {
    LAS unsigned char* Kt = c.lds + c.wave * ATT_WAVE_BYTES;
    LAS unsigned char* Vt = Kt + 32 * ATT_ROWB;
    LAS float* bias = (LAS float*)(Vt + 32 * ATT_ROWB);
    const int lane = c.lane, l31 = lane & 31, hh = lane >> 5;
    const int gw = c.bid * NWAVES + c.wave, NGW = c.G * NWAVES;
    constexpr int NU = BATCH * NCH * AH * 2;
    const float scale = 0.08838834764831845f;
    float kg[8];
    { const int ch = lane & 15; const f32x4 a = *(const f32x4*)(k_gain + ch * 8), b = *(const f32x4*)(k_gain + ch * 8 + 4);
#pragma unroll
      for (int k = 0; k < 4; ++k) { kg[k] = a[k]; kg[4 + k] = b[k]; } }
    for (int u = gw; u < NU; u += NGW) {
        const int qh = u & 1, h = (u >> 1) & 15, ck = (u >> 5) & 127, b = u >> 12;
        const size_t row_q0 = (size_t)b * SEQ + (size_t)ck * CH + qh * 32;
        for (int i = lane; i < NREL; i += 64) bias[i] = rel_bias[h * NREL + i];
        bf16x8 qf[8];
        {
            float qv[8][8]; float ss = 0.f;
            const bf16_t* qp = QKV + (row_q0 + l31) * 6144 + h * AHD + hh * 8;
#pragma unroll
            for (int ks = 0; ks < 8; ++ks) { const u32x4 a = *(const u32x4*)(qp + ks * 16);
#pragma unroll
                for (int k = 0; k < 4; ++k) { qv[ks][2 * k] = bflo(a[k]); qv[ks][2 * k + 1] = bfhi(a[k]); }
#pragma unroll
                for (int k = 0; k < 8; ++k) ss += qv[ks][k] * qv[ks][k]; }
            ss += __shfl_xor(ss, 32);
            const float rq = scale / sqrtf(ss * (1.0f / AHD) + EPS);
#pragma unroll
            for (int ks = 0; ks < 8; ++ks) { const f32x4 g0 = *(const f32x4*)(q_gain + ks * 16 + hh * 8), g1 = *(const f32x4*)(q_gain + ks * 16 + hh * 8 + 4);
                u32x4 w; w.x = cvt_pk_bf16(qv[ks][0] * rq * g0[0], qv[ks][1] * rq * g0[1]); w.y = cvt_pk_bf16(qv[ks][2] * rq * g0[2], qv[ks][3] * rq * g0[3]);
                w.z = cvt_pk_bf16(qv[ks][4] * rq * g1[0], qv[ks][5] * rq * g1[1]); w.w = cvt_pk_bf16(qv[ks][6] * rq * g1[2], qv[ks][7] * rq * g1[3]);
                qf[ks] = __builtin_bit_cast(bf16x8, w); }
        }
        float mrun = -1e30f, lsum = 0.f;
        f32x16 oacc[4];
#pragma unroll
        for (int dt = 0; dt < 4; ++dt)
#pragma unroll
            for (int r = 0; r < 16; ++r) oacc[dt][r] = 0.f;
        const int qi = qh * 32 + l31;
        const int kt_first = (ck >= 8) ? 0 : 2 * (8 - ck);
        for (int kt = kt_first; kt < 18; ++kt) {
            const int kj0 = kt * 32;
            const size_t krow0 = (size_t)b * SEQ + (size_t)((ck - 8) * CH + kj0);
            {
                const int ch = lane & 15, rr = lane >> 4;
#pragma unroll
                for (int i = 0; i < 8; ++i) {
                    const int row = rr + 4 * i;
                    const bf16_t* kp = QKV + (krow0 + row) * 6144 + 2048 + h * AHD + ch * 8;
                    const u32x4 a = *(const u32x4*)kp, vv = *(const u32x4*)(kp + 2048);
                    float kv[8]; float ss = 0.f;
#pragma unroll
                    for (int k = 0; k < 4; ++k) { kv[2 * k] = bflo(a[k]); kv[2 * k + 1] = bfhi(a[k]); }
#pragma unroll
                    for (int k = 0; k < 8; ++k) ss += kv[k] * kv[k];
                    ss += __shfl_xor(ss, 1); ss += __shfl_xor(ss, 2); ss += __shfl_xor(ss, 4); ss += __shfl_xor(ss, 8);
                    const float rk = 1.0f / sqrtf(ss * (1.0f / AHD) + EPS);
                    u32x4 w; w.x = cvt_pk_bf16(kv[0] * rk * kg[0], kv[1] * rk * kg[1]); w.y = cvt_pk_bf16(kv[2] * rk * kg[2], kv[3] * rk * kg[3]);
                    w.z = cvt_pk_bf16(kv[4] * rk * kg[4], kv[5] * rk * kg[5]); w.w = cvt_pk_bf16(kv[6] * rk * kg[6], kv[7] * rk * kg[7]);
                    *(LAS u32x4*)(Kt + row * ATT_ROWB + ch * 16) = w;
                    *(LAS u32x4*)(Vt + row * ATT_ROWB + ch * 16) = vv;
                }
            }
            LDS_WAIT();
            f32x16 st;
#pragma unroll
            for (int r = 0; r < 16; ++r) st[r] = 0.f;
#pragma unroll
            for (int ks = 0; ks < 8; ++ks) { const bf16x8 kf = *(const LAS bf16x8*)(Kt + l31 * ATT_ROWB + ks * 32 + hh * 16);
                st = __builtin_amdgcn_mfma_f32_32x32x16_bf16(kf, qf[ks], st, 0, 0, 0); }
            float mt = -1e30f;
#pragma unroll
            for (int r = 0; r < 16; ++r) { const int kj = kj0 + (r & 3) + 8 * (r >> 2) + 4 * hh; int idx = 575 + qi - kj; idx = idx > 319 ? 319 : idx; st[r] += bias[idx]; mt = fmaxf(mt, st[r]); }
            mt = fmaxf(mt, __shfl_xor(mt, 32));
            const float mnew = fmaxf(mrun, mt), alpha = __expf(mrun - mnew);
            mrun = mnew;
            float ps = 0.f;
#pragma unroll
            for (int r = 0; r < 16; ++r) { st[r] = __expf(st[r] - mnew); ps += st[r]; }
            lsum = lsum * alpha + ps;
#pragma unroll
            for (int dt = 0; dt < 4; ++dt)
#pragma unroll
                for (int r = 0; r < 16; ++r) oacc[dt][r] *= alpha;
            bf16x8 pf[2];
#pragma unroll
            for (int s = 0; s < 2; ++s) { u32x4 w; w.x = cvt_pk_bf16(st[8 * s + 0], st[8 * s + 1]); w.y = cvt_pk_bf16(st[8 * s + 2], st[8 * s + 3]); w.z = cvt_pk_bf16(st[8 * s + 4], st[8 * s + 5]); w.w = cvt_pk_bf16(st[8 * s + 6], st[8 * s + 7]);
                pf[s] = __builtin_bit_cast(bf16x8, w); }
            {
                const int i16 = lane & 15, g1 = (lane >> 4) & 1;
                LAS unsigned char* vb = Vt + (4 * hh + (i16 >> 2)) * ATT_ROWB + (16 * g1 + 4 * (i16 & 3)) * 2;
#pragma unroll
                for (int dt = 0; dt < 4; ++dt)
#pragma unroll
                    for (int s = 0; s < 2; ++s) {
                        const s16x4 lo = __builtin_bit_cast(s16x4, __builtin_amdgcn_ds_read_tr16_b64_v4i16((LAS s16x4*)(vb + (16 * s) * ATT_ROWB + dt * 64)));
                        const s16x4 hi = __builtin_bit_cast(s16x4, __builtin_amdgcn_ds_read_tr16_b64_v4i16((LAS s16x4*)(vb + (16 * s + 8) * ATT_ROWB + dt * 64)));
                        const bf16x8 vf = (bf16x8){lo[0], lo[1], lo[2], lo[3], hi[0], hi[1], hi[2], hi[3]};
                        oacc[dt] = __builtin_amdgcn_mfma_f32_32x32x16_bf16(vf, pf[s], oacc[dt], 0, 0, 0);
                    }
            }
            LDS_WAIT();
        }
        lsum += __shfl_xor(lsum, 32);
        const float inv = 1.0f / lsum;
        bf16_t* op = O + (row_q0 + l31) * D + h * AHD + 4 * hh;
#pragma unroll
        for (int dt = 0; dt < 4; ++dt)
#pragma unroll
            for (int g = 0; g < 4; ++g) { u32x2 w; w.x = cvt_pk_bf16(oacc[dt][4 * g] * inv, oacc[dt][4 * g + 1] * inv); w.y = cvt_pk_bf16(oacc[dt][4 * g + 2] * inv, oacc[dt][4 * g + 3] * inv);
                *(u32x2*)(op + dt * 32 + g * 8) = w; }
        LDS_WAIT();
    }
}

constexpr int AT_SLOT = 32768, AT_BIAS = 4 * AT_SLOT, AT_NB = 640, AT_RK = AT_BIAS + AT_NB * 4, AT_END = AT_RK + 768 * 4;
static_assert(AT_END <= MISC_OFF, "attention LDS");
__device__ __forceinline__ void glds16(const void* gsrc, unsigned lds_dst) { unsigned keep;
    asm volatile("s_mov_b32 %0, m0\n\ts_mov_b32 m0, %2\n\ts_nop 0\n\tglobal_load_lds_dwordx4 %1, off\n\ts_mov_b32 m0, %0" : "=&s"(keep) : "v"(gsrc), "s"(lds_dst) : "memory"); }
__device__ __forceinline__ void phase_attention3(const Ctx& c, const bf16_t* QKV, bf16_t* O, const float* PART, const float* q_gain, const float* k_gain, const float* rel_bias) {
    LAS unsigned char* lds = c.lds;
    const unsigned lds0 = (unsigned)(size_t)lds;
    LAS float* bias = (LAS float*)(lds + AT_BIAS);
    LAS float* rkt = (LAS float*)(lds + AT_RK);
    const int lane = c.lane, w = c.wave, l31 = lane & 31, hh = lane >> 5, i16 = lane & 15, g1 = (lane >> 4) & 1;
    const int wo = w >> 1, qi = 32 * (w & 1) + l31;
    const int fr = ((l31 & 3) << 2) | ((l31 >> 2) & 3);
    constexpr float LOG2E = 1.4426950408889634f;
    constexpr int NU = BATCH * 32 * AH;
    for (int u = c.bid; u < NU; u += c.G) {
        const int h = u & 15, cq = (u >> 4) & 31, b = u >> 9;
        const int jf = (cq >= 2) ? 0 : 8 - 4 * cq;
        const bf16_t* ksrc[2];
#pragma unroll
        for (int pp = 0; pp < 2; ++pp) { const int row = 8 * w + 4 * pp + (lane >> 4), chl = (lane & 15) ^ (((row & 3) << 2) | ((row >> 2) & 3));
            ksrc[pp] = QKV + ((size_t)b * SEQ + (size_t)((4 * cq - 8) * CH + row)) * 6144 + 2048 + h * AHD + chl * 8; }
#define AT_DMA(j) do { const unsigned sl_ = lds0 + (unsigned)(((j) & 3) * AT_SLOT) + (unsigned)(2 * w) * 1024u; const size_t to_ = (size_t)(j) * CH * 6144; \
            glds16(ksrc[0] + to_, sl_); glds16(ksrc[1] + to_, sl_ + 1024u); glds16(ksrc[0] + to_ + 2048, sl_ + 16384u); glds16(ksrc[1] + to_ + 2048, sl_ + 16384u + 1024u); } while (0)
        AT_DMA(jf); AT_DMA(jf + 1); AT_DMA(jf + 2);
        for (int i = c.tid; i < AT_NB; i += NTHREADS) bias[i] = rel_bias[h * NREL + (i < NREL - 1 ? i : NREL - 1)] * LOG2E;
        for (int i = c.tid; i < 768; i += NTHREADS) { const int kr = (4 * cq - 8) * CH + i;
            if (kr >= 0) { const f32x4 p = *(const f32x4*)(PART + (((size_t)(8 + (h >> 1)) * T + ((size_t)b * SEQ + kr)) * 2 + (h & 1)) * 4); rkt[i] = 1.0f / sqrtf(((p[0] + p[1]) + (p[2] + p[3])) * (1.0f / AHD) + EPS); } }
        bf16x8 qf[8];
        { const size_t qrow = (size_t)b * SEQ + 256 * cq + 32 * w + l31;
          const f32x4 pq = *(const f32x4*)(PART + (((size_t)(h >> 1) * T + qrow) * 2 + (h & 1)) * 4);
          const float rq = 0.08838834764831845f * LOG2E / sqrtf(((pq[0] + pq[1]) + (pq[2] + pq[3])) * (1.0f / AHD) + EPS);
          const bf16_t* qp = QKV + qrow * 6144 + h * AHD + hh * 8;
#pragma unroll
          for (int ks = 0; ks < 8; ++ks) { const u32x4 a = *(const u32x4*)(qp + ks * 16);
              const f32x4 gq0 = *(const f32x4*)(q_gain + ks * 16 + hh * 8), gq1 = *(const f32x4*)(q_gain + ks * 16 + hh * 8 + 4), gk0 = *(const f32x4*)(k_gain + ks * 16 + hh * 8), gk1 = *(const f32x4*)(k_gain + ks * 16 + hh * 8 + 4);
              u32x4 wv; wv.x = cvt_pk_bf16_op(bflo(a.x) * rq * gq0[0] * gk0[0], bfhi(a.x) * rq * gq0[1] * gk0[1]); wv.y = cvt_pk_bf16_op(bflo(a.y) * rq * gq0[2] * gk0[2], bfhi(a.y) * rq * gq0[3] * gk0[3]);
              wv.z = cvt_pk_bf16_op(bflo(a.z) * rq * gq1[0] * gk1[0], bfhi(a.z) * rq * gq1[1] * gk1[1]); wv.w = cvt_pk_bf16_op(bflo(a.w) * rq * gq1[2] * gk1[2], bfhi(a.w) * rq * gq1[3] * gk1[3]);
              qf[ks] = __builtin_bit_cast(bf16x8, wv); } }
        __builtin_amdgcn_s_waitcnt(0);
#pragma unroll
        for (int ks = 0; ks < 8; ++ks) asm volatile("" : "+v"(qf[ks]));
        __syncthreads();
        float mrun = -1e30f, lsum = 0.f;
        f32x16 oacc[4];
#pragma unroll
        for (int dt = 0; dt < 4; ++dt)
#pragma unroll
            for (int r = 0; r < 16; ++r) oacc[dt][r] = 0.f;
        for (int j = jf; j < 12; ++j) {
            if (j <= 9) asm volatile("s_waitcnt vmcnt(8)\n\ts_barrier" ::: "memory");
            else if (j == 10) asm volatile("s_waitcnt vmcnt(4)\n\ts_barrier" ::: "memory");
            else asm volatile("s_waitcnt vmcnt(0)\n\ts_barrier" ::: "memory");
            if (j + 3 < 12) AT_DMA(j + 3);
            if (j >= wo && j <= wo + 8) {
                const LAS unsigned char* Kt = lds + (j & 3) * AT_SLOT; const LAS unsigned char* Vt = Kt + 16384;
                const int bp = j - wo;
                f32x16 st[2];
#pragma unroll
                for (int k2 = 0; k2 < 2; ++k2)
#pragma unroll
                    for (int r = 0; r < 16; ++r) st[k2][r] = 0.f;
                {
                    bf16x8 kfa[8], kfb[8];
#pragma unroll
                    for (int ks = 0; ks < 8; ++ks) { kfa[ks] = *(const LAS bf16x8*)(Kt + 256 * l31 + 16 * ((2 * ks + hh) ^ fr)); kfb[ks] = *(const LAS bf16x8*)(Kt + 256 * (32 + l31) + 16 * ((2 * ks + hh) ^ fr)); }
                    __builtin_amdgcn_sched_barrier(0);
#pragma unroll
                    for (int ks = 0; ks < 8; ++ks) { st[0] = __builtin_amdgcn_mfma_f32_32x32x16_bf16(kfa[ks], qf[ks], st[0], 0, 0, 0); st[1] = __builtin_amdgcn_mfma_f32_32x32x16_bf16(kfb[ks], qf[ks], st[1], 0, 0, 0); }
                }
                float mt = -1e30f;
                {
                    const LAS float* rkp = rkt + 64 * j + 4 * hh;
                    const LAS float* bp_ = bias + (575 + qi - 64 * bp - 4 * hh - 59);
#pragma unroll
                    for (int k2 = 0; k2 < 2; ++k2) {
                        f32x4 rkv[4]; float bv[16];
#pragma unroll
                        for (int g = 0; g < 4; ++g) rkv[g] = *(const LAS f32x4*)(rkp + 32 * k2 + 8 * g);
#pragma unroll
                        for (int r = 0; r < 16; ++r) bv[r] = bp_[59 - (32 * k2 + (r & 3) + 8 * (r >> 2))];
                        __builtin_amdgcn_sched_barrier(0);
                        if (k2 == 0) asm volatile("s_nop 15\n\ts_nop 15\n\ts_nop 15" ::: "memory");
#pragma unroll
                        for (int r = 0; r < 16; ++r) { st[k2][r] = st[k2][r] * rkv[r >> 2][r & 3] + bv[r]; mt = fmaxf(mt, st[k2][r]); }
                        __builtin_amdgcn_sched_barrier(0);
                    }
                }
                mt = fmaxf(mt, __shfl_xor(mt, 32));
                if (__builtin_amdgcn_ballot_w64(mt > mrun + 8.0f) != 0ull) {
                    const float mnew = (mt > mrun + 8.0f) ? mt : mrun, alpha = __builtin_amdgcn_exp2f(mrun - mnew);
                    mrun = mnew; lsum *= alpha;
#pragma unroll
                    for (int dt = 0; dt < 4; ++dt)
#pragma unroll
                        for (int r = 0; r < 16; ++r) oacc[dt][r] *= alpha;
                }
                float ps = 0.f;
#pragma unroll
                for (int k2 = 0; k2 < 2; ++k2)
#pragma unroll
                    for (int r = 0; r < 16; ++r) { st[k2][r] = __builtin_amdgcn_exp2f(st[k2][r] - mrun); ps += st[k2][r]; }
                lsum += ps;
                bf16x8 pf[4];
#pragma unroll
                for (int s = 0; s < 4; ++s) { const f32x16& sv = st[s >> 1]; const int o8 = 8 * (s & 1);
                    u32x4 wv; wv.x = cvt_pk_bf16_op(sv[o8 + 0], sv[o8 + 1]); wv.y = cvt_pk_bf16_op(sv[o8 + 2], sv[o8 + 3]); wv.z = cvt_pk_bf16_op(sv[o8 + 4], sv[o8 + 5]); wv.w = cvt_pk_bf16_op(sv[o8 + 6], sv[o8 + 7]);
                    pf[s] = __builtin_bit_cast(bf16x8, wv); }
                const int q4 = i16 >> 2, p4 = i16 & 3;
#pragma unroll
                for (int sp = 0; sp < 2; ++sp) {
                    s16x4 lo[2][4], hi[2][4];
#pragma unroll
                    for (int s2 = 0; s2 < 2; ++s2) { const int s = 2 * sp + s2, rlo = 16 * s + 4 * hh + q4, flo = (q4 << 2) | hh, fhi = (q4 << 2) | (hh + 2);
#pragma unroll
                        for (int dt = 0; dt < 4; ++dt) { const int chl = 4 * dt + 2 * g1 + (p4 >> 1);
                            lo[s2][dt] = __builtin_bit_cast(s16x4, __builtin_amdgcn_ds_read_tr16_b64_v4i16((LAS s16x4*)(Vt + 256 * rlo + 16 * (chl ^ flo) + 8 * (p4 & 1))));
                            hi[s2][dt] = __builtin_bit_cast(s16x4, __builtin_amdgcn_ds_read_tr16_b64_v4i16((LAS s16x4*)(Vt + 256 * (rlo + 8) + 16 * (chl ^ fhi) + 8 * (p4 & 1)))); } }
                    __builtin_amdgcn_sched_barrier(0);
#pragma unroll
                    for (int s2 = 0; s2 < 2; ++s2)
#pragma unroll
                        for (int dt = 0; dt < 4; ++dt) { const bf16x8 vf = (bf16x8){lo[s2][dt][0], lo[s2][dt][1], lo[s2][dt][2], lo[s2][dt][3], hi[s2][dt][0], hi[s2][dt][1], hi[s2][dt][2], hi[s2][dt][3]};
                            oacc[dt] = __builtin_amdgcn_mfma_f32_32x32x16_bf16(vf, pf[2 * sp + s2], oacc[dt], 0, 0, 0); }
                    __builtin_amdgcn_sched_barrier(0);
                }
            }
        }
#undef AT_DMA
        MFMA_SETTLE();
        lsum += __shfl_xor(lsum, 32);
        const float inv = 1.0f / lsum;
        bf16_t* op = O + ((size_t)b * SEQ + 256 * cq + 32 * w + l31) * D + h * AHD + 4 * hh;
#pragma unroll
        for (int dt = 0; dt < 4; ++dt)
#pragma unroll
            for (int g = 0; g < 4; ++g) { u32x2 wv; wv.x = cvt_pk_bf16(oacc[dt][4 * g] * inv, oacc[dt][4 * g + 1] * inv); wv.y = cvt_pk_bf16(oacc[dt][4 * g + 2] * inv, oacc[dt][4 * g + 3] * inv);
                *(u32x2*)(op + dt * 32 + g * 8) = wv; }
        asm volatile("s_waitcnt vmcnt(0) lgkmcnt(0)" ::: "memory");
        __syncthreads();
    }
}

constexpr int G2_QS = 0, G2_KS = 17408, G2_VS = 34816, G2_KK = G2_VS + 64 * 528, G2_QK = G2_KK + 64 * 65 * 4, G2_AT = G2_QK + 64 * 65 * 4, G2_GC = G2_AT + 2 * 64 * 64 * 4, G2_BETA = G2_GC + 512, G2_END = G2_BETA + 512;
constexpr int G2_TI = G2_END, G2_FBW = G2_TI + 8192, G2_END2 = G2_FBW + 512;
static_assert(G2_END2 <= MISC_OFF && (G2_AT % 16) == 0 && (G2_TI % 16) == 0, "G2 LDS");
#define G2_CL16(x) ((x) < 0 ? 0 : ((x) > 16 ? 16 : (x)))
#define G2_ORD(j) (4 * ((j) < 15 ? (j) : 15) + 3 * G2_CL16((j) - 15) + 2 * G2_CL16((j) - 31) + G2_CL16((j) - 47))
#define G2_SUBST_LOOP(SG_LO, SG_HI) \
_Pragma("unroll") \
            for (int sg = SG_LO; sg < SG_HI; ++sg) { \
                const int j = sg >> 2, cq = sg & 3, lo = ((j + 1) >> 2) + 4 * cq; \
                if (lo < 16) { \
                    const int ord = G2_ORD(j) + cq; \
                    const bool m1 = (lo + 4 < 16);  const int j1 = m1 ? j : j + 1,   l1 = m1 ? lo + 4 : ((j + 2) >> 2); \
                    const bool m2 = (l1 + 4 < 16);  const int j2 = m2 ? j1 : j1 + 1, l2 = m2 ? l1 + 4 : ((j1 + 2) >> 2); \
                    if (j2 < 63) { \
_Pragma("unroll") \
                        for (int g = 0; g < 4; ++g) if (l2 + g < 16) cb[(ord + 2) % 3][g] = *(const LAS f32x4*)(Ae + j2 * 64 + 4 * (l2 + g)); \
                    } \
                    __builtin_amdgcn_sched_barrier(0); \
                    const float xu = ru[j], xw = rw[j]; \
_Pragma("unroll") \
                    for (int g = 0; g < 4; ++g) if (lo + g < 16) { const f32x4 a = cb[ord % 3][g]; const int r_ = 4 * (lo + g); \
                        ru[r_ + 0] -= a[0] * xu; ru[r_ + 1] -= a[1] * xu; ru[r_ + 2] -= a[2] * xu; ru[r_ + 3] -= a[3] * xu; \
                        rw[r_ + 0] -= a[0] * xw; rw[r_ + 1] -= a[1] * xw; rw[r_ + 2] -= a[2] * xw; rw[r_ + 3] -= a[3] * xw; } \
                    __builtin_amdgcn_sched_barrier(0); \
                } \
            }

__device__ __forceinline__ void phase_gdn_local(const Ctx& c, bf16_t* C, bf16_t* W, bf16_t* ATT, const float* AB, float* GC, const bf16_t* HEAD3, const bf16_t* TAIL3, const float* cw, const float* a_log, const float* dt_bias) {
    LAS unsigned char* lds = c.lds;
    LAS float* KKs = (LAS float*)(lds + G2_KK); LAS float* QKs = (LAS float*)(lds + G2_QK); LAS float* At = (LAS float*)(lds + G2_AT);
    LAS float* gcs = (LAS float*)(lds + G2_GC); LAS float* betas = (LAS float*)(lds + G2_BETA);
    LAS float* TI = (LAS float*)(lds + G2_TI); LAS float* fbw = (LAS float*)(lds + G2_FBW);
    const int wave = c.wave;
    constexpr int NUNITS = (MH / CH) * GKH;
    u32x4 pQ[2], pK[2], pV[4]; float pcw[4]; unsigned short ph3[3], pt3[3]; float pav = 0.f, pbv = 0.f;
#define G2_PREFETCH(un_) do { int tp_ = c.tid; asm volatile("" : "+v"(tp_)); const int hk_ = (un_) & 15, cg_ = (un_) >> 4, r0_ = cg_ * CH; \
        _Pragma("unroll") for (int i = 0; i < 2; ++i) { const int idx = tp_ + i * 512, row = idx >> 4, ch = idx & 15; \
            pQ[i] = *(const u32x4*)(C + (size_t)(r0_ + row) * 8192 + hk_ * 128 + ch * 8); pK[i] = *(const u32x4*)(C + (size_t)(r0_ + row) * 8192 + 2048 + hk_ * 128 + ch * 8); } \
        _Pragma("unroll") for (int i = 0; i < 4; ++i) { const int idx = tp_ + i * 512, row = idx >> 5, ch = idx & 31; \
            pV[i] = *(const u32x4*)(C + (size_t)(r0_ + row) * 8192 + 4096 + hk_ * 256 + ch * 8); } \
        { const int chg = (tp_ < 128) ? hk_ * 128 + tp_ : (tp_ < 256) ? 2048 + hk_ * 128 + (tp_ - 128) : 4096 + hk_ * 256 + (tp_ - 256); \
          _Pragma("unroll") for (int q = 0; q < 4; ++q) pcw[q] = cw[q * 8192 + chg]; \
          _Pragma("unroll") for (int q = 0; q < 3; ++q) { ph3[q] = HEAD3[(size_t)(cg_ * 3 + q) * 8192 + chg]; pt3[q] = ((r0_ % SEQ) != 0) ? TAIL3[(size_t)(cg_ * 3 - 3 + q) * 8192 + chg] : (unsigned short)0; } } \
        if (tp_ < 128) { const int hv_ = 2 * hk_ + (tp_ >> 6), ln_ = tp_ & 63; pav = AB[(size_t)(r0_ + ln_) * 64 + hv_]; pbv = AB[(size_t)(r0_ + ln_) * 64 + 32 + hv_]; } } while (0)
    if (c.bid < NUNITS) G2_PREFETCH(c.bid);
    for (int u = c.bid; u < NUNITS; u += c.G) {
        int tid = c.tid; asm volatile("" : "+v"(tid));
        const int lane = tid & 63, l31 = lane & 31, hh = lane >> 5;
        const int hk = u & 15, cg = u >> 4, r0 = cg * CH;
#pragma unroll
        for (int i = 0; i < 2; ++i) { const int idx = tid + i * 512, row = idx >> 4, ch = idx & 15;
#pragma unroll
            for (int tile = 0; tile < 2; ++tile) { const u32x4 a = tile ? pK[i] : pQ[i];
                float x[8]; float ss = 0.f;
#pragma unroll
                for (int k = 0; k < 4; ++k) { x[2 * k] = bflo(a[k]); x[2 * k + 1] = bfhi(a[k]); }
#pragma unroll
                for (int k = 0; k < 8; ++k) ss += x[k] * x[k];
                ss = sum16(ss);
                const float rr = (tile ? 1.0f : 0.08838834764831845f) / sqrtf(ss + EPS);
                u32x4 w; w.x = cvt_pk_bf16(x[0] * rr, x[1] * rr); w.y = cvt_pk_bf16(x[2] * rr, x[3] * rr); w.z = cvt_pk_bf16(x[4] * rr, x[5] * rr); w.w = cvt_pk_bf16(x[6] * rr, x[7] * rr);
                if (row >= 3) { *(LAS u32x4*)(lds + (tile ? G2_KS : G2_QS) + row * 272 + ch * 16) = w;
                    if (tile == 0) *(u32x4*)(C + (size_t)(r0 + row) * 8192 + hk * 128 + ch * 8) = w; } } }
#pragma unroll
        for (int i = 0; i < 4; ++i) { const int idx = tid + i * 512, row = idx >> 5, ch = idx & 31;
            if (row >= 3) *(LAS u32x4*)(lds + G2_VS + row * 528 + ch * 16) = pV[i]; }
        {
            const float w0 = pcw[0], w1 = pcw[1], w2 = pcw[2], w3 = pcw[3];
            const float h0 = bf2f(ph3[0]), h1 = bf2f(ph3[1]), h2 = bf2f(ph3[2]), t0 = bf2f(pt3[0]), t1 = bf2f(pt3[1]), t2 = bf2f(pt3[2]);
            const float y0 = siluf(w0 * t0 + w1 * t1 + w2 * t2 + w3 * h0), y1 = siluf(w0 * t1 + w1 * t2 + w2 * h0 + w3 * h1), y2 = siluf(w0 * t2 + w1 * h0 + w2 * h1 + w3 * h2);
            LAS unsigned char* dst = (tid < 128) ? lds + G2_QS + tid * 2 : (tid < 256) ? lds + G2_KS + (tid - 128) * 2 : lds + G2_VS + (tid - 256) * 2;
            const int rs = (tid < 256) ? 272 : 528;
            *(LAS bf16_t*)(dst) = (bf16_t)f2bf(y0); *(LAS bf16_t*)(dst + rs) = (bf16_t)f2bf(y1); *(LAS bf16_t*)(dst + 2 * rs) = (bf16_t)f2bf(y2);
        }
        if (wave < 2) {
            const int hv = 2 * hk + wave;
            const float z = pav + dt_bias[hv];
            const float sp = z > 20.f ? z : log1pf(__expf(z));
            float g = -__expf(a_log[hv]) * sp;
            g = scan64(g);
            gcs[wave * 64 + lane] = g; betas[wave * 64 + lane] = 1.0f / (1.0f + __expf(-pbv));
            GC[(size_t)hv * MH + r0 + lane] = g;
        }
        __syncthreads();
        if (tid < 96) {
            const int tile = tid / 48, row = (tid % 48) >> 4, ch = tid & 15;
            LAS unsigned char* p = lds + (tile ? G2_KS : G2_QS) + row * 272 + ch * 16;
            const u32x4 a = *(const LAS u32x4*)p;
            float x[8]; float ss = 0.f;
#pragma unroll
            for (int k = 0; k < 4; ++k) { x[2 * k] = bflo(a[k]); x[2 * k + 1] = bfhi(a[k]); }
#pragma unroll
            for (int k = 0; k < 8; ++k) ss += x[k] * x[k];
            ss = sum16(ss);
            const float rr = (tile ? 1.0f : 0.08838834764831845f) / sqrtf(ss + EPS);
            u32x4 w; w.x = cvt_pk_bf16(x[0] * rr, x[1] * rr); w.y = cvt_pk_bf16(x[2] * rr, x[3] * rr); w.z = cvt_pk_bf16(x[4] * rr, x[5] * rr); w.w = cvt_pk_bf16(x[6] * rr, x[7] * rr);
            *(LAS u32x4*)p = w;
            if (tile == 0) *(u32x4*)(C + (size_t)(r0 + row) * 8192 + hk * 128 + ch * 8) = w;
        }
        __syncthreads();
        {
            const int mat = wave >> 2, ti = (wave >> 1) & 1, tj = wave & 1;
            LAS unsigned char* xa = lds + (mat ? G2_QS : G2_KS) + (32 * ti + l31) * 272 + hh * 16;
            LAS unsigned char* xb = lds + G2_KS + (32 * tj + l31) * 272 + hh * 16;
            f32x16 acc;
#pragma unroll
            for (int r = 0; r < 16; ++r) acc[r] = 0.f;
#pragma unroll
            for (int ks = 0; ks < 8; ++ks) acc = __builtin_amdgcn_mfma_f32_32x32x16_bf16(*(const LAS bf16x8*)(xa + ks * 32), *(const LAS bf16x8*)(xb + ks * 32), acc, 0, 0, 0);
            MFMA_SETTLE();
            const int j = 32 * tj + l31;
            if (mat == 0) {
                if (ti >= tj) {
#pragma unroll
                    for (int e = 0; e < 2; ++e) { const float gj = gcs[e * 64 + j];
#pragma unroll
                        for (int g = 0; g < 4; ++g) { const int i0 = 32 * ti + 8 * g + 4 * hh;
                            const f32x4 gi = *(const LAS f32x4*)(gcs + e * 64 + i0), bi = *(const LAS f32x4*)(betas + e * 64 + i0);
#pragma unroll
                            for (int q = 0; q < 4; ++q) { const int i = i0 + q;
                                At[e * 4096 + i * 64 + j] = (i > j) ? -bi[q] * acc[4 * g + q] * __expf(gi[q] - gj) : 0.f; } } }
                } else {
                    fbw[lane] = betas[lane] * __expf(gcs[lane]); fbw[64 + lane] = betas[64 + lane] * __expf(gcs[64 + lane]);
                }
            } else {
#pragma unroll
                for (int e = 0; e < 2; ++e) { const float gj = gcs[e * 64 + j];
                    bf16_t* ap = ATT + ((size_t)(cg * 32 + 2 * hk + e) * 64) * 64 + j;
#pragma unroll
                    for (int g = 0; g < 4; ++g) { const int i0 = 32 * ti + 8 * g + 4 * hh;
                        const f32x4 gi = *(const LAS f32x4*)(gcs + e * 64 + i0);
#pragma unroll
                        for (int q = 0; q < 4; ++q) { const int i = i0 + q;
                            const float v = (i >= j) ? acc[4 * g + q] * __expf(gi[q] - gj) : 0.f;
                            ap[(size_t)i * 64] = (bf16_t)f2bf(v); } } }
            }
        }
        __syncthreads();
        { const int un = (u + c.G < NUNITS) ? u + c.G : u; G2_PREFETCH(un); }
        if (wave < 2) {
            const int e = tid >> 6, b = (tid >> 4) & 3, cc = tid & 15;
            const LAS float* An = At + e * 4096 + (16 * b) * 64 + 16 * b;
            float x[16];
#pragma unroll
            for (int r = 0; r < 16; ++r) x[r] = (r == cc) ? 1.f : 0.f;
            f32x4 ca[4], cn[4];
            ca[0] = *(const LAS f32x4*)(An + 1 * 64);
#pragma unroll
            for (int r = 1; r < 16; ++r) {
                if (r + 1 < 16) {
#pragma unroll
                    for (int k4 = 0; k4 < (r + 4) / 4; ++k4) cn[k4] = *(const LAS f32x4*)(An + (r + 1) * 64 + 4 * k4);
                }
                __builtin_amdgcn_sched_barrier(0);
                float acc = x[r];
#pragma unroll
                for (int k4 = 0; k4 < (r + 3) / 4; ++k4)
#pragma unroll
                    for (int q = 0; q < 4; ++q) if (4 * k4 + q < r) acc += ca[k4][q] * x[4 * k4 + q];
                x[r] = acc;
                __builtin_amdgcn_sched_barrier(0);
#pragma unroll
                for (int k4 = 0; k4 < 4; ++k4) ca[k4] = cn[k4];
            }
#pragma unroll
            for (int r = 0; r < 16; ++r) TI[((e * 4 + b) * 16 + r) * 16 + cc] = x[r];
        } else if (wave >= 4) {
            const int t2 = tid - 256;
#pragma unroll
            for (int p = 0; p < 2; ++p) {
                const int t3 = t2 + 256 * p, dk = t3 >> 2, ib = (t3 & 3) * 16;
                unsigned wv[8];
#pragma unroll
                for (int q = 0; q < 8; ++q) { const unsigned lo = *(const LAS bf16_t*)(lds + G2_KS + (ib + 2 * q) * 272 + dk * 2), hi = *(const LAS bf16_t*)(lds + G2_KS + (ib + 2 * q + 1) * 272 + dk * 2); wv[q] = lo | (hi << 16); }
                bf16_t* kp = C + (size_t)(r0 + (dk >> 1)) * 8192 + 2048 + hk * 128 + (dk & 1) * 64 + ib;
                *(u32x4*)(kp) = (u32x4){wv[0], wv[1], wv[2], wv[3]}; *(u32x4*)(kp + 8) = (u32x4){wv[4], wv[5], wv[6], wv[7]};
            }
        }
        __syncthreads();
        {
            const int e = wave >> 2, fr = lane & 15, fq = lane >> 4, hv = 2 * hk + e, ct0 = (wave & 1) * 4;
            const bool isw = (wave & 2) != 0;
            f32x4 ti[4], an[6];
#pragma unroll
            for (int b = 0; b < 4; ++b) ti[b] = *(const LAS f32x4*)(TI + ((e * 4 + b) * 16 + fr) * 16 + 4 * fq);
            an[0] = *(const LAS f32x4*)(At + e * 4096 + (16 + fr) * 64 + 0 + 4 * fq);
            an[1] = *(const LAS f32x4*)(At + e * 4096 + (32 + fr) * 64 + 0 + 4 * fq);  an[2] = *(const LAS f32x4*)(At + e * 4096 + (32 + fr) * 64 + 16 + 4 * fq);
            an[3] = *(const LAS f32x4*)(At + e * 4096 + (48 + fr) * 64 + 0 + 4 * fq);  an[4] = *(const LAS f32x4*)(At + e * 4096 + (48 + fr) * 64 + 16 + 4 * fq);
            an[5] = *(const LAS f32x4*)(At + e * 4096 + (48 + fr) * 64 + 32 + 4 * fq);
            f32x4 R[4][4], X[4][4];
#pragma unroll
            for (int b = 0; b < 4; ++b) { const f32x4 fac = *(const LAS f32x4*)((isw ? fbw : betas) + e * 64 + 16 * b + 4 * fq);
#pragma unroll
                for (int t = 0; t < 4; ++t) { const int col = 16 * (ct0 + t) + fr;
#pragma unroll
                    for (int q = 0; q < 4; ++q) { const int i = 16 * b + 4 * fq + q;
                        const unsigned short raw = isw ? *(const LAS bf16_t*)(lds + G2_KS + i * 272 + col * 2) : *(const LAS bf16_t*)(lds + G2_VS + i * 528 + (e * 128 + col) * 2);
                        R[t][b][q] = fac[q] * bf2f(raw); } } }
#define G2_MM(dst, av, bv) do { _Pragma("unroll") for (int q = 0; q < 4; ++q) dst = __builtin_amdgcn_mfma_f32_16x16x4f32(av[q], bv[q], dst, 0, 0, 0); } while (0)
#pragma unroll
            for (int t = 0; t < 4; ++t) { X[t][0] = (f32x4){0.f, 0.f, 0.f, 0.f}; G2_MM(X[t][0], ti[0], R[t][0]); }
#pragma unroll
            for (int t = 0; t < 4; ++t) G2_MM(R[t][1], an[0], X[t][0]);
#pragma unroll
            for (int t = 0; t < 4; ++t) { X[t][1] = (f32x4){0.f, 0.f, 0.f, 0.f}; G2_MM(X[t][1], ti[1], R[t][1]); }
#pragma unroll
            for (int t = 0; t < 4; ++t) { G2_MM(R[t][2], an[1], X[t][0]); G2_MM(R[t][2], an[2], X[t][1]); }
#pragma unroll
            for (int t = 0; t < 4; ++t) { X[t][2] = (f32x4){0.f, 0.f, 0.f, 0.f}; G2_MM(X[t][2], ti[2], R[t][2]); }
#pragma unroll
            for (int t = 0; t < 4; ++t) { G2_MM(R[t][3], an[3], X[t][0]); G2_MM(R[t][3], an[4], X[t][1]); G2_MM(R[t][3], an[5], X[t][2]); }
#pragma unroll
            for (int t = 0; t < 4; ++t) { X[t][3] = (f32x4){0.f, 0.f, 0.f, 0.f}; G2_MM(X[t][3], ti[3], R[t][3]); }
#undef G2_MM
            MFMA_SETTLE();
            if (!isw) {
#pragma unroll
                for (int t = 0; t < 4; ++t) { const int dv = 16 * (ct0 + t) + fr;
                    bf16_t* up = C + (size_t)(r0 + (dv >> 1)) * 8192 + 4096 + hv * 128 + (dv & 1) * 64 + 4 * fq;
#pragma unroll
                    for (int b = 0; b < 4; ++b) { u32x2 w; w.x = cvt_pk_bf16(X[t][b][0], X[t][b][1]); w.y = cvt_pk_bf16(X[t][b][2], X[t][b][3]); *(u32x2*)(up + 16 * b) = w; } }
            } else {
#pragma unroll
                for (int t = 0; t < 4; ++t) { bf16_t* wp = W + (size_t)(r0 + 4 * fq) * 4096 + hv * 128 + 16 * (ct0 + t) + fr;
#pragma unroll
                    for (int b = 0; b < 4; ++b)
#pragma unroll
                        for (int q = 0; q < 4; ++q) wp[(size_t)(16 * b + q) * 4096] = (bf16_t)f2bf(X[t][b][q]); }
            }
        }
        __syncthreads();
    }
}

#undef G2_PREFETCH
constexpr int G3_W = 0, G3_Q = 17408, G3_KT = 34816, G3_A = G3_KT + 128 * 144, G3_UT = G3_A + 64 * 144, G3_GCB = G3_UT + 32 * 144, G3_BUF = G3_GCB + 512;
static_assert(2 * G3_BUF <= MISC_OFF, "G3 LDS");
__device__ __forceinline__ void g3_wperm(LAS unsigned char* rowp, int cidx, u32x4 v) {
    LAS unsigned char* p = rowp + (cidx >> 2) * 64 + (((cidx & 1) << 2) + ((cidx >> 1) & 1)) * 8;
    *(LAS u32x2*)p = (u32x2){v.x, v.y}; *(LAS u32x2*)(p + 16) = (u32x2){v.z, v.w};
}
__device__ __forceinline__ void g3_stage(LAS unsigned char* buf, const bf16_t* PROJ, const bf16_t* C, const bf16_t* ATT, const float* GC, int cgl, int hv, int dq, int t, int nt) {
    const size_t r0 = (size_t)cgl * CH; const int hk = hv >> 1;
    for (int i = t; i < 1024; i += nt) { const int row = i >> 4, ch = i & 15;
        g3_wperm(buf + G3_W + row * 272, ch, *(const u32x4*)(PROJ + (r0 + row) * 4096 + hv * 128 + ch * 8));
        g3_wperm(buf + G3_Q + row * 272, ch, *(const u32x4*)(C + (r0 + row) * 8192 + hk * 128 + ch * 8)); }
    for (int i = t; i < 1024; i += nt) { const int rr = i >> 4, ch = i & 15, dk = 2 * rr + (ch >> 3);
        g3_wperm(buf + G3_KT + dk * 144, ch & 7, *(const u32x4*)(C + (r0 + rr) * 8192 + 2048 + hk * 128 + ch * 8)); }
    for (int i = t; i < 512; i += nt) { const int row = i >> 3, ch = i & 7;
        g3_wperm(buf + G3_A + row * 144, ch, *(const u32x4*)(ATT + ((size_t)(cgl * 32 + hv) * 64 + row) * 64 + ch * 8)); }
    for (int i = t; i < 256; i += nt) { const int rr = i >> 4, ch = i & 15, dvl = 2 * rr + (ch >> 3);
        *(LAS u32x4*)(buf + G3_UT + dvl * 144 + (ch & 7) * 16) = *(const u32x4*)(C + (r0 + 16 * dq + rr) * 8192 + 4096 + hv * 128 + ch * 8); }
    if (t < 64) { const float gct = GC[(size_t)hv * MH + r0 + t], gl = GC[(size_t)hv * MH + r0 + 63];
        *(LAS float*)(buf + G3_GCB + t * 4) = __expf(gct); *(LAS float*)(buf + G3_GCB + 256 + t * 4) = __expf(gl - gct); }
}
__device__ __forceinline__ bf16x8 pack8(const f32x16& v, int s) {
    u32x4 w; w.x = cvt_pk_bf16_op(v[8 * s + 0], v[8 * s + 1]); w.y = cvt_pk_bf16_op(v[8 * s + 2], v[8 * s + 3]); w.z = cvt_pk_bf16_op(v[8 * s + 4], v[8 * s + 5]); w.w = cvt_pk_bf16_op(v[8 * s + 6], v[8 * s + 7]);
    return __builtin_bit_cast(bf16x8, w);
}
__device__ __forceinline__ bf16x8 ld2x8(const LAS unsigned char* p) {
    const u32x2 a = *(const LAS u32x2*)p, b = *(const LAS u32x2*)(p + 16);
    return __builtin_bit_cast(bf16x8, (u32x4){a.x, a.y, b.x, b.y});
}
__device__ __forceinline__ u32x4 gld16(const void* p) { u32x4 r; asm volatile("global_load_dwordx4 %0, %1, off" : "=v"(r) : "v"(p) : "memory"); return r; }
__device__ __forceinline__ float gld4(const void* p) { float r; asm volatile("global_load_dword %0, %1, off" : "=v"(r) : "v"(p) : "memory"); return r; }
#define G3_BAR() asm volatile("s_waitcnt lgkmcnt(0)\n\ts_barrier" ::: "memory")
__device__ __forceinline__ bf16x8 ldfrag(const LAS unsigned char* rowp, int s32, int fq) {
    return *(const LAS bf16x8*)(rowp + s32 * 64 + fq * 16);
}
__device__ __forceinline__ bf16x8 pack44(const f32x4& lo, const f32x4& hi) {
    u32x4 w; w.x = cvt_pk_bf16_op(lo[0], lo[1]); w.y = cvt_pk_bf16_op(lo[2], lo[3]); w.z = cvt_pk_bf16_op(hi[0], hi[1]); w.w = cvt_pk_bf16_op(hi[2], hi[3]);
    return __builtin_bit_cast(bf16x8, w);
}
__device__ __forceinline__ void phase_gdn_scan(const Ctx& c, const bf16_t* PROJ  , bf16_t* OUT, const bf16_t* C, const bf16_t* ATT, const float* GC) {
    LAS unsigned char* lds = c.lds;
    constexpr int NITEMS = 2 * GVH * 4;
    for (int wi = c.bid; wi < NITEMS; wi += c.G) {
        int tid = c.tid; asm volatile("" : "+v"(tid));
        const int xslot = wi >> 3, grp = (wi & 7) * 8 + (xslot >> 2), bl = grp >> 5, hv = grp & 31, dq = xslot & 3;
        g3_stage(lds, PROJ, C, ATT, GC, bl * NCH, hv, dq, tid, NTHREADS);
        __syncthreads();
        if (c.wave >= 2) {
            int t2 = c.tid; asm volatile("" : "+v"(t2));
            const int hk = hv >> 1;
#define G3_CLAMP(x) ((x) < NCH ? (x) : NCH - 1)
#define G3_LOOP2(LD_, WR_) do { LD_(sa, bl * NCH + 1); LD_(sb, bl * NCH + 2); \
                for (int ch = 0; ch < NCH; ch += 2) { \
                    asm volatile("s_sleep 3" ::: "memory"); WR_(sa, lds + G3_BUF); LD_(sa, bl * NCH + G3_CLAMP(ch + 3)); G3_BAR(); \
                    asm volatile("s_sleep 3" ::: "memory"); WR_(sb, lds); LD_(sb, bl * NCH + G3_CLAMP(ch + 4)); G3_BAR(); } \
                asm volatile("s_waitcnt vmcnt(0)" ::: "memory"); } while (0)
            if (c.wave <= 5) {
                const int l4 = t2 - 128, row0 = l4 >> 4, ch16 = l4 & 15;
                struct S3 { u32x4 W[4], Q[4], K[4]; }; S3 sa, sb;
#define G3_LD3(P, cgl_) do { const size_t r0_ = (size_t)(cgl_) * CH; _Pragma("unroll") for (int j = 0; j < 4; ++j) { const int row = row0 + 16 * j; \
                    P.W[j] = gld16(PROJ + (r0_ + row) * 4096 + hv * 128 + ch16 * 8); \
                    P.Q[j] = gld16(C + (r0_ + row) * 8192 + hk * 128 + ch16 * 8); \
                    P.K[j] = gld16(C + (r0_ + row) * 8192 + 2048 + hk * 128 + ch16 * 8); } } while (0)
#define G3_WR3(P, nb_) do { asm volatile("s_waitcnt vmcnt(12)" : "+v"(P.W[0]), "+v"(P.W[1]), "+v"(P.W[2]), "+v"(P.W[3]), "+v"(P.Q[0]), "+v"(P.Q[1]), "+v"(P.Q[2]), "+v"(P.Q[3]), \
                                                                  "+v"(P.K[0]), "+v"(P.K[1]), "+v"(P.K[2]), "+v"(P.K[3]) :: "memory"); \
                _Pragma("unroll") for (int j = 0; j < 4; ++j) { const int row = row0 + 16 * j; \
                    g3_wperm((nb_) + G3_W + row * 272, ch16, P.W[j]); \
                    g3_wperm((nb_) + G3_Q + row * 272, ch16, P.Q[j]); \
                    g3_wperm((nb_) + G3_KT + (2 * row + (ch16 >> 3)) * 144, ch16 & 7, P.K[j]); } } while (0)
                G3_LOOP2(G3_LD3, G3_WR3);
#undef G3_LD3
#undef G3_WR3
            } else if (c.wave == 6) {
                const int l2 = t2 - 384, row0 = l2 >> 3, ch8 = l2 & 7;
                struct S1 { u32x4 A[8]; }; S1 sa, sb;
#define G3_LD1(P, cgl_) do { _Pragma("unroll") for (int j = 0; j < 8; ++j) P.A[j] = gld16(ATT + ((size_t)((cgl_) * 32 + hv) * 64 + row0 + 8 * j) * 64 + ch8 * 8); } while (0)
#define G3_WR1(P, nb_) do { asm volatile("s_waitcnt vmcnt(8)" : "+v"(P.A[0]), "+v"(P.A[1]), "+v"(P.A[2]), "+v"(P.A[3]), "+v"(P.A[4]), "+v"(P.A[5]), "+v"(P.A[6]), "+v"(P.A[7]) :: "memory"); \
                _Pragma("unroll") for (int j = 0; j < 8; ++j) g3_wperm((nb_) + G3_A + (row0 + 8 * j) * 144, ch8, P.A[j]); } while (0)
                G3_LOOP2(G3_LD1, G3_WR1);
#undef G3_LD1
#undef G3_WR1
            } else {
                const int l1 = t2 - 448, rr0 = l1 >> 4, ch16 = l1 & 15;
                struct SU { u32x4 U[4]; float g0, g1; }; SU sa, sb;
#define G3_LDU(P, cgl_) do { const size_t r0_ = (size_t)(cgl_) * CH; _Pragma("unroll") for (int j = 0; j < 4; ++j) P.U[j] = gld16(C + (r0_ + 16 * dq + rr0 + 4 * j) * 8192 + 4096 + hv * 128 + ch16 * 8); \
                    P.g0 = gld4(GC + (size_t)hv * MH + r0_ + l1); P.g1 = gld4(GC + (size_t)hv * MH + r0_ + 63); } while (0)
#define G3_WRU(P, nb_) do { asm volatile("s_waitcnt vmcnt(6)" : "+v"(P.U[0]), "+v"(P.U[1]), "+v"(P.U[2]), "+v"(P.U[3]), "+v"(P.g0), "+v"(P.g1) :: "memory"); \
                _Pragma("unroll") for (int j = 0; j < 4; ++j) *(LAS u32x4*)((nb_) + G3_UT + (2 * (rr0 + 4 * j) + (ch16 >> 3)) * 144 + (ch16 & 7) * 16) = P.U[j]; \
                    *(LAS float*)((nb_) + G3_GCB + l1 * 4) = __expf(P.g0); *(LAS float*)((nb_) + G3_GCB + 256 + l1 * 4) = __expf(P.g1 - P.g0); } while (0)
                G3_LOOP2(G3_LDU, G3_WRU);
#undef G3_LDU
#undef G3_WRU
            }
#undef G3_LOOP2
#undef G3_CLAMP
        } else {
            const int p = c.wave;
            f32x4 Sacc[8];
#pragma unroll
            for (int T8 = 0; T8 < 8; ++T8) Sacc[T8] = (f32x4){0.f, 0.f, 0.f, 0.f};
            bf16x8 Sb[4];
#pragma unroll
            for (int s4 = 0; s4 < 4; ++s4) Sb[s4] = pack44(Sacc[2 * s4], Sacc[2 * s4 + 1]);
            for (int ch = 0; ch < NCH; ++ch) {
                int ln = c.tid & 63; asm volatile("" : "+v"(ln));
                const int fr = ln & 15, fq = ln >> 4;
                LAS unsigned char* buf = lds + (ch & 1) * G3_BUF;
                const LAS float* gcb = (const LAS float*)(buf + G3_GCB);
                bf16x8 fA[16], fB[16];
#pragma unroll
                for (int t = 0; t < 4; ++t)
#pragma unroll
                    for (int s4 = 0; s4 < 4; ++s4) { fA[t * 4 + s4] = ldfrag(buf + G3_W + (16 * t + fr) * 272, s4, fq); fB[t * 4 + s4] = ldfrag(buf + G3_Q + (16 * t + fr) * 272, s4, fq); }
                f32x4 vn[4], oa[4];
#pragma unroll
                for (int t = 0; t < 4; ++t) { vn[t] = (f32x4){0.f, 0.f, 0.f, 0.f}; oa[t] = vn[t]; }
                __builtin_amdgcn_sched_barrier(0);
#pragma unroll
                for (int s4 = 0; s4 < 4; ++s4)
#pragma unroll
                    for (int t = 0; t < 4; ++t) vn[t] = __builtin_amdgcn_mfma_f32_16x16x32_bf16(fA[t * 4 + s4], Sb[s4], vn[t], 0, 0, 0);
                __builtin_amdgcn_sched_barrier(0);
#pragma unroll
                for (int T8 = 0; T8 < 8; ++T8)
#pragma unroll
                    for (int s2 = 0; s2 < 2; ++s2) fA[T8 * 2 + s2] = ldfrag(buf + G3_KT + (16 * T8 + fr) * 144, s2, fq);
                u32x2 uur[4]; f32x4 e2r[4];
#pragma unroll
                for (int t = 0; t < 4; ++t) { uur[t] = *(const LAS u32x2*)(buf + G3_UT + (16 * p + fr) * 144 + (16 * t + 4 * fq) * 2); e2r[t] = *(const LAS f32x4*)(gcb + 64 + 16 * t + 4 * fq); }
                const float dec = gcb[63];
                __builtin_amdgcn_sched_barrier(0);
#pragma unroll
                for (int s4 = 0; s4 < 4; ++s4)
#pragma unroll
                    for (int t = 0; t < 4; ++t) oa[t] = __builtin_amdgcn_mfma_f32_16x16x32_bf16(fB[t * 4 + s4], Sb[s4], oa[t], 0, 0, 0);
                __builtin_amdgcn_sched_barrier(0);
                bf16x8 af[6]; f32x4 e1v[4];
                af[0] = ldfrag(buf + G3_A + (0 + fr) * 144, 0, fq); af[1] = ldfrag(buf + G3_A + (16 + fr) * 144, 0, fq);
                af[2] = ldfrag(buf + G3_A + (32 + fr) * 144, 0, fq); af[3] = ldfrag(buf + G3_A + (32 + fr) * 144, 1, fq);
                af[4] = ldfrag(buf + G3_A + (48 + fr) * 144, 0, fq); af[5] = ldfrag(buf + G3_A + (48 + fr) * 144, 1, fq);
#pragma unroll
                for (int t = 0; t < 4; ++t) e1v[t] = *(const LAS f32x4*)(gcb + 16 * t + 4 * fq);
                MFMA_SETTLE();
                f32x4 vw[4], vs[4];
#pragma unroll
                for (int t = 0; t < 4; ++t) { const float u4[4] = {bflo(uur[t].x), bfhi(uur[t].x), bflo(uur[t].y), bfhi(uur[t].y)};
#pragma unroll
                    for (int q = 0; q < 4; ++q) { const float v = u4[q] - vn[t][q]; vw[t][q] = v; vs[t][q] = v * e2r[t][q]; oa[t][q] *= e1v[t][q]; } }
                bf16x8 Vb[2], Vsb[2];
#pragma unroll
                for (int s2 = 0; s2 < 2; ++s2) { Vb[s2] = pack44(vw[2 * s2], vw[2 * s2 + 1]); Vsb[s2] = pack44(vs[2 * s2], vs[2 * s2 + 1]); }
#pragma unroll
                for (int T8 = 0; T8 < 8; ++T8)
#pragma unroll
                    for (int q = 0; q < 4; ++q) Sacc[T8][q] *= dec;
                __builtin_amdgcn_sched_barrier(0);
                oa[0] = __builtin_amdgcn_mfma_f32_16x16x32_bf16(af[0], Vb[0], oa[0], 0, 0, 0);
                oa[1] = __builtin_amdgcn_mfma_f32_16x16x32_bf16(af[1], Vb[0], oa[1], 0, 0, 0);
                oa[2] = __builtin_amdgcn_mfma_f32_16x16x32_bf16(af[2], Vb[0], oa[2], 0, 0, 0);
                oa[3] = __builtin_amdgcn_mfma_f32_16x16x32_bf16(af[4], Vb[0], oa[3], 0, 0, 0);
                oa[2] = __builtin_amdgcn_mfma_f32_16x16x32_bf16(af[3], Vb[1], oa[2], 0, 0, 0);
                oa[3] = __builtin_amdgcn_mfma_f32_16x16x32_bf16(af[5], Vb[1], oa[3], 0, 0, 0);
#pragma unroll
                for (int s2 = 0; s2 < 2; ++s2)
#pragma unroll
                    for (int T8 = 0; T8 < 8; ++T8) Sacc[T8] = __builtin_amdgcn_mfma_f32_16x16x32_bf16(fA[T8 * 2 + s2], Vsb[s2], Sacc[T8], 0, 0, 0);
                MFMA_SETTLE();
                { bf16_t* op = OUT + ((size_t)(bl * NCH + ch) * CH) * 4096 + hv * 128 + 32 * dq + 16 * p + fr;
#pragma unroll
                  for (int t = 0; t < 4; ++t)
#pragma unroll
                    for (int q = 0; q < 4; ++q) op[(size_t)(16 * t + 4 * fq + q) * 4096] = (bf16_t)(cvt_pk_bf16(oa[t][q], oa[t][q]) & 0xffffu); }
#pragma unroll
                for (int s4 = 0; s4 < 4; ++s4) Sb[s4] = pack44(Sacc[2 * s4], Sacc[2 * s4 + 1]);
                __builtin_amdgcn_sched_barrier(0);
                G3_BAR();
            }
        }
        __syncthreads();
    }
}
#undef G3_BAR

__device__ __forceinline__ void phase_gdn_onorm(const Ctx& c, bf16_t* OUT, const bf16_t* GATE, const float* o_gain) {
    const int gw = c.bid * NWAVES + c.wave, NGW = c.G * NWAVES, sub = c.lane >> 4, ch = c.lane & 15;
    float og[8];
    { const f32x4 a = *(const f32x4*)(o_gain + ch * 8), b = *(const f32x4*)(o_gain + ch * 8 + 4);
#pragma unroll
      for (int k = 0; k < 4; ++k) { og[k] = a[k]; og[4 + k] = b[k]; } }
    const int npairs = MH * GVH / 4;
    for (int it0 = gw; it0 < npairs; it0 += 4 * NGW) {
        u32x4 ovr[4], gvr[4];
#pragma unroll
        for (int q = 0; q < 4; ++q) { const int it = it0 + q * NGW;
            if (it < npairs) { const int pr = it * 4 + sub, row = pr >> 5, hv = pr & 31;
                ovr[q] = *(const u32x4*)(OUT + (size_t)row * 4096 + hv * 128 + ch * 8); gvr[q] = *(const u32x4*)(GATE + (size_t)row * 4096 + hv * 128 + ch * 8); } }
#pragma unroll
        for (int q = 0; q < 4; ++q) { const int it = it0 + q * NGW;
            if (it < npairs) { const int pr = it * 4 + sub, row = pr >> 5, hv = pr & 31;
                bf16_t* op = OUT + (size_t)row * 4096 + hv * 128 + ch * 8;
                const u32x4 ov = ovr[q], gv = gvr[q];
                float o[8], g[8]; float ss = 0.f;
#pragma unroll
                for (int k = 0; k < 4; ++k) { o[2 * k] = bflo(ov[k]); o[2 * k + 1] = bfhi(ov[k]); g[2 * k] = bflo(gv[k]); g[2 * k + 1] = bfhi(gv[k]); }
#pragma unroll
                for (int k = 0; k < 8; ++k) ss += o[k] * o[k];
                ss = sum16(ss);
                const float rs = 1.0f / sqrtf(ss * (1.0f / 128.f) + EPS);
                float y[8];
#pragma unroll
                for (int k = 0; k < 8; ++k) y[k] = o[k] * rs * og[k] * siluf(g[k]);
                u32x4 w; w.x = cvt_pk_bf16(y[0], y[1]); w.y = cvt_pk_bf16(y[2], y[3]); w.z = cvt_pk_bf16(y[4], y[5]); w.w = cvt_pk_bf16(y[6], y[7]);
                *(u32x4*)op = w; } }
    }
}

typedef const __attribute__((address_space(4))) Args* KArgsP;
__device__ __forceinline__ KArgsP kargs() { const unsigned long long p0 = (unsigned long long)__builtin_amdgcn_kernarg_segment_ptr(); unsigned lo32 = (unsigned)p0, hi32 = (unsigned)(p0 >> 32);
    asm volatile("" : "+v"(lo32), "+v"(hi32)); lo32 = __builtin_amdgcn_readfirstlane(lo32); hi32 = __builtin_amdgcn_readfirstlane(hi32); return (KArgsP)(((unsigned long long)hi32 << 32) | lo32); }
__device__ __forceinline__ Ctx mkctx(LAS unsigned char* lds, int wv0) { Ctx c; int tid = wv0 * 64 + lane_id(); asm volatile("" : "+v"(tid)); c.lds = lds; c.tid = tid; c.lane = tid & 63; c.wave = __builtin_amdgcn_readfirstlane(tid >> 6); c.G = gridDim.x; c.bid = blockIdx.x; return c; }
#ifndef PHASE_EN
#define PHASE_EN 0xFFFFFFFFu
#endif
#define EN(id) (((PHASE_EN) >> (id)) & 1u)
#ifndef DUP_MASK
#define DUP_MASK 0u
#endif
#define DUP(id) (((DUP_MASK) >> (id)) & 1u)
#ifndef STAMP_ID
#define STAMP_ID (-1)
#endif
#define ST0(id) do { if (STAMP_ID == (id)) st_t0 = __builtin_amdgcn_s_memrealtime(); } while (0)
#define ST1(id) do { if (STAMP_ID == (id)) st_acc += __builtin_amdgcn_s_memrealtime() - st_t0; } while (0)

__global__ void __launch_bounds__(NTHREADS, 2) fwd_kernel(Args args) {
    extern __shared__ __attribute__((aligned(16))) unsigned char lds_raw[];
    LAS unsigned char* const lds = (LAS unsigned char*)lds_raw;
    volatile LAS unsigned* MISC = (volatile LAS unsigned*)(lds + MISC_OFF);
    const int wv0 = __builtin_amdgcn_readfirstlane((int)threadIdx.x >> 6);
    if (wv0 == 0) MISC[lane_id()] = 0u;
    __syncthreads();
    XcdBarrier bar; bar.bar = nullptr; bar.x = 0; bar.st = nullptr; bar.wv = wv0;
    if (N_LAUNCH_MODE == 1) { KArgsP ap = kargs(); bar = xcd_barrier_post((unsigned*)(ap->ws + WS_CTL) + CW_BAR, MISC + 8, wv0); }
    const int lo = args.ph_lo, hi = args.ph_hi;
    int ph = 0;
    unsigned long long st_t0 = 0ull, st_acc = 0ull;
#define PH_IN (ph >= lo && ph < hi)
#define PH_END do { if (PH_IN && ph + 1 < hi) { if (N_LAUNCH_MODE == 1) xcd_barrier(bar); } ++ph; } while (0)

    ST0(0);
    if (EN(0) && PH_IN) { const Ctx c = mkctx(lds, wv0); phase_weights(c, kargs()); if (DUP(0)) { __syncthreads(); phase_weights(c, kargs()); } }
    PH_END;
    ST1(0);

    for (int layer = 0; layer < 4; ++layer) {
        const int kind = layer % 3, j = layer / 3;
        ST0(1);
        if (EN(1) && PH_IN) { const Ctx c = mkctx(lds, wv0); KArgsP ap = kargs(); unsigned char* ws = ap->ws;
            phase_rmsnorm(c, (layer == 0) ? ap->x : (const float*)ap->out, ap->mix_norm + layer * D, (bf16_t*)(ws + WS_H));
            if (DUP(1)) phase_rmsnorm(c, (layer == 0) ? ap->x : (const float*)ap->out, ap->mix_norm + layer * D, (bf16_t*)(ws + WS_H)); }
        PH_END;
        ST1(1);
        if (kind == 0) {
            ST0(2);
            if (EN(2) && PH_IN) { const Ctx c = mkctx(lds, wv0); KArgsP ap = kargs(); unsigned char* ws = ap->ws;
                pg8::Gemm g{(const bf16_t*)(ws + WS_H), (const bf16_t*)(ws + WS_WQKV) + (size_t)j * 6144 * D, T, 6144, D, D, D, 0}; pg8::StaticOrder S; S.init(T, 6144, c.G, c.bid);
                pg8::EpiQkv E{(bf16_t*)(ws + WS_QKV), 6144, (float*)(ws + WS_PART)}; pg8::gemm_phase(c.lds, c.tid, g, S, E); if (DUP(2)) pg8::gemm_phase(c.lds, c.tid, g, S, E); }
            PH_END;
            ST1(2);
            ST0(3);
            if (EN(3) && PH_IN) { const Ctx c = mkctx(lds, wv0); KArgsP ap = kargs(); unsigned char* ws = ap->ws;
                phase_attention3(c, (const bf16_t*)(ws + WS_QKV), (bf16_t*)(ws + WS_AO), (const float*)(ws + WS_PART), ap->att_q_gain + j * AHD, ap->att_k_gain + j * AHD, ap->att_rel_bias + (size_t)j * AH * NREL);
                if (DUP(3)) phase_attention3(c, (const bf16_t*)(ws + WS_QKV), (bf16_t*)(ws + WS_AO), (const float*)(ws + WS_PART), ap->att_q_gain + j * AHD, ap->att_k_gain + j * AHD, ap->att_rel_bias + (size_t)j * AH * NREL); }
            PH_END;
            ST1(3);
            ST0(4);
            if (EN(4) && PH_IN) { const Ctx c = mkctx(lds, wv0); KArgsP ap = kargs(); unsigned char* ws = ap->ws;
                pg8::Gemm g{(const bf16_t*)(ws + WS_AO), (const bf16_t*)(ws + WS_WO) + (size_t)j * D * D, T, D, D, D, D, 0}; pg8::StaticOrder S; S.init(T, D, c.G, c.bid);
                pg8::EpiRes E{(layer == 0) ? ap->x : (const float*)ap->out, ap->out, D, nullptr}; pg8::gemm_phase(c.lds, c.tid, g, S, E);
                if (DUP(4)) { pg8::EpiBf16 E2{(bf16_t*)(ws + WS_H), D}; pg8::gemm_phase(c.lds, c.tid, g, S, E2); } }
            PH_END;
            ST1(4);
        } else if (kind == 1) {
            ST0(5);
            if (EN(5) && PH_IN) { const Ctx c = mkctx(lds, wv0); KArgsP ap = kargs(); unsigned char* ws = ap->ws;
                phase_pool_prep(c, (const bf16_t*)(ws + WS_H), (bf16_t*)(ws + WS_POOLED)); if (DUP(5)) phase_pool_prep(c, (const bf16_t*)(ws + WS_H), (bf16_t*)(ws + WS_POOLED)); }
            PH_END;
            ST1(5);
            ST0(6);
            if (EN(6) && PH_IN) { const Ctx c = mkctx(lds, wv0); KArgsP ap = kargs(); unsigned char* ws = ap->ws;
                pg8::Gemm g{(const bf16_t*)(ws + WS_POOLED), (const bf16_t*)(ws + WS_WPOOL), T, D, 512, D, 512, 2}; pg8::StaticOrder S; S.init(T, D, c.G, c.bid);
                pg8::EpiRes E{ap->out, ap->out, D, ap->pool_scale + j * D}; pg8::gemm_phase(c.lds, c.tid, g, S, E); }
            PH_END;
            ST1(6);
        } else {
            for (int half = 0; half < 2; ++half) {
                ST0(7);
                if (EN(7) && PH_IN) { const Ctx c = mkctx(lds, wv0); KArgsP ap = kargs(); unsigned char* ws = ap->ws;
                    pg8::Gemm g{(const bf16_t*)(ws + WS_H) + (size_t)half * MH * D, (const bf16_t*)(ws + WS_WGIN), MH, GINP, D, D, D, 0}; pg8::StaticOrder S; S.init(MH, GINP, c.G, c.bid);
                    pg8::EpiGdn E{(bf16_t*)(ws + WS_C), (bf16_t*)(ws + WS_GATE), (float*)(ws + WS_AB), ap->gdn_conv, (bf16_t*)(ws + WS_HEAD3), (bf16_t*)(ws + WS_TAIL3)};
                    pg8::gemm_phase(c.lds, c.tid, g, S, E); if (DUP(7)) pg8::gemm_phase(c.lds, c.tid, g, S, E); }
                PH_END;
                ST1(7);
                ST0(9);
                if (EN(9) && PH_IN) { const Ctx c = mkctx(lds, wv0); KArgsP ap = kargs(); unsigned char* ws = ap->ws;
                    phase_gdn_local(c, (bf16_t*)(ws + WS_C), (bf16_t*)(ws + WS_W), (bf16_t*)(ws + WS_ATT), (const float*)(ws + WS_AB), (float*)(ws + WS_GC), (const bf16_t*)(ws + WS_HEAD3), (const bf16_t*)(ws + WS_TAIL3),
                                    ap->gdn_conv, ap->gdn_a_log, ap->gdn_dt_bias); }
                PH_END;
                ST1(9);
                ST0(10);
                if (EN(10) && PH_IN) { const Ctx c = mkctx(lds, wv0); KArgsP ap = kargs(); unsigned char* ws = ap->ws;
                    phase_gdn_scan(c, (const bf16_t*)(ws + WS_W), (bf16_t*)(ws + WS_O), (const bf16_t*)(ws + WS_C), (const bf16_t*)(ws + WS_ATT), (const float*)(ws + WS_GC));
                    if (DUP(10)) phase_gdn_scan(c, (const bf16_t*)(ws + WS_W), (bf16_t*)(ws + WS_O), (const bf16_t*)(ws + WS_C), (const bf16_t*)(ws + WS_ATT), (const float*)(ws + WS_GC)); }
                PH_END;
                ST1(10);
                ST0(11);
                if (EN(11) && PH_IN) { const Ctx c = mkctx(lds, wv0); KArgsP ap = kargs(); unsigned char* ws = ap->ws;
                    phase_gdn_onorm(c, (bf16_t*)(ws + WS_O), (const bf16_t*)(ws + WS_GATE), ap->gdn_o_gain); }
                PH_END;
                ST1(11);
                ST0(12);
                if (EN(12) && PH_IN) { const Ctx c = mkctx(lds, wv0); KArgsP ap = kargs(); unsigned char* ws = ap->ws;
                    pg8::Gemm g{(const bf16_t*)(ws + WS_O), (const bf16_t*)(ws + WS_WGO), MH, D, 4096, 4096, 4096, 0}; pg8::StaticOrder S; S.init(MH, D, c.G, c.bid);
                    pg8::EpiRes E{(const float*)ap->out + (size_t)half * MH * D, ap->out + (size_t)half * MH * D, D, nullptr}; pg8::gemm_phase(c.lds, c.tid, g, S, E); }
                PH_END;
                ST1(12);
            }
        }
        ST0(13);
        if (EN(13) && PH_IN) { const Ctx c = mkctx(lds, wv0); KArgsP ap = kargs(); unsigned char* ws = ap->ws;
            phase_rmsnorm(c, ap->out, ap->ffn_norm + layer * D, (bf16_t*)(ws + WS_H)); if (DUP(13)) phase_rmsnorm(c, ap->out, ap->ffn_norm + layer * D, (bf16_t*)(ws + WS_H)); }
        PH_END;
        ST1(13);
        ST0(14);
        if (EN(14) && PH_IN) { const Ctx c = mkctx(lds, wv0); KArgsP ap = kargs(); unsigned char* ws = ap->ws;
            pg8::Gemm g{(const bf16_t*)(ws + WS_H), (const bf16_t*)(ws + WS_WUP) + (size_t)layer * FF2 * D, T, FF2, D, D, D, 0}; pg8::StaticOrder S; S.init(T, FF2, c.G, c.bid);
            pg8::EpiFfn E{(bf16_t*)(ws + WS_ACT), ap->ffn_conv + (size_t)layer * 3 * FF, (bf16_t*)(ws + WS_TAILU), (bf16_t*)(ws + WS_HEADU), (bf16_t*)(ws + WS_HEADG)};
            pg8::gemm_phase(c.lds, c.tid, g, S, E); if (DUP(14)) pg8::gemm_phase(c.lds, c.tid, g, S, E); }
        PH_END;
        ST1(14);
        ST0(15);
        if (EN(15) && PH_IN) { const Ctx c = mkctx(lds, wv0); KArgsP ap = kargs(); unsigned char* ws = ap->ws;
            phase_ffn_fix(c, (bf16_t*)(ws + WS_ACT), ap->ffn_conv + (size_t)layer * 3 * FF, (const bf16_t*)(ws + WS_TAILU), (const bf16_t*)(ws + WS_HEADU), (const bf16_t*)(ws + WS_HEADG)); }
        PH_END;
        ST1(15);
        ST0(16);
        if (EN(16) && PH_IN) { const Ctx c = mkctx(lds, wv0); KArgsP ap = kargs(); unsigned char* ws = ap->ws;
            pg8::Gemm g{(const bf16_t*)(ws + WS_ACT), (const bf16_t*)(ws + WS_WDN) + (size_t)layer * D * FF, T, D, FF, FF, FF, 0}; pg8::StaticOrder S; S.init(T, D, c.G, c.bid);
            pg8::EpiRes E{ap->out, ap->out, D, nullptr}; pg8::gemm_phase(c.lds, c.tid, g, S, E);
            if (DUP(16)) { pg8::EpiBf16 E2{(bf16_t*)(ws + WS_H), D}; pg8::gemm_phase(c.lds, c.tid, g, S, E2); } }
        PH_END;
        ST1(16);
    }
#undef PH_IN
#undef PH_END
    if (STAMP_ID >= 0 && blockIdx.x == 0 && wv0 == 0 && lane_id() == 0) kargs()->out[0] = (float)st_acc * 0.01f;
}

constexpr int N_PHASES = 1 + 8 + 7 + 15 + 8;

extern "C" void kernel_launch(void* const* d_in, const int* in_sizes, int n_in, void* d_out, int out_size, void* d_ws, size_t ws_size, hipStream_t stream) {
    static int grid = 0;
    if (grid == 0) {
        if (n_in != 19 || out_size != T * D || ws_size < WS_NEED) { fprintf(stderr, "kernel_launch: unexpected problem (n_in %d, out %d, ws %zu, need %zu)\n", n_in, out_size, ws_size, (size_t)WS_NEED); grid = -1; return; }
        int dev = 0, cus = 0, per_cu = 0;
        if (hipGetDevice(&dev) != hipSuccess || hipDeviceGetAttribute(&cus, hipDeviceAttributeMultiprocessorCount, dev) != hipSuccess) { grid = -1; return; }
        if (hipFuncSetAttribute((const void*)fwd_kernel, hipFuncAttributeMaxDynamicSharedMemorySize, LDS_BYTES) != hipSuccess) { fprintf(stderr, "kernel_launch: hipFuncSetAttribute failed\n"); grid = -1; return; }
        if (hipOccupancyMaxActiveBlocksPerMultiprocessor(&per_cu, (const void*)fwd_kernel, NTHREADS, LDS_BYTES) != hipSuccess || per_cu < 1) fprintf(stderr, "kernel_launch: occupancy query says %d\n", per_cu);
        (void)hipGetLastError();
        grid = cus;
    }
    if (grid < 0) return;
    unsigned char* ws = (unsigned char*)d_ws;
    (void)hipMemsetAsync(ws + WS_CTL, 0, CTL_ZERO_BYTES, stream);
    Args a{};
    a.x = (const float*)d_in[0]; a.mix_norm = (const float*)d_in[1]; a.ffn_norm = (const float*)d_in[2];
    a.att_q_gain = (const float*)d_in[4]; a.att_k_gain = (const float*)d_in[5]; a.att_rel_bias = (const float*)d_in[6];
    a.pool_scale = (const float*)d_in[9]; a.gdn_conv = (const float*)d_in[11]; a.gdn_a_log = (const float*)d_in[12]; a.gdn_dt_bias = (const float*)d_in[13];
    a.gdn_o_gain = (const float*)d_in[14]; a.ffn_conv = (const float*)d_in[17];
    a.out = (float*)d_out; a.ws = ws;
    a.wd[0] = WDesc{(const float*)d_in[3],  (bf16_t*)(ws + WS_WQKV), D, 6144, 2, 0};
    a.wd[1] = WDesc{(const float*)d_in[7],  (bf16_t*)(ws + WS_WO),   D, D, 2, 0};
    a.wd[2] = WDesc{(const float*)d_in[8],  (bf16_t*)(ws + WS_WPOOL), 512, 512, 4, 0};
    a.wd[3] = WDesc{(const float*)d_in[10], (bf16_t*)(ws + WS_WGIN), D, GIN, 1, 0};
    a.wd[4] = WDesc{(const float*)d_in[15], (bf16_t*)(ws + WS_WGO),  4096, D, 1, 0};
    a.wd[5] = WDesc{(const float*)d_in[16], (bf16_t*)(ws + WS_WUP),  D, FF2, 4, 1};
    a.wd[6] = WDesc{(const float*)d_in[18], (bf16_t*)(ws + WS_WDN),  FF, D, 4, 0};
    if (N_LAUNCH_MODE == 1) {
        a.ph_lo = 0; a.ph_hi = N_PHASES;
        hipLaunchKernelGGL(fwd_kernel, dim3(grid), dim3(NTHREADS), LDS_BYTES, stream, a);
    } else {
        for (int p = 0; p < N_PHASES; ++p) { a.ph_lo = p; a.ph_hi = p + 1; hipLaunchKernelGGL(fwd_kernel, dim3(grid), dim3(NTHREADS), LDS_BYTES, stream, a); }
    }
}
```
